# Optimizing an MI355X kernel written in HIP

```python
import math
import jax
import jax.numpy as jnp
from jax import lax
import numpy as np

D_MODEL = 2048
BATCH = 4
SEQ = 4096
DEPTH = 2

GRID_W = 64
CTX_LEN = 256

D_MIX = D_MODEL
N_MIXERS = 4
MIXER_W = D_MIX // N_MIXERS
HEAD_DIM = 64

POOL_WINDOWS = (2, 4, 8, 16)
POOL_GROUP = MIXER_W // len(POOL_WINDOWS)

N_HEADS = MIXER_W // HEAD_DIM
N_KV_HEADS = 2
KV_GROUP = N_HEADS // N_KV_HEADS
KV_W = N_KV_HEADS * HEAD_DIM
WINDOW = 128
ATTN_BLOCK = 128
ROPE_THETA = 10000.0

HYENA_ORDER = 2
HYENA_EMB = 33
HYENA_HIDDEN = 64
SHORT_CONV = 3
HYENA_TARGET = 1e-2
HYENA_FAST = 0.3
HYENA_SLOW = 1.5

GMLP_CHUNK = 128
GMLP_GROUPS = MIXER_W // HEAD_DIM
GMLP_GROUP_DIM = MIXER_W // GMLP_GROUPS

N_EXPERTS = 32
N_EXPERT_GROUPS = 8
TOP_K = 2
D_EXPERT = 768
MOE_BLOCK = 256

LN_EPS = 1e-6

IN_SPLITS = (MIXER_W, MIXER_W, KV_W, KV_W, (HYENA_ORDER + 1) * MIXER_W, 2 * MIXER_W)
IN_W = sum(IN_SPLITS)

kernel_name = 'hybrid_pool_swa_hyena_gmlp_moe_dit'


def _layer_norm(x):
    xf = x.astype(jnp.float32)
    mu = jnp.mean(xf, -1, keepdims=True)
    var = jnp.mean(jnp.square(xf - mu), -1, keepdims=True)
    return ((xf - mu) * lax.rsqrt(var + LN_EPS)).astype(x.dtype)


def _modulate(x, shift, scale):
    return _layer_norm(x) * (1 + scale) + shift


def _post_norm(x, y, alpha, g, b):
    return _layer_norm(alpha * x + y) * g + b


def _group_rms(y, g):
    yf = y.astype(jnp.float32).reshape(y.shape[:-1] + (N_MIXERS, MIXER_W))
    yf = yf * lax.rsqrt(jnp.mean(jnp.square(yf), -1, keepdims=True) + LN_EPS)
    return yf.reshape(y.shape).astype(y.dtype) * g


def _split_proj(z):
    cuts, acc = [], 0
    for w in IN_SPLITS[:-1]:
        acc += w
        cuts.append(acc)
    return jnp.split(z, cuts, axis=-1)


def _pool_mixer(p, w_pool, pool_scale):
    B, L, C = p.shape
    pf = p.astype(jnp.float32)
    cs = jnp.concatenate([jnp.zeros((B, 1, C), jnp.float32), jnp.cumsum(pf, axis=1)], axis=1)
    t = jnp.arange(L)
    outs = []
    for gi, w in enumerate(POOL_WINDOWS):
        sl = slice(gi * POOL_GROUP, (gi + 1) * POOL_GROUP)
        lo = jnp.clip(t - w // 2, 0, L)
        hi = jnp.clip(t + w // 2, 0, L)
        cg = cs[:, :, sl]
        mean = (cg[:, hi] - cg[:, lo]) / (hi - lo).astype(jnp.float32)[None, :, None]
        outs.append((mean - pf[:, :, sl]).astype(p.dtype) @ w_pool[gi])
    return jnp.concatenate(outs, -1) * pool_scale


def _axial_rope(x, row_idx, col_idx):
    half = HEAD_DIM // 2
    nf = half // 2
    inv = ROPE_THETA ** (-jnp.arange(nf, dtype=jnp.float32) / nf)
    xf = x.astype(jnp.float32)

    def rot(xa, pos):
        ang = pos.astype(jnp.float32)[:, None] * inv[None, :]
        cos = jnp.cos(ang)[None, :, None, :]
        sin = jnp.sin(ang)[None, :, None, :]
        a, b = xa[..., :nf], xa[..., nf:]
        return jnp.concatenate([a * cos - b * sin, b * cos + a * sin], -1)

    out = jnp.concatenate([rot(xf[..., :half], row_idx), rot(xf[..., half:], col_idx)], -1)
    return out.astype(x.dtype)


def _attn_latent(q, k, v, kc, vc, sink):
    B, L = q.shape[:2]
    nb = L // ATTN_BLOCK
    scale = HEAD_DIM ** -0.5
    qb = q.reshape(B, nb, ATTN_BLOCK, N_KV_HEADS, KV_GROUP, HEAD_DIM)

    def band(t):
        tp = jnp.pad(t, ((0, 0), (ATTN_BLOCK, ATTN_BLOCK), (0, 0), (0, 0)))
        tp = tp.reshape(B, nb + 2, ATTN_BLOCK, N_KV_HEADS, HEAD_DIM)
        return jnp.concatenate([tp[:, :-2], tp[:, 1:-1], tp[:, 2:]], axis=2)

    kb, vb = band(k), band(v)
    s_band = jnp.einsum('bnqkgd,bnskd->bnkgqs', qb, kb, preferred_element_type=jnp.float32) * scale
    s_ctx = jnp.einsum('bnqkgd,bckd->bnkgqc', qb, kc, preferred_element_type=jnp.float32) * scale
    qpos = jnp.arange(nb)[:, None] * ATTN_BLOCK + jnp.arange(ATTN_BLOCK)[None, :]
    kpos = (jnp.arange(nb)[:, None] - 1) * ATTN_BLOCK + jnp.arange(3 * ATTN_BLOCK)[None, :]
    valid = ((jnp.abs(qpos[:, :, None] - kpos[:, None, :]) <= WINDOW)
             & (kpos >= 0)[:, None, :] & (kpos < L)[:, None, :])
    s_band = jnp.where(valid[None, :, None, None], s_band, -jnp.inf)
    sink_b = jnp.broadcast_to(
        sink.astype(jnp.float32).reshape(N_KV_HEADS, KV_GROUP)[None, None, :, :, None, None],
        s_band.shape[:-1] + (1,))
    p = jax.nn.softmax(jnp.concatenate([sink_b, s_band, s_ctx], -1), axis=-1)
    nk = 3 * ATTN_BLOCK
    p_band = p[..., 1:1 + nk].astype(v.dtype)
    p_ctx = p[..., 1 + nk:].astype(v.dtype)
    out = (jnp.einsum('bnkgqs,bnskd->bnqkgd', p_band, vb)
           + jnp.einsum('bnkgqc,bckd->bnqkgd', p_ctx, vc))
    return out.reshape(B, L, N_HEADS * HEAD_DIM)


def _attn_context(qc, kc, vc, sink):
    B, C = qc.shape[:2]
    qg = qc.reshape(B, C, N_KV_HEADS, KV_GROUP, HEAD_DIM)
    s = jnp.einsum('bqkgd,bckd->bkgqc', qg, kc, preferred_element_type=jnp.float32) * HEAD_DIM ** -0.5
    sink_b = jnp.broadcast_to(
        sink.astype(jnp.float32).reshape(N_KV_HEADS, KV_GROUP)[None, :, :, None, None], s.shape[:-1] + (1,))
    p = jax.nn.softmax(jnp.concatenate([sink_b, s], -1), axis=-1)[..., 1:].astype(vc.dtype)
    return jnp.einsum('bkgqc,bckd->bqkgd', p, vc).reshape(B, C, N_HEADS * HEAD_DIM)


def _short_conv(z, w, b):
    L = z.shape[1]
    p = SHORT_CONV // 2
    zp = jnp.pad(z, ((0, 0), (p, p), (0, 0)))
    out = b
    for i in range(SHORT_CONV):
        out = out + zp[:, i:i + L] * w[i]
    return out


def _hyena_filters(L, w1, b1, f1, w2, b2, f2, w3):
    f32 = jnp.float32
    t = jnp.linspace(0.0, 1.0, L, dtype=f32)[:, None]
    bands = (HYENA_EMB - 1) // 2
    freqs = jnp.linspace(1e-4, bands - 1, bands, dtype=f32)[None, :]
    ang = (2.0 * math.pi / L) * jnp.arange(L, dtype=f32)[:, None] * freqs
    feat = jnp.concatenate([t, jnp.cos(ang), -jnp.sin(ang)], -1)
    hdn = jnp.sin(f1.astype(f32) * (feat @ w1.astype(f32) + b1.astype(f32)))
    hdn = jnp.sin(f2.astype(f32) * (hdn @ w2.astype(f32) + b2.astype(f32)))
    filt = hdn @ w3.astype(f32)
    deltas = jnp.abs(jnp.linspace(math.log(HYENA_TARGET) / HYENA_SLOW,
                                  math.log(HYENA_TARGET) / HYENA_FAST, MIXER_W, dtype=f32))
    decay = jnp.exp(-t * deltas[None, :])
    return filt.reshape(L, HYENA_ORDER, 2, MIXER_W) * decay[:, None, None, :]


def _two_sided_fftconv(u, hf, hb, skip):
    B, L, C = u.shape
    k2 = jnp.concatenate([hf, jnp.zeros((1, C), hf.dtype), hb[1:][::-1]], axis=0)
    uf = jnp.fft.rfft(u.astype(jnp.float32), n=2 * L, axis=1)
    kf = jnp.fft.rfft(k2, n=2 * L, axis=0)
    y = jnp.fft.irfft(uf * kf[None], n=2 * L, axis=1)[:, :L]
    return (y + u.astype(jnp.float32) * skip.astype(jnp.float32)).astype(u.dtype)


def _hyena_mixer(z, lp):
    L = z.shape[1]
    z = _short_conv(z, lp['hy_conv_w'], lp['hy_conv_b'])
    parts = jnp.split(z, HYENA_ORDER + 1, axis=-1)
    gates, y = parts[:-1], parts[-1]
    filt = _hyena_filters(L, lp['hy_w1'], lp['hy_b1'], lp['hy_f1'], lp['hy_w2'], lp['hy_b2'],
                          lp['hy_f2'], lp['hy_w3'])
    for o in range(HYENA_ORDER):
        y = gates[o] * _two_sided_fftconv(y, filt[:, o, 0], filt[:, o, 1], lp['hy_skip'][o])
    return y


def _gmlp_mixer(z, ln_g, ln_b, w_s, b_s):
    B, L = z.shape[:2]
    z = jax.nn.gelu(z)
    u, v = jnp.split(z, 2, axis=-1)
    v = _layer_norm(v) * ln_g + ln_b
    nc = L // GMLP_CHUNK
    vc = v.reshape(B, nc, GMLP_CHUNK, GMLP_GROUPS, GMLP_GROUP_DIM)
    s = jnp.einsum('gpq,bnqgc->bnpgc', w_s, vc) + b_s.T[None, None, :, :, None]
    return u * s.reshape(B, L, MIXER_W)


def _token_mixer(h_lat, h_ctx, row_idx, col_idx, lp, need_ctx):
    B, L = h_lat.shape[:2]
    C = h_ctx.shape[1]
    zp_l, q_l, k_l, v_l, zh_l, zg_l = _split_proj(h_lat @ lp['w_in'])
    zp_c, q_c, k_c, v_c, zh_c, zg_c = _split_proj(h_ctx @ lp['w_in'])
    q_l = _axial_rope(q_l.reshape(B, L, N_HEADS, HEAD_DIM), row_idx, col_idx)
    k_l = _axial_rope(k_l.reshape(B, L, N_KV_HEADS, HEAD_DIM), row_idx, col_idx)
    v_l = v_l.reshape(B, L, N_KV_HEADS, HEAD_DIM)
    k_c = k_c.reshape(B, C, N_KV_HEADS, HEAD_DIM)
    v_c = v_c.reshape(B, C, N_KV_HEADS, HEAD_DIM)

    def merge(parts):
        return _group_rms(jnp.concatenate(parts, -1), lp['mix_norm_g']) @ lp['w_out']

    y_lat = merge([
        _pool_mixer(zp_l, lp['pool_w'], lp['pool_scale']),
        _attn_latent(q_l, k_l, v_l, k_c, v_c, lp['attn_sink']),
        _hyena_mixer(zh_l, lp),
        _gmlp_mixer(zg_l, lp['gm_ln_g'], lp['gm_ln_b'], lp['gm_ws'], lp['gm_bs']),
    ])
    y_ctx = None
    if need_ctx:
        y_ctx = merge([
            _pool_mixer(zp_c, lp['pool_w'], lp['pool_scale']),
            _attn_context(q_c.reshape(B, C, N_HEADS, HEAD_DIM), k_c, v_c, lp['attn_sink']),
            _hyena_mixer(zh_c, lp),
            _gmlp_mixer(zg_c, lp['gm_ln_g'], lp['gm_ln_b'], lp['gm_ws'], lp['gm_bs']),
        ])
    return y_lat, y_ctx


def _route(h, w_router, router_bias):
    T = h.shape[0]
    per = N_EXPERTS // N_EXPERT_GROUPS
    s = jax.nn.sigmoid(jnp.dot(h, w_router, preferred_element_type=jnp.float32))
    sel = s + router_bias.astype(jnp.float32)
    grp = lax.top_k(sel.reshape(T, N_EXPERT_GROUPS, per), 2)[0].sum(-1)
    best = jnp.argmax(grp, -1)
    in_grp = (jnp.arange(N_EXPERTS) // per)[None, :] == best[:, None]
    _, idx = lax.top_k(jnp.where(in_grp, sel, -jnp.inf), TOP_K)
    w = jnp.take_along_axis(s, idx, -1)
    return idx, w / jnp.sum(w, -1, keepdims=True)


def _moe(h, w_router, router_bias, w_gate, w_up, w_down):
    T, D = h.shape
    idx, gate = _route(h, w_router, router_bias)
    A = T * TOP_K
    flat_e = idx.reshape(A)
    flat_tok = jnp.repeat(jnp.arange(T, dtype=jnp.int32), TOP_K)
    flat_w = gate.reshape(A)
    order = jnp.argsort(flat_e)
    se = flat_e[order]
    counts = jnp.bincount(flat_e, length=N_EXPERTS)
    padded = (counts + MOE_BLOCK - 1) // MOE_BLOCK * MOE_BLOCK
    pad_end = jnp.cumsum(padded)
    pad_start = pad_end - padded
    start = jnp.cumsum(counts) - counts
    dest = pad_start[se] + jnp.arange(A) - start[se]
    n_blocks = (A + N_EXPERTS * (MOE_BLOCK - 1) + MOE_BLOCK - 1) // MOE_BLOCK
    n_slots = n_blocks * MOE_BLOCK
    slot_tok = jnp.full((n_slots,), T, jnp.int32).at[dest].set(flat_tok[order])
    slot_w = jnp.zeros((n_slots,), jnp.float32).at[dest].set(flat_w[order])
    block_e = jnp.minimum(jnp.searchsorted(pad_end, jnp.arange(n_blocks) * MOE_BLOCK, side='right'),
                          N_EXPERTS - 1)
    h_pad = jnp.concatenate([h, jnp.zeros((1, D), h.dtype)], axis=0)

    def run_block(args):
        tok, e = args
        xb = h_pad[tok]
        return (jax.nn.silu(xb @ w_gate[e]) * (xb @ w_up[e])) @ w_down[e]

    y = lax.map(run_block, (slot_tok.reshape(n_blocks, MOE_BLOCK), block_e))
    y = y.reshape(n_slots, D) * slot_w[:, None].astype(y.dtype)
    return jnp.zeros((T + 1, D), y.dtype).at[slot_tok].add(y)[:T]


def setup_inputs(seed: int = 0) -> dict:
    key = jax.random.key(seed)
    ks = iter(jax.random.split(key, 40))

    def nrm(shape, s):
        return jax.random.normal(next(ks), shape, jnp.float32) * s

    beta = (8 * DEPTH) ** -0.25
    Lr, D = DEPTH, D_MODEL
    return {
        'x': nrm((BATCH, SEQ, D), 1.0),
        'c': nrm((BATCH, D), 1.0),
        'ctx': nrm((BATCH, CTX_LEN, D), 1.0),
        'c_ctx': nrm((D,), 1.0),
        'w_ada': nrm((Lr, D, 6 * D), D ** -0.5),
        'b_ada': nrm((Lr, 6 * D), 0.02),
        'w_in': nrm((Lr, D, IN_W), D ** -0.5),
        'w_out': nrm((Lr, D_MIX, D), D_MIX ** -0.5 * beta),
        'mix_norm_g': 1.0 + nrm((Lr, D_MIX), 0.02),
        'pool_w': nrm((Lr, len(POOL_WINDOWS), POOL_GROUP, POOL_GROUP), POOL_GROUP ** -0.5),
        'pool_scale': 1.0 + nrm((Lr, MIXER_W), 0.1),
        'attn_sink': nrm((Lr, N_HEADS), 1.0),
        'hy_conv_w': nrm((Lr, SHORT_CONV, (HYENA_ORDER + 1) * MIXER_W), SHORT_CONV ** -0.5),
        'hy_conv_b': nrm((Lr, (HYENA_ORDER + 1) * MIXER_W), 0.02),
        'hy_w1': nrm((Lr, HYENA_EMB, HYENA_HIDDEN), HYENA_EMB ** -0.5),
        'hy_b1': nrm((Lr, HYENA_HIDDEN), 0.1),
        'hy_f1': 1.0 + nrm((Lr, HYENA_HIDDEN), 0.1),
        'hy_w2': nrm((Lr, HYENA_HIDDEN, HYENA_HIDDEN), HYENA_HIDDEN ** -0.5),
        'hy_b2': nrm((Lr, HYENA_HIDDEN), 0.1),
        'hy_f2': 1.0 + nrm((Lr, HYENA_HIDDEN), 0.1),
        'hy_w3': nrm((Lr, HYENA_HIDDEN, HYENA_ORDER * 2 * MIXER_W), 0.1 * HYENA_HIDDEN ** -0.5),
        'hy_skip': nrm((Lr, HYENA_ORDER, MIXER_W), 1.0),
        'gm_ln_g': 1.0 + nrm((Lr, MIXER_W), 0.02),
        'gm_ln_b': nrm((Lr, MIXER_W), 0.02),
        'gm_ws': nrm((Lr, GMLP_GROUPS, GMLP_CHUNK, GMLP_CHUNK), 0.02),
        'gm_bs': 1.0 + nrm((Lr, GMLP_GROUPS, GMLP_CHUNK), 0.02),
        'ln1_g': 1.0 + nrm((Lr, D), 0.02),
        'ln1_b': nrm((Lr, D), 0.02),
        'ln2_g': 1.0 + nrm((Lr, D), 0.02),
        'ln2_b': nrm((Lr, D), 0.02),
        'w_router': nrm((D, N_EXPERTS), D ** -0.5),
        'router_bias': nrm((N_EXPERTS,), 0.01),
        'w_gate': nrm((Lr, N_EXPERTS, D, D_EXPERT), D ** -0.5),
        'w_up': nrm((Lr, N_EXPERTS, D, D_EXPERT), D ** -0.5),
        'w_down': nrm((Lr, N_EXPERTS, D_EXPERT, D), D_EXPERT ** -0.5 * beta),
    }


def reference(x, c, ctx, c_ctx, w_ada, b_ada, w_in, w_out, mix_norm_g, pool_w, pool_scale, attn_sink,
              hy_conv_w, hy_conv_b, hy_w1, hy_b1, hy_f1, hy_w2, hy_b2, hy_f2, hy_w3, hy_skip,
              gm_ln_g, gm_ln_b, gm_ws, gm_bs, ln1_g, ln1_b, ln2_g, ln2_b, w_router, router_bias,
              w_gate, w_up, w_down):
    alpha = (2 * DEPTH) ** 0.25
    B, L, D = x.shape
    C = ctx.shape[1]
    rows = L // GRID_W
    row_idx = jnp.repeat(jnp.arange(rows), GRID_W)
    col_idx = jnp.tile(jnp.arange(GRID_W), rows)
    for layer in range(DEPTH):
        last = layer == DEPTH - 1
        lp = {
            'w_in': w_in[layer], 'w_out': w_out[layer], 'mix_norm_g': mix_norm_g[layer],
            'pool_w': pool_w[layer], 'pool_scale': pool_scale[layer], 'attn_sink': attn_sink[layer],
            'hy_conv_w': hy_conv_w[layer], 'hy_conv_b': hy_conv_b[layer],
            'hy_w1': hy_w1[layer], 'hy_b1': hy_b1[layer], 'hy_f1': hy_f1[layer],
            'hy_w2': hy_w2[layer], 'hy_b2': hy_b2[layer], 'hy_f2': hy_f2[layer],
            'hy_w3': hy_w3[layer], 'hy_skip': hy_skip[layer],
            'gm_ln_g': gm_ln_g[layer], 'gm_ln_b': gm_ln_b[layer], 'gm_ws': gm_ws[layer], 'gm_bs': gm_bs[layer],
        }
        mod = jax.nn.silu(c) @ w_ada[layer] + b_ada[layer]
        mod_c = jax.nn.silu(c_ctx) @ w_ada[layer] + b_ada[layer]
        sh1, sc1, g1, sh2, sc2, g2 = [m[:, None, :] for m in jnp.split(mod, 6, axis=-1)]
        csh1, csc1, cg1, csh2, csc2, cg2 = jnp.split(mod_c, 6, axis=-1)

        y_lat, y_ctx = _token_mixer(_modulate(x, sh1, sc1), _modulate(ctx, csh1, csc1),
                                    row_idx, col_idx, lp, not last)
        x = _post_norm(x, g1 * y_lat, alpha, ln1_g[layer], ln1_b[layer])
        h_lat = _modulate(x, sh2, sc2).reshape(B * L, D)
        if last:
            f = _moe(h_lat, w_router, router_bias, w_gate[layer], w_up[layer], w_down[layer])
            x = _post_norm(x, g2 * f.reshape(B, L, D), alpha, ln2_g[layer], ln2_b[layer])
        else:
            ctx = _post_norm(ctx, cg1 * y_ctx, alpha, ln1_g[layer], ln1_b[layer])
            h_ctx = _modulate(ctx, csh2, csc2).reshape(B * C, D)
            f = _moe(jnp.concatenate([h_lat, h_ctx], axis=0), w_router, router_bias,
                     w_gate[layer], w_up[layer], w_down[layer])
            x = _post_norm(x, g2 * f[:B * L].reshape(B, L, D), alpha, ln2_g[layer], ln2_b[layer])
            ctx = _post_norm(ctx, cg2 * f[B * L:].reshape(B, C, D), alpha, ln2_g[layer], ln2_b[layer])
    return x
```

```cpp
#include <hip/hip_runtime.h>
#include <cstdio>
#include <cstdint>

#ifndef DUP_MASK
#define DUP_MASK 0u
#endif
#ifndef PROBE_P1
#define PROBE_P1 0
#endif
#ifndef PROBE_P2
#define PROBE_P2 0
#endif
#ifndef FP8_IN
#define FP8_IN 1
#endif
#ifndef FP8_OUT
#define FP8_OUT 1
#endif
#ifndef PROBE_P0
#define PROBE_P0 0
#endif
#ifndef PROBE_CONV
#define PROBE_CONV 0
#endif
#ifndef DUP_SUB
#define DUP_SUB 0u
#endif
#define NSUB(k) (((DUP_SUB >> (k)) & 1u) ? 2 : 1)
#define NREP(k) (((DUP_MASK >> (k)) & 1u) ? 2 : 1)
#ifndef MK_N_LAUNCHES
#define MK_N_LAUNCHES 1
#endif

#define LAS __attribute__((address_space(3)))
#define GAS __attribute__((address_space(1)))
typedef unsigned short bf16;
typedef short bf16x8 __attribute__((ext_vector_type(8)));
typedef float f32x2 __attribute__((ext_vector_type(2)));
typedef float f32x4 __attribute__((ext_vector_type(4)));
typedef float f32x16 __attribute__((ext_vector_type(16)));
typedef unsigned u32x2 __attribute__((ext_vector_type(2)));
typedef unsigned u32x4 __attribute__((ext_vector_type(4)));
typedef __bf16 bf16x2_t __attribute__((ext_vector_type(2)));

constexpr int DM = 2048, NB = 4, SL = 4096, CL = 256, NLAT = NB * SL, NCTX = NB * CL, NTOK = NLAT + NCTX;
constexpr int INW = 3840, DE = 768, NE = 32, MAXBLK = 168;
constexpr float LN_EPS = 1e-6f, ALPHA = 1.41421356237f, LOG2E = 1.44269504089f;

constexpr size_t MiB = 1u << 20;
constexpr size_t WS_CTL = 0, CTL_ZERO_BYTES = 1 * MiB;
constexpr size_t WS_MOD = 1 * MiB;
constexpr size_t WS_ROPE = 2 * MiB;
constexpr size_t WS_TOKINFO = 2 * MiB + 65536;
constexpr size_t WS_TOKW = WS_TOKINFO + (size_t)NTOK * 16;
constexpr size_t WS_ROWSLOT = WS_TOKW + (size_t)NTOK * 8;
constexpr size_t WS_SLOTW = WS_ROWSLOT + (size_t)NTOK * 8;
static_assert(WS_SLOTW + 43008 * 4 <= 4 * MiB, "small tables");
constexpr size_t WS_POOLWT = 3 * MiB;
constexpr size_t WS_GWSB = 3 * MiB + 512 * 1024;
constexpr size_t WS_WIN = 4 * MiB;
constexpr size_t WS_WOUT = 34 * MiB;
constexpr size_t WS_WGU = 50 * MiB;
constexpr size_t WS_WD = 434 * MiB;
constexpr size_t WS_FILT = 626 * MiB;
constexpr size_t WS_FILTC = 658 * MiB;
constexpr size_t WS_X = 660 * MiB;
constexpr size_t WS_HB = 796 * MiB;
constexpr size_t WS_Z = 864 * MiB;
constexpr size_t WS_YCAT = 992 * MiB;
constexpr size_t WS_TL = 1060 * MiB;
constexpr size_t WS_TC = 1108 * MiB;
constexpr size_t WS_YHT = 1112 * MiB;
constexpr size_t WS_YO = 1129 * MiB;
constexpr size_t WS_EXPTOK = 864 * MiB;
constexpr size_t WS_HG = 1032 * MiB;
constexpr size_t WS_YS = 1095 * MiB;
constexpr size_t WS_HB8 = 1265 * MiB;
constexpr size_t WS_HA8 = 1300 * MiB;
constexpr size_t WS_END = 1334 * MiB;
constexpr int CW_BAR = 4096;
constexpr int CW_CNT = 8192;
constexpr int CW_QUEUE = 14336;
constexpr int CW_NBLK = 12288;
constexpr int CW_BLKE = 12544;
constexpr int LDS_TAB = 132096;
constexpr int LDS_BYTES = 147456;
constexpr int LDS_MISC = 147392;

__device__ __forceinline__ unsigned pk2(float lo, float hi) { f32x2 v = {lo, hi}; bf16x2_t b = __builtin_convertvector(v, bf16x2_t); return __builtin_bit_cast(unsigned, b); }
__device__ __forceinline__ unsigned pk4_fp8(float a, float b, float c, float d) { int p = 0; p = __builtin_amdgcn_cvt_pk_fp8_f32(a, b, p, false); p = __builtin_amdgcn_cvt_pk_fp8_f32(c, d, p, true); return (unsigned)p; }
__device__ __forceinline__ float bflo(unsigned w) { return __uint_as_float(w << 16); }
__device__ __forceinline__ float bfhi(unsigned w) { return __uint_as_float(w & 0xffff0000u); }
__device__ __forceinline__ float bf1(bf16 v) { return __uint_as_float(((unsigned)v) << 16); }
template <int CTRL> __device__ __forceinline__ float dpp_f(float x) { return __int_as_float(__builtin_amdgcn_update_dpp(0, __float_as_int(x), CTRL, 0xF, 0xF, true)); }
#define DPP_XOR1 0xB1
#define DPP_XOR2 0x4E
#define DPP_HMIRROR 0x141
#define DPP_MIRROR 0x140
#define DPP_ROR8 0x128
__device__ __forceinline__ float xor16_sum(float x) { const auto r = __builtin_amdgcn_permlane16_swap(__float_as_uint(x), __float_as_uint(x), false, false); return __uint_as_float(r[0]) + __uint_as_float(r[1]); }
__device__ __forceinline__ float xor32_sum(float x) { const auto r = __builtin_amdgcn_permlane32_swap(__float_as_uint(x), __float_as_uint(x), false, false); return __uint_as_float(r[0]) + __uint_as_float(r[1]); }
__device__ __forceinline__ float xor32_max(float x) { const auto r = __builtin_amdgcn_permlane32_swap(__float_as_uint(x), __float_as_uint(x), false, false); return fmaxf(__uint_as_float(r[0]), __uint_as_float(r[1])); }
__device__ __forceinline__ float row16_sum(float v) { v += dpp_f<DPP_XOR1>(v); v += dpp_f<DPP_XOR2>(v); v += dpp_f<DPP_HMIRROR>(v); v += dpp_f<DPP_MIRROR>(v); return v; }
__device__ __forceinline__ float wave_sum(float v) { return xor32_sum(xor16_sum(row16_sum(v))); }
__device__ __forceinline__ float gelu_tanh(float x) { const float y = 0.7978845608f * (x + 0.044715f * x * x * x); const float t = __expf(2.0f * y); return 0.5f * x * (2.0f - 2.0f * __builtin_amdgcn_rcpf(t + 1.0f)); }
__device__ __forceinline__ float silu_f(float x) { return x * __builtin_amdgcn_rcpf(1.0f + __expf(-x)); }
#define LDS_WAIT() asm volatile("s_waitcnt lgkmcnt(0)" ::: "memory")
#define VM_WAIT() asm volatile("s_waitcnt vmcnt(0)" ::: "memory")

namespace pg8 {
#define PG8_LAS __attribute__((address_space(3)))
typedef unsigned short bf16_t;
constexpr int BM = 256, BK = 64, HALF = 128, HTB = HALF * BK * 2, STAGE_BYTES = 8 * HTB, NXCD = 8, WGM = 8;
__host__ __device__ __forceinline__ int lds_byte(int r, int c) { const int st = (r >> 4) * 2 + (c >> 5), rr = r & 15, cc = c & 31, ob = rr * 64 + cc * 2; return st * 1024 + (ob ^ (((ob >> 9) & 1) << 5)); }
__host__ __device__ __forceinline__ void stage_rc(int b, int& R, int& C) { const int st = b / 1024, sb = b % 1024, swz = sb ^ (((sb >> 9) & 1) << 5); R = (st >> 1) * 16 + swz / 64; C = (st & 1) * 32 + (swz % 64) / 2; }
__host__ __device__ __forceinline__ int perm32(int rho) { const int n = rho >> 4, i = rho & 15; return 8 * (i >> 2) + 4 * n + (i & 3); }

struct Unit { int pm, pn, pb; const int* amap; int nvalid; };
struct Gemm { const bf16_t* A; const bf16_t* Bt; int K; };

struct DenseOrder {
    int nM, nN, nwg, G, c;
    __device__ void init(int M, int N, int G_, int c_) { nM = M / BM; nN = N / BM; nwg = nM * nN; G = G_; c = c_; }
    __device__ bool next(int i, Unit& u) const {
        const long L = (long)i * G + c; if (L >= nwg) return false;
        int wgid = (int)L; { const int q = nwg / NXCD, r = nwg % NXCD, xcd = wgid % NXCD, off = wgid / NXCD; wgid = (xcd < r ? xcd * (q + 1) : r * (q + 1) + (xcd - r) * q) + off; }
        const int nig = WGM * nN, gid = wgid / nig, fm = gid * WGM, gsz = (nM - fm) < WGM ? (nM - fm) : WGM;
        u.pm = fm + ((wgid % nig) % gsz); u.pn = (wgid % nig) / gsz; u.pb = u.pn; u.amap = nullptr; u.nvalid = 0; return true;
    }
    __device__ __forceinline__ void a_ready(const Unit&) const {}
    __device__ __forceinline__ void done(const Unit&) const {}
};
struct MoeOrder {
    int nblk, nN, G, c; const PG8_LAS int* blk_e; const PG8_LAS int* bst; const PG8_LAS int* cnt; const int* exptok; int ntok;
    __device__ bool next(int i, Unit& u) const {
        const long L = (long)i * G + c; const int nwg = nblk * nN; if (L >= nwg) return false;
        int wgid = (int)L; { const int q = nwg / NXCD, r = nwg % NXCD, xcd = wgid % NXCD, off = wgid / NXCD; wgid = (xcd < r ? xcd * (q + 1) : r * (q + 1) + (xcd - r) * q) + off; }
        const int blk = wgid / nN, pn = wgid % nN, e = blk_e[blk], p0 = (blk - bst[e]) * 256;
        u.pm = blk; u.pn = pn; u.pb = e * nN + pn; u.amap = exptok + (size_t)e * ntok + p0; u.nvalid = cnt[e] - p0; return true;
    }
    __device__ __forceinline__ void a_ready(const Unit&) const {}
    __device__ __forceinline__ void done(const Unit&) const {}
};

struct EpiBf16 {
    static constexpr bool PERM = true;
    bf16_t* O; int ldc; int gelu_from;
    __device__ __forceinline__ void operator()(const f32x4 (&acc)[2][2][4][2], const Unit& u, int wr, int wc, int fr, int fq) const {
        const int row0 = u.pm * BM + wr * 64 + fr; const int col0 = u.pn * BM + wc * 32 + 8 * fq; const bool act = u.pn >= gelu_from;
#pragma unroll
        for (int ai = 0; ai < 2; ++ai)
#pragma unroll
            for (int m = 0; m < 4; ++m) { bf16_t* rowp = O + (size_t)(row0 + ai * HALF + m * 16) * ldc + col0;
#pragma unroll
                for (int bj = 0; bj < 2; ++bj) { f32x4 v0 = acc[ai][bj][m][0], v1 = acc[ai][bj][m][1];
                    if (act) {
#pragma unroll
                        for (int j = 0; j < 4; ++j) { v0[j] = gelu_tanh(v0[j]); v1[j] = gelu_tanh(v1[j]); } }
                    u32x4 w; w.x = pk2(v0[0], v0[1]); w.y = pk2(v0[2], v0[3]); w.z = pk2(v1[0], v1[1]); w.w = pk2(v1[2], v1[3]);
                    *(u32x4*)(rowp + bj * HALF) = w; } }
    }
};
struct EpiFp8 {
    static constexpr bool PERM = true;
    unsigned char* O; int ldc; float scale;
    __device__ __forceinline__ void operator()(const f32x4 (&acc)[2][2][4][2], const Unit& u, int wr, int wc, int fr, int fq) const {
        const int row0 = u.pm * BM + wr * 64 + fr; const int col0 = u.pn * BM + wc * 32 + 8 * fq;
#pragma unroll
        for (int ai = 0; ai < 2; ++ai)
#pragma unroll
            for (int m = 0; m < 4; ++m) { unsigned char* rowp = O + (size_t)(row0 + ai * HALF + m * 16) * ldc + col0;
#pragma unroll
                for (int bj = 0; bj < 2; ++bj) { const f32x4 v0 = acc[ai][bj][m][0] * scale, v1 = acc[ai][bj][m][1] * scale;
                    u32x2 w; w.x = pk4_fp8(v0[0], v0[1], v0[2], v0[3]); w.y = pk4_fp8(v1[0], v1[1], v1[2], v1[3]);
                    *(u32x2*)(rowp + bj * HALF) = w; } }
    }
};
struct EpiF32 {
    static constexpr bool PERM = false;
    float* C; int ldc;
    __device__ __forceinline__ void operator()(const f32x4 (&acc)[2][2][4][2], const Unit& u, int wr, int wc, int fr, int fq) const {
        const int row0 = u.pm * BM + wr * 64 + fr, col0 = u.pn * BM + wc * 32 + 4 * fq;
#pragma unroll
        for (int ai = 0; ai < 2; ++ai)
#pragma unroll
            for (int m = 0; m < 4; ++m) { float* rowp = C + (size_t)(row0 + ai * HALF + m * 16) * ldc + col0;
#pragma unroll
                for (int bj = 0; bj < 2; ++bj)
#pragma unroll
                    for (int n = 0; n < 2; ++n) *(f32x4*)(rowp + bj * HALF + n * 16) = acc[ai][bj][m][n]; }
    }
};
struct EpiGLU {
    static constexpr bool PERM = true;
    unsigned char* O; int ldc;
    __device__ __forceinline__ void operator()(const f32x4 (&acc)[2][2][4][2], const Unit& u, int wr, int wc, int fr, int fq) const {
        const int row0 = u.pm * BM + wr * 64 + fr; const int col0 = u.pn * HALF + wc * 32 + 8 * fq;
#pragma unroll
        for (int ai = 0; ai < 2; ++ai)
#pragma unroll
            for (int m = 0; m < 4; ++m) { unsigned char* rowp = O + (size_t)(row0 + ai * HALF + m * 16) * ldc + col0;
                float o[8];
#pragma unroll
                for (int n = 0; n < 2; ++n)
#pragma unroll
                    for (int j = 0; j < 4; ++j) { const float g = acc[ai][0][m][n][j], up = acc[ai][1][m][n][j]; o[4 * n + j] = (g * __builtin_amdgcn_rcpf(1.0f + __expf(-g))) * up; }
                u32x2 w; w.x = pk4_fp8(o[0], o[1], o[2], o[3]); w.y = pk4_fp8(o[4], o[5], o[6], o[7]);
                *(u32x2*)rowp = w; }
    }
};
struct EpiScaleBf16 {
    static constexpr bool PERM = true;
    bf16_t* O; int ldc; const float* rs;
    __device__ __forceinline__ void operator()(const f32x4 (&acc)[2][2][4][2], const Unit& u, int wr, int wc, int fr, int fq) const {
        const int row0 = u.pm * BM + wr * 64 + fr; const int col0 = u.pn * BM + wc * 32 + 8 * fq;
#pragma unroll
        for (int ai = 0; ai < 2; ++ai)
#pragma unroll
            for (int m = 0; m < 4; ++m) { const int row = row0 + ai * HALF + m * 16; const float s = rs[row]; bf16_t* rowp = O + (size_t)row * ldc + col0;
#pragma unroll
                for (int bj = 0; bj < 2; ++bj) { const f32x4 v0 = acc[ai][bj][m][0] * s, v1 = acc[ai][bj][m][1] * s;
                    u32x4 w; w.x = pk2(v0[0], v0[1]); w.y = pk2(v0[2], v0[3]); w.z = pk2(v1[0], v1[1]); w.w = pk2(v1[2], v1[3]);
                    *(u32x4*)(rowp + bj * HALF) = w; } }
    }
};

typedef int i32x8 __attribute__((ext_vector_type(8)));
typedef int i32x4v __attribute__((ext_vector_type(4)));
template <class Epi, class Sched, bool GATHER = false, bool FP8 = false, bool ALIGN_EPI = true, bool SP2 = true>
__device__ __forceinline__ void gemm_phase(PG8_LAS unsigned char* lds, const Gemm g, const Sched& S, const Epi& E) {
    int tid_ = threadIdx.x; asm volatile("" : "+v"(tid_));
    const int tid = tid_, wid = __builtin_amdgcn_readfirstlane(tid >> 6), lane = tid & 63, wr = wid >> 2, wc = wid & 3, fr = lane & 15, fq = lane >> 4;
    int K_ = g.K; asm volatile("" : "+s"(K_));
    const int K = K_, nt = K / BK;
    unsigned voffA[2], voffB[2];
#pragma unroll
    for (int i = 0; i < 2; ++i) { int R, C; stage_rc(tid * 16 + i * 8192, R, C); const int Rb = Epi::PERM ? ((R & ~31) + perm32(R & 31)) : R;
        voffA[i] = (unsigned)(R * K + C) * 2u; voffB[i] = (unsigned)(Rb * K + C) * 2u; }
    const size_t kstep = (size_t)(BK * 2);
    const size_t hstep = (size_t)HALF * K * 2;
    const size_t tstep = 2 * hstep;
    const unsigned ldsw = (unsigned)wid * 1024u;
    const int aoff = lds_byte(wr * 64 + fr, fq * 8), boff = lds_byte(wc * 32 + fr, fq * 8);
#define PG8_SA(b, h) (((b) * 2 + (h)) * HTB)
#define PG8_SB(b, h) ((4 + (b) * 2 + (h)) * HTB)
#define PG8_STAGE(bufoff, gbase, voff) do { _Pragma("unroll") for (int _i = 0; _i < 2; ++_i) \
        __builtin_amdgcn_global_load_lds((const unsigned*)((const char*)(gbase) + (voff)[_i]), (PG8_LAS unsigned*)(lds + (bufoff) + ldsw + _i * 8192), 16, 0, 0); } while (0)
#define PG8_STAGE_G(bufoff, kbytes, o0, o1) do { \
        __builtin_amdgcn_global_load_lds((const unsigned*)((const char*)g.A + (kbytes) + (o0)), (PG8_LAS unsigned*)(lds + (bufoff) + ldsw), 16, 0, 0); \
        __builtin_amdgcn_global_load_lds((const unsigned*)((const char*)g.A + (kbytes) + (o1)), (PG8_LAS unsigned*)(lds + (bufoff) + ldsw + 8192), 16, 0, 0); } while (0)
#define PG8_LOADMAP(u, O) do { _Pragma("unroll") for (int _h = 0; _h < 2; ++_h) _Pragma("unroll") for (int _i = 0; _i < 2; ++_i) { int _R, _C; stage_rc(tid * 16 + _i * 8192, _R, _C); const int _rr = _h * HALF + _R; \
        int _t = (_rr < (u).nvalid) ? (u).amap[_rr] : 0; _t = ((unsigned)_t < 17408u) ? _t : 0; O[_h][_i] = (unsigned)(_t * K + _C) * 2u; } } while (0)
#define PG8_LD8(p) __builtin_shufflevector(*(const PG8_LAS i32x4v*)(p), *(const PG8_LAS i32x4v*)((p) + 1024), 0, 1, 2, 3, 4, 5, 6, 7)
#define PG8_LDA(dst, b, h) do { if constexpr (FP8) { _Pragma("unroll") for (int m = 0; m < 4; ++m) dst##8[m] = PG8_LD8(lds + PG8_SA(b, h) + aoff + m * 2048); } \
        else { _Pragma("unroll") for (int m = 0; m < 4; ++m) _Pragma("unroll") for (int k = 0; k < 2; ++k) dst[m][k] = *(const PG8_LAS bf16x8*)(lds + PG8_SA(b, h) + aoff + m * 2048 + k * 1024); } } while (0)
#define PG8_LDB(dst, b, h) do { if constexpr (FP8) { _Pragma("unroll") for (int n = 0; n < 2; ++n) dst##8[n] = PG8_LD8(lds + PG8_SB(b, h) + boff + n * 2048); } \
        else { _Pragma("unroll") for (int n = 0; n < 2; ++n) _Pragma("unroll") for (int k = 0; k < 2; ++k) dst[n][k] = *(const PG8_LAS bf16x8*)(lds + PG8_SB(b, h) + boff + n * 2048 + k * 1024); } } while (0)
#define PG8_MMA(ai, bj, At, Bt) do { __builtin_amdgcn_s_setprio(1); \
        if constexpr (FP8) { _Pragma("unroll") for (int m = 0; m < 4; ++m) _Pragma("unroll") for (int n = 0; n < 2; ++n) \
            asm volatile("v_mfma_scale_f32_16x16x128_f8f6f4 %0, %1, %2, %0, %3, %4 op_sel_hi:[0,0,0]" : "+v"(acc[ai][bj][m][n]) : "v"(Bt##8[n]), "v"(At##8[m]), "v"(sc_w), "v"(sc_x)); } \
        else { _Pragma("unroll") for (int m = 0; m < 4; ++m) _Pragma("unroll") for (int n = 0; n < 2; ++n) _Pragma("unroll") for (int k = 0; k < 2; ++k) \
            acc[ai][bj][m][n] = __builtin_amdgcn_mfma_f32_16x16x32_bf16(Bt[n][k], At[m][k], acc[ai][bj][m][n], 0, 0, 0); } \
        __builtin_amdgcn_s_setprio(0); } while (0)
#define PG8_WAIT_V(n) asm volatile("s_waitcnt vmcnt(" #n ")" ::: "memory")
#define PG8_WAIT_L(n) asm volatile("s_waitcnt lgkmcnt(" #n ")" ::: "memory")
#define PG8_BAR __builtin_amdgcn_s_barrier()
#define PG8_SCHED __builtin_amdgcn_sched_barrier(0)
    Unit cur, nxt; int ui = 0;
    if (!S.next(0, cur)) return;
    f32x4 acc[2][2][4][2];
#pragma unroll
    for (int a = 0; a < 2; ++a)
#pragma unroll
        for (int b = 0; b < 2; ++b)
#pragma unroll
            for (int m = 0; m < 4; ++m)
#pragma unroll
                for (int n = 0; n < 2; ++n) acc[a][b][m][n] = (f32x4){0.f, 0.f, 0.f, 0.f};
    bf16x8 At[4][2], B0[2][2], B1[2][2]; i32x8 At8[4], B08[2], B18[2];
    const int sc_w = 0x79797979, sc_x = 0x7f7f7f7f;
    const char* cA = (const char*)g.A + (size_t)cur.pm * tstep; const char* cB = (const char*)g.Bt + (size_t)cur.pb * tstep;
    unsigned cO[2][2] = {{0u, 0u}, {0u, 0u}}, nO[2][2] = {{0u, 0u}, {0u, 0u}};
    S.a_ready(cur);
    if constexpr (GATHER) { static_assert(SP2, "GATHER needs the SP2 loop"); PG8_LOADMAP(cur, cO); }
    if constexpr (SP2) {
        PG8_STAGE(PG8_SB(0, 0), cB, voffB); PG8_STAGE(PG8_SB(0, 1), cB + hstep, voffB);
        if constexpr (GATHER) { PG8_STAGE_G(PG8_SA(0, 0), 0, cO[0][0], cO[0][1]); PG8_STAGE_G(PG8_SA(0, 1), 0, cO[1][0], cO[1][1]); }
        else { PG8_STAGE(PG8_SA(0, 0), cA, voffA); PG8_STAGE(PG8_SA(0, 1), cA + hstep, voffA); }
        if (wr == 1) PG8_BAR;
        PG8_WAIT_V(2); PG8_BAR;
        PG8_STAGE(PG8_SB(1, 0), cB + kstep, voffB);
        if constexpr (GATHER) PG8_STAGE_G(PG8_SA(1, 0), kstep, cO[0][0], cO[0][1]); else PG8_STAGE(PG8_SA(1, 0), cA + kstep, voffA);
        PG8_STAGE(PG8_SB(1, 1), cB + hstep + kstep, voffB);
        PG8_WAIT_V(6); PG8_BAR;
    } else {
        PG8_STAGE(PG8_SB(0, 0), cB, voffB); PG8_STAGE(PG8_SA(0, 0), cA, voffA); PG8_STAGE(PG8_SB(0, 1), cB + hstep, voffB); PG8_STAGE(PG8_SA(0, 1), cA + hstep, voffA);
        if (wr == 1) PG8_BAR;
        PG8_WAIT_V(4); PG8_BAR;
        PG8_STAGE(PG8_SB(1, 0), cB + kstep, voffB); PG8_STAGE(PG8_SA(1, 0), cA + kstep, voffA); PG8_STAGE(PG8_SB(1, 1), cB + hstep + kstep, voffB);
        PG8_WAIT_V(6); PG8_BAR;
    }
    for (;;) {
        const bool has_next = S.next(ui + 1, nxt);
        const char* nA = has_next ? (const char*)g.A + (size_t)nxt.pm * tstep : cA; const char* nB = has_next ? (const char*)g.Bt + (size_t)nxt.pb * tstep : cB;
        if constexpr (GATHER) { if (has_next) PG8_LOADMAP(nxt, nO); else {
#pragma unroll
            for (int _h = 0; _h < 2; ++_h) { nO[_h][0] = cO[_h][0]; nO[_h][1] = cO[_h][1]; } } }
#pragma unroll 1
        for (int t = 0; t < nt; t += 2) {
            const bool last = (t == nt - 2);
            const char* a1 = cA + (size_t)(t + 1) * kstep;
            const char* a2 = last ? nA : cA + (size_t)(t + 2) * kstep; const char* b2 = last ? nB : cB + (size_t)(t + 2) * kstep;
            const char* a3 = a2 + kstep; const char* b3 = b2 + kstep;
            if (last && has_next) S.a_ready(nxt);
            if constexpr (SP2) {
            const size_t k1 = (size_t)(t + 1) * kstep, k2 = last ? (size_t)0 : (size_t)(t + 2) * kstep, k3 = k2 + kstep;
            const unsigned g00 = last ? nO[0][0] : cO[0][0], g01 = last ? nO[0][1] : cO[0][1], g10 = last ? nO[1][0] : cO[1][0], g11 = last ? nO[1][1] : cO[1][1];
            PG8_LDB(B0, 0, 0); PG8_LDB(B1, 0, 1); PG8_SCHED; PG8_LDA(At, 0, 0);
            if constexpr (GATHER) PG8_STAGE_G(PG8_SA(1, 1), k1, cO[1][0], cO[1][1]); else PG8_STAGE(PG8_SA(1, 1), a1 + hstep, voffA);
            PG8_WAIT_V(8); PG8_WAIT_L(0); PG8_BAR; PG8_MMA(0, 0, At, B0); PG8_MMA(0, 1, At, B1); PG8_BAR; PG8_SCHED;
            PG8_LDA(At, 0, 1); PG8_STAGE(PG8_SB(0, 0), b2, voffB); PG8_STAGE(PG8_SB(0, 1), b2 + hstep, voffB);
            if constexpr (GATHER) PG8_STAGE_G(PG8_SA(0, 0), k2, g00, g01); else PG8_STAGE(PG8_SA(0, 0), a2, voffA);
            PG8_WAIT_V(8); PG8_WAIT_L(0); PG8_BAR; PG8_MMA(1, 0, At, B0); PG8_MMA(1, 1, At, B1); PG8_BAR; PG8_SCHED;
            PG8_LDB(B0, 1, 0); PG8_LDB(B1, 1, 1); PG8_SCHED; PG8_LDA(At, 1, 0);
            if constexpr (GATHER) PG8_STAGE_G(PG8_SA(0, 1), k2, g10, g11); else PG8_STAGE(PG8_SA(0, 1), a2 + hstep, voffA);
            PG8_WAIT_V(8); PG8_WAIT_L(0); PG8_BAR; PG8_MMA(0, 0, At, B0); PG8_MMA(0, 1, At, B1); PG8_BAR; PG8_SCHED;
            PG8_LDA(At, 1, 1); PG8_STAGE(PG8_SB(1, 0), b3, voffB); PG8_STAGE(PG8_SB(1, 1), b3 + hstep, voffB);
            if constexpr (GATHER) PG8_STAGE_G(PG8_SA(1, 0), k3, g00, g01); else PG8_STAGE(PG8_SA(1, 0), a3, voffA);
            PG8_WAIT_V(8); PG8_WAIT_L(0); PG8_BAR; PG8_MMA(1, 0, At, B0); PG8_MMA(1, 1, At, B1); PG8_BAR; PG8_SCHED;
            } else {
            PG8_LDB(B0, 0, 0); PG8_SCHED; PG8_LDA(At, 0, 0); PG8_STAGE(PG8_SA(1, 1), a1 + hstep, voffA);
            PG8_WAIT_L(8); PG8_BAR; PG8_WAIT_L(0); PG8_MMA(0, 0, At, B0); PG8_BAR; PG8_SCHED;
            PG8_LDB(B1, 0, 1); PG8_STAGE(PG8_SB(0, 0), b2, voffB);
            PG8_BAR; PG8_WAIT_L(0); PG8_MMA(0, 1, At, B1); PG8_BAR;
            PG8_LDA(At, 0, 1); PG8_STAGE(PG8_SA(0, 0), a2, voffA);
            PG8_BAR; PG8_WAIT_L(0); PG8_MMA(1, 0, At, B0); PG8_BAR; PG8_SCHED;
            PG8_STAGE(PG8_SB(0, 1), b2 + hstep, voffB);
            PG8_WAIT_V(6); PG8_BAR; PG8_MMA(1, 1, At, B1); PG8_BAR;
            PG8_LDB(B0, 1, 0); PG8_SCHED; PG8_LDA(At, 1, 0); PG8_STAGE(PG8_SA(0, 1), a2 + hstep, voffA);
            PG8_WAIT_L(8); PG8_BAR; PG8_WAIT_L(0); PG8_MMA(0, 0, At, B0); PG8_BAR; PG8_SCHED;
            PG8_LDB(B1, 1, 1); PG8_STAGE(PG8_SB(1, 0), b3, voffB);
            PG8_BAR; PG8_WAIT_L(0); PG8_MMA(0, 1, At, B1); PG8_BAR;
            PG8_LDA(At, 1, 1); PG8_STAGE(PG8_SA(1, 0), a3, voffA);
            PG8_BAR; PG8_WAIT_L(0); PG8_MMA(1, 0, At, B0); PG8_BAR; PG8_SCHED;
            PG8_STAGE(PG8_SB(1, 1), b3 + hstep, voffB);
            PG8_WAIT_V(6); PG8_BAR; PG8_MMA(1, 1, At, B1); PG8_BAR;
            }
        }
        if constexpr (ALIGN_EPI) { if (wr == 0) PG8_BAR; }
        if constexpr (FP8) asm volatile("s_nop 15\n\ts_nop 15" ::: "memory");
        E(acc, cur, wr, wc, fr, fq); S.done(cur);
        if (!has_next) break;
#pragma unroll
        for (int a = 0; a < 2; ++a)
#pragma unroll
            for (int b = 0; b < 2; ++b)
#pragma unroll
                for (int m = 0; m < 4; ++m)
#pragma unroll
                    for (int n = 0; n < 2; ++n) acc[a][b][m][n] = (f32x4){0.f, 0.f, 0.f, 0.f};
        cur = nxt; cA = nA; cB = nB; ++ui;
        if constexpr (GATHER) {
#pragma unroll
            for (int _h = 0; _h < 2; ++_h) { cO[_h][0] = nO[_h][0]; cO[_h][1] = nO[_h][1]; } }
        if constexpr (ALIGN_EPI) { if (wr == 1) PG8_BAR; }
    }
    PG8_WAIT_V(0);
    if constexpr (!ALIGN_EPI) { if (wr == 0) PG8_BAR; }
    PG8_BAR;
#undef PG8_SA
#undef PG8_SB
#undef PG8_STAGE
#undef PG8_STAGE_G
#undef PG8_LOADMAP
#undef PG8_LDA
#undef PG8_LDB
#undef PG8_MMA
#undef PG8_LD8
#undef PG8_WAIT_V
#undef PG8_WAIT_L
#undef PG8_BAR
#undef PG8_SCHED
}
}

#define XB_TMO      128
#define XB_XCNT(j)  (256  + 64 * (j))
#define XB_XSUB(j)  (1280 + 64 * (j))
#define XB_XGEN(j)  (2304 + 64 * (j))
#define XB_TOP      3328
#define XB_TOPGEN   3392
#define XCD_BAR_WORDS 3456
#define XB_SPIN_CAP (1u << 18)
__device__ __forceinline__ unsigned xb_ld(unsigned* p)              { return __hip_atomic_load(p, __ATOMIC_RELAXED, __HIP_MEMORY_SCOPE_AGENT); }
__device__ __forceinline__ unsigned xb_add(unsigned* p, unsigned v) { return __hip_atomic_fetch_add(p, v, __ATOMIC_RELAXED, __HIP_MEMORY_SCOPE_AGENT); }
__device__ __forceinline__ unsigned xb_xcc_id() { return (unsigned)__builtin_amdgcn_s_getreg((3 << 11) | 20) & 0xFu; }
#define XB_SPIN(cond, bar) do { unsigned _sp = 0; while (cond) { __builtin_amdgcn_s_sleep(1); \
    if ((++_sp & 255u) == 0u) { if (xb_ld(&(bar)[XB_TMO])) break; if (_sp > XB_SPIN_CAP) { atomicAdd(&(bar)[XB_TMO], 1u); break; } } } } while (0)
struct XcdBarrier { unsigned* bar; unsigned x; volatile LAS unsigned* st; };
__device__ __forceinline__ XcdBarrier xcd_barrier_post(unsigned* bar, volatile LAS unsigned* st) {
    XcdBarrier b; b.bar = bar; b.x = xb_xcc_id(); b.st = st;
    if (threadIdx.x == 0) (void)xb_add(&bar[XB_XCNT(b.x)], 1u);
    return b;
}
__device__ __forceinline__ void xcd_barrier_complete(unsigned* bar, unsigned x, unsigned& nloc, unsigned& nx) {
    const unsigned G = gridDim.x * gridDim.y * gridDim.z;
    unsigned sum, cnt, mine, sp = 0u;
    for (;;) {
        sum = 0u; cnt = 0u; mine = 0u;
#pragma unroll
        for (unsigned j = 0; j < 16; ++j) { const unsigned c = xb_ld(&bar[XB_XCNT(j)]); sum += c; cnt += (c > 0u) ? 1u : 0u; mine = (j == x) ? c : mine; }
        if (sum == G) break;
        __builtin_amdgcn_s_sleep(1);
        if ((++sp & 255u) == 0u) { if (xb_ld(&bar[XB_TMO])) break; if (sp > XB_SPIN_CAP) { atomicAdd(&bar[XB_TMO], 1u); break; } }
    }
    nloc = mine > 0u ? mine : 1u; nx = cnt > 0u ? cnt : 1u;
}
__device__ __forceinline__ void xcd_barrier(const XcdBarrier& b) {
    asm volatile("s_waitcnt vmcnt(0)" ::: "memory");
    __syncthreads();
    if (threadIdx.x == 0) {
        unsigned* bar = b.bar;
        __builtin_amdgcn_s_waitcnt(0);
        unsigned nloc = b.st[0], nx = b.st[1];
        if (nloc == 0u) { xcd_barrier_complete(bar, b.x, nloc, nx); b.st[0] = nloc; b.st[1] = nx; }
        const unsigned old = xb_add(&bar[XB_XSUB(b.x)], 1u);
        const unsigned gen = old / nloc;
        if (old + 1u == (gen + 1u) * nloc) {
            __builtin_amdgcn_fence(__ATOMIC_RELEASE, "agent");
            asm volatile("s_waitcnt vmcnt(0)" ::: "memory");
            const unsigned og = xb_add(&bar[XB_TOP], 1u);
            const unsigned tg = og / nx;
            if (og + 1u == (tg + 1u) * nx) xb_add(&bar[XB_TOPGEN], 1u);
            else XB_SPIN(xb_ld(&bar[XB_TOPGEN]) == tg, bar);
            __builtin_amdgcn_fence(__ATOMIC_ACQUIRE, "agent");
            xb_add(&bar[XB_XGEN(b.x)], 1u);
            asm volatile("s_waitcnt vmcnt(0)" ::: "memory");
        } else {
            XB_SPIN(xb_ld(&bar[XB_XGEN(b.x)]) == gen, bar);
            __builtin_amdgcn_fence(__ATOMIC_ACQUIRE, "agent");
            asm volatile("s_waitcnt vmcnt(0)" ::: "memory");
        }
    }
    __syncthreads();
}

struct Args { const float* in[35]; float* out; unsigned char* ws; int ph_lo, ph_hi; };
enum { I_X = 0, I_C, I_CTX, I_CCTX, I_WADA, I_BADA, I_WIN, I_WOUT, I_MNG, I_POOLW, I_POOLS, I_SINK, I_HCW, I_HCB, I_HW1, I_HB1, I_HF1, I_HW2, I_HB2, I_HF2, I_HW3, I_HSKIP,
       I_GLG, I_GLB, I_GWS, I_GBS, I_LN1G, I_LN1B, I_LN2G, I_LN2B, I_WR, I_RB, I_WG, I_WU, I_WD };
struct Ctx {
    LAS unsigned char* lds; int tid, lane, wave, bid, G;
    const float GAS* const __attribute__((address_space(4)))* in; float GAS* out; unsigned char GAS* ws;
};
#define WSP(T, off) ((T*)(T GAS*)(C.ws + (off)))
#define INP(k) ((const float*)C.in[k])
#define FRESH(D, S) Ctx D = S; asm volatile("" : "+v"(D.tid)); D.lane = D.tid & 63; D.wave = __builtin_amdgcn_readfirstlane(D.tid >> 6); asm volatile("" : "+s"(D.bid), "+s"(D.G), "+s"(D.in), "+s"(D.ws), "+s"(D.out))

struct TrItem { const float* src; unsigned char* dst; int N, pitch; };
__device__ __forceinline__ TrItem tr_decode(Ctx& C, int it) {
    constexpr int N1 = 2 * 1920, N2 = N1 + 2 * 1024;
    const bool c0 = it < N1, c1 = !c0 && it < N2, ce = !c0 && !c1;
    const int q = it - (c0 ? 0 : (c1 ? N1 : N2));
    const int mat = c0 ? q / 1920 : (c1 ? q / 1024 : q / 1152), r0 = c0 ? q % 1920 : (c1 ? q % 1024 : q % 1152);
    const int which = ce ? r0 / 384 : 0, r = ce ? r0 % 384 : r0;
    const bool gu = ce && which < 2, dn = ce && which == 2;
    const int p = r >> 1, half = r & 1;
    const int kb = 2 * (c0 ? p / 60 : (gu ? p / 12 : p / 32)) + half, nb = c0 ? p % 60 : (gu ? p % 12 : p % 32), n0 = 64 * nb;
    const int N = c0 ? INW : (gu ? DE : DM), K = dn ? DE : DM;
    const float GAS* base = c0 ? C.in[I_WIN] : (c1 ? C.in[I_WOUT] : (which == 0 ? C.in[I_WG] : (which == 1 ? C.in[I_WU] : C.in[I_WD])));
    const size_t wsoff = c0 ? WS_WIN : (c1 ? WS_WOUT : (gu ? WS_WGU : WS_WD));
    const int nrows = c0 ? INW : (gu ? 1536 : DM);
    const int drow = gu ? ((n0 >> 7) * 256 + (n0 & 127) + 128 * which) : n0;
    TrItem t; t.N = N; t.pitch = K;
    t.src = (const float*)(base + (size_t)mat * K * N + (size_t)(64 * kb) * N + n0);
    t.dst = (unsigned char*)(C.ws + wsoff + ((size_t)mat * nrows + drow) * K + 64 * kb);
    return t;
}
__device__ __forceinline__ void tr_load(const TrItem& t, int lane, f32x4 (&v)[16]) {
#pragma unroll
    for (int i = 0; i < 16; ++i) { const int kk = 4 * i + (lane >> 4); v[i] = *(const f32x4*)(t.src + (size_t)kk * t.N + 4 * (lane & 15)); }
}
__device__ __forceinline__ void tr_process(const TrItem& t, int lane, const f32x4 (&v)[16], LAS float* scr) {
#pragma unroll
    for (int i = 0; i < 16; ++i) { const int kk = 4 * i + (lane >> 4); LAS float* d = scr + kk * 65 + 4 * (lane & 15); d[0] = v[i][0]; d[1] = v[i][1]; d[2] = v[i][2]; d[3] = v[i][3]; }
    LDS_WAIT(); asm volatile("" ::: "memory");
    const int c = lane & 7;
#pragma unroll
    for (int j = 0; j < 8; ++j) { const int n = (lane >> 3) + 8 * j; const LAS float* s = scr + (8 * c) * 65 + n;
        u32x2 o; o.x = pk4_fp8(64.f * s[0], 64.f * s[65], 64.f * s[2 * 65], 64.f * s[3 * 65]); o.y = pk4_fp8(64.f * s[4 * 65], 64.f * s[5 * 65], 64.f * s[6 * 65], 64.f * s[7 * 65]);
        *(u32x2*)(t.dst + (size_t)n * t.pitch + 8 * c) = o; }
    LDS_WAIT(); asm volatile("" ::: "memory");
}
constexpr int NPL = 19904;
__device__ __forceinline__ int tr_layer_item(int L, int j) {
    constexpr int N1 = 2 * 1920, N2 = N1 + 2 * 1024;
    return j < 1920 ? L * 1920 + j : (j < 2944 ? N1 + L * 1024 + (j - 1920) : N2 + L * 36864 + (j - 2944));
}
__device__ __forceinline__ void tr_pair(Ctx& C, int L, int q, LAS float* scr) {
    f32x4 va[16], vb[16];
    const TrItem ta = tr_decode(C, tr_layer_item(L, 2 * q)), tb = tr_decode(C, tr_layer_item(L, 2 * q + 1));
    tr_load(ta, C.lane, va); tr_load(tb, C.lane, vb);
    tr_process(ta, C.lane, va, scr);
    tr_process(tb, C.lane, vb, scr);
}
__device__ __forceinline__ void p0_convert(Ctx& C, int L, int npairs) {
    LAS float* scr = (LAS float*)(C.lds + C.wave * 16640);
    const int gw = C.bid * 8 + C.wave, NGW = C.G * 8;
#pragma unroll 1
    for (int q = gw; q < npairs; q += NGW) tr_pair(C, L, q, scr);
}
constexpr int NCU = NPL / 16;
#ifndef CONV_SPLIT
#define CONV_SPLIT 0
#endif
__device__ __forceinline__ void conv_unit(Ctx& C, int L, int q0) {
    LAS float* scr = (LAS float*)(C.lds + C.wave * 16640);
    __syncthreads();
    tr_pair(C, L, q0 + C.wave, scr);
    tr_pair(C, L, q0 + 8 + C.wave, scr);
    __syncthreads();
}
constexpr int NPP = 1472;
constexpr int NCU_E = (NPL - NPP) / 16, NCU_P = NPP / 16;
__device__ __forceinline__ void bg_conv_unit(Ctx& C, int l, int cu) {
    if (cu < NCU_E) conv_unit(C, l, NPP + cu * 16); else conv_unit(C, 1, (cu - NCU_E) * 16);
}
__device__ __forceinline__ void p0_adaln(Ctx& C) {
    LAS float* sc = (LAS float*)C.lds;
    LAS float* red = (LAS float*)(C.lds + 40960);
    float* MOD = WSP(float, WS_MOD);
    for (int u = C.bid; u < 256; u += C.G) {
        const int l = u >> 7, colbase = (u & 127) * 96;
        __syncthreads();
        for (int i = C.tid; i < 5 * DM; i += 512) { const int r = i >> 11, k = i & 2047; const float v = r < 4 ? INP(I_C)[r * DM + k] : INP(I_CCTX)[k]; sc[i] = silu_f(v); }
        __syncthreads();
        float acc[5][2];
#pragma unroll
        for (int r = 0; r < 5; ++r) { acc[r][0] = 0.f; acc[r][1] = 0.f; }
        const int ln = C.lane < 48 ? C.lane : 47;
        const float* wp = INP(I_WADA) + ((size_t)l * DM + C.wave * 256) * 12288 + colbase + 2 * ln;
#pragma unroll 1
        for (int k0 = 0; k0 < 256; k0 += 16) { f32x2 wv[16];
#pragma unroll
            for (int k = 0; k < 16; ++k) wv[k] = *(const f32x2*)(wp + (size_t)(k0 + k) * 12288);
#pragma unroll
            for (int k = 0; k < 16; ++k)
#pragma unroll
                for (int r = 0; r < 5; ++r) { const float s = sc[r * DM + C.wave * 256 + k0 + k]; acc[r][0] += s * wv[k].x; acc[r][1] += s * wv[k].y; } }
        if (C.lane < 48) {
#pragma unroll
            for (int r = 0; r < 5; ++r) { red[(C.wave * 5 + r) * 96 + 2 * C.lane] = acc[r][0]; red[(C.wave * 5 + r) * 96 + 2 * C.lane + 1] = acc[r][1]; } }
        __syncthreads();
        for (int i = C.tid; i < 480; i += 512) { const int r = i / 96, cc = i % 96; float s = INP(I_BADA)[l * 12288 + colbase + cc];
#pragma unroll
            for (int w = 0; w < 8; ++w) s += red[(w * 5 + r) * 96 + cc];
            MOD[(size_t)(l * 5 + r) * 12288 + colbase + cc] = s; }
    }
    __syncthreads();
}
__device__ __forceinline__ void p0_filters(Ctx& C) {
    LAS float* feat = (LAS float*)C.lds;
    LAS float* h1 = (LAS float*)(C.lds + 4096);
    LAS float* h2 = (LAS float*)(C.lds + 8192);
    volatile LAS int* qn = (volatile LAS int*)(C.lds + LDS_MISC + 32);
    unsigned* fctr = WSP(unsigned, WS_CTL) + CW_QUEUE + 20 * 64;
    for (int u = C.bid; u < 528; ) {
        int nxt = 528; if (C.tid == 0) nxt = (int)atomicAdd(fctr, 1u) + C.G;
        int l, L, tb; bf16* dst;
        if (u < 512) { l = u >> 8; tb = u & 255; L = SL; dst = WSP(bf16, WS_FILT) + (size_t)l * 2 * 512 * 8192; }
        else { l = 0; tb = u - 512; L = CL; dst = WSP(bf16, WS_FILTC); }
        const float invLm1 = 1.0f / (float)(L - 1);
        __syncthreads();
        LAS float* w1s = (LAS float*)(C.lds + 12288);
        LAS float* w2s = (LAS float*)(C.lds + 12288 + 33 * 64 * 4);
        for (int i = C.tid; i < 33 * 64; i += 512) w1s[i] = INP(I_HW1)[l * 33 * 64 + i];
        for (int i = C.tid; i < 64 * 64; i += 512) w2s[i] = INP(I_HW2)[l * 64 * 64 + i];
        for (int i = C.tid; i < 16 * 33; i += 512) { const int p = i / 33, j = i % 33; const int t = 16 * tb + p; float v;
            if (j == 0) v = (float)t * invLm1;
            else { const int fi = (j - 1) & 15; const float fr = 1e-4f + (float)fi * ((15.0f - 1e-4f) / 15.0f); const float ang = (6.283185307179586f / (float)L) * (float)t * fr; v = (j <= 16) ? cosf(ang) : -sinf(ang); }
            feat[i] = v; }
        __syncthreads();
        for (int i = C.tid; i < 1024; i += 512) { const int p = i >> 6, hh = i & 63; float s = INP(I_HB1)[l * 64 + hh];
#pragma unroll
            for (int j = 0; j < 33; ++j) s += feat[p * 33 + j] * w1s[j * 64 + hh];
            h1[i] = sinf(INP(I_HF1)[l * 64 + hh] * s); }
        __syncthreads();
        for (int i = C.tid; i < 1024; i += 512) { const int p = i >> 6, hh = i & 63; float s = INP(I_HB2)[l * 64 + hh];
#pragma unroll 16
            for (int j = 0; j < 64; ++j) s += h1[p * 64 + j] * w2s[j * 64 + hh];
            h2[i] = sinf(INP(I_HF2)[l * 64 + hh] * s); }
        __syncthreads();
        f32x2 acc2[16][2];
#pragma unroll
        for (int p = 0; p < 16; ++p) { acc2[p][0] = (f32x2){0.f, 0.f}; acc2[p][1] = (f32x2){0.f, 0.f}; }
#pragma unroll 4
        for (int k = 0; k < 64; k += 4) { f32x4 w[4];
#pragma unroll
            for (int kk = 0; kk < 4; ++kk) w[kk] = *(const f32x4*)(INP(I_HW3) + (size_t)(l * 64 + k + kk) * 2048 + 4 * C.tid);
#pragma unroll
            for (int p = 0; p < 16; ++p) { const f32x4 hq = *(const LAS f32x4*)(h2 + p * 64 + k);
#pragma unroll
                for (int kk = 0; kk < 4; ++kk) { const f32x2 hh = {hq[kk], hq[kk]}; acc2[p][0] += hh * (f32x2){w[kk][0], w[kk][1]}; acc2[p][1] += hh * (f32x2){w[kk][2], w[kk][3]}; } } }
        float acc[16][4];
#pragma unroll
        for (int p = 0; p < 16; ++p) { acc[p][0] = acc2[p][0].x; acc[p][1] = acc2[p][0].y; acc[p][2] = acc2[p][1].x; acc[p][3] = acc2[p][1].y; }
#pragma unroll
        for (int j = 0; j < 4; ++j) { const int col = 4 * C.tid + j, o = col >> 10, dir = (col >> 9) & 1, c = col & 511;
            const float delta = 4.605170186f * (1.0f / 1.5f + (float)c * ((1.0f / 0.3f - 1.0f / 1.5f) / 511.0f));
            bf16* d = dst + (size_t)(o * 512 + c) * (2 * L);
            float val[16];
#pragma unroll
            for (int p = 0; p < 16; ++p) { const int t = 16 * tb + p; val[p] = acc[p][j] * __expf(-(float)t * invLm1 * delta); }
            if (dir == 0) {
                u32x4 w0, w1; w0.x = pk2(val[15], val[14]); w0.y = pk2(val[13], val[12]); w0.z = pk2(val[11], val[10]); w0.w = pk2(val[9], val[8]);
                w1.x = pk2(val[7], val[6]); w1.y = pk2(val[5], val[4]); w1.z = pk2(val[3], val[2]); w1.w = pk2(val[1], val[0]);
                u32x4* q = (u32x4*)(d + L - 16 * (tb + 1)); q[0] = w0; q[1] = w1;
            } else if (tb == 0) {
#pragma unroll
                for (int p = 1; p < 16; ++p) d[L - 1 + p] = (bf16)(pk2(val[p], 0.f) & 0xffffu);
            } else {
                typedef u32x4 __attribute__((aligned(2))) u32x4_u;
                u32x4 w0, w1; w0.x = pk2(val[0], val[1]); w0.y = pk2(val[2], val[3]); w0.z = pk2(val[4], val[5]); w0.w = pk2(val[6], val[7]);
                w1.x = pk2(val[8], val[9]); w1.y = pk2(val[10], val[11]); w1.z = pk2(val[12], val[13]); w1.w = pk2(val[14], val[15]);
                u32x4_u* q = (u32x4_u*)(d + L - 1 + 16 * tb); q[0] = w0; q[1] = w1;
            }
            if (dir == 1 && 16 * (tb + 1) == L) d[2 * L - 1] = 0; }
        __syncthreads(); if (C.tid == 0) *qn = nxt; __syncthreads(); u = __builtin_amdgcn_readfirstlane(*qn);
    }
    __syncthreads();
}
__device__ __forceinline__ void p0_rope(Ctx& C) {
    { const int idx = C.bid * 512 + C.tid;
      for (int e = idx; e < 131072; e += C.G * 512) { const f32x2 v = *(const f32x2*)(INP(I_GWS) + 2 * (size_t)e); WSP(unsigned, WS_GWSB)[e] = pk2(v.x, v.y); } }
    { const int idx = C.bid * 512 + C.tid;
      for (int e = idx; e < 131072; e += C.G * 512) { const int i = e & 127, j = (e >> 7) & 127, lg = e >> 14, l = lg >> 2, gi = lg & 3;
          const float v = INP(I_POOLW)[(size_t)lg * 16384 + i * 128 + j] * INP(I_POOLS)[l * 512 + 128 * gi + j];
          WSP(bf16, WS_POOLWT)[e] = (bf16)(pk2(v, 0.f) & 0xffffu); } }
    if (C.bid == (C.G > 200 ? 200 : 0)) { f32x2* R = WSP(f32x2, WS_ROPE);
        for (int i = C.tid; i < 1024; i += 512) { const int pos = i >> 4, fi = i & 15; const float inv = powf(10000.0f, -(float)fi / 16.0f); const float a = (float)pos * inv; R[i] = (f32x2){cosf(a), sinf(a)}; } }
}

__device__ __forceinline__ const float* src_x0(Ctx& C, int row) {
    return row < NLAT ? INP(I_X) + (size_t)row * DM : INP(I_CTX) + (size_t)(row - NLAT) * DM;
}
__device__ __forceinline__ void row_load(const float* p, int lane, float (&v)[32]) {
#pragma unroll
    for (int j = 0; j < 4; ++j) { const f32x4 a = *(const f32x4*)(p + 512 * j + 8 * lane), b = *(const f32x4*)(p + 512 * j + 8 * lane + 4);
        v[8 * j] = a[0]; v[8 * j + 1] = a[1]; v[8 * j + 2] = a[2]; v[8 * j + 3] = a[3]; v[8 * j + 4] = b[0]; v[8 * j + 5] = b[1]; v[8 * j + 6] = b[2]; v[8 * j + 7] = b[3]; }
}
__device__ __forceinline__ void row_load_bf16(const bf16* p, int lane, float (&v)[32]) {
#pragma unroll
    for (int j = 0; j < 4; ++j) { const u32x4 r = *(const u32x4*)(p + 512 * j + 8 * lane);
        v[8 * j] = __uint_as_float(r.x << 16); v[8 * j + 1] = __uint_as_float(r.x & 0xffff0000u); v[8 * j + 2] = __uint_as_float(r.y << 16); v[8 * j + 3] = __uint_as_float(r.y & 0xffff0000u);
        v[8 * j + 4] = __uint_as_float(r.z << 16); v[8 * j + 5] = __uint_as_float(r.z & 0xffff0000u); v[8 * j + 6] = __uint_as_float(r.w << 16); v[8 * j + 7] = __uint_as_float(r.w & 0xffff0000u); }
}
__device__ __forceinline__ void row_store(float* p, int lane, const float (&v)[32]) {
#pragma unroll
    for (int j = 0; j < 4; ++j) { *(f32x4*)(p + 512 * j + 8 * lane) = (f32x4){v[8 * j], v[8 * j + 1], v[8 * j + 2], v[8 * j + 3]}; *(f32x4*)(p + 512 * j + 8 * lane + 4) = (f32x4){v[8 * j + 4], v[8 * j + 5], v[8 * j + 6], v[8 * j + 7]}; }
}
__device__ __forceinline__ void row_store_bf16(bf16* p, int lane, const float (&v)[32]) {
#pragma unroll
    for (int j = 0; j < 4; ++j) { u32x4 w; w.x = pk2(v[8 * j], v[8 * j + 1]); w.y = pk2(v[8 * j + 2], v[8 * j + 3]); w.z = pk2(v[8 * j + 4], v[8 * j + 5]); w.w = pk2(v[8 * j + 6], v[8 * j + 7]); *(u32x4*)(p + 512 * j + 8 * lane) = w; }
}
__device__ __forceinline__ void row_store_fp8(unsigned char* p, int lane, const float (&v)[32]) {
#pragma unroll
    for (int j = 0; j < 4; ++j) { u32x2 w; w.x = pk4_fp8(v[8 * j], v[8 * j + 1], v[8 * j + 2], v[8 * j + 3]); w.y = pk4_fp8(v[8 * j + 4], v[8 * j + 5], v[8 * j + 6], v[8 * j + 7]); *(u32x2*)(p + 512 * j + 8 * lane) = w; }
}
__device__ __forceinline__ void row_ln(float (&v)[32]) {
    float s = 0.f;
#pragma unroll
    for (int i = 0; i < 32; ++i) s += v[i];
    const float mean = wave_sum(s) * (1.0f / DM); float q = 0.f;
#pragma unroll
    for (int i = 0; i < 32; ++i) { v[i] -= mean; q += v[i] * v[i]; }
    const float rstd = 1.0f / sqrtf(wave_sum(q) * (1.0f / DM) + LN_EPS);
#pragma unroll
    for (int i = 0; i < 32; ++i) v[i] *= rstd;
}
__device__ __forceinline__ void row_affine(float (&v)[32], const float* mul, const float* add, int lane, float mul_off) {
    float a[32], b[32]; row_load(mul, lane, a); row_load(add, lane, b);
#pragma unroll
    for (int i = 0; i < 32; ++i) v[i] = v[i] * (a[i] + mul_off) + b[i];
}
__device__ __forceinline__ void row_load_lds(const LAS float* p, int lane, float (&v)[32]) {
#pragma unroll
    for (int j = 0; j < 4; ++j) { const f32x4 a = *(const LAS f32x4*)(p + 512 * j + 8 * lane), b = *(const LAS f32x4*)(p + 512 * j + 8 * lane + 4);
        v[8 * j] = a[0]; v[8 * j + 1] = a[1]; v[8 * j + 2] = a[2]; v[8 * j + 3] = a[3]; v[8 * j + 4] = b[0]; v[8 * j + 5] = b[1]; v[8 * j + 6] = b[2]; v[8 * j + 7] = b[3]; }
}
__device__ __forceinline__ void row_affine_lds(float (&v)[32], const LAS float* mul, const LAS float* add, int lane, float mul_off) {
    float a[32], b[32]; row_load_lds(mul, lane, a); row_load_lds(add, lane, b);
#pragma unroll
    for (int i = 0; i < 32; ++i) v[i] = v[i] * (a[i] + mul_off) + b[i];
}
__device__ __forceinline__ void stage2048(Ctx& C, LAS float* dst, const float* src) { *(LAS f32x4*)(dst + 4 * C.tid) = *(const f32x4*)(src + 4 * C.tid); }
__device__ __forceinline__ void ph_ln_mod(Ctx& C, int l, int nrows) {
    LAS float* PAR = (LAS float*)C.lds;
    const int r0 = (int)(((long)C.bid * nrows) / C.G), r1 = (int)(((long)(C.bid + 1) * nrows) / C.G);
    int cur_mrow = -1;
    for (int rb = r0 & ~7; rb < r1; rb += 8) {
        const int mrow = rb < NLAT ? rb / SL : 4; const float* mod = WSP(float, WS_MOD) + (size_t)(l * 5 + mrow) * 12288;
        if (mrow != cur_mrow) { __syncthreads(); stage2048(C, PAR, mod + 2048); stage2048(C, PAR + 2048, mod); cur_mrow = mrow; __syncthreads(); }
        const int row = rb + C.wave;
        if (row >= r0 && row < r1) {
            float v[32]; row_load(src_x0(C, row), C.lane, v); row_ln(v); row_affine_lds(v, PAR, PAR + 2048, C.lane, 1.0f);
            if (FP8_IN) row_store_fp8(WSP(unsigned char, WS_HA8) + (size_t)row * DM, C.lane, v); else row_store_bf16(WSP(bf16, WS_HB) + (size_t)row * DM, C.lane, v);
        }
    }
    __syncthreads();
}

__device__ __forceinline__ void cvt8(const u32x4 r, float (&f)[8]) { f[0] = bflo(r.x); f[1] = bfhi(r.x); f[2] = bflo(r.y); f[3] = bfhi(r.y); f[4] = bflo(r.z); f[5] = bfhi(r.z); f[6] = bflo(r.w); f[7] = bfhi(r.w); }
__device__ __forceinline__ void cvt8_fp8(const u32x2 r, float (&f)[8]) { const f32x2 a = __builtin_amdgcn_cvt_pk_f32_fp8((int)r.x, false), b = __builtin_amdgcn_cvt_pk_f32_fp8((int)r.x, true), c = __builtin_amdgcn_cvt_pk_f32_fp8((int)r.y, false), d = __builtin_amdgcn_cvt_pk_f32_fp8((int)r.y, true);
    f[0] = a.x; f[1] = a.y; f[2] = b.x; f[3] = b.y; f[4] = c.x; f[5] = c.y; f[6] = d.x; f[7] = d.y; }
__device__ __forceinline__ bf16x8 pack8(const float (&f)[8]) { u32x4 w; w.x = pk2(f[0], f[1]); w.y = pk2(f[2], f[3]); w.z = pk2(f[4], f[5]); w.w = pk2(f[6], f[7]); return __builtin_bit_cast(bf16x8, w); }
#define MFMA32(a, b, c) __builtin_amdgcn_mfma_f32_32x32x16_bf16((a), (b), (c), 0, 0, 0)

__device__ __forceinline__ void attn_unit(Ctx& C, int l, int uidx) {
    constexpr int KS = 144, VS = 272, VT_OFF = 128 * KS;
    const bool isctx = uidx >= 256;
    int b, kh, nb;
    if (!isctx) { b = uidx >> 6; kh = (uidx >> 5) & 1; nb = uidx & 31; } else { const int v = uidx - 256; b = v >> 2; kh = (v >> 1) & 1; nb = v & 1; }
    const int rowbase = isctx ? NLAT + b * CL : b * SL, crow = NLAT + b * CL;
    const int g = C.wave >> 1, th = C.wave & 1, head = kh * 4 + g, r32 = C.lane & 31, h = C.lane >> 5;
    const bf16* Z = WSP(bf16, WS_Z); const f32x2* ROPE = WSP(f32x2, WS_ROPE);
    bf16x8 Qf[2][4];
#pragma unroll
    for (int qb = 0; qb < 2; ++qb) {
        const int tq = 128 * nb + 64 * th + 32 * qb + r32;
        const bf16* qp = Z + (size_t)(rowbase + tq) * INW + 512 + 64 * head + 8 * h;
        float f[4][8];
#pragma unroll
        for (int s = 0; s < 4; ++s) cvt8(*(const u32x4*)(qp + 16 * s), f[s]);
        if (!isctx) {
            const int pr = tq >> 6, pc = tq & 63;
#pragma unroll
            for (int j = 0; j < 8; ++j) {
                const f32x2 cr = ROPE[pr * 16 + 8 * h + j], cc = ROPE[pc * 16 + 8 * h + j];
                const float a0 = f[0][j], b0 = f[1][j]; f[0][j] = a0 * cr.x - b0 * cr.y; f[1][j] = b0 * cr.x + a0 * cr.y;
                const float a1 = f[2][j], b1 = f[3][j]; f[2][j] = a1 * cc.x - b1 * cc.y; f[3][j] = b1 * cc.x + a1 * cc.y; }
        }
#pragma unroll
        for (int s = 0; s < 4; ++s) {
#pragma unroll
            for (int j = 0; j < 8; ++j) f[s][j] *= 0.125f * LOG2E;
            Qf[qb][s] = pack8(f[s]); }
    }
    float m_[2], l_[2]; f32x16 O[2][2];
    { const float sk = INP(I_SINK)[l * 8 + head] * LOG2E; m_[0] = sk; m_[1] = sk; l_[0] = 1.f; l_[1] = 1.f; }
#pragma unroll
    for (int a = 0; a < 2; ++a)
#pragma unroll
        for (int q = 0; q < 2; ++q)
#pragma unroll
            for (int i = 0; i < 16; ++i) O[a][q][i] = 0.f;
#define AT_VALID(tt_) ((tt_) >= 3 || ((nb - 1 + (tt_)) >= 0 && (nb - 1 + (tt_)) < SL / 128))
#define AT_KROW0(tt_) (((tt_) < 3) ? rowbase + 128 * (nb - 1 + (tt_)) : crow + 128 * ((tt_) - 3))
#define AT_PREFETCH(tt_) do { const int krow0_ = AT_KROW0(tt_); _Pragma("unroll") for (int r = 0; r < 2; ++r) { const int idx = C.tid + 512 * r, key = idx >> 3, cd = idx & 7; \
        const bf16* kp = Z + (size_t)(krow0_ + key) * INW + 1024 + 64 * kh; kraw[r] = *(const u32x4*)(kp + 8 * cd); if ((tt_) < 3) kpar[r] = *(const u32x4*)(kp + 8 * (cd ^ 2)); \
        vraw[r] = *(const u32x4*)(kp + 128 + 8 * cd); } } while (0)
    __syncthreads();
    u32x4 kraw[2], kpar[2], vraw[2];
    kpar[0] = (u32x4){0u, 0u, 0u, 0u}; kpar[1] = kpar[0];
    int tt = isctx ? 3 : (nb == 0 ? 1 : 0);
    AT_PREFETCH(tt);
    while (tt < 5) {
        int ntt = tt + 1; if (ntt < 3 && !AT_VALID(ntt)) ntt = 3;
        const bool band = tt < 3; const int kb = nb - 1 + tt;
        LDS_WAIT(); __builtin_amdgcn_s_barrier(); asm volatile("" ::: "memory");
#pragma unroll
        for (int r = 0; r < 2; ++r) {
            const int idx = C.tid + 512 * r, key = idx >> 3, cd = idx & 7;
            u32x4 raw = kraw[r];
            if (band) {
                float x[8], y[8]; cvt8(raw, x); cvt8(kpar[r], y);
                const int tk = 128 * kb + key, pos = (cd & 4) ? (tk & 63) : (tk >> 6), i0 = 8 * (cd & 1); const bool isb = (cd >> 1) & 1;
#pragma unroll
                for (int j = 0; j < 8; ++j) { const f32x2 cs = ROPE[pos * 16 + i0 + j]; x[j] = isb ? (x[j] * cs.x + y[j] * cs.y) : (x[j] * cs.x - y[j] * cs.y); }
                raw = __builtin_bit_cast(u32x4, pack8(x));
            }
            *(LAS u32x4*)(C.lds + key * KS + cd * 16) = raw;
            const u32x4 vr = vraw[r];
            LAS bf16* vt = (LAS bf16*)(C.lds + VT_OFF + (8 * cd) * VS + key * 2);
            vt[0] = (bf16)(vr.x & 0xffff); vt[VS / 2] = (bf16)(vr.x >> 16); vt[2 * (VS / 2)] = (bf16)(vr.y & 0xffff); vt[3 * (VS / 2)] = (bf16)(vr.y >> 16);
            vt[4 * (VS / 2)] = (bf16)(vr.z & 0xffff); vt[5 * (VS / 2)] = (bf16)(vr.z >> 16); vt[6 * (VS / 2)] = (bf16)(vr.w & 0xffff); vt[7 * (VS / 2)] = (bf16)(vr.w >> 16);
        }
        if (ntt < 5) AT_PREFETCH(ntt);
        LDS_WAIT(); __builtin_amdgcn_s_barrier(); asm volatile("" ::: "memory");
        const int sub_lo = (tt == 0) ? 2 * th : 0, sub_hi = (tt == 2) ? 2 * th + 1 : 3;
        for (int sub = sub_lo; sub <= sub_hi; ++sub) {
            bf16x8 Kf[4];
#pragma unroll
            for (int s = 0; s < 4; ++s) Kf[s] = *(const LAS bf16x8*)(C.lds + (32 * sub + r32) * KS + (16 * s + 8 * h) * 2);
            bf16x8 Pf[2][2];
#pragma unroll
            for (int qb = 0; qb < 2; ++qb) {
                f32x16 S;
#pragma unroll
                for (int i = 0; i < 16; ++i) S[i] = 0.f;
#pragma unroll
                for (int s = 0; s < 4; ++s) S = MFMA32(Kf[s], Qf[qb][s], S);
                const int tq = 128 * nb + 64 * th + 32 * qb + r32;
                float mx = -INFINITY; const int dq0 = tq - (128 * kb + 32 * sub + 4 * h);
#pragma unroll
                for (int i = 0; i < 16; ++i) { float x = S[i];
                    if (tt == 0 || tt == 2) { if ((unsigned)(dq0 - ((i & 3) + 8 * (i >> 2)) + 128) > 256u) x = -INFINITY; }
                    S[i] = x; mx = fmaxf(mx, x); }
                mx = xor32_max(mx);
                const float mnew = fmaxf(m_[qb], mx), alpha = __builtin_amdgcn_exp2f(m_[qb] - mnew);
                float rs = 0.f; float p[16];
#pragma unroll
                for (int i = 0; i < 16; ++i) { p[i] = __builtin_amdgcn_exp2f(S[i] - mnew); rs += p[i]; }
                rs = xor32_sum(rs);
                l_[qb] = l_[qb] * alpha + rs; m_[qb] = mnew;
                O[0][qb] = O[0][qb] * alpha; O[1][qb] = O[1][qb] * alpha;
#pragma unroll
                for (int s2 = 0; s2 < 2; ++s2) { float t8[8];
#pragma unroll
                    for (int j = 0; j < 8; ++j) t8[j] = p[8 * s2 + j];
                    Pf[qb][s2] = pack8(t8); }
            }
#pragma unroll
            for (int db = 0; db < 2; ++db)
#pragma unroll
                for (int s2 = 0; s2 < 2; ++s2) {
                    const LAS unsigned char* vp = C.lds + VT_OFF + (32 * db + r32) * VS + (32 * sub + 16 * s2 + 4 * h) * 2;
                    const u32x2 v0 = *(const LAS u32x2*)vp, v1 = *(const LAS u32x2*)(vp + 16);
                    const u32x4 vv = {v0.x, v0.y, v1.x, v1.y}; const bf16x8 Vf = __builtin_bit_cast(bf16x8, vv);
                    O[db][0] = MFMA32(Vf, Pf[0][s2], O[db][0]); O[db][1] = MFMA32(Vf, Pf[1][s2], O[db][1]);
                }
        }
        tt = ntt;
    }
#undef AT_VALID
#undef AT_KROW0
#undef AT_PREFETCH
    bf16* Y = WSP(bf16, WS_YCAT);
#pragma unroll
    for (int qb = 0; qb < 2; ++qb) {
        const int tq = 128 * nb + 64 * th + 32 * qb + r32; const float inv = 1.0f / l_[qb];
        bf16* yp = Y + (size_t)(rowbase + tq) * DM + 512 + 64 * head;
#pragma unroll
        for (int db = 0; db < 2; ++db)
#pragma unroll
            for (int rg = 0; rg < 4; ++rg) { u32x2 w; w.x = pk2(O[db][qb][4 * rg] * inv, O[db][qb][4 * rg + 1] * inv); w.y = pk2(O[db][qb][4 * rg + 2] * inv, O[db][qb][4 * rg + 3] * inv);
                *(u32x2*)(yp + 32 * db + 8 * rg + 4 * h) = w; }
    }
}

__device__ __forceinline__ void gmlp_unit(Ctx& C, int l, int uidx) {
    constexpr int VS = 272;
    const int ck = uidx >> 1, hf = uidx & 1, row0 = 128 * ck;
    const bf16* Z = WSP(bf16, WS_Z);
    const int gl = C.wave >> 1, ph = C.wave & 1, g = 4 * hf + gl, r32 = C.lane & 31, h = C.lane >> 5;
    bf16x8 Wf[2][8]; u32x2 upre[2][2][4];
    { const bf16* wsb = WSP(bf16, WS_GWSB) + ((size_t)(l * 8 + g) * 128 + 64 * ph + r32) * 128 + 8 * h;
#pragma unroll
      for (int pb = 0; pb < 2; ++pb)
#pragma unroll
          for (int s = 0; s < 8; ++s) Wf[pb][s] = *(const bf16x8*)(wsb + (size_t)(32 * pb) * 128 + 16 * s);
#pragma unroll
      for (int pb = 0; pb < 2; ++pb) { const bf16* up = Z + (size_t)(row0 + 64 * ph + 32 * pb + r32) * INW + 2816 + 64 * g + 4 * h;
#pragma unroll
          for (int cb = 0; cb < 2; ++cb)
#pragma unroll
              for (int rg = 0; rg < 4; ++rg) upre[pb][cb][rg] = *(const u32x2*)(up + 32 * cb + 8 * rg); } }
    __syncthreads();
    {
        const int tok = C.tid >> 2, part = C.tid & 3;
        const bf16* zp = Z + (size_t)(row0 + tok) * INW + 3328 + 128 * part;
        const bf16* zq = Z + (size_t)(row0 + tok) * INW + 3328 + 256 * hf + 64 * part;
        u32x4 r1[16], r2[8];
#pragma unroll
        for (int c8 = 0; c8 < 16; ++c8) r1[c8] = *(const u32x4*)(zp + 8 * c8);
#pragma unroll
        for (int c8 = 0; c8 < 8; ++c8) r2[c8] = *(const u32x4*)(zq + 8 * c8);
        float s = 0.f, q = 0.f;
#pragma unroll
        for (int c8 = 0; c8 < 16; ++c8) { float f[8]; cvt8(r1[c8], f);
#pragma unroll
            for (int j = 0; j < 8; ++j) { s += f[j]; q += f[j] * f[j]; } }
        s += dpp_f<DPP_XOR1>(s); s += dpp_f<DPP_XOR2>(s); q += dpp_f<DPP_XOR1>(q); q += dpp_f<DPP_XOR2>(q);
        const float mean = s * (1.0f / 512.0f); const float var = fmaxf(q * (1.0f / 512.0f) - mean * mean, 0.f); const float rstd = 1.0f / sqrtf(var + LN_EPS);
        const float* lg = INP(I_GLG) + l * 512 + 256 * hf + 64 * part; const float* lb = INP(I_GLB) + l * 512 + 256 * hf + 64 * part;
#pragma unroll
        for (int c8 = 0; c8 < 8; ++c8) { float f[8]; cvt8(r2[c8], f);
            const f32x4 g0 = *(const f32x4*)(lg + 8 * c8), g1 = *(const f32x4*)(lg + 8 * c8 + 4), b0 = *(const f32x4*)(lb + 8 * c8), b1 = *(const f32x4*)(lb + 8 * c8 + 4);
            const float gg[8] = {g0[0], g0[1], g0[2], g0[3], g1[0], g1[1], g1[2], g1[3]}, bb[8] = {b0[0], b0[1], b0[2], b0[3], b1[0], b1[1], b1[2], b1[3]};
#pragma unroll
            for (int j = 0; j < 8; ++j) { const float vn = (f[j] - mean) * rstd * gg[j] + bb[j];
                *(LAS bf16*)(C.lds + (64 * part + 8 * c8 + j) * VS + tok * 2) = (bf16)(pk2(vn, 0.f) & 0xffffu); } }
    }
    __syncthreads();
    f32x16 acc[2][2];
#pragma unroll
    for (int a = 0; a < 2; ++a)
#pragma unroll
        for (int b = 0; b < 2; ++b)
#pragma unroll
            for (int i = 0; i < 16; ++i) acc[a][b][i] = 0.f;
#pragma unroll
    for (int s = 0; s < 8; ++s) {
        bf16x8 Vf[2];
#pragma unroll
        for (int cb = 0; cb < 2; ++cb) Vf[cb] = *(const LAS bf16x8*)(C.lds + (64 * gl + 32 * cb + r32) * VS + (16 * s + 8 * h) * 2);
#pragma unroll
        for (int cb = 0; cb < 2; ++cb)
#pragma unroll
            for (int pb = 0; pb < 2; ++pb) acc[cb][pb] = MFMA32(Vf[cb], Wf[pb][s], acc[cb][pb]);
    }
    bf16* Y = WSP(bf16, WS_YCAT);
#pragma unroll
    for (int pb = 0; pb < 2; ++pb) { const int p = 64 * ph + 32 * pb + r32; const float bs = INP(I_GBS)[(l * 8 + g) * 128 + p];
        bf16* yp = Y + (size_t)(row0 + p) * DM + 1536 + 64 * g + 4 * h;
#pragma unroll
        for (int cb = 0; cb < 2; ++cb)
#pragma unroll
            for (int rg = 0; rg < 4; ++rg) { const u32x2 uv = upre[pb][cb][rg];
                u32x2 w; w.x = pk2(bflo(uv.x) * (acc[cb][pb][4 * rg] + bs), bfhi(uv.x) * (acc[cb][pb][4 * rg + 1] + bs)); w.y = pk2(bflo(uv.y) * (acc[cb][pb][4 * rg + 2] + bs), bfhi(uv.y) * (acc[cb][pb][4 * rg + 3] + bs));
                *(u32x2*)(yp + 32 * cb + 8 * rg) = w; } }
}

__device__ __forceinline__ void pool_unit(Ctx& C, int l, int blk) {
    constexpr int RS = 1040, DT_OFF = 48 * RS;
    const int row0 = 32 * blk;
    const int s0 = row0 < NLAT ? (row0 / SL) * SL : NLAT + ((row0 - NLAT) / CL) * CL, L = row0 < NLAT ? SL : CL, t0 = row0 - s0;
    const bf16* Z = WSP(bf16, WS_Z);
    __syncthreads();
    for (int idx = C.tid; idx < 48 * 64; idx += 512) { const int r = idx >> 6, ch = idx & 63, t = t0 - 8 + r; u32x4 v = {0u, 0u, 0u, 0u};
        if (t >= 0 && t < L) v = *(const u32x4*)(Z + (size_t)(s0 + t) * INW + 8 * ch);
        *(LAS u32x4*)(C.lds + r * RS + ch * 16) = v; }
    __syncthreads();
    {
        const int c8 = C.tid & 63, tg = C.tid >> 6, hw = 1 << (c8 >> 4);
#pragma unroll 1
        for (int k = 0; k < 4; ++k) { const int tt = 4 * tg + k, t = t0 + tt; const int lo = max(t - hw, 0), hi = min(t + hw, L);
            float sacc[8];
#pragma unroll
            for (int j = 0; j < 8; ++j) sacc[j] = 0.f;
            for (int q = lo; q < hi; ++q) { float f[8]; cvt8(*(const LAS u32x4*)(C.lds + (q - t0 + 8) * RS + c8 * 16), f);
#pragma unroll
                for (int j = 0; j < 8; ++j) sacc[j] += f[j]; }
            float cf[8]; cvt8(*(const LAS u32x4*)(C.lds + (tt + 8) * RS + c8 * 16), cf); const float inv = 1.0f / (float)(hi - lo);
#pragma unroll
            for (int j = 0; j < 8; ++j) sacc[j] = sacc[j] * inv - cf[j];
            *(LAS bf16x8*)(C.lds + DT_OFF + tt * RS + c8 * 16) = pack8(sacc); }
    }
    __syncthreads();
    const int gi = C.wave >> 1, oh = C.wave & 1, r32 = C.lane & 31, h = C.lane >> 5;
    f32x16 acc[2];
#pragma unroll
    for (int a = 0; a < 2; ++a)
#pragma unroll
        for (int i = 0; i < 16; ++i) acc[a][i] = 0.f;
    const bf16* wt = WSP(bf16, WS_POOLWT) + (size_t)((l * 4 + gi) * 128 + 64 * oh + r32) * 128 + 8 * h;
#pragma unroll
    for (int s = 0; s < 8; ++s) {
        const bf16x8 Bf = *(const LAS bf16x8*)(C.lds + DT_OFF + r32 * RS + (128 * gi + 16 * s + 8 * h) * 2);
#pragma unroll
        for (int rb = 0; rb < 2; ++rb) { const bf16x8 Af = *(const bf16x8*)(wt + (size_t)(32 * rb) * 128 + 16 * s); acc[rb] = MFMA32(Af, Bf, acc[rb]); }
    }
    bf16* yp = WSP(bf16, WS_YCAT) + (size_t)(row0 + r32) * DM + 128 * gi + 64 * oh;
#pragma unroll
    for (int rb = 0; rb < 2; ++rb)
#pragma unroll
        for (int rg = 0; rg < 4; ++rg) { u32x2 w; w.x = pk2(acc[rb][4 * rg], acc[rb][4 * rg + 1]); w.y = pk2(acc[rb][4 * rg + 2], acc[rb][4 * rg + 3]); *(u32x2*)(yp + 32 * rb + 8 * rg + 4 * h) = w; }
}

__device__ __forceinline__ void hyprep_unit(Ctx& C, int l, int uidx) {
    constexpr int RS = 528;
    int seq, tb, cb, L, rowbase; bf16* T;
    if (uidx < 1536) { seq = uidx / 384; const int rem = uidx % 384; tb = rem / 6; cb = rem % 6; L = SL; rowbase = seq * SL; T = WSP(bf16, WS_TL); }
    else { const int v = uidx - 1536; seq = v / 24; const int rem = v % 24; tb = rem / 6; cb = rem % 6; L = CL; rowbase = NLAT + seq * CL; T = WSP(bf16, WS_TC); }
    const int t0 = 64 * tb; const bf16* Z = WSP(bf16, WS_Z);
    __syncthreads();
    for (int idx = C.tid; idx < 66 * 32; idx += 512) { const int r = idx >> 5, ch = idx & 31, t = t0 - 1 + r; u32x4 v = {0u, 0u, 0u, 0u};
        if (t >= 0 && t < L) v = *(const u32x4*)(Z + (size_t)(rowbase + t) * INW + 1280 + 256 * cb + 8 * ch);
        *(LAS u32x4*)(C.lds + r * RS + ch * 16) = v; }
    __syncthreads();
    const int c = C.tid & 255, hf = C.tid >> 8, ch = 256 * cb + c, comp = ch >> 9, cc = ch & 511;
    const float w0 = INP(I_HCW)[(l * 3 + 0) * 1536 + ch], w1 = INP(I_HCW)[(l * 3 + 1) * 1536 + ch], w2 = INP(I_HCW)[(l * 3 + 2) * 1536 + ch], bias = INP(I_HCB)[l * 1536 + ch];
    bf16* dst = T + ((size_t)(comp * 512 + cc) * 4 + seq) * L + t0 + 32 * hf;
    float zm = bf1(*(const LAS bf16*)(C.lds + (32 * hf) * RS + c * 2)), zc = bf1(*(const LAS bf16*)(C.lds + (32 * hf + 1) * RS + c * 2));
#pragma unroll
    for (int k = 0; k < 4; ++k) { float o[8];
#pragma unroll
        for (int e = 0; e < 8; ++e) { const float zn = bf1(*(const LAS bf16*)(C.lds + (32 * hf + 8 * k + e + 2) * RS + c * 2)); o[e] = bias + w0 * zm + w1 * zc + w2 * zn; zm = zc; zc = zn; }
        u32x4 w; w.x = pk2(o[0], o[1]); w.y = pk2(o[2], o[3]); w.z = pk2(o[4], o[5]); w.w = pk2(o[6], o[7]); *(u32x4*)(dst + 8 * k) = w; }
}

template <int L>
__device__ __forceinline__ void hyena_unit(Ctx& C, int l, int c) {
    constexpr int NBLK = L / 32, NTILE = NBLK / 8, NTL = (NTILE >= 16) ? 2 : 1;
    constexpr int SB = 2 * L + 16, Z_OFF = 4 * SB, R_OFF = Z_OFF + 64, CSZ = 4 * L;
    const bf16* T = (L == SL) ? WSP(bf16, WS_TL) : WSP(bf16, WS_TC);
    const int r32 = C.lane & 31, h = C.lane >> 5;
    const bool active = (2 * C.wave < NTILE);
    const int qi = (r32 + 1) >> 2, ri = (r32 + 1) & 3, pcp = (4 - ri) & 3;
    const int laneA = R_OFF + pcp * CSZ + (pcp ? 8 + 64 * pcp : 0) - 8 * (qi + (ri ? 1 : 0)) + 16 * h;
    const int al = r32 >> 2, bb = r32 & 3;
    const int laneB = bb * SB + 16 * h;
    for (int o = 0; o < 2; ++o) {
        __syncthreads();
        if (o == 0) { const bf16* src = T + (size_t)(2 * 512 + c) * 4 * L;
            for (int idx = C.tid; idx < 4 * L / 8; idx += 512) { const int b = idx / (L / 8), tc = idx % (L / 8); *(LAS u32x4*)(C.lds + b * SB + tc * 16) = *(const u32x4*)(src + 8 * idx); }
            if (C.tid < 4) *(LAS u32x4*)(C.lds + Z_OFF + 16 * C.tid) = (u32x4){0u, 0u, 0u, 0u}; }
        { const bf16* fsrc = (L == SL) ? WSP(bf16, WS_FILT) + (size_t)((l * 2 + o) * 512 + c) * (2 * L) : WSP(bf16, WS_FILTC) + (size_t)(o * 512 + c) * (2 * L);
          for (int idx = C.tid; idx < L / 4; idx += 512) *(LAS u32x4*)(C.lds + R_OFF + 16 * idx) = *(const u32x4*)(fsrc + 8 * idx); }
        __syncthreads();
        for (int idx = C.tid; idx < 3 * (L / 2); idx += 512) { const int p = 1 + idx / (L / 2), w = idx % (L / 2); unsigned short e[4];
#pragma unroll
            for (int k = 0; k < 4; ++k) { const int n = 4 * w + p + k; e[k] = n < 2 * L ? *(const LAS bf16*)(C.lds + R_OFF + 2 * n) : (bf16)0; }
            *(LAS u32x2*)(C.lds + R_OFF + p * CSZ + 8 + 64 * p + 8 * w) = (u32x2){(unsigned)e[0] | ((unsigned)e[1] << 16), (unsigned)e[2] | ((unsigned)e[3] << 16)}; }
        __syncthreads();
        f32x16 acc[NTL];
#pragma unroll
        for (int t = 0; t < NTL; ++t)
#pragma unroll
            for (int i = 0; i < 16; ++i) acc[t][i] = 0.f;
        u32x2 gpre[NTL][4]; float skip = 0.f;
        if (active) { skip = INP(I_HSKIP)[(l * 2 + o) * 512 + c]; const bf16* gate_ = T + (size_t)(o * 512 + c) * 4 * L + (size_t)bb * L;
#pragma unroll
            for (int t = 0; t < NTL; ++t)
#pragma unroll
                for (int rg = 0; rg < 4; ++rg) gpre[t][rg] = *(const u32x2*)(gate_ + 32 * (8 * (2 * C.wave + t) + al) + 8 * rg + 4 * h); }
        if (active) {
            const int a0 = 8 * (2 * C.wave);
            const int m_lo = a0 - (NBLK - 1), m_hi = a0 + 8 * (NTL - 1) + 7;
            const int mA = m_hi - (NBLK - 1), mB = a0;
            int off8 = 8; asm volatile("" : "+v"(off8));
#define HY_STEP_CHK(m_) do { bf16x8 Af_[2]; \
                _Pragma("unroll") for (int s = 0; s < 2; ++s) { const LAS unsigned char* ap = C.lds + laneA + 2 * (L - 32 * (m_) + 16 * s); const u32x2 x0 = *(const LAS u32x2*)ap, x1 = *(const LAS u32x2*)(ap + off8); \
                    const u32x4 xx = {x0.x, x0.y, x1.x, x1.y}; Af_[s] = __builtin_bit_cast(bf16x8, xx); } \
                _Pragma("unroll") for (int t = 0; t < NTL; ++t) { const int q = a0 + 8 * t + al - (m_); const bool ok = (q >= 0) && (q < NBLK); \
                    _Pragma("unroll") for (int s = 0; s < 2; ++s) { const int addr = ok ? (laneB + 64 * q + 32 * s) : Z_OFF; const bf16x8 Bf_ = *(const LAS bf16x8*)(C.lds + addr); acc[t] = MFMA32(Af_[s], Bf_, acc[t]); } } } while (0)
#pragma unroll 1
            for (int m = m_lo; m < mA; ++m) HY_STEP_CHK(m);
            {
                int o1 = 8, o2 = 32, o3 = 40; asm volatile("" : "+v"(o1), "+v"(o2), "+v"(o3));
                const LAS unsigned char* pa0 = C.lds + laneA + 2 * (L - 32 * mA); const LAS unsigned char* pa1 = pa0 + o1; const LAS unsigned char* pa2 = pa0 + o2; const LAS unsigned char* pa3 = pa0 + o3;
                const LAS unsigned char* pb = C.lds + laneB + 64 * (a0 + al - mA);
#define HY_LOADF(Af_, Bf_) do { { const u32x2 x0 = *(const LAS u32x2*)pa0, x1 = *(const LAS u32x2*)pa1, x2 = *(const LAS u32x2*)pa2, x3 = *(const LAS u32x2*)pa3; \
                    const u32x4 xa = {x0.x, x0.y, x1.x, x1.y}, xb = {x2.x, x2.y, x3.x, x3.y}; Af_[0] = __builtin_bit_cast(bf16x8, xa); Af_[1] = __builtin_bit_cast(bf16x8, xb); } \
                _Pragma("unroll") for (int t = 0; t < NTL; ++t) _Pragma("unroll") for (int s = 0; s < 2; ++s) Bf_[t][s] = *(const LAS bf16x8*)(pb + 512 * t + 32 * s); \
                pa0 -= 64; pa1 -= 64; pa2 -= 64; pa3 -= 64; pb -= 64; asm volatile("" : "+v"(pa0), "+v"(pa1), "+v"(pa2), "+v"(pa3)); } while (0)
#define HY_MMA(Af_, Bf_) do { _Pragma("unroll") for (int s = 0; s < 2; ++s) _Pragma("unroll") for (int t = 0; t < NTL; ++t) acc[t] = MFMA32(Af_[s], Bf_[t][s], acc[t]); } while (0)
                int nfast = mB - mA + 1;
                if constexpr (NTL == 2) {
                    bf16x8 Bx[8][2], By[8][2];
#define HY_LOADA(Af_) do { const u32x2 x0 = *(const LAS u32x2*)pa0, x1 = *(const LAS u32x2*)pa1, x2 = *(const LAS u32x2*)pa2, x3 = *(const LAS u32x2*)pa3; \
                        const u32x4 xa = {x0.x, x0.y, x1.x, x1.y}, xb = {x2.x, x2.y, x3.x, x3.y}; Af_[0] = __builtin_bit_cast(bf16x8, xa); Af_[1] = __builtin_bit_cast(bf16x8, xb); \
                        pa0 -= 64; pa1 -= 64; pa2 -= 64; pa3 -= 64; asm volatile("" : "+v"(pa0), "+v"(pa1), "+v"(pa2), "+v"(pa3)); } while (0)
#define HY_GROUP(Bold, Bnew, more) do { _Pragma("unroll") for (int i = 0; i < 8; ++i) { bf16x8 An_[2] = {Ac_[0], Ac_[1]}; \
                        if (i < 7) { HY_LOADA(An_); Bnew[i + 1][0] = *(const LAS bf16x8*)(pb - 64 * (i + 1)); Bnew[i + 1][1] = *(const LAS bf16x8*)(pb - 64 * (i + 1) + 32); } \
                        else if (more) { HY_LOADA(An_); Bold[0][0] = *(const LAS bf16x8*)(pb - 512); Bold[0][1] = *(const LAS bf16x8*)(pb - 512 + 32); }        \
                        acc[0] = MFMA32(Ac_[0], Bnew[i][0], acc[0]); acc[1] = MFMA32(Ac_[0], Bold[i][0], acc[1]); acc[0] = MFMA32(Ac_[1], Bnew[i][1], acc[0]); acc[1] = MFMA32(Ac_[1], Bold[i][1], acc[1]); \
                        Ac_[0] = An_[0]; Ac_[1] = An_[1]; } \
                        pb -= 512; } while (0)
                    if (nfast >= 16) {
#pragma unroll
                        for (int i = 0; i < 8; ++i) { Bx[i][0] = *(const LAS bf16x8*)(pb + 512 - 64 * i); Bx[i][1] = *(const LAS bf16x8*)(pb + 512 - 64 * i + 32); }
                        bf16x8 Ac_[2]; HY_LOADA(Ac_); By[0][0] = *(const LAS bf16x8*)pb; By[0][1] = *(const LAS bf16x8*)(pb + 32);
#pragma unroll 1
                        while (nfast >= 16) { HY_GROUP(Bx, By, true); HY_GROUP(By, Bx, nfast >= 32); nfast -= 16; }
                    }
#undef HY_LOADA
#undef HY_GROUP
                }
                bf16x8 A0[2], B0[NTL][2], A1[2], B1[NTL][2];
                if (nfast > 0) {
                    int rem = nfast - 1;
                    HY_LOADF(A0, B0);
#pragma unroll 1
                    while (rem >= 2) { HY_LOADF(A1, B1); HY_MMA(A0, B0); HY_LOADF(A0, B0); HY_MMA(A1, B1); rem -= 2; }
                    if (rem == 1) { HY_LOADF(A1, B1); HY_MMA(A0, B0); HY_MMA(A1, B1); } else { HY_MMA(A0, B0); }
                }
#undef HY_LOADF
#undef HY_MMA
            }
#pragma unroll 1
            for (int m = mB + 1; m <= m_hi; ++m) HY_STEP_CHK(m);
#undef HY_STEP_CHK
        }
        __syncthreads();
        if (active) {
#pragma unroll
            for (int t = 0; t < NTL; ++t) { const int a = 8 * (2 * C.wave + t) + al;
#pragma unroll
                for (int rg = 0; rg < 4; ++rg) { const int t4 = 32 * a + 8 * rg + 4 * h;
                    LAS u32x2* up = (LAS u32x2*)(C.lds + bb * SB + t4 * 2); const u32x2 uo = *up; const u32x2 gv = gpre[t][rg];
                    const float v0 = bflo(gv.x) * (acc[t][4 * rg] + skip * bflo(uo.x)), v1 = bfhi(gv.x) * (acc[t][4 * rg + 1] + skip * bfhi(uo.x));
                    const float v2 = bflo(gv.y) * (acc[t][4 * rg + 2] + skip * bflo(uo.y)), v3 = bfhi(gv.y) * (acc[t][4 * rg + 3] + skip * bfhi(uo.y));
                    const u32x2 w = {pk2(v0, v1), pk2(v2, v3)};
                    if (o == 0) *up = w;
                    else { const int row = (L == SL) ? bb * SL + t4 : NLAT + bb * CL + t4; *(u32x2*)(WSP(bf16, WS_YHT) + (size_t)c * NTOK + row) = w; } } }
        }
    }
}

constexpr int RMS_GN_OFF = 34816;
__device__ __forceinline__ void rms_stage_gain(Ctx& C, int l) { __syncthreads(); stage2048(C, (LAS float*)(C.lds + RMS_GN_OFF), INP(I_MNG) + l * DM); __syncthreads(); }
__device__ __forceinline__ void rms_unit(Ctx& C, int l, int blk) {
    constexpr int RS = 1040;
    const int row0 = 32 * blk;
    const int tok = C.tid >> 4, sub = C.tid & 15;
    const bf16* Y = WSP(bf16, WS_YCAT) + (size_t)(row0 + tok) * DM + 32 * sub;
    u32x4 raw[3][4];
#pragma unroll
    for (int gi = 0; gi < 3; ++gi)
#pragma unroll
        for (int c8 = 0; c8 < 4; ++c8) raw[gi][c8] = *(const u32x4*)(Y + 512 * (gi == 2 ? 3 : gi) + 8 * c8);
    u32x4 hy[4];
    { const bf16* yh = WSP(bf16, WS_YHT);
#pragma unroll
      for (int k = 0; k < 4; ++k) { const int idx = C.tid + 512 * k, ch = idx >> 2, tc = idx & 3; hy[k] = *(const u32x4*)(yh + (size_t)ch * NTOK + row0 + 8 * tc); } }
    __syncthreads();
#pragma unroll
    for (int k = 0; k < 4; ++k) { const int idx = C.tid + 512 * k, ch = idx >> 2, tc = idx & 3; const u32x4 v = hy[k];
        LAS bf16* d = (LAS bf16*)(C.lds + (8 * tc) * RS + ch * 2);
        d[0] = (bf16)(v.x & 0xffff); d[RS / 2] = (bf16)(v.x >> 16); d[2 * (RS / 2)] = (bf16)(v.y & 0xffff); d[3 * (RS / 2)] = (bf16)(v.y >> 16);
        d[4 * (RS / 2)] = (bf16)(v.z & 0xffff); d[5 * (RS / 2)] = (bf16)(v.z >> 16); d[6 * (RS / 2)] = (bf16)(v.w & 0xffff); d[7 * (RS / 2)] = (bf16)(v.w >> 16); }
    __syncthreads();
    const LAS float* gn = (const LAS float*)(C.lds + RMS_GN_OFF);
    unsigned char* O = WSP(unsigned char, WS_HA8) + (size_t)(row0 + tok) * DM + 32 * sub;
#pragma unroll
    for (int gq = 0; gq < 4; ++gq) {
        float f[32]; float q = 0.f;
#pragma unroll
        for (int c8 = 0; c8 < 4; ++c8) { const u32x4 v = (gq == 2) ? *(const LAS u32x4*)(C.lds + tok * RS + (32 * sub + 8 * c8) * 2) : raw[gq == 3 ? 2 : gq][c8];
            float t8[8]; cvt8(v, t8);
#pragma unroll
            for (int j = 0; j < 8; ++j) { f[8 * c8 + j] = t8[j]; q += t8[j] * t8[j]; } }
        q = row16_sum(q);
        const float rs = 1.0f / sqrtf(q * (1.0f / 512.0f) + LN_EPS);
        const LAS float* gp = gn + 512 * gq + 32 * sub;
#pragma unroll
        for (int c8 = 0; c8 < 4; ++c8) { const f32x4 g0 = *(const LAS f32x4*)(gp + 8 * c8), g1 = *(const LAS f32x4*)(gp + 8 * c8 + 4);
            u32x2 w; w.x = pk4_fp8(f[8 * c8] * rs * g0[0], f[8 * c8 + 1] * rs * g0[1], f[8 * c8 + 2] * rs * g0[2], f[8 * c8 + 3] * rs * g0[3]);
            w.y = pk4_fp8(f[8 * c8 + 4] * rs * g1[0], f[8 * c8 + 5] * rs * g1[1], f[8 * c8 + 6] * rs * g1[2], f[8 * c8 + 7] * rs * g1[3]);
            *(u32x2*)(O + 512 * gq + 8 * c8) = w; }
        __builtin_amdgcn_sched_barrier(0);
    }
}

__device__ __forceinline__ void ph_post1(Ctx& C, int l, int nrows, bool dry = false) {
    LAS float* H2 = (LAS float*)C.lds;
    LAS float* RED = (LAS float*)(C.lds + 65536);
    LAS float* SGA = (LAS float*)(C.lds + 81920);
    LAS float* PAR = (LAS float*)(C.lds + 92160);
    unsigned* ctl = WSP(unsigned, WS_CTL);
    int nit = 0, cur_mrow = -1;
    const int nit_all = nrows / 8, it0 = (int)(((long)C.bid * nit_all) / C.G), it1 = (int)(((long)(C.bid + 1) * nit_all) / C.G);
    for (int it = it0; it < it1; ++it, ++nit) {
        const int row = it * 8 + C.wave;
        const int mrow = row < NLAT ? row / SL : 4; const float* mod = WSP(float, WS_MOD) + (size_t)(l * 5 + mrow) * 12288;
        __syncthreads();
        if (mrow != cur_mrow) { stage2048(C, PAR, mod + 4096); stage2048(C, PAR + 2048, INP(I_LN1G) + l * DM); stage2048(C, PAR + 4096, INP(I_LN1B) + l * DM); stage2048(C, PAR + 6144, mod + 8192); stage2048(C, PAR + 8192, mod + 6144); cur_mrow = mrow; __syncthreads(); }
        {
            float v[32], y[32], g1[32];
            if (l == 0) row_load(src_x0(C, row), C.lane, v); else row_load_bf16(WSP(bf16, WS_X) + (size_t)row * DM, C.lane, v);
            row_load_lds(PAR, C.lane, g1);
            { const bf16* yo = WSP(bf16, WS_YO) + (size_t)row * DM;
#pragma unroll
              for (int j = 0; j < 4; ++j) { float t8[8]; cvt8(*(const u32x4*)(yo + 512 * j + 8 * C.lane), t8);
#pragma unroll
                  for (int e = 0; e < 8; ++e) y[8 * j + e] = t8[e]; } }
#pragma unroll
            for (int i = 0; i < 32; ++i) v[i] = ALPHA * v[i] + g1[i] * y[i];
            row_ln(v); row_affine_lds(v, PAR + 2048, PAR + 4096, C.lane, 0.f);
            row_store_bf16(WSP(bf16, WS_X) + (size_t)row * DM, C.lane, v);
            row_ln(v); row_affine_lds(v, PAR + 6144, PAR + 8192, C.lane, 1.0f);
            row_store_fp8(WSP(unsigned char, WS_HB8) + (size_t)row * DM, C.lane, v);
#pragma unroll
            for (int j = 0; j < 4; ++j) { *(LAS f32x4*)(H2 + C.wave * DM + 512 * j + 8 * C.lane) = (f32x4){v[8 * j], v[8 * j + 1], v[8 * j + 2], v[8 * j + 3]};
                *(LAS f32x4*)(H2 + C.wave * DM + 512 * j + 8 * C.lane + 4) = (f32x4){v[8 * j + 4], v[8 * j + 5], v[8 * j + 6], v[8 * j + 7]}; }
        }
        __syncthreads();
        {
            const int e4 = C.lane & 7, cg = C.lane >> 3, cbase = 256 * C.wave + 32 * cg;
            f32x2 acc[8][2];
#pragma unroll
            for (int r = 0; r < 8; ++r) { acc[r][0] = (f32x2){0.f, 0.f}; acc[r][1] = (f32x2){0.f, 0.f}; }
            const float* wr = INP(I_WR) + (size_t)cbase * NE + 4 * e4;
#pragma unroll 2
            for (int cq = 0; cq < 32; cq += 4) {
                f32x4 w4[4];
#pragma unroll
                for (int k = 0; k < 4; ++k) w4[k] = *(const f32x4*)(wr + (size_t)(cq + k) * NE);
#pragma unroll
                for (int r = 0; r < 8; ++r) { const f32x4 hv = *(const LAS f32x4*)(H2 + r * DM + cbase + cq);
#pragma unroll
                    for (int k = 0; k < 4; ++k) { const f32x2 hh = {hv[k], hv[k]}; acc[r][0] += hh * (f32x2){w4[k][0], w4[k][1]}; acc[r][1] += hh * (f32x2){w4[k][2], w4[k][3]}; } } }
#pragma unroll
            for (int r = 0; r < 8; ++r)
#pragma unroll
                for (int k = 0; k < 2; ++k) { float x = acc[r][k].x, y = acc[r][k].y;
                    x += dpp_f<DPP_ROR8>(x); y += dpp_f<DPP_ROR8>(y); x = xor32_sum(xor16_sum(x)); y = xor32_sum(xor16_sum(y));
                    if (cg == 0) { RED[(C.wave * 8 + r) * 32 + 4 * e4 + 2 * k] = x; RED[(C.wave * 8 + r) * 32 + 4 * e4 + 2 * k + 1] = y; } }
        }
        __syncthreads();
        if (C.tid < 256) { const int r = C.tid >> 5, e = C.tid & 31; float s = 0.f;
#pragma unroll
            for (int p = 0; p < 8; ++p) s += RED[(p * 8 + r) * 32 + e];
            SGA[(nit * 8 + r) * 32 + e] = 1.0f / (1.0f + expf(-s)); }
    }
    __syncthreads();
    if (C.tid < nit * 8 && !dry) { const int r = C.tid, rw = (it0 + (r >> 3)) * 8 + (r & 7); float best = -INFINITY; int bg = 0;
        const LAS float* sg = SGA + r * 32; const float* rb = INP(I_RB);
        for (int gq = 0; gq < 8; ++gq) { const float a = sg[4 * gq] + rb[4 * gq], b = sg[4 * gq + 1] + rb[4 * gq + 1], c = sg[4 * gq + 2] + rb[4 * gq + 2], d = sg[4 * gq + 3] + rb[4 * gq + 3];
            const float hi1 = fmaxf(a, b), lo1 = fminf(a, b), hi2 = fmaxf(c, d), lo2 = fminf(c, d);
            const float top = fmaxf(hi1, hi2), second = fmaxf(fminf(hi1, hi2), (hi1 >= hi2) ? lo1 : lo2);
            const float sc = top + second; if (sc > best) { best = sc; bg = gq; } }
        int i0 = 0; float v0 = -INFINITY;
        for (int k = 0; k < 4; ++k) { const float x = sg[4 * bg + k] + rb[4 * bg + k]; if (x > v0) { v0 = x; i0 = k; } }
        int i1 = 0; float v1 = -INFINITY;
        for (int k = 0; k < 4; ++k) { const float x = sg[4 * bg + k] + rb[4 * bg + k]; if (k != i0 && x > v1) { v1 = x; i1 = k; } }
        const int e0 = 4 * bg + i0, e1 = 4 * bg + i1; const float w0 = sg[e0], w1 = sg[e1], ws = w0 + w1;
        const int p0 = (int)atomicAdd(ctl + CW_CNT + l * 2048 + e0 * 64, 1u), p1 = (int)atomicAdd(ctl + CW_CNT + l * 2048 + e1 * 64, 1u);
        WSP(int4, WS_TOKINFO)[rw] = make_int4(e0, p0, e1, p1); WSP(f32x2, WS_TOKW)[rw] = (f32x2){w0 / ws, w1 / ws};
        WSP(int, WS_EXPTOK)[(size_t)e0 * NTOK + p0] = rw; WSP(int, WS_EXPTOK)[(size_t)e1 * NTOK + p1] = rw; }
    __syncthreads();
}

__device__ __forceinline__ int moe_tables(Ctx& C, int l) {
    LAS int* T = (LAS int*)(C.lds + LDS_TAB);
    __syncthreads();
    if (C.tid < NE) { unsigned* ctl = WSP(unsigned, WS_CTL); T[200 + C.tid] = (int)__hip_atomic_load(ctl + CW_CNT + l * 2048 + C.tid * 64, __ATOMIC_RELAXED, __HIP_MEMORY_SCOPE_AGENT); }
    __syncthreads();
    if (C.tid == 0) { int nb = 0;
        for (int e = 0; e < NE; ++e) { const int cnt = T[200 + e]; T[168 + e] = nb; const int nbk = (cnt + 255) >> 8;
            for (int k = 0; k < nbk; ++k) if (nb + k < MAXBLK) T[nb + k] = e;
            nb += nbk; }
        T[232] = nb < MAXBLK ? nb : MAXBLK; }
    __syncthreads();
    return T[232];
}

__device__ __forceinline__ void ph_post2(Ctx& C, int l, int nrows) {
    const bool last = (l == 1);
    (void)moe_tables(C, l);
    const LAS int* T = (const LAS int*)(C.lds + LDS_TAB);
    LAS float* PAR = (LAS float*)C.lds;
    const int r0 = (int)(((long)C.bid * nrows) / C.G), r1 = (int)(((long)(C.bid + 1) * nrows) / C.G);
    int cur_mrow = -1;
    for (int rb = r0 & ~7; rb < r1; rb += 8) {
        const int mrow = rb < NLAT ? rb / SL : 4; const float* mod = WSP(float, WS_MOD) + (size_t)(l * 5 + mrow) * 12288;
        if (mrow != cur_mrow) { const float* modn = WSP(float, WS_MOD) + (size_t)((last ? l : l + 1) * 5 + mrow) * 12288;
            __syncthreads(); stage2048(C, PAR, mod + 10240); stage2048(C, PAR + 2048, INP(I_LN2G) + l * DM); stage2048(C, PAR + 4096, INP(I_LN2B) + l * DM); stage2048(C, PAR + 6144, modn + 2048); stage2048(C, PAR + 8192, modn); cur_mrow = mrow; __syncthreads(); }
        const int row = rb + C.wave;
        if (row >= r0 && row < r1) {
        const int4 ti = WSP(int4, WS_TOKINFO)[row]; const f32x2 tw = WSP(f32x2, WS_TOKW)[row];
        const int s0 = T[168 + ti.x] * 256 + ti.y, s1 = T[168 + ti.z] * 256 + ti.w;
        const unsigned char* y0 = WSP(unsigned char, WS_YS) + (size_t)s0 * DM; const unsigned char* y1 = WSP(unsigned char, WS_YS) + (size_t)s1 * DM;
        float v[32], g2[32]; row_load_bf16(WSP(bf16, WS_X) + (size_t)row * DM, C.lane, v); row_load_lds(PAR, C.lane, g2);
#pragma unroll
        for (int j = 0; j < 4; ++j) { float a[8], b[8]; cvt8_fp8(*(const u32x2*)(y0 + 512 * j + 8 * C.lane), a); cvt8_fp8(*(const u32x2*)(y1 + 512 * j + 8 * C.lane), b);
#pragma unroll
            for (int e = 0; e < 8; ++e) v[8 * j + e] = ALPHA * v[8 * j + e] + g2[8 * j + e] * ((tw.x * 0.0625f) * a[e] + (tw.y * 0.0625f) * b[e]); }
        row_ln(v); row_affine_lds(v, PAR + 2048, PAR + 4096, C.lane, 0.f);
        if (last) { row_store((float*)(C.out + (size_t)row * DM), C.lane, v); }
        else { row_store_bf16(WSP(bf16, WS_X) + (size_t)row * DM, C.lane, v);
            row_ln(v); row_affine_lds(v, PAR + 6144, PAR + 8192, C.lane, 1.0f);
            if (FP8_IN) row_store_fp8(WSP(unsigned char, WS_HA8) + (size_t)row * DM, C.lane, v); else row_store_bf16(WSP(bf16, WS_HB) + (size_t)row * DM, C.lane, v); }
        }
    }
}

constexpr int N_PHASES = 20;
__global__ void __launch_bounds__(512, 2) fwd_kernel(Args args) {
    extern __shared__ __attribute__((aligned(16))) unsigned char lds_raw[];
    Ctx C0; C0.lds = (LAS unsigned char*)lds_raw; C0.tid = threadIdx.x; C0.lane = C0.tid & 63; C0.wave = __builtin_amdgcn_readfirstlane(C0.tid >> 6); C0.bid = blockIdx.x; C0.G = gridDim.x;
    C0.in = (const float GAS* const __attribute__((address_space(4)))*)((const __attribute__((address_space(4))) Args*)__builtin_amdgcn_kernarg_segment_ptr())->in; C0.out = (float GAS*)args.out; C0.ws = (unsigned char GAS*)args.ws;
    volatile LAS unsigned* MISC = (volatile LAS unsigned*)(C0.lds + LDS_MISC);
    if (C0.tid < 4) MISC[C0.tid] = 0u;
    __syncthreads();
    XcdBarrier bar; bar.bar = (unsigned*)(unsigned GAS*)(C0.ws + WS_CTL) + CW_BAR; bar.x = 0; bar.st = nullptr;
    const int lo = args.ph_lo, hi = args.ph_hi;
    if (hi - lo > 1) bar = xcd_barrier_post((unsigned*)(unsigned GAS*)(C0.ws + WS_CTL) + CW_BAR, MISC);
#ifdef ONLY
#define IN(k) ((k) == ONLY)
#define INL(j) ((j) + 2 == ONLY)
#define SEAM(k) do { } while (0)
#else
#define IN(k) (lo <= (k) && (k) < hi)
#define INL(j) IN(pb + (j))
#define SEAM(k) do { if (IN(k) && IN((k) + 1)) xcd_barrier(bar); } while (0)
#endif

    if (IN(0)) { _Pragma("unroll") for (int rep = 0; rep < NREP(0); ++rep) { if (rep) xcd_barrier(bar); FRESH(D, C0);
        if (D.bid & 1) { p0_filters(D); p0_adaln(D); } else { p0_adaln(D); p0_filters(D); }        p0_rope(D); __syncthreads(); p0_convert(D, 0, 1472); } }
    SEAM(0);
    if (IN(1)) { _Pragma("unroll") for (int rep = 0; rep < NREP(1); ++rep) { if (rep) xcd_barrier(bar); FRESH(D, C0); ph_ln_mod(D, 0, NTOK); } }
    SEAM(1);
#define LAYER_BODY(l) do { \
        const int pb = 2 + 9 * l; const bool last = (l == 1); const int nrows = last ? NLAT : NTOK; \
        if (INL(0)) { _Pragma("unroll") for (int rep = 0; rep < NREP(2 + 9 * l + 0); ++rep) { if (rep) xcd_barrier(bar); \
            FRESH(C, C0); \
            pg8::Gemm g{FP8_IN ? (const bf16*)WSP(unsigned char, WS_HA8) : WSP(bf16, WS_HB), FP8_IN ? (const bf16*)(WSP(unsigned char, WS_WIN) + (size_t)l * INW * DM) : WSP(bf16, WS_WIN) + (size_t)l * INW * DM, FP8_IN ? DM / 2 : DM}; \
            pg8::DenseOrder S; S.init(NTOK, INW, C.G, C.bid); \
            pg8::EpiBf16 E{WSP(bf16, WS_Z), INW, 11}; \
            pg8::gemm_phase<pg8::EpiBf16, pg8::DenseOrder, false, FP8_IN != 0>(C.lds, g, S, E); \
        } \
        } SEAM(pb + 0); \
        if (INL(1)) { _Pragma("unroll") for (int rep = 0; rep < NREP(2 + 9 * l + 1); ++rep) { if (rep) xcd_barrier(bar); \
            const int n_attn = last ? 256 : 272, n_gmlp = last ? 256 : 272, n_pool = last ? 512 : 544, n_hyp = last ? 1536 : 1632; \
            { FRESH(C, C0); \
                \
              volatile LAS int* qn = (volatile LAS int*)(C.lds + LDS_MISC + 32); \
              unsigned* qctr = WSP(unsigned, WS_CTL) + CW_QUEUE + (l * 2 + rep) * 64; \
              const int b0 = 256, b1 = b0 + n_gmlp, b2 = b1 + (n_attn - 256), b3 = b2 + n_pool, total = b3 + n_hyp; \
              volatile LAS int* qc = (volatile LAS int*)(C.lds + LDS_MISC + 36); \
              unsigned* cctr = WSP(unsigned, WS_CTL) + CW_QUEUE + (4 + rep) * 64; \
              int u = C.bid, cu = (last || C.bid >= CONV_SPLIT) ? NCU : C.bid;        \
              while (u < total || cu < NCU) { \
                  int nxt = total, nxc = NCU; \
                  if (C.tid == 0) { if (u < total) nxt = (int)atomicAdd(qctr, 1u) + C.G; if (cu < NCU) { nxc = (int)atomicAdd(cctr, 1u) + C.G; if (nxc >= CONV_SPLIT) nxc = NCU; } } \
                  if (u < total) { FRESH(Cu, C); if (u < b0) attn_unit(Cu, l, u); else if (u < b1) gmlp_unit(Cu, l, u - b0); else if (u < b2) attn_unit(Cu, l, 256 + u - b1); else if (u < b3) pool_unit(Cu, l, u - b2); else hyprep_unit(Cu, l, u - b3); } \
                  if (cu < NCU) { FRESH(Cu, C); conv_unit(Cu, 1, cu * 16); } \
                  __syncthreads(); if (C.tid == 0) { *qn = nxt; *qc = nxc; } __syncthreads(); u = __builtin_amdgcn_readfirstlane(*qn); cu = __builtin_amdgcn_readfirstlane(*qc); \
              } } \
        } \
        } SEAM(pb + 1); \
        if (INL(2)) { _Pragma("unroll") for (int rep = 0; rep < NREP(2 + 9 * l + 2); ++rep) { if (rep) xcd_barrier(bar); \
            { FRESH(C, C0);        \
              volatile LAS int* qc = (volatile LAS int*)(C.lds + LDS_MISC + 36); \
              unsigned* cctr = WSP(unsigned, WS_CTL) + CW_QUEUE + (6 + 2 * l + rep) * 64; \
              const int nhu = last ? 512 : 1024, ncu = last ? NCU_E : NCU_E + NCU_P; \
              int hu = C.bid, cu = C.bid; \
              while (hu < nhu || cu < ncu) { \
                  int nxc = ncu; if (C.tid == 0 && cu < ncu) nxc = (int)atomicAdd(cctr, 1u) + C.G; \
                  if ((C.bid & 1) && cu < ncu) { FRESH(Cu, C); bg_conv_unit(Cu, l, cu); }        \
                  if (hu < nhu) { FRESH(Cu, C); if (hu < 512) hyena_unit<SL>(Cu, l, hu); else hyena_unit<CL>(Cu, l, hu - 512); hu += C.G; } \
                  if (!(C.bid & 1) && cu < ncu) { FRESH(Cu, C); bg_conv_unit(Cu, l, cu); } \
                  __syncthreads(); if (C.tid == 0) *qc = nxc; __syncthreads(); cu = __builtin_amdgcn_readfirstlane(*qc); \
              } } \
        } \
        } SEAM(pb + 2); \
        if (INL(3)) { _Pragma("unroll") for (int rep = 0; rep < NREP(2 + 9 * l + 3); ++rep) { if (rep) xcd_barrier(bar); FRESH(C, C0); rms_stage_gain(C, l); for (int u = C.bid; u < nrows / 32; u += C.G) { FRESH(Cu, C); rms_unit(Cu, l, u); } } \
        } SEAM(pb + 3); \
        if (INL(4)) { _Pragma("unroll") for (int rep = 0; rep < NREP(2 + 9 * l + 4); ++rep) { if (rep) xcd_barrier(bar); \
            FRESH(C, C0); \
            pg8::Gemm g{FP8_OUT ? (const bf16*)WSP(unsigned char, WS_HA8) : WSP(bf16, WS_HB), FP8_OUT ? (const bf16*)(WSP(unsigned char, WS_WOUT) + (size_t)l * DM * DM) : WSP(bf16, WS_WOUT) + (size_t)l * DM * DM, FP8_OUT ? DM / 2 : DM}; \
            pg8::DenseOrder S; S.init(nrows, DM, C.G, C.bid); \
            pg8::EpiBf16 E{WSP(bf16, WS_YO), DM, 1 << 30}; \
            pg8::gemm_phase<pg8::EpiBf16, pg8::DenseOrder, false, FP8_OUT != 0>(C.lds, g, S, E); \
        } \
        } SEAM(pb + 4); \
        if (INL(5)) { FRESH(C, C0); ph_post1(C, l, nrows); if (PROBE_P1 && l == 0) { xcd_barrier(bar); FRESH(C2, C0); ph_post1(C2, l, nrows, true); } } \
        SEAM(pb + 5); \
        if (INL(6)) { _Pragma("unroll") for (int rep = 0; rep < NREP(2 + 9 * l + 6); ++rep) { if (rep) xcd_barrier(bar); \
            FRESH(C, C0); \
            const int nblk = moe_tables(C, l); const LAS int* T = (const LAS int*)(C.lds + LDS_TAB); \
            pg8::Gemm g{(const bf16*)WSP(unsigned char, WS_HB8), (const bf16*)(WSP(unsigned char, WS_WGU) + (size_t)l * NE * 1536 * DM), DM / 2}; \
            pg8::MoeOrder S; S.nblk = nblk; S.nN = 6; S.G = C.G; S.c = C.bid; S.blk_e = T; S.bst = T + 168; S.cnt = T + 200; S.exptok = WSP(int, WS_EXPTOK); S.ntok = NTOK; \
            pg8::EpiGLU E{WSP(unsigned char, WS_HG), DE}; \
            pg8::gemm_phase<pg8::EpiGLU, pg8::MoeOrder, true, true>(C.lds, g, S, E); \
        } } \
        SEAM(pb + 6); \
        if (INL(7)) { _Pragma("unroll") for (int rep = 0; rep < NREP(2 + 9 * l + 7); ++rep) { if (rep) xcd_barrier(bar); \
            FRESH(C, C0); \
            const int nblk = moe_tables(C, l); const LAS int* T = (const LAS int*)(C.lds + LDS_TAB); \
            pg8::Gemm g{(const bf16*)WSP(unsigned char, WS_HG), (const bf16*)(WSP(unsigned char, WS_WD) + (size_t)l * NE * DM * DE), DE / 2}; \
            pg8::MoeOrder S; S.nblk = nblk; S.nN = 8; S.G = C.G; S.c = C.bid; S.blk_e = T; S.bst = T + 168; S.cnt = T + 200; S.exptok = WSP(int, WS_EXPTOK); S.ntok = NTOK; \
            pg8::EpiFp8 E{WSP(unsigned char, WS_YS), DM, 16.0f}; \
            pg8::gemm_phase<pg8::EpiFp8, pg8::MoeOrder, false, true>(C.lds, g, S, E); \
        } } \
        SEAM(pb + 7); \
        if (INL(8)) { FRESH(C, C0); ph_post2(C, l, nrows); if (PROBE_P2 && l == 1) { xcd_barrier(bar); FRESH(C2, C0); ph_post2(C2, l, nrows); } } \
        SEAM(pb + 8); \
} while (0)
    LAYER_BODY(0);
    LAYER_BODY(1);
#undef IN
#undef INL
#undef SEAM
}

extern "C" void kernel_launch(void* const* d_in, const int* in_sizes, int n_in, void* d_out, int out_size, void* d_ws, size_t ws_size, hipStream_t stream) {
    static int grid = 0;
    if (grid == 0) {
        if (n_in != 35 || out_size != NLAT * DM || ws_size < WS_END) { fprintf(stderr, "kernel_launch: unexpected shapes (n_in %d out %d ws %zu)\n", n_in, out_size, ws_size); grid = -1; return; }
        int dev = 0, cus = 0;
        if (hipGetDevice(&dev) != hipSuccess || hipDeviceGetAttribute(&cus, hipDeviceAttributeMultiprocessorCount, dev) != hipSuccess) { grid = -1; return; }
        if (hipFuncSetAttribute((const void*)fwd_kernel, hipFuncAttributeMaxDynamicSharedMemorySize, LDS_BYTES) != hipSuccess) { fprintf(stderr, "kernel_launch: hipFuncSetAttribute failed\n"); grid = -1; return; }
        int per_cu = 0;
        if (hipOccupancyMaxActiveBlocksPerMultiprocessor(&per_cu, (const void*)fwd_kernel, 512, LDS_BYTES) != hipSuccess || per_cu < 1) fprintf(stderr, "kernel_launch: occupancy query says %d\n", per_cu);
        (void)hipGetLastError();
        grid = cus;
    }
    if (grid < 0) return;
    (void)hipMemsetAsync((char*)d_ws + WS_CTL, 0, CTL_ZERO_BYTES, stream);
    Args a{};
    for (int i = 0; i < 35; ++i) a.in[i] = (const float*)d_in[i];
    a.out = (float*)d_out; a.ws = (unsigned char*)d_ws;
    if (MK_N_LAUNCHES == 1) { a.ph_lo = 0; a.ph_hi = N_PHASES; hipLaunchKernelGGL(fwd_kernel, dim3(grid), dim3(512), LDS_BYTES, stream, a); }
    else for (int p = 0; p < N_PHASES; ++p) { a.ph_lo = p; a.ph_hi = p + 1; hipLaunchKernelGGL(fwd_kernel, dim3(grid), dim3(512), LDS_BYTES, stream, a); }
}
```

```cpp
#include <hip/hip_runtime.h>
#include <cstdio>
#include <cstdint>

#ifndef DUP_MASK
#define DUP_MASK 0u
#endif
#ifndef PROBE_P1
#define PROBE_P1 0
#endif
#ifndef PROBE_P2
#define PROBE_P2 0
#endif
#ifndef FP8_IN
#define FP8_IN 1
#endif
#ifndef FP8_OUT
#define FP8_OUT 1
#endif
#ifndef PROBE_P0
#define PROBE_P0 0
#endif
#ifndef PROBE_CONV
#define PROBE_CONV 0
#endif
#ifndef DUP_SUB
#define DUP_SUB 0u
#endif
#define NSUB(k) (((DUP_SUB >> (k)) & 1u) ? 2 : 1)
#define NREP(k) (((DUP_MASK >> (k)) & 1u) ? 2 : 1)
#ifndef MK_N_LAUNCHES
#define MK_N_LAUNCHES 1
#endif

#define LAS __attribute__((address_space(3)))
#define GAS __attribute__((address_space(1)))
typedef unsigned short bf16;
typedef short bf16x8 __attribute__((ext_vector_type(8)));
typedef float f32x2 __attribute__((ext_vector_type(2)));
typedef float f32x4 __attribute__((ext_vector_type(4)));
typedef float f32x16 __attribute__((ext_vector_type(16)));
typedef unsigned u32x2 __attribute__((ext_vector_type(2)));
typedef unsigned u32x4 __attribute__((ext_vector_type(4)));
typedef __bf16 bf16x2_t __attribute__((ext_vector_type(2)));

constexpr int DM = 2048, NB = 4, SL = 4096, CL = 256, NLAT = NB * SL, NCTX = NB * CL, NTOK = NLAT + NCTX;
constexpr int INW = 3840, DE = 768, NE = 32, MAXBLK = 168;
constexpr float LN_EPS = 1e-6f, ALPHA = 1.41421356237f, LOG2E = 1.44269504089f;

constexpr size_t MiB = 1u << 20;
constexpr size_t WS_CTL = 0, CTL_ZERO_BYTES = 1 * MiB;
constexpr size_t WS_MOD = 1 * MiB;
constexpr size_t WS_ROPE = 2 * MiB;
constexpr size_t WS_TOKINFO = 2 * MiB + 65536;
constexpr size_t WS_TOKW = WS_TOKINFO + (size_t)NTOK * 16;
constexpr size_t WS_ROWSLOT = WS_TOKW + (size_t)NTOK * 8;
constexpr size_t WS_SLOTW = WS_ROWSLOT + (size_t)NTOK * 8;
static_assert(WS_SLOTW + 43008 * 4 <= 4 * MiB, "small tables");
constexpr size_t WS_POOLWT = 3 * MiB;
constexpr size_t WS_GWSB = 3 * MiB + 512 * 1024;
constexpr size_t WS_WIN = 4 * MiB;
constexpr size_t WS_WOUT = 34 * MiB;
constexpr size_t WS_WGU = 50 * MiB;
constexpr size_t WS_WD = 434 * MiB;
constexpr size_t WS_FILT = 626 * MiB;
constexpr size_t WS_FILTC = 658 * MiB;
constexpr size_t WS_X = 660 * MiB;
constexpr size_t WS_HB = 796 * MiB;
constexpr size_t WS_Z = 864 * MiB;
constexpr size_t WS_YCAT = 992 * MiB;
constexpr size_t WS_TL = 1060 * MiB;
constexpr size_t WS_TC = 1108 * MiB;
constexpr size_t WS_YHT = 1112 * MiB;
constexpr size_t WS_YO = 1129 * MiB;
constexpr size_t WS_EXPTOK = 864 * MiB;
constexpr size_t WS_HG = 1032 * MiB;
constexpr size_t WS_YS = 1095 * MiB;
constexpr size_t WS_HB8 = 1265 * MiB;
constexpr size_t WS_HA8 = 1300 * MiB;
constexpr size_t WS_END = 1334 * MiB;
constexpr int CW_BAR = 4096;
constexpr int CW_CNT = 8192;
constexpr int CW_QUEUE = 14336;
constexpr int CW_NBLK = 12288;
constexpr int CW_BLKE = 12544;
constexpr int LDS_TAB = 132096;
constexpr int LDS_BYTES = 147456;
constexpr int LDS_MISC = 147392;

__device__ __forceinline__ unsigned pk2(float lo, float hi) { f32x2 v = {lo, hi}; bf16x2_t b = __builtin_convertvector(v, bf16x2_t); return __builtin_bit_cast(unsigned, b); }
__device__ __forceinline__ unsigned pk4_fp8(float a, float b, float c, float d) { int p = 0; p = __builtin_amdgcn_cvt_pk_fp8_f32(a, b, p, false); p = __builtin_amdgcn_cvt_pk_fp8_f32(c, d, p, true); return (unsigned)p; }
__device__ __forceinline__ float bflo(unsigned w) { return __uint_as_float(w << 16); }
__device__ __forceinline__ float bfhi(unsigned w) { return __uint_as_float(w & 0xffff0000u); }
__device__ __forceinline__ float bf1(bf16 v) { return __uint_as_float(((unsigned)v) << 16); }
template <int CTRL> __device__ __forceinline__ float dpp_f(float x) { return __int_as_float(__builtin_amdgcn_update_dpp(0, __float_as_int(x), CTRL, 0xF, 0xF, true)); }
#define DPP_XOR1 0xB1
#define DPP_XOR2 0x4E
#define DPP_HMIRROR 0x141
#define DPP_MIRROR 0x140
#define DPP_ROR8 0x128
__device__ __forceinline__ float xor16_sum(float x) { const auto r = __builtin_amdgcn_permlane16_swap(__float_as_uint(x), __float_as_uint(x), false, false); return __uint_as_float(r[0]) + __uint_as_float(r[1]); }
__device__ __forceinline__ float xor32_sum(float x) { const auto r = __builtin_amdgcn_permlane32_swap(__float_as_uint(x), __float_as_uint(x), false, false); return __uint_as_float(r[0]) + __uint_as_float(r[1]); }
__device__ __forceinline__ float xor32_max(float x) { const auto r = __builtin_amdgcn_permlane32_swap(__float_as_uint(x), __float_as_uint(x), false, false); return fmaxf(__uint_as_float(r[0]), __uint_as_float(r[1])); }
__device__ __forceinline__ float row16_sum(float v) { v += dpp_f<DPP_XOR1>(v); v += dpp_f<DPP_XOR2>(v); v += dpp_f<DPP_HMIRROR>(v); v += dpp_f<DPP_MIRROR>(v); return v; }
__device__ __forceinline__ float wave_sum(float v) { return xor32_sum(xor16_sum(row16_sum(v))); }
__device__ __forceinline__ float gelu_tanh(float x) { const float y = 0.7978845608f * (x + 0.044715f * x * x * x); const float t = __expf(2.0f * y); return 0.5f * x * (2.0f - 2.0f * __builtin_amdgcn_rcpf(t + 1.0f)); }
__device__ __forceinline__ float silu_f(float x) { return x * __builtin_amdgcn_rcpf(1.0f + __expf(-x)); }
#define LDS_WAIT() asm volatile("s_waitcnt lgkmcnt(0)" ::: "memory")
#define VM_WAIT() asm volatile("s_waitcnt vmcnt(0)" ::: "memory")

namespace pg8 {
#define PG8_LAS __attribute__((address_space(3)))
typedef unsigned short bf16_t;
constexpr int BM = 256, BK = 64, HALF = 128, HTB = HALF * BK * 2, STAGE_BYTES = 8 * HTB, NXCD = 8, WGM = 8;
__host__ __device__ __forceinline__ int lds_byte(int r, int c) { const int st = (r >> 4) * 2 + (c >> 5), rr = r & 15, cc = c & 31, ob = rr * 64 + cc * 2; return st * 1024 + (ob ^ (((ob >> 9) & 1) << 5)); }
__host__ __device__ __forceinline__ void stage_rc(int b, int& R, int& C) { const int st = b / 1024, sb = b % 1024, swz = sb ^ (((sb >> 9) & 1) << 5); R = (st >> 1) * 16 + swz / 64; C = (st & 1) * 32 + (swz % 64) / 2; }
__host__ __device__ __forceinline__ int perm32(int rho) { const int n = rho >> 4, i = rho & 15; return 8 * (i >> 2) + 4 * n + (i & 3); }

struct Unit { int pm, pn, pb; const int* amap; int nvalid; };
struct Gemm { const bf16_t* A; const bf16_t* Bt; int K; };

struct DenseOrder {
    int nM, nN, nwg, G, c;
    __device__ void init(int M, int N, int G_, int c_) { nM = M / BM; nN = N / BM; nwg = nM * nN; G = G_; c = c_; }
    __device__ bool next(int i, Unit& u) const {
        const long L = (long)i * G + c; if (L >= nwg) return false;
        int wgid = (int)L; { const int q = nwg / NXCD, r = nwg % NXCD, xcd = wgid % NXCD, off = wgid / NXCD; wgid = (xcd < r ? xcd * (q + 1) : r * (q + 1) + (xcd - r) * q) + off; }
        const int nig = WGM * nN, gid = wgid / nig, fm = gid * WGM, gsz = (nM - fm) < WGM ? (nM - fm) : WGM;
        u.pm = fm + ((wgid % nig) % gsz); u.pn = (wgid % nig) / gsz; u.pb = u.pn; u.amap = nullptr; u.nvalid = 0; return true;
    }
    __device__ __forceinline__ void a_ready(const Unit&) const {}
    __device__ __forceinline__ void done(const Unit&) const {}
};
struct MoeOrder {
    int nblk, nN, G, c; const PG8_LAS int* blk_e; const PG8_LAS int* bst; const PG8_LAS int* cnt; const int* exptok; int ntok;
    __device__ bool next(int i, Unit& u) const {
        const long L = (long)i * G + c; const int nwg = nblk * nN; if (L >= nwg) return false;
        int wgid = (int)L; { const int q = nwg / NXCD, r = nwg % NXCD, xcd = wgid % NXCD, off = wgid / NXCD; wgid = (xcd < r ? xcd * (q + 1) : r * (q + 1) + (xcd - r) * q) + off; }
        const int blk = wgid / nN, pn = wgid % nN, e = blk_e[blk], p0 = (blk - bst[e]) * 256;
        u.pm = blk; u.pn = pn; u.pb = e * nN + pn; u.amap = exptok + (size_t)e * ntok + p0; u.nvalid = cnt[e] - p0; return true;
    }
    __device__ __forceinline__ void a_ready(const Unit&) const {}
    __device__ __forceinline__ void done(const Unit&) const {}
};

struct EpiBf16 {
    static constexpr bool PERM = true;
    bf16_t* O; int ldc; int gelu_from;
    __device__ __forceinline__ void operator()(const f32x4 (&acc)[2][2][4][2], const Unit& u, int wr, int wc, int fr, int fq) const {
        const int row0 = u.pm * BM + wr * 64 + fr; const int col0 = u.pn * BM + wc * 32 + 8 * fq; const bool act = u.pn >= gelu_from;
#pragma unroll
        for (int ai = 0; ai < 2; ++ai)
#pragma unroll
            for (int m = 0; m < 4; ++m) { bf16_t* rowp = O + (size_t)(row0 + ai * HALF + m * 16) * ldc + col0;
#pragma unroll
                for (int bj = 0; bj < 2; ++bj) { f32x4 v0 = acc[ai][bj][m][0], v1 = acc[ai][bj][m][1];
                    if (act) {
#pragma unroll
                        for (int j = 0; j < 4; ++j) { v0[j] = gelu_tanh(v0[j]); v1[j] = gelu_tanh(v1[j]); } }
                    u32x4 w; w.x = pk2(v0[0], v0[1]); w.y = pk2(v0[2], v0[3]); w.z = pk2(v1[0], v1[1]); w.w = pk2(v1[2], v1[3]);
                    *(u32x4*)(rowp + bj * HALF) = w; } }
    }
};
struct EpiFp8 {
    static constexpr bool PERM = true;
    unsigned char* O; int ldc; float scale;
    __device__ __forceinline__ void operator()(const f32x4 (&acc)[2][2][4][2], const Unit& u, int wr, int wc, int fr, int fq) const {
        const int row0 = u.pm * BM + wr * 64 + fr; const int col0 = u.pn * BM + wc * 32 + 8 * fq;
#pragma unroll
        for (int ai = 0; ai < 2; ++ai)
#pragma unroll
            for (int m = 0; m < 4; ++m) { unsigned char* rowp = O + (size_t)(row0 + ai * HALF + m * 16) * ldc + col0;
#pragma unroll
                for (int bj = 0; bj < 2; ++bj) { const f32x4 v0 = acc[ai][bj][m][0] * scale, v1 = acc[ai][bj][m][1] * scale;
                    u32x2 w; w.x = pk4_fp8(v0[0], v0[1], v0[2], v0[3]); w.y = pk4_fp8(v1[0], v1[1], v1[2], v1[3]);
                    *(u32x2*)(rowp + bj * HALF) = w; } }
    }
};
struct EpiF32 {
    static constexpr bool PERM = false;
    float* C; int ldc;
    __device__ __forceinline__ void operator()(const f32x4 (&acc)[2][2][4][2], const Unit& u, int wr, int wc, int fr, int fq) const {
        const int row0 = u.pm * BM + wr * 64 + fr, col0 = u.pn * BM + wc * 32 + 4 * fq;
#pragma unroll
        for (int ai = 0; ai < 2; ++ai)
#pragma unroll
            for (int m = 0; m < 4; ++m) { float* rowp = C + (size_t)(row0 + ai * HALF + m * 16) * ldc + col0;
#pragma unroll
                for (int bj = 0; bj < 2; ++bj)
#pragma unroll
                    for (int n = 0; n < 2; ++n) *(f32x4*)(rowp + bj * HALF + n * 16) = acc[ai][bj][m][n]; }
    }
};
struct EpiGLU {
    static constexpr bool PERM = true;
    unsigned char* O; int ldc;
    __device__ __forceinline__ void operator()(const f32x4 (&acc)[2][2][4][2], const Unit& u, int wr, int wc, int fr, int fq) const {
        const int row0 = u.pm * BM + wr * 64 + fr; const int col0 = u.pn * HALF + wc * 32 + 8 * fq;
#pragma unroll
        for (int ai = 0; ai < 2; ++ai)
#pragma unroll
            for (int m = 0; m < 4; ++m) { unsigned char* rowp = O + (size_t)(row0 + ai * HALF + m * 16) * ldc + col0;
                float o[8];
#pragma unroll
                for (int n = 0; n < 2; ++n)
#pragma unroll
                    for (int j = 0; j < 4; ++j) { const float g = acc[ai][0][m][n][j], up = acc[ai][1][m][n][j]; o[4 * n + j] = (g * __builtin_amdgcn_rcpf(1.0f + __expf(-g))) * up; }
                u32x2 w; w.x = pk4_fp8(o[0], o[1], o[2], o[3]); w.y = pk4_fp8(o[4], o[5], o[6], o[7]);
                *(u32x2*)rowp = w; }
    }
};
struct EpiScaleBf16 {
    static constexpr bool PERM = true;
    bf16_t* O; int ldc; const float* rs;
    __device__ __forceinline__ void operator()(const f32x4 (&acc)[2][2][4][2], const Unit& u, int wr, int wc, int fr, int fq) const {
        const int row0 = u.pm * BM + wr * 64 + fr; const int col0 = u.pn * BM + wc * 32 + 8 * fq;
#pragma unroll
        for (int ai = 0; ai < 2; ++ai)
#pragma unroll
            for (int m = 0; m < 4; ++m) { const int row = row0 + ai * HALF + m * 16; const float s = rs[row]; bf16_t* rowp = O + (size_t)row * ldc + col0;
#pragma unroll
                for (int bj = 0; bj < 2; ++bj) { const f32x4 v0 = acc[ai][bj][m][0] * s, v1 = acc[ai][bj][m][1] * s;
                    u32x4 w; w.x = pk2(v0[0], v0[1]); w.y = pk2(v0[2], v0[3]); w.z = pk2(v1[0], v1[1]); w.w = pk2(v1[2], v1[3]);
                    *(u32x4*)(rowp + bj * HALF) = w; } }
    }
};

typedef int i32x8 __attribute__((ext_vector_type(8)));
typedef int i32x4v __attribute__((ext_vector_type(4)));
template <class Epi, class Sched, bool GATHER = false, bool FP8 = false, bool ALIGN_EPI = true, bool SP2 = true>
__device__ __forceinline__ void gemm_phase(PG8_LAS unsigned char* lds, const Gemm g, const Sched& S, const Epi& E) {
    int tid_ = threadIdx.x; asm volatile("" : "+v"(tid_));
    const int tid = tid_, wid = __builtin_amdgcn_readfirstlane(tid >> 6), lane = tid & 63, wr = wid >> 2, wc = wid & 3, fr = lane & 15, fq = lane >> 4;
    int K_ = g.K; asm volatile("" : "+s"(K_));
    const int K = K_, nt = K / BK;
    unsigned voffA[2], voffB[2];
#pragma unroll
    for (int i = 0; i < 2; ++i) { int R, C; stage_rc(tid * 16 + i * 8192, R, C); const int Rb = Epi::PERM ? ((R & ~31) + perm32(R & 31)) : R;
        voffA[i] = (unsigned)(R * K + C) * 2u; voffB[i] = (unsigned)(Rb * K + C) * 2u; }
    const size_t kstep = (size_t)(BK * 2);
    const size_t hstep = (size_t)HALF * K * 2;
    const size_t tstep = 2 * hstep;
    const unsigned ldsw = (unsigned)wid * 1024u;
    const int aoff = lds_byte(wr * 64 + fr, fq * 8), boff = lds_byte(wc * 32 + fr, fq * 8);
#define PG8_SA(b, h) (((b) * 2 + (h)) * HTB)
#define PG8_SB(b, h) ((4 + (b) * 2 + (h)) * HTB)
#define PG8_STAGE(bufoff, gbase, voff) do { _Pragma("unroll") for (int _i = 0; _i < 2; ++_i) \
        __builtin_amdgcn_global_load_lds((const unsigned*)((const char*)(gbase) + (voff)[_i]), (PG8_LAS unsigned*)(lds + (bufoff) + ldsw + _i * 8192), 16, 0, 0); } while (0)
#define PG8_STAGE_G(bufoff, kbytes, o0, o1) do { \
        __builtin_amdgcn_global_load_lds((const unsigned*)((const char*)g.A + (kbytes) + (o0)), (PG8_LAS unsigned*)(lds + (bufoff) + ldsw), 16, 0, 0); \
        __builtin_amdgcn_global_load_lds((const unsigned*)((const char*)g.A + (kbytes) + (o1)), (PG8_LAS unsigned*)(lds + (bufoff) + ldsw + 8192), 16, 0, 0); } while (0)
#define PG8_LOADMAP(u, O) do { _Pragma("unroll") for (int _h = 0; _h < 2; ++_h) _Pragma("unroll") for (int _i = 0; _i < 2; ++_i) { int _R, _C; stage_rc(tid * 16 + _i * 8192, _R, _C); const int _rr = _h * HALF + _R; \
        int _t = (_rr < (u).nvalid) ? (u).amap[_rr] : 0; _t = ((unsigned)_t < 17408u) ? _t : 0; O[_h][_i] = (unsigned)(_t * K + _C) * 2u; } } while (0)
#define PG8_LD8(p) __builtin_shufflevector(*(const PG8_LAS i32x4v*)(p), *(const PG8_LAS i32x4v*)((p) + 1024), 0, 1, 2, 3, 4, 5, 6, 7)
#define PG8_LDA(dst, b, h) do { if constexpr (FP8) { _Pragma("unroll") for (int m = 0; m < 4; ++m) dst##8[m] = PG8_LD8(lds + PG8_SA(b, h) + aoff + m * 2048); } \
        else { _Pragma("unroll") for (int m = 0; m < 4; ++m) _Pragma("unroll") for (int k = 0; k < 2; ++k) dst[m][k] = *(const PG8_LAS bf16x8*)(lds + PG8_SA(b, h) + aoff + m * 2048 + k * 1024); } } while (0)
#define PG8_LDB(dst, b, h) do { if constexpr (FP8) { _Pragma("unroll") for (int n = 0; n < 2; ++n) dst##8[n] = PG8_LD8(lds + PG8_SB(b, h) + boff + n * 2048); } \
        else { _Pragma("unroll") for (int n = 0; n < 2; ++n) _Pragma("unroll") for (int k = 0; k < 2; ++k) dst[n][k] = *(const PG8_LAS bf16x8*)(lds + PG8_SB(b, h) + boff + n * 2048 + k * 1024); } } while (0)
#define PG8_MMA(ai, bj, At, Bt) do { __builtin_amdgcn_s_setprio(1); \
        if constexpr (FP8) { _Pragma("unroll") for (int m = 0; m < 4; ++m) _Pragma("unroll") for (int n = 0; n < 2; ++n) \
            asm volatile("v_mfma_scale_f32_16x16x128_f8f6f4 %0, %1, %2, %0, %3, %4 op_sel_hi:[0,0,0]" : "+v"(acc[ai][bj][m][n]) : "v"(Bt##8[n]), "v"(At##8[m]), "v"(sc_w), "v"(sc_x)); } \
        else { _Pragma("unroll") for (int m = 0; m < 4; ++m) _Pragma("unroll") for (int n = 0; n < 2; ++n) _Pragma("unroll") for (int k = 0; k < 2; ++k) \
            acc[ai][bj][m][n] = __builtin_amdgcn_mfma_f32_16x16x32_bf16(Bt[n][k], At[m][k], acc[ai][bj][m][n], 0, 0, 0); } \
        __builtin_amdgcn_s_setprio(0); } while (0)
#define PG8_WAIT_V(n) asm volatile("s_waitcnt vmcnt(" #n ")" ::: "memory")
#define PG8_WAIT_L(n) asm volatile("s_waitcnt lgkmcnt(" #n ")" ::: "memory")
#define PG8_BAR __builtin_amdgcn_s_barrier()
#define PG8_SCHED __builtin_amdgcn_sched_barrier(0)
    Unit cur, nxt; int ui = 0;
    if (!S.next(0, cur)) return;
    f32x4 acc[2][2][4][2];
#pragma unroll
    for (int a = 0; a < 2; ++a)
#pragma unroll
        for (int b = 0; b < 2; ++b)
#pragma unroll
            for (int m = 0; m < 4; ++m)
#pragma unroll
                for (int n = 0; n < 2; ++n) acc[a][b][m][n] = (f32x4){0.f, 0.f, 0.f, 0.f};
    bf16x8 At[4][2], B0[2][2], B1[2][2]; i32x8 At8[4], B08[2], B18[2];
    const int sc_w = 0x79797979, sc_x = 0x7f7f7f7f;
    const char* cA = (const char*)g.A + (size_t)cur.pm * tstep; const char* cB = (const char*)g.Bt + (size_t)cur.pb * tstep;
    unsigned cO[2][2] = {{0u, 0u}, {0u, 0u}}, nO[2][2] = {{0u, 0u}, {0u, 0u}};
    S.a_ready(cur);
    if constexpr (GATHER) { static_assert(SP2, "GATHER needs the SP2 loop"); PG8_LOADMAP(cur, cO); }
    if constexpr (SP2) {
        PG8_STAGE(PG8_SB(0, 0), cB, voffB); PG8_STAGE(PG8_SB(0, 1), cB + hstep, voffB);
        if constexpr (GATHER) { PG8_STAGE_G(PG8_SA(0, 0), 0, cO[0][0], cO[0][1]); PG8_STAGE_G(PG8_SA(0, 1), 0, cO[1][0], cO[1][1]); }
        else { PG8_STAGE(PG8_SA(0, 0), cA, voffA); PG8_STAGE(PG8_SA(0, 1), cA + hstep, voffA); }
        if (wr == 1) PG8_BAR;
        PG8_WAIT_V(2); PG8_BAR;
        PG8_STAGE(PG8_SB(1, 0), cB + kstep, voffB);
        if constexpr (GATHER) PG8_STAGE_G(PG8_SA(1, 0), kstep, cO[0][0], cO[0][1]); else PG8_STAGE(PG8_SA(1, 0), cA + kstep, voffA);
        PG8_STAGE(PG8_SB(1, 1), cB + hstep + kstep, voffB);
        PG8_WAIT_V(6); PG8_BAR;
    } else {
        PG8_STAGE(PG8_SB(0, 0), cB, voffB); PG8_STAGE(PG8_SA(0, 0), cA, voffA); PG8_STAGE(PG8_SB(0, 1), cB + hstep, voffB); PG8_STAGE(PG8_SA(0, 1), cA + hstep, voffA);
        if (wr == 1) PG8_BAR;
        PG8_WAIT_V(4); PG8_BAR;
        PG8_STAGE(PG8_SB(1, 0), cB + kstep, voffB); PG8_STAGE(PG8_SA(1, 0), cA + kstep, voffA); PG8_STAGE(PG8_SB(1, 1), cB + hstep + kstep, voffB);
        PG8_WAIT_V(6); PG8_BAR;
    }
    for (;;) {
        const bool has_next = S.next(ui + 1, nxt);
        const char* nA = has_next ? (const char*)g.A + (size_t)nxt.pm * tstep : cA; const char* nB = has_next ? (const char*)g.Bt + (size_t)nxt.pb * tstep : cB;
        if constexpr (GATHER) { if (has_next) PG8_LOADMAP(nxt, nO); else {
#pragma unroll
            for (int _h = 0; _h < 2; ++_h) { nO[_h][0] = cO[_h][0]; nO[_h][1] = cO[_h][1]; } } }
#pragma unroll 1
        for (int t = 0; t < nt; t += 2) {
            const bool last = (t == nt - 2);
            const char* a1 = cA + (size_t)(t + 1) * kstep;
            const char* a2 = last ? nA : cA + (size_t)(t + 2) * kstep; const char* b2 = last ? nB : cB + (size_t)(t + 2) * kstep;
            const char* a3 = a2 + kstep; const char* b3 = b2 + kstep;
            if (last && has_next) S.a_ready(nxt);
            if constexpr (SP2) {
            const size_t k1 = (size_t)(t + 1) * kstep, k2 = last ? (size_t)0 : (size_t)(t + 2) * kstep, k3 = k2 + kstep;
            const unsigned g00 = last ? nO[0][0] : cO[0][0], g01 = last ? nO[0][1] : cO[0][1], g10 = last ? nO[1][0] : cO[1][0], g11 = last ? nO[1][1] : cO[1][1];
            PG8_LDB(B0, 0, 0); PG8_LDB(B1, 0, 1); PG8_SCHED; PG8_LDA(At, 0, 0);
            if constexpr (GATHER) PG8_STAGE_G(PG8_SA(1, 1), k1, cO[1][0], cO[1][1]); else PG8_STAGE(PG8_SA(1, 1), a1 + hstep, voffA);
            PG8_WAIT_V(8); PG8_WAIT_L(0); PG8_BAR; PG8_MMA(0, 0, At, B0); PG8_MMA(0, 1, At, B1); PG8_BAR; PG8_SCHED;
            PG8_LDA(At, 0, 1); PG8_STAGE(PG8_SB(0, 0), b2, voffB); PG8_STAGE(PG8_SB(0, 1), b2 + hstep, voffB);
            if constexpr (GATHER) PG8_STAGE_G(PG8_SA(0, 0), k2, g00, g01); else PG8_STAGE(PG8_SA(0, 0), a2, voffA);
            PG8_WAIT_V(8); PG8_WAIT_L(0); PG8_BAR; PG8_MMA(1, 0, At, B0); PG8_MMA(1, 1, At, B1); PG8_BAR; PG8_SCHED;
            PG8_LDB(B0, 1, 0); PG8_LDB(B1, 1, 1); PG8_SCHED; PG8_LDA(At, 1, 0);
            if constexpr (GATHER) PG8_STAGE_G(PG8_SA(0, 1), k2, g10, g11); else PG8_STAGE(PG8_SA(0, 1), a2 + hstep, voffA);
            PG8_WAIT_V(8); PG8_WAIT_L(0); PG8_BAR; PG8_MMA(0, 0, At, B0); PG8_MMA(0, 1, At, B1); PG8_BAR; PG8_SCHED;
            PG8_LDA(At, 1, 1); PG8_STAGE(PG8_SB(1, 0), b3, voffB); PG8_STAGE(PG8_SB(1, 1), b3 + hstep, voffB);
            if constexpr (GATHER) PG8_STAGE_G(PG8_SA(1, 0), k3, g00, g01); else PG8_STAGE(PG8_SA(1, 0), a3, voffA);
            PG8_WAIT_V(8); PG8_WAIT_L(0); PG8_BAR; PG8_MMA(1, 0, At, B0); PG8_MMA(1, 1, At, B1); PG8_BAR; PG8_SCHED;
            } else {
            PG8_LDB(B0, 0, 0); PG8_SCHED; PG8_LDA(At, 0, 0); PG8_STAGE(PG8_SA(1, 1), a1 + hstep, voffA);
            PG8_WAIT_L(8); PG8_BAR; PG8_WAIT_L(0); PG8_MMA(0, 0, At, B0); PG8_BAR; PG8_SCHED;
            PG8_LDB(B1, 0, 1); PG8_STAGE(PG8_SB(0, 0), b2, voffB);
            PG8_BAR; PG8_WAIT_L(0); PG8_MMA(0, 1, At, B1); PG8_BAR;
            PG8_LDA(At, 0, 1); PG8_STAGE(PG8_SA(0, 0), a2, voffA);
            PG8_BAR; PG8_WAIT_L(0); PG8_MMA(1, 0, At, B0); PG8_BAR; PG8_SCHED;
            PG8_STAGE(PG8_SB(0, 1), b2 + hstep, voffB);
            PG8_WAIT_V(6); PG8_BAR; PG8_MMA(1, 1, At, B1); PG8_BAR;
            PG8_LDB(B0, 1, 0); PG8_SCHED; PG8_LDA(At, 1, 0); PG8_STAGE(PG8_SA(0, 1), a2 + hstep, voffA);
            PG8_WAIT_L(8); PG8_BAR; PG8_WAIT_L(0); PG8_MMA(0, 0, At, B0); PG8_BAR; PG8_SCHED;
            PG8_LDB(B1, 1, 1); PG8_STAGE(PG8_SB(1, 0), b3, voffB);
            PG8_BAR; PG8_WAIT_L(0); PG8_MMA(0, 1, At, B1); PG8_BAR;
            PG8_LDA(At, 1, 1); PG8_STAGE(PG8_SA(1, 0), a3, voffA);
            PG8_BAR; PG8_WAIT_L(0); PG8_MMA(1, 0, At, B0); PG8_BAR; PG8_SCHED;
            PG8_STAGE(PG8_SB(1, 1), b3 + hstep, voffB);
            PG8_WAIT_V(6); PG8_BAR; PG8_MMA(1, 1, At, B1); PG8_BAR;
            }
        }
        if constexpr (ALIGN_EPI) { if (wr == 0) PG8_BAR; }
        if constexpr (FP8) asm volatile("s_nop 15\n\ts_nop 15" ::: "memory");
        E(acc, cur, wr, wc, fr, fq); S.done(cur);
        if (!has_next) break;
#pragma unroll
        for (int a = 0; a < 2; ++a)
#pragma unroll
            for (int b = 0; b < 2; ++b)
#pragma unroll
                for (int m = 0; m < 4; ++m)
#pragma unroll
                    for (int n = 0; n < 2; ++n) acc[a][b][m][n] = (f32x4){0.f, 0.f, 0.f, 0.f};
        cur = nxt; cA = nA; cB = nB; ++ui;
        if constexpr (GATHER) {
#pragma unroll
            for (int _h = 0; _h < 2; ++_h) { cO[_h][0] = nO[_h][0]; cO[_h][1] = nO[_h][1]; } }
        if constexpr (ALIGN_EPI) { if (wr == 1) PG8_BAR; }
    }
    PG8_WAIT_V(0);
    if constexpr (!ALIGN_EPI) { if (wr == 0) PG8_BAR; }
    PG8_BAR;
#undef PG8_SA
#undef PG8_SB
#undef PG8_STAGE
#undef PG8_STAGE_G
#undef PG8_LOADMAP
#undef PG8_LDA
#undef PG8_LDB
#undef PG8_MMA
#undef PG8_LD8
#undef PG8_WAIT_V
#undef PG8_WAIT_L
#undef PG8_BAR
#undef PG8_SCHED
}
}

#define XB_TMO      128
#define XB_XCNT(j)  (256  + 64 * (j))
#define XB_XSUB(j)  (1280 + 64 * (j))
#define XB_XGEN(j)  (2304 + 64 * (j))
#define XB_TOP      3328
#define XB_TOPGEN   3392
#define XCD_BAR_WORDS 3456
#define XB_SPIN_CAP (1u << 18)
__device__ __forceinline__ unsigned xb_ld(unsigned* p)              { return __hip_atomic_load(p, __ATOMIC_RELAXED, __HIP_MEMORY_SCOPE_AGENT); }
__device__ __forceinline__ unsigned xb_add(unsigned* p, unsigned v) { return __hip_atomic_fetch_add(p, v, __ATOMIC_RELAXED, __HIP_MEMORY_SCOPE_AGENT); }
__device__ __forceinline__ unsigned xb_xcc_id() { return (unsigned)__builtin_amdgcn_s_getreg((3 << 11) | 20) & 0xFu; }
#define XB_SPIN(cond, bar) do { unsigned _sp = 0; while (cond) { __builtin_amdgcn_s_sleep(1); \
    if ((++_sp & 255u) == 0u) { if (xb_ld(&(bar)[XB_TMO])) break; if (_sp > XB_SPIN_CAP) { atomicAdd(&(bar)[XB_TMO], 1u); break; } } } } while (0)
struct XcdBarrier { unsigned* bar; unsigned x; volatile LAS unsigned* st; };
__device__ __forceinline__ XcdBarrier xcd_barrier_post(unsigned* bar, volatile LAS unsigned* st) {
    XcdBarrier b; b.bar = bar; b.x = xb_xcc_id(); b.st = st;
    if (threadIdx.x == 0) (void)xb_add(&bar[XB_XCNT(b.x)], 1u);
    return b;
}
__device__ __forceinline__ void xcd_barrier_complete(unsigned* bar, unsigned x, unsigned& nloc, unsigned& nx) {
    const unsigned G = gridDim.x * gridDim.y * gridDim.z;
    unsigned sum, cnt, mine, sp = 0u;
    for (;;) {
        sum = 0u; cnt = 0u; mine = 0u;
#pragma unroll
        for (unsigned j = 0; j < 16; ++j) { const unsigned c = xb_ld(&bar[XB_XCNT(j)]); sum += c; cnt += (c > 0u) ? 1u : 0u; mine = (j == x) ? c : mine; }
        if (sum == G) break;
        __builtin_amdgcn_s_sleep(1);
        if ((++sp & 255u) == 0u) { if (xb_ld(&bar[XB_TMO])) break; if (sp > XB_SPIN_CAP) { atomicAdd(&bar[XB_TMO], 1u); break; } }
    }
    nloc = mine > 0u ? mine : 1u; nx = cnt > 0u ? cnt : 1u;
}
__device__ __forceinline__ void xcd_barrier(const XcdBarrier& b) {
    asm volatile("s_waitcnt vmcnt(0)" ::: "memory");
    __syncthreads();
    if (threadIdx.x == 0) {
        unsigned* bar = b.bar;
        __builtin_amdgcn_s_waitcnt(0);
        unsigned nloc = b.st[0], nx = b.st[1];
        if (nloc == 0u) { xcd_barrier_complete(bar, b.x, nloc, nx); b.st[0] = nloc; b.st[1] = nx; }
        const unsigned old = xb_add(&bar[XB_XSUB(b.x)], 1u);
        const unsigned gen = old / nloc;
        if (old + 1u == (gen + 1u) * nloc) {
            __builtin_amdgcn_fence(__ATOMIC_RELEASE, "agent");
            asm volatile("s_waitcnt vmcnt(0)" ::: "memory");
            const unsigned og = xb_add(&bar[XB_TOP], 1u);
            const unsigned tg = og / nx;
            if (og + 1u == (tg + 1u) * nx) xb_add(&bar[XB_TOPGEN], 1u);
            else XB_SPIN(xb_ld(&bar[XB_TOPGEN]) == tg, bar);
            __builtin_amdgcn_fence(__ATOMIC_ACQUIRE, "agent");
            xb_add(&bar[XB_XGEN(b.x)], 1u);
            asm volatile("s_waitcnt vmcnt(0)" ::: "memory");
        } else {
            XB_SPIN(xb_ld(&bar[XB_XGEN(b.x)]) == gen, bar);
            __builtin_amdgcn_fence(__ATOMIC_ACQUIRE, "agent");
            asm volatile("s_waitcnt vmcnt(0)" ::: "memory");
        }
    }
    __syncthreads();
}

struct Args { const float* in[35]; float* out; unsigned char* ws; int ph_lo, ph_hi; };
enum { I_X = 0, I_C, I_CTX, I_CCTX, I_WADA, I_BADA, I_WIN, I_WOUT, I_MNG, I_POOLW, I_POOLS, I_SINK, I_HCW, I_HCB, I_HW1, I_HB1, I_HF1, I_HW2, I_HB2, I_HF2, I_HW3, I_HSKIP,
       I_GLG, I_GLB, I_GWS, I_GBS, I_LN1G, I_LN1B, I_LN2G, I_LN2B, I_WR, I_RB, I_WG, I_WU, I_WD };
struct Ctx {
    LAS unsigned char* lds; int tid, lane, wave, bid, G;
    const float GAS* const __attribute__((address_space(4)))* in; float GAS* out; unsigned char GAS* ws;
};
#define WSP(T, off) ((T*)(T GAS*)(C.ws + (off)))
#define INP(k) ((const float*)C.in[k])
#define FRESH(D, S) Ctx D = S; asm volatile("" : "+v"(D.tid)); D.lane = D.tid & 63; D.wave = __builtin_amdgcn_readfirstlane(D.tid >> 6); asm volatile("" : "+s"(D.bid), "+s"(D.G), "+s"(D.in), "+s"(D.ws), "+s"(D.out))

struct TrBlk { const float GAS* src; unsigned char GAS* dst; int N, K, nb, which; bool gu; };
constexpr int TRP = 144, TRBUF = 256 * TRP;
#define WG_BAR() do { LDS_WAIT(); __builtin_amdgcn_s_barrier(); asm volatile("" ::: "memory"); } while (0)
constexpr int NBL = 4976, NBP = 368;
__device__ __forceinline__ TrBlk tr_decode(Ctx& C, int L, int j) {
    const bool c0 = j < 240, c1 = !c0 && j < NBP, ce = !c0 && !c1;
    const int q = j - (c0 ? 0 : (c1 ? 240 : NBP));
    const int e = ce ? q / 144 : 0, r = ce ? q % 144 : q;
    const int which = ce ? r / 48 : 0, r2 = ce ? r % 48 : r;
    const bool gu = ce && which < 2, dn = ce && which == 2;
    const int NB = c0 ? 15 : (gu ? 3 : 8), nb = r2 % NB, kb = r2 / NB;
    const int N = c0 ? INW : (gu ? DE : DM), K = dn ? DE : DM;
    const int mat = ce ? L * NE + e : L;
    const float GAS* base = c0 ? C.in[I_WIN] : (c1 ? C.in[I_WOUT] : (which == 0 ? C.in[I_WG] : (which == 1 ? C.in[I_WU] : C.in[I_WD])));
    const size_t wsoff = c0 ? WS_WIN : (c1 ? WS_WOUT : (gu ? WS_WGU : WS_WD));
    const int nrows = c0 ? INW : (gu ? 1536 : DM);
    TrBlk t; t.N = N; t.K = K; t.nb = nb; t.which = which; t.gu = gu;
    t.src = base + (size_t)mat * K * N + (size_t)(128 * kb) * N + 256 * nb;
    t.dst = C.ws + wsoff + (size_t)mat * nrows * K + 128 * kb;
    return t;
}
__device__ __forceinline__ void tr_load(const TrBlk& t, int wave, int lane, f32x4 (&v)[16]) {
#pragma unroll
    for (int i = 0; i < 16; ++i) v[i] = __builtin_nontemporal_load((const f32x4 GAS*)((const char GAS*)t.src + (size_t)(16 * wave + i) * t.N * 4 + 16u * lane));
}
__device__ __forceinline__ void tr_pack(LAS unsigned char* buf, int wave, int lane, const f32x4 (&v)[16]) {
#pragma unroll
    for (int j = 0; j < 4; ++j) { u32x4 o;
#pragma unroll
        for (int w = 0; w < 4; ++w) o[w] = pk4_fp8(64.f * v[4 * w][j], 64.f * v[4 * w + 1][j], 64.f * v[4 * w + 2][j], 64.f * v[4 * w + 3][j]);
        *(LAS u32x4*)(buf + (4 * lane + j) * TRP + 16 * wave) = o; }
}
__device__ __forceinline__ void tr_flush(const TrBlk& t, const LAS unsigned char* buf, int wave, int lane) {
#pragma unroll
    for (int tt = 0; tt < 4; ++tt) { const int nl = 32 * wave + 8 * tt + (lane >> 3), n = 256 * t.nb + nl;
        const u32x4 o = *(const LAS u32x4*)(buf + nl * TRP + 16 * (lane & 7));
        const int drow = t.gu ? ((n >> 7) * 256 + (n & 127) + 128 * t.which) : n;
        *(u32x4 GAS*)(t.dst + (size_t)drow * t.K + 16 * (lane & 7)) = o; }
}
template <int NBK> __device__ __forceinline__ void tr_blocks(Ctx& C, int L, int b0) {
    f32x4 r0[16], r1[16], r2[16];
    LAS unsigned char* buf0 = C.lds; LAS unsigned char* buf1 = C.lds + TRBUF;
    const TrBlk t0 = tr_decode(C, L, b0), t1 = tr_decode(C, L, b0 + (NBK > 1 ? 1 : 0)), t2 = tr_decode(C, L, b0 + (NBK > 2 ? 2 : 0)), t3 = tr_decode(C, L, b0 + (NBK > 3 ? 3 : 0));
    tr_load(t0, C.wave, C.lane, r0); if (NBK > 1) tr_load(t1, C.wave, C.lane, r1); if (NBK > 2) tr_load(t2, C.wave, C.lane, r2);
    WG_BAR();
    tr_pack(buf0, C.wave, C.lane, r0);
    if (NBK > 3) tr_load(t3, C.wave, C.lane, r0);
    WG_BAR(); tr_flush(t0, buf0, C.wave, C.lane);
    if (NBK > 1) { tr_pack(buf1, C.wave, C.lane, r1); WG_BAR(); tr_flush(t1, buf1, C.wave, C.lane); }
    if (NBK > 2) { tr_pack(buf0, C.wave, C.lane, r2); WG_BAR(); tr_flush(t2, buf0, C.wave, C.lane); }
    if (NBK > 3) { tr_pack(buf1, C.wave, C.lane, r0); WG_BAR(); tr_flush(t3, buf1, C.wave, C.lane); }
}
__device__ __forceinline__ void p0_convert(Ctx& C, int L, int nblocks) {
#pragma unroll 1
    for (int j = C.bid; j < nblocks; j += C.G) tr_blocks<1>(C, L, j);
    __syncthreads();
}
constexpr int NCU = NBL / 4;
#ifndef CONV_SPLIT
#define CONV_SPLIT 0
#endif
__device__ __forceinline__ void conv_unit(Ctx& C, int L, int b0) { tr_blocks<4>(C, L, b0); }
constexpr int NCU_E = (NBL - NBP) / 4, NCU_P = NBP / 4;
__device__ __forceinline__ void bg_conv_unit(Ctx& C, int l, int cu) {
    const bool e = cu < NCU_E; conv_unit(C, e ? l : 1, e ? NBP + cu * 4 : (cu - NCU_E) * 4);
}
__device__ __forceinline__ void p0_adaln(Ctx& C) {
    LAS float* sc = (LAS float*)C.lds;
    LAS float* red = (LAS float*)(C.lds + 40960);
    float* MOD = WSP(float, WS_MOD);
    for (int u = C.bid; u < 256; u += C.G) {
        const int l = u >> 7, colbase = (u & 127) * 96;
        __syncthreads();
        for (int i = C.tid; i < 5 * DM; i += 512) { const int r = i >> 11, k = i & 2047; const float v = r < 4 ? INP(I_C)[r * DM + k] : INP(I_CCTX)[k]; sc[i] = silu_f(v); }
        __syncthreads();
        float acc[5][2];
#pragma unroll
        for (int r = 0; r < 5; ++r) { acc[r][0] = 0.f; acc[r][1] = 0.f; }
        const int ln = C.lane < 48 ? C.lane : 47;
        const float* wp = INP(I_WADA) + ((size_t)l * DM + C.wave * 256) * 12288 + colbase + 2 * ln;
#pragma unroll 1
        for (int k0 = 0; k0 < 256; k0 += 16) { f32x2 wv[16];
#pragma unroll
            for (int k = 0; k < 16; ++k) wv[k] = *(const f32x2*)(wp + (size_t)(k0 + k) * 12288);
#pragma unroll
            for (int k = 0; k < 16; ++k)
#pragma unroll
                for (int r = 0; r < 5; ++r) { const float s = sc[r * DM + C.wave * 256 + k0 + k]; acc[r][0] += s * wv[k].x; acc[r][1] += s * wv[k].y; } }
        if (C.lane < 48) {
#pragma unroll
            for (int r = 0; r < 5; ++r) { red[(C.wave * 5 + r) * 96 + 2 * C.lane] = acc[r][0]; red[(C.wave * 5 + r) * 96 + 2 * C.lane + 1] = acc[r][1]; } }
        __syncthreads();
        for (int i = C.tid; i < 480; i += 512) { const int r = i / 96, cc = i % 96; float s = INP(I_BADA)[l * 12288 + colbase + cc];
#pragma unroll
            for (int w = 0; w < 8; ++w) s += red[(w * 5 + r) * 96 + cc];
            MOD[(size_t)(l * 5 + r) * 12288 + colbase + cc] = s; }
    }
    __syncthreads();
}
__device__ __forceinline__ void p0_filters(Ctx& C) {
    LAS float* feat = (LAS float*)C.lds;
    LAS float* h1 = (LAS float*)(C.lds + 4096);
    LAS float* h2 = (LAS float*)(C.lds + 8192);
    for (int u2 = C.bid; u2 < 528 + 0 * C.G; u2 += C.G) {
        const int u = 2 * (u2 % 264) + (u2 / 264);
        int l, L, tb; bf16* dst;
        if (u < 512) { l = u >> 8; tb = u & 255; L = SL; dst = WSP(bf16, WS_FILT) + (size_t)l * 2 * 512 * 8192; }
        else { l = 0; tb = u - 512; L = CL; dst = WSP(bf16, WS_FILTC); }
        const float invLm1 = 1.0f / (float)(L - 1);
        __syncthreads();
        LAS float* w1s = (LAS float*)(C.lds + 12288);
        LAS float* w2s = (LAS float*)(C.lds + 12288 + 33 * 64 * 4);
        for (int i = C.tid; i < 33 * 64; i += 512) w1s[i] = INP(I_HW1)[l * 33 * 64 + i];
        for (int i = C.tid; i < 64 * 64; i += 512) w2s[i] = INP(I_HW2)[l * 64 * 64 + i];
        for (int i = C.tid; i < 16 * 33; i += 512) { const int p = i / 33, j = i % 33; const int t = 16 * tb + p; float v;
            if (j == 0) v = (float)t * invLm1;
            else { const int fi = (j - 1) & 15; const float fr = 1e-4f + (float)fi * ((15.0f - 1e-4f) / 15.0f); const float ang = (6.283185307179586f / (float)L) * (float)t * fr; v = (j <= 16) ? cosf(ang) : -sinf(ang); }
            feat[i] = v; }
        __syncthreads();
        for (int i = C.tid; i < 1024; i += 512) { const int p = i >> 6, hh = i & 63; float s = INP(I_HB1)[l * 64 + hh];
#pragma unroll
            for (int j = 0; j < 33; ++j) s += feat[p * 33 + j] * w1s[j * 64 + hh];
            h1[i] = sinf(INP(I_HF1)[l * 64 + hh] * s); }
        __syncthreads();
        for (int i = C.tid; i < 1024; i += 512) { const int p = i >> 6, hh = i & 63; float s = INP(I_HB2)[l * 64 + hh];
#pragma unroll 16
            for (int j = 0; j < 64; ++j) s += h1[p * 64 + j] * w2s[j * 64 + hh];
            h2[i] = sinf(INP(I_HF2)[l * 64 + hh] * s); }
        __syncthreads();
        float acc[16][4];
#pragma unroll
        for (int p = 0; p < 16; ++p) { acc[p][0] = 0.f; acc[p][1] = 0.f; acc[p][2] = 0.f; acc[p][3] = 0.f; }
#pragma unroll 4
        for (int k = 0; k < 64; ++k) { const f32x4 w = *(const f32x4*)(INP(I_HW3) + (size_t)(l * 64 + k) * 2048 + 4 * C.tid);
#pragma unroll
            for (int p = 0; p < 16; ++p) { const float h = h2[p * 64 + k]; acc[p][0] += h * w[0]; acc[p][1] += h * w[1]; acc[p][2] += h * w[2]; acc[p][3] += h * w[3]; } }
#pragma unroll
        for (int j = 0; j < 4; ++j) { const int col = 4 * C.tid + j, o = col >> 10, dir = (col >> 9) & 1, c = col & 511;
            const float delta = 4.605170186f * (1.0f / 1.5f + (float)c * ((1.0f / 0.3f - 1.0f / 1.5f) / 511.0f));
            bf16* d = dst + (size_t)(o * 512 + c) * (2 * L);
            float val[16];
#pragma unroll
            for (int p = 0; p < 16; ++p) { const int t = 16 * tb + p; val[p] = acc[p][j] * __expf(-(float)t * invLm1 * delta); }
            if (dir == 0) {
                u32x4 w0, w1; w0.x = pk2(val[15], val[14]); w0.y = pk2(val[13], val[12]); w0.z = pk2(val[11], val[10]); w0.w = pk2(val[9], val[8]);
                w1.x = pk2(val[7], val[6]); w1.y = pk2(val[5], val[4]); w1.z = pk2(val[3], val[2]); w1.w = pk2(val[1], val[0]);
                u32x4* q = (u32x4*)(d + L - 16 * (tb + 1)); q[0] = w0; q[1] = w1;
            } else if (tb == 0) {
#pragma unroll
                for (int p = 1; p < 16; ++p) d[L - 1 + p] = (bf16)(pk2(val[p], 0.f) & 0xffffu);
            } else {
                typedef u32x4 __attribute__((aligned(2))) u32x4_u;
                u32x4 w0, w1; w0.x = pk2(val[0], val[1]); w0.y = pk2(val[2], val[3]); w0.z = pk2(val[4], val[5]); w0.w = pk2(val[6], val[7]);
                w1.x = pk2(val[8], val[9]); w1.y = pk2(val[10], val[11]); w1.z = pk2(val[12], val[13]); w1.w = pk2(val[14], val[15]);
                u32x4_u* q = (u32x4_u*)(d + L - 1 + 16 * tb); q[0] = w0; q[1] = w1;
            }
            if (dir == 1 && 16 * (tb + 1) == L) d[2 * L - 1] = 0; }
    }
    __syncthreads();
}
__device__ __forceinline__ void p0_rope(Ctx& C) {
    { const int idx = C.bid * 512 + C.tid;
      for (int e = idx; e < 131072; e += C.G * 512) { const f32x2 v = *(const f32x2*)(INP(I_GWS) + 2 * (size_t)e); WSP(unsigned, WS_GWSB)[e] = pk2(v.x, v.y); } }
    { const int idx = C.bid * 512 + C.tid;
      for (int e = idx; e < 131072; e += C.G * 512) { const int i = e & 127, j = (e >> 7) & 127, lg = e >> 14, l = lg >> 2, gi = lg & 3;
          const float v = INP(I_POOLW)[(size_t)lg * 16384 + i * 128 + j] * INP(I_POOLS)[l * 512 + 128 * gi + j];
          WSP(bf16, WS_POOLWT)[e] = (bf16)(pk2(v, 0.f) & 0xffffu); } }
    if (C.bid == (C.G > 200 ? 200 : 0)) { f32x2* R = WSP(f32x2, WS_ROPE);
        for (int i = C.tid; i < 1024; i += 512) { const int pos = i >> 4, fi = i & 15; const float inv = powf(10000.0f, -(float)fi / 16.0f); const float a = (float)pos * inv; R[i] = (f32x2){cosf(a), sinf(a)}; } }
}

__device__ __forceinline__ const float* src_x0(Ctx& C, int row) {
    return row < NLAT ? INP(I_X) + (size_t)row * DM : INP(I_CTX) + (size_t)(row - NLAT) * DM;
}
__device__ __forceinline__ void row_load(const float* p, int lane, float (&v)[32]) {
#pragma unroll
    for (int j = 0; j < 4; ++j) { const f32x4 a = *(const f32x4*)(p + 512 * j + 8 * lane), b = *(const f32x4*)(p + 512 * j + 8 * lane + 4);
        v[8 * j] = a[0]; v[8 * j + 1] = a[1]; v[8 * j + 2] = a[2]; v[8 * j + 3] = a[3]; v[8 * j + 4] = b[0]; v[8 * j + 5] = b[1]; v[8 * j + 6] = b[2]; v[8 * j + 7] = b[3]; }
}
__device__ __forceinline__ void row_load_bf16(const bf16* p, int lane, float (&v)[32]) {
#pragma unroll
    for (int j = 0; j < 4; ++j) { const u32x4 r = *(const u32x4*)(p + 512 * j + 8 * lane);
        v[8 * j] = __uint_as_float(r.x << 16); v[8 * j + 1] = __uint_as_float(r.x & 0xffff0000u); v[8 * j + 2] = __uint_as_float(r.y << 16); v[8 * j + 3] = __uint_as_float(r.y & 0xffff0000u);
        v[8 * j + 4] = __uint_as_float(r.z << 16); v[8 * j + 5] = __uint_as_float(r.z & 0xffff0000u); v[8 * j + 6] = __uint_as_float(r.w << 16); v[8 * j + 7] = __uint_as_float(r.w & 0xffff0000u); }
}
__device__ __forceinline__ void row_store(float* p, int lane, const float (&v)[32]) {
#pragma unroll
    for (int j = 0; j < 4; ++j) { *(f32x4*)(p + 512 * j + 8 * lane) = (f32x4){v[8 * j], v[8 * j + 1], v[8 * j + 2], v[8 * j + 3]}; *(f32x4*)(p + 512 * j + 8 * lane + 4) = (f32x4){v[8 * j + 4], v[8 * j + 5], v[8 * j + 6], v[8 * j + 7]}; }
}
__device__ __forceinline__ void row_store_bf16(bf16* p, int lane, const float (&v)[32]) {
#pragma unroll
    for (int j = 0; j < 4; ++j) { u32x4 w; w.x = pk2(v[8 * j], v[8 * j + 1]); w.y = pk2(v[8 * j + 2], v[8 * j + 3]); w.z = pk2(v[8 * j + 4], v[8 * j + 5]); w.w = pk2(v[8 * j + 6], v[8 * j + 7]); *(u32x4*)(p + 512 * j + 8 * lane) = w; }
}
__device__ __forceinline__ void row_store_fp8(unsigned char* p, int lane, const float (&v)[32]) {
#pragma unroll
    for (int j = 0; j < 4; ++j) { u32x2 w; w.x = pk4_fp8(v[8 * j], v[8 * j + 1], v[8 * j + 2], v[8 * j + 3]); w.y = pk4_fp8(v[8 * j + 4], v[8 * j + 5], v[8 * j + 6], v[8 * j + 7]); *(u32x2*)(p + 512 * j + 8 * lane) = w; }
}
__device__ __forceinline__ void row_ln(float (&v)[32]) {
    float s = 0.f;
#pragma unroll
    for (int i = 0; i < 32; ++i) s += v[i];
    const float mean = wave_sum(s) * (1.0f / DM); float q = 0.f;
#pragma unroll
    for (int i = 0; i < 32; ++i) { v[i] -= mean; q += v[i] * v[i]; }
    const float rstd = 1.0f / sqrtf(wave_sum(q) * (1.0f / DM) + LN_EPS);
#pragma unroll
    for (int i = 0; i < 32; ++i) v[i] *= rstd;
}
__device__ __forceinline__ void row_affine(float (&v)[32], const float* mul, const float* add, int lane, float mul_off) {
    float a[32], b[32]; row_load(mul, lane, a); row_load(add, lane, b);
#pragma unroll
    for (int i = 0; i < 32; ++i) v[i] = v[i] * (a[i] + mul_off) + b[i];
}
__device__ __forceinline__ void row_load_lds(const LAS float* p, int lane, float (&v)[32]) {
#pragma unroll
    for (int j = 0; j < 4; ++j) { const f32x4 a = *(const LAS f32x4*)(p + 512 * j + 8 * lane), b = *(const LAS f32x4*)(p + 512 * j + 8 * lane + 4);
        v[8 * j] = a[0]; v[8 * j + 1] = a[1]; v[8 * j + 2] = a[2]; v[8 * j + 3] = a[3]; v[8 * j + 4] = b[0]; v[8 * j + 5] = b[1]; v[8 * j + 6] = b[2]; v[8 * j + 7] = b[3]; }
}
__device__ __forceinline__ void row_affine_lds(float (&v)[32], const LAS float* mul, const LAS float* add, int lane, float mul_off) {
    float a[32], b[32]; row_load_lds(mul, lane, a); row_load_lds(add, lane, b);
#pragma unroll
    for (int i = 0; i < 32; ++i) v[i] = v[i] * (a[i] + mul_off) + b[i];
}
__device__ __forceinline__ void stage2048(Ctx& C, LAS float* dst, const float* src) { *(LAS f32x4*)(dst + 4 * C.tid) = *(const f32x4*)(src + 4 * C.tid); }
__device__ __forceinline__ void ph_ln_mod(Ctx& C, int l, int nrows) {
    LAS float* PAR = (LAS float*)C.lds;
    const int r0 = (int)(((long)C.bid * nrows) / C.G), r1 = (int)(((long)(C.bid + 1) * nrows) / C.G);
    int cur_mrow = -1;
    for (int rb = r0 & ~7; rb < r1; rb += 8) {
        const int mrow = rb < NLAT ? rb / SL : 4; const float* mod = WSP(float, WS_MOD) + (size_t)(l * 5 + mrow) * 12288;
        if (mrow != cur_mrow) { __syncthreads(); stage2048(C, PAR, mod + 2048); stage2048(C, PAR + 2048, mod); cur_mrow = mrow; __syncthreads(); }
        const int row = rb + C.wave;
        if (row >= r0 && row < r1) {
            float v[32]; row_load(src_x0(C, row), C.lane, v); row_ln(v); row_affine_lds(v, PAR, PAR + 2048, C.lane, 1.0f);
            if (FP8_IN) row_store_fp8(WSP(unsigned char, WS_HA8) + (size_t)row * DM, C.lane, v); else row_store_bf16(WSP(bf16, WS_HB) + (size_t)row * DM, C.lane, v);
        }
    }
    __syncthreads();
}

__device__ __forceinline__ void cvt8(const u32x4 r, float (&f)[8]) { f[0] = bflo(r.x); f[1] = bfhi(r.x); f[2] = bflo(r.y); f[3] = bfhi(r.y); f[4] = bflo(r.z); f[5] = bfhi(r.z); f[6] = bflo(r.w); f[7] = bfhi(r.w); }
__device__ __forceinline__ void cvt8_fp8(const u32x2 r, float (&f)[8]) { const f32x2 a = __builtin_amdgcn_cvt_pk_f32_fp8((int)r.x, false), b = __builtin_amdgcn_cvt_pk_f32_fp8((int)r.x, true), c = __builtin_amdgcn_cvt_pk_f32_fp8((int)r.y, false), d = __builtin_amdgcn_cvt_pk_f32_fp8((int)r.y, true);
    f[0] = a.x; f[1] = a.y; f[2] = b.x; f[3] = b.y; f[4] = c.x; f[5] = c.y; f[6] = d.x; f[7] = d.y; }
__device__ __forceinline__ bf16x8 pack8(const float (&f)[8]) { u32x4 w; w.x = pk2(f[0], f[1]); w.y = pk2(f[2], f[3]); w.z = pk2(f[4], f[5]); w.w = pk2(f[6], f[7]); return __builtin_bit_cast(bf16x8, w); }
#define MFMA32(a, b, c) __builtin_amdgcn_mfma_f32_32x32x16_bf16((a), (b), (c), 0, 0, 0)

__device__ __forceinline__ void attn_unit(Ctx& C, int l, int uidx) {
    constexpr int KS = 144, VS = 272, VT_OFF = 128 * KS;
    const bool isctx = uidx >= 256;
    int b, kh, nb;
    if (!isctx) { b = uidx >> 6; kh = (uidx >> 5) & 1; nb = uidx & 31; } else { const int v = uidx - 256; b = v >> 2; kh = (v >> 1) & 1; nb = v & 1; }
    const int rowbase = isctx ? NLAT + b * CL : b * SL, crow = NLAT + b * CL;
    const int g = C.wave >> 1, th = C.wave & 1, head = kh * 4 + g, r32 = C.lane & 31, h = C.lane >> 5;
    const bf16* Z = WSP(bf16, WS_Z); const f32x2* ROPE = WSP(f32x2, WS_ROPE);
    bf16x8 Qf[2][4];
#pragma unroll
    for (int qb = 0; qb < 2; ++qb) {
        const int tq = 128 * nb + 64 * th + 32 * qb + r32;
        const bf16* qp = Z + (size_t)(rowbase + tq) * INW + 512 + 64 * head + 8 * h;
        float f[4][8];
#pragma unroll
        for (int s = 0; s < 4; ++s) cvt8(*(const u32x4*)(qp + 16 * s), f[s]);
        if (!isctx) {
            const int pr = tq >> 6, pc = tq & 63;
#pragma unroll
            for (int j = 0; j < 8; ++j) {
                const f32x2 cr = ROPE[pr * 16 + 8 * h + j], cc = ROPE[pc * 16 + 8 * h + j];
                const float a0 = f[0][j], b0 = f[1][j]; f[0][j] = a0 * cr.x - b0 * cr.y; f[1][j] = b0 * cr.x + a0 * cr.y;
                const float a1 = f[2][j], b1 = f[3][j]; f[2][j] = a1 * cc.x - b1 * cc.y; f[3][j] = b1 * cc.x + a1 * cc.y; }
        }
#pragma unroll
        for (int s = 0; s < 4; ++s) {
#pragma unroll
            for (int j = 0; j < 8; ++j) f[s][j] *= 0.125f * LOG2E;
            Qf[qb][s] = pack8(f[s]); }
    }
    float m_[2], l_[2]; f32x16 O[2][2];
    { const float sk = INP(I_SINK)[l * 8 + head] * LOG2E; m_[0] = sk; m_[1] = sk; l_[0] = 1.f; l_[1] = 1.f; }
#pragma unroll
    for (int a = 0; a < 2; ++a)
#pragma unroll
        for (int q = 0; q < 2; ++q)
#pragma unroll
            for (int i = 0; i < 16; ++i) O[a][q][i] = 0.f;
#define AT_VALID(tt_) ((tt_) >= 3 || ((nb - 1 + (tt_)) >= 0 && (nb - 1 + (tt_)) < SL / 128))
#define AT_KROW0(tt_) (((tt_) < 3) ? rowbase + 128 * (nb - 1 + (tt_)) : crow + 128 * ((tt_) - 3))
#define AT_PREFETCH(tt_) do { const int krow0_ = AT_KROW0(tt_); _Pragma("unroll") for (int r = 0; r < 2; ++r) { const int idx = C.tid + 512 * r, key = idx >> 3, cd = idx & 7; \
        const bf16* kp = Z + (size_t)(krow0_ + key) * INW + 1024 + 64 * kh; kraw[r] = *(const u32x4*)(kp + 8 * cd); if ((tt_) < 3) kpar[r] = *(const u32x4*)(kp + 8 * (cd ^ 2)); \
        vraw[r] = *(const u32x4*)(kp + 128 + 8 * cd); } } while (0)
    __syncthreads();
    u32x4 kraw[2], kpar[2], vraw[2];
    kpar[0] = (u32x4){0u, 0u, 0u, 0u}; kpar[1] = kpar[0];
    int tt = isctx ? 3 : (nb == 0 ? 1 : 0);
    AT_PREFETCH(tt);
    while (tt < 5) {
        int ntt = tt + 1; if (ntt < 3 && !AT_VALID(ntt)) ntt = 3;
        const bool band = tt < 3; const int kb = nb - 1 + tt;
        LDS_WAIT(); __builtin_amdgcn_s_barrier(); asm volatile("" ::: "memory");
#pragma unroll
        for (int r = 0; r < 2; ++r) {
            const int idx = C.tid + 512 * r, key = idx >> 3, cd = idx & 7;
            u32x4 raw = kraw[r];
            if (band) {
                float x[8], y[8]; cvt8(raw, x); cvt8(kpar[r], y);
                const int tk = 128 * kb + key, pos = (cd & 4) ? (tk & 63) : (tk >> 6), i0 = 8 * (cd & 1); const bool isb = (cd >> 1) & 1;
#pragma unroll
                for (int j = 0; j < 8; ++j) { const f32x2 cs = ROPE[pos * 16 + i0 + j]; x[j] = isb ? (x[j] * cs.x + y[j] * cs.y) : (x[j] * cs.x - y[j] * cs.y); }
                raw = __builtin_bit_cast(u32x4, pack8(x));
            }
            *(LAS u32x4*)(C.lds + key * KS + cd * 16) = raw;
            const u32x4 vr = vraw[r];
            LAS bf16* vt = (LAS bf16*)(C.lds + VT_OFF + (8 * cd) * VS + key * 2);
            vt[0] = (bf16)(vr.x & 0xffff); vt[VS / 2] = (bf16)(vr.x >> 16); vt[2 * (VS / 2)] = (bf16)(vr.y & 0xffff); vt[3 * (VS / 2)] = (bf16)(vr.y >> 16);
            vt[4 * (VS / 2)] = (bf16)(vr.z & 0xffff); vt[5 * (VS / 2)] = (bf16)(vr.z >> 16); vt[6 * (VS / 2)] = (bf16)(vr.w & 0xffff); vt[7 * (VS / 2)] = (bf16)(vr.w >> 16);
        }
        if (ntt < 5) AT_PREFETCH(ntt);
        LDS_WAIT(); __builtin_amdgcn_s_barrier(); asm volatile("" ::: "memory");
        const int sub_lo = (tt == 0) ? 2 * th : 0, sub_hi = (tt == 2) ? 2 * th + 1 : 3;
        for (int sub = sub_lo; sub <= sub_hi; ++sub) {
            bf16x8 Kf[4];
#pragma unroll
            for (int s = 0; s < 4; ++s) Kf[s] = *(const LAS bf16x8*)(C.lds + (32 * sub + r32) * KS + (16 * s + 8 * h) * 2);
            bf16x8 Pf[2][2];
#pragma unroll
            for (int qb = 0; qb < 2; ++qb) {
                f32x16 S;
#pragma unroll
                for (int i = 0; i < 16; ++i) S[i] = 0.f;
#pragma unroll
                for (int s = 0; s < 4; ++s) S = MFMA32(Kf[s], Qf[qb][s], S);
                const int tq = 128 * nb + 64 * th + 32 * qb + r32;
                float mx = -INFINITY;
#pragma unroll
                for (int i = 0; i < 16; ++i) { float x = S[i];
                    if (tt == 0 || tt == 2) { const int kpos = 128 * kb + 32 * sub + (i & 3) + 8 * (i >> 2) + 4 * h; const int dq = tq - kpos; if (dq > 128 || dq < -128) x = -INFINITY; }
                    S[i] = x; mx = fmaxf(mx, x); }
                mx = xor32_max(mx);
                const float mnew = fmaxf(m_[qb], mx), alpha = __builtin_amdgcn_exp2f(m_[qb] - mnew);
                float rs = 0.f; float p[16];
#pragma unroll
                for (int i = 0; i < 16; ++i) { p[i] = __builtin_amdgcn_exp2f(S[i] - mnew); rs += p[i]; }
                rs = xor32_sum(rs);
                l_[qb] = l_[qb] * alpha + rs; m_[qb] = mnew;
#pragma unroll
                for (int i = 0; i < 16; ++i) { O[0][qb][i] *= alpha; O[1][qb][i] *= alpha; }
#pragma unroll
                for (int s2 = 0; s2 < 2; ++s2) { float t8[8];
#pragma unroll
                    for (int j = 0; j < 8; ++j) t8[j] = p[8 * s2 + j];
                    Pf[qb][s2] = pack8(t8); }
            }
#pragma unroll
            for (int db = 0; db < 2; ++db)
#pragma unroll
                for (int s2 = 0; s2 < 2; ++s2) {
                    const LAS unsigned char* vp = C.lds + VT_OFF + (32 * db + r32) * VS + (32 * sub + 16 * s2 + 4 * h) * 2;
                    const u32x2 v0 = *(const LAS u32x2*)vp, v1 = *(const LAS u32x2*)(vp + 16);
                    const u32x4 vv = {v0.x, v0.y, v1.x, v1.y}; const bf16x8 Vf = __builtin_bit_cast(bf16x8, vv);
                    O[db][0] = MFMA32(Vf, Pf[0][s2], O[db][0]); O[db][1] = MFMA32(Vf, Pf[1][s2], O[db][1]);
                }
        }
        tt = ntt;
    }
#undef AT_VALID
#undef AT_KROW0
#undef AT_PREFETCH
    bf16* Y = WSP(bf16, WS_YCAT);
#pragma unroll
    for (int qb = 0; qb < 2; ++qb) {
        const int tq = 128 * nb + 64 * th + 32 * qb + r32; const float inv = 1.0f / l_[qb];
        bf16* yp = Y + (size_t)(rowbase + tq) * DM + 512 + 64 * head;
#pragma unroll
        for (int db = 0; db < 2; ++db)
#pragma unroll
            for (int rg = 0; rg < 4; ++rg) { u32x2 w; w.x = pk2(O[db][qb][4 * rg] * inv, O[db][qb][4 * rg + 1] * inv); w.y = pk2(O[db][qb][4 * rg + 2] * inv, O[db][qb][4 * rg + 3] * inv);
                *(u32x2*)(yp + 32 * db + 8 * rg + 4 * h) = w; }
    }
}

__device__ __forceinline__ void gmlp_unit(Ctx& C, int l, int uidx) {
    constexpr int VS = 272;
    const int ck = uidx >> 1, hf = uidx & 1, row0 = 128 * ck;
    const bf16* Z = WSP(bf16, WS_Z);
    const int gl = C.wave >> 1, ph = C.wave & 1, g = 4 * hf + gl, r32 = C.lane & 31, h = C.lane >> 5;
    bf16x8 Wf[2][8]; u32x2 upre[2][2][4];
    { const bf16* wsb = WSP(bf16, WS_GWSB) + ((size_t)(l * 8 + g) * 128 + 64 * ph + r32) * 128 + 8 * h;
#pragma unroll
      for (int pb = 0; pb < 2; ++pb)
#pragma unroll
          for (int s = 0; s < 8; ++s) Wf[pb][s] = *(const bf16x8*)(wsb + (size_t)(32 * pb) * 128 + 16 * s);
#pragma unroll
      for (int pb = 0; pb < 2; ++pb) { const bf16* up = Z + (size_t)(row0 + 64 * ph + 32 * pb + r32) * INW + 2816 + 64 * g + 4 * h;
#pragma unroll
          for (int cb = 0; cb < 2; ++cb)
#pragma unroll
              for (int rg = 0; rg < 4; ++rg) upre[pb][cb][rg] = *(const u32x2*)(up + 32 * cb + 8 * rg); } }
    __syncthreads();
    {
        const int tok = C.tid >> 2, part = C.tid & 3;
        const bf16* zp = Z + (size_t)(row0 + tok) * INW + 3328 + 128 * part;
        const bf16* zq = Z + (size_t)(row0 + tok) * INW + 3328 + 256 * hf + 64 * part;
        u32x4 r1[16], r2[8];
#pragma unroll
        for (int c8 = 0; c8 < 16; ++c8) r1[c8] = *(const u32x4*)(zp + 8 * c8);
#pragma unroll
        for (int c8 = 0; c8 < 8; ++c8) r2[c8] = *(const u32x4*)(zq + 8 * c8);
        float s = 0.f, q = 0.f;
#pragma unroll
        for (int c8 = 0; c8 < 16; ++c8) { float f[8]; cvt8(r1[c8], f);
#pragma unroll
            for (int j = 0; j < 8; ++j) { s += f[j]; q += f[j] * f[j]; } }
        s += dpp_f<DPP_XOR1>(s); s += dpp_f<DPP_XOR2>(s); q += dpp_f<DPP_XOR1>(q); q += dpp_f<DPP_XOR2>(q);
        const float mean = s * (1.0f / 512.0f); const float var = fmaxf(q * (1.0f / 512.0f) - mean * mean, 0.f); const float rstd = 1.0f / sqrtf(var + LN_EPS);
        const float* lg = INP(I_GLG) + l * 512 + 256 * hf + 64 * part; const float* lb = INP(I_GLB) + l * 512 + 256 * hf + 64 * part;
#pragma unroll
        for (int c8 = 0; c8 < 8; ++c8) { float f[8]; cvt8(r2[c8], f);
            const f32x4 g0 = *(const f32x4*)(lg + 8 * c8), g1 = *(const f32x4*)(lg + 8 * c8 + 4), b0 = *(const f32x4*)(lb + 8 * c8), b1 = *(const f32x4*)(lb + 8 * c8 + 4);
            const float gg[8] = {g0[0], g0[1], g0[2], g0[3], g1[0], g1[1], g1[2], g1[3]}, bb[8] = {b0[0], b0[1], b0[2], b0[3], b1[0], b1[1], b1[2], b1[3]};
#pragma unroll
            for (int j = 0; j < 8; ++j) { const float vn = (f[j] - mean) * rstd * gg[j] + bb[j];
                *(LAS bf16*)(C.lds + (64 * part + 8 * c8 + j) * VS + tok * 2) = (bf16)(pk2(vn, 0.f) & 0xffffu); } }
    }
    __syncthreads();
    f32x16 acc[2][2];
#pragma unroll
    for (int a = 0; a < 2; ++a)
#pragma unroll
        for (int b = 0; b < 2; ++b)
#pragma unroll
            for (int i = 0; i < 16; ++i) acc[a][b][i] = 0.f;
#pragma unroll
    for (int s = 0; s < 8; ++s) {
        bf16x8 Vf[2];
#pragma unroll
        for (int cb = 0; cb < 2; ++cb) Vf[cb] = *(const LAS bf16x8*)(C.lds + (64 * gl + 32 * cb + r32) * VS + (16 * s + 8 * h) * 2);
#pragma unroll
        for (int cb = 0; cb < 2; ++cb)
#pragma unroll
            for (int pb = 0; pb < 2; ++pb) acc[cb][pb] = MFMA32(Vf[cb], Wf[pb][s], acc[cb][pb]);
    }
    bf16* Y = WSP(bf16, WS_YCAT);
#pragma unroll
    for (int pb = 0; pb < 2; ++pb) { const int p = 64 * ph + 32 * pb + r32; const float bs = INP(I_GBS)[(l * 8 + g) * 128 + p];
        bf16* yp = Y + (size_t)(row0 + p) * DM + 1536 + 64 * g + 4 * h;
#pragma unroll
        for (int cb = 0; cb < 2; ++cb)
#pragma unroll
            for (int rg = 0; rg < 4; ++rg) { const u32x2 uv = upre[pb][cb][rg];
                u32x2 w; w.x = pk2(bflo(uv.x) * (acc[cb][pb][4 * rg] + bs), bfhi(uv.x) * (acc[cb][pb][4 * rg + 1] + bs)); w.y = pk2(bflo(uv.y) * (acc[cb][pb][4 * rg + 2] + bs), bfhi(uv.y) * (acc[cb][pb][4 * rg + 3] + bs));
                *(u32x2*)(yp + 32 * cb + 8 * rg) = w; } }
}

__device__ __forceinline__ void pool_unit(Ctx& C, int l, int blk) {
    constexpr int RS = 1040, DT_OFF = 48 * RS;
    const int row0 = 32 * blk;
    const int s0 = row0 < NLAT ? (row0 / SL) * SL : NLAT + ((row0 - NLAT) / CL) * CL, L = row0 < NLAT ? SL : CL, t0 = row0 - s0;
    const bf16* Z = WSP(bf16, WS_Z);
    __syncthreads();
    for (int idx = C.tid; idx < 48 * 64; idx += 512) { const int r = idx >> 6, ch = idx & 63, t = t0 - 8 + r; u32x4 v = {0u, 0u, 0u, 0u};
        if (t >= 0 && t < L) v = *(const u32x4*)(Z + (size_t)(s0 + t) * INW + 8 * ch);
        *(LAS u32x4*)(C.lds + r * RS + ch * 16) = v; }
    __syncthreads();
    {
        const int c8 = C.tid & 63, tg = C.tid >> 6, hw = 1 << (c8 >> 4);
#pragma unroll 1
        for (int k = 0; k < 4; ++k) { const int tt = 4 * tg + k, t = t0 + tt; const int lo = max(t - hw, 0), hi = min(t + hw, L);
            float sacc[8];
#pragma unroll
            for (int j = 0; j < 8; ++j) sacc[j] = 0.f;
            for (int q = lo; q < hi; ++q) { float f[8]; cvt8(*(const LAS u32x4*)(C.lds + (q - t0 + 8) * RS + c8 * 16), f);
#pragma unroll
                for (int j = 0; j < 8; ++j) sacc[j] += f[j]; }
            float cf[8]; cvt8(*(const LAS u32x4*)(C.lds + (tt + 8) * RS + c8 * 16), cf); const float inv = 1.0f / (float)(hi - lo);
#pragma unroll
            for (int j = 0; j < 8; ++j) sacc[j] = sacc[j] * inv - cf[j];
            *(LAS bf16x8*)(C.lds + DT_OFF + tt * RS + c8 * 16) = pack8(sacc); }
    }
    __syncthreads();
    const int gi = C.wave >> 1, oh = C.wave & 1, r32 = C.lane & 31, h = C.lane >> 5;
    f32x16 acc[2];
#pragma unroll
    for (int a = 0; a < 2; ++a)
#pragma unroll
        for (int i = 0; i < 16; ++i) acc[a][i] = 0.f;
    const bf16* wt = WSP(bf16, WS_POOLWT) + (size_t)((l * 4 + gi) * 128 + 64 * oh + r32) * 128 + 8 * h;
#pragma unroll
    for (int s = 0; s < 8; ++s) {
        const bf16x8 Bf = *(const LAS bf16x8*)(C.lds + DT_OFF + r32 * RS + (128 * gi + 16 * s + 8 * h) * 2);
#pragma unroll
        for (int rb = 0; rb < 2; ++rb) { const bf16x8 Af = *(const bf16x8*)(wt + (size_t)(32 * rb) * 128 + 16 * s); acc[rb] = MFMA32(Af, Bf, acc[rb]); }
    }
    bf16* yp = WSP(bf16, WS_YCAT) + (size_t)(row0 + r32) * DM + 128 * gi + 64 * oh;
#pragma unroll
    for (int rb = 0; rb < 2; ++rb)
#pragma unroll
        for (int rg = 0; rg < 4; ++rg) { u32x2 w; w.x = pk2(acc[rb][4 * rg], acc[rb][4 * rg + 1]); w.y = pk2(acc[rb][4 * rg + 2], acc[rb][4 * rg + 3]); *(u32x2*)(yp + 32 * rb + 8 * rg + 4 * h) = w; }
}

__device__ __forceinline__ void hyprep_unit(Ctx& C, int l, int uidx) {
    constexpr int RS = 528;
    int seq, tb, cb, L, rowbase; bf16* T;
    if (uidx < 1536) { seq = uidx / 384; const int rem = uidx % 384; tb = rem / 6; cb = rem % 6; L = SL; rowbase = seq * SL; T = WSP(bf16, WS_TL); }
    else { const int v = uidx - 1536; seq = v / 24; const int rem = v % 24; tb = rem / 6; cb = rem % 6; L = CL; rowbase = NLAT + seq * CL; T = WSP(bf16, WS_TC); }
    const int t0 = 64 * tb; const bf16* Z = WSP(bf16, WS_Z);
    __syncthreads();
    for (int idx = C.tid; idx < 66 * 32; idx += 512) { const int r = idx >> 5, ch = idx & 31, t = t0 - 1 + r; u32x4 v = {0u, 0u, 0u, 0u};
        if (t >= 0 && t < L) v = *(const u32x4*)(Z + (size_t)(rowbase + t) * INW + 1280 + 256 * cb + 8 * ch);
        *(LAS u32x4*)(C.lds + r * RS + ch * 16) = v; }
    __syncthreads();
    const int c = C.tid & 255, hf = C.tid >> 8, ch = 256 * cb + c, comp = ch >> 9, cc = ch & 511;
    const float w0 = INP(I_HCW)[(l * 3 + 0) * 1536 + ch], w1 = INP(I_HCW)[(l * 3 + 1) * 1536 + ch], w2 = INP(I_HCW)[(l * 3 + 2) * 1536 + ch], bias = INP(I_HCB)[l * 1536 + ch];
    bf16* dst = T + ((size_t)(comp * 512 + cc) * 4 + seq) * L + t0 + 32 * hf;
    float zm = bf1(*(const LAS bf16*)(C.lds + (32 * hf) * RS + c * 2)), zc = bf1(*(const LAS bf16*)(C.lds + (32 * hf + 1) * RS + c * 2));
#pragma unroll
    for (int k = 0; k < 4; ++k) { float o[8];
#pragma unroll
        for (int e = 0; e < 8; ++e) { const float zn = bf1(*(const LAS bf16*)(C.lds + (32 * hf + 8 * k + e + 2) * RS + c * 2)); o[e] = bias + w0 * zm + w1 * zc + w2 * zn; zm = zc; zc = zn; }
        u32x4 w; w.x = pk2(o[0], o[1]); w.y = pk2(o[2], o[3]); w.z = pk2(o[4], o[5]); w.w = pk2(o[6], o[7]); *(u32x4*)(dst + 8 * k) = w; }
}

template <int L>
__device__ __forceinline__ void hyena_unit(Ctx& C, int l, int c) {
    constexpr int NBLK = L / 32, NTILE = NBLK / 8, NTL = (NTILE >= 16) ? 2 : 1;
    constexpr int SB = 2 * L + 16, Z_OFF = 4 * SB, R_OFF = Z_OFF + 64, CSZ = 4 * L;
    const bf16* T = (L == SL) ? WSP(bf16, WS_TL) : WSP(bf16, WS_TC);
    const int r32 = C.lane & 31, h = C.lane >> 5;
    const bool active = (2 * C.wave < NTILE);
    const int qi = (r32 + 1) >> 2, ri = (r32 + 1) & 3, pcp = (4 - ri) & 3;
    const int laneA = R_OFF + pcp * CSZ + (pcp ? 8 + 64 * pcp : 0) - 8 * (qi + (ri ? 1 : 0)) + 16 * h;
    const int al = r32 >> 2, bb = r32 & 3;
    const int laneB = bb * SB + 16 * h;
    for (int o = 0; o < 2; ++o) {
        __syncthreads();
        if (o == 0) { const bf16* src = T + (size_t)(2 * 512 + c) * 4 * L;
            for (int idx = C.tid; idx < 4 * L / 8; idx += 512) { const int b = idx / (L / 8), tc = idx % (L / 8); *(LAS u32x4*)(C.lds + b * SB + tc * 16) = *(const u32x4*)(src + 8 * idx); }
            if (C.tid < 4) *(LAS u32x4*)(C.lds + Z_OFF + 16 * C.tid) = (u32x4){0u, 0u, 0u, 0u}; }
        { const bf16* fsrc = (L == SL) ? WSP(bf16, WS_FILT) + (size_t)((l * 2 + o) * 512 + c) * (2 * L) : WSP(bf16, WS_FILTC) + (size_t)(o * 512 + c) * (2 * L);
          for (int idx = C.tid; idx < L / 4; idx += 512) *(LAS u32x4*)(C.lds + R_OFF + 16 * idx) = *(const u32x4*)(fsrc + 8 * idx); }
        __syncthreads();
        for (int idx = C.tid; idx < 3 * (L / 2); idx += 512) { const int p = 1 + idx / (L / 2), w = idx % (L / 2); unsigned short e[4];
#pragma unroll
            for (int k = 0; k < 4; ++k) { const int n = 4 * w + p + k; e[k] = n < 2 * L ? *(const LAS bf16*)(C.lds + R_OFF + 2 * n) : (bf16)0; }
            *(LAS u32x2*)(C.lds + R_OFF + p * CSZ + 8 + 64 * p + 8 * w) = (u32x2){(unsigned)e[0] | ((unsigned)e[1] << 16), (unsigned)e[2] | ((unsigned)e[3] << 16)}; }
        __syncthreads();
        f32x16 acc[NTL];
#pragma unroll
        for (int t = 0; t < NTL; ++t)
#pragma unroll
            for (int i = 0; i < 16; ++i) acc[t][i] = 0.f;
        u32x2 gpre[NTL][4]; float skip = 0.f;
        if (active) { skip = INP(I_HSKIP)[(l * 2 + o) * 512 + c]; const bf16* gate_ = T + (size_t)(o * 512 + c) * 4 * L + (size_t)bb * L;
#pragma unroll
            for (int t = 0; t < NTL; ++t)
#pragma unroll
                for (int rg = 0; rg < 4; ++rg) gpre[t][rg] = *(const u32x2*)(gate_ + 32 * (8 * (2 * C.wave + t) + al) + 8 * rg + 4 * h); }
        if (active) {
            const int a0 = 8 * (2 * C.wave);
            const int m_lo = a0 - (NBLK - 1), m_hi = a0 + 8 * (NTL - 1) + 7;
            const int mA = m_hi - (NBLK - 1), mB = a0;
            int off8 = 8; asm volatile("" : "+v"(off8));
#define HY_STEP_CHK(m_) do { bf16x8 Af_[2]; \
                _Pragma("unroll") for (int s = 0; s < 2; ++s) { const LAS unsigned char* ap = C.lds + laneA + 2 * (L - 32 * (m_) + 16 * s); const u32x2 x0 = *(const LAS u32x2*)ap, x1 = *(const LAS u32x2*)(ap + off8); \
                    const u32x4 xx = {x0.x, x0.y, x1.x, x1.y}; Af_[s] = __builtin_bit_cast(bf16x8, xx); } \
                _Pragma("unroll") for (int t = 0; t < NTL; ++t) { const int q = a0 + 8 * t + al - (m_); const bool ok = (q >= 0) && (q < NBLK); \
                    _Pragma("unroll") for (int s = 0; s < 2; ++s) { const int addr = ok ? (laneB + 64 * q + 32 * s) : Z_OFF; const bf16x8 Bf_ = *(const LAS bf16x8*)(C.lds + addr); acc[t] = MFMA32(Af_[s], Bf_, acc[t]); } } } while (0)
#pragma unroll 1
            for (int m = m_lo; m < mA; ++m) HY_STEP_CHK(m);
            {
                int o1 = 8, o2 = 32, o3 = 40; asm volatile("" : "+v"(o1), "+v"(o2), "+v"(o3));
                const LAS unsigned char* pa0 = C.lds + laneA + 2 * (L - 32 * mA); const LAS unsigned char* pa1 = pa0 + o1; const LAS unsigned char* pa2 = pa0 + o2; const LAS unsigned char* pa3 = pa0 + o3;
                const LAS unsigned char* pb = C.lds + laneB + 64 * (a0 + al - mA);
#define HY_LOADF(Af_, Bf_) do { { const u32x2 x0 = *(const LAS u32x2*)pa0, x1 = *(const LAS u32x2*)pa1, x2 = *(const LAS u32x2*)pa2, x3 = *(const LAS u32x2*)pa3; \
                    const u32x4 xa = {x0.x, x0.y, x1.x, x1.y}, xb = {x2.x, x2.y, x3.x, x3.y}; Af_[0] = __builtin_bit_cast(bf16x8, xa); Af_[1] = __builtin_bit_cast(bf16x8, xb); } \
                _Pragma("unroll") for (int t = 0; t < NTL; ++t) _Pragma("unroll") for (int s = 0; s < 2; ++s) Bf_[t][s] = *(const LAS bf16x8*)(pb + 512 * t + 32 * s); \
                pa0 -= 64; pa1 -= 64; pa2 -= 64; pa3 -= 64; pb -= 64; asm volatile("" : "+v"(pa0), "+v"(pa1), "+v"(pa2), "+v"(pa3)); } while (0)
#define HY_MMA(Af_, Bf_) do { _Pragma("unroll") for (int s = 0; s < 2; ++s) _Pragma("unroll") for (int t = 0; t < NTL; ++t) acc[t] = MFMA32(Af_[s], Bf_[t][s], acc[t]); } while (0)
                int nfast = mB - mA + 1;
                if constexpr (NTL == 2) {
                    bf16x8 Bx[8][2], By[8][2];
#define HY_LOADA(Af_) do { const u32x2 x0 = *(const LAS u32x2*)pa0, x1 = *(const LAS u32x2*)pa1, x2 = *(const LAS u32x2*)pa2, x3 = *(const LAS u32x2*)pa3; \
                        const u32x4 xa = {x0.x, x0.y, x1.x, x1.y}, xb = {x2.x, x2.y, x3.x, x3.y}; Af_[0] = __builtin_bit_cast(bf16x8, xa); Af_[1] = __builtin_bit_cast(bf16x8, xb); \
                        pa0 -= 64; pa1 -= 64; pa2 -= 64; pa3 -= 64; asm volatile("" : "+v"(pa0), "+v"(pa1), "+v"(pa2), "+v"(pa3)); } while (0)
#define HY_GROUP(Bold, Bnew, more) do { _Pragma("unroll") for (int i = 0; i < 8; ++i) { bf16x8 An_[2] = {Ac_[0], Ac_[1]}; \
                        if (i < 7) { HY_LOADA(An_); Bnew[i + 1][0] = *(const LAS bf16x8*)(pb - 64 * (i + 1)); Bnew[i + 1][1] = *(const LAS bf16x8*)(pb - 64 * (i + 1) + 32); } \
                        else if (more) { HY_LOADA(An_); Bold[0][0] = *(const LAS bf16x8*)(pb - 512); Bold[0][1] = *(const LAS bf16x8*)(pb - 512 + 32); }        \
                        acc[0] = MFMA32(Ac_[0], Bnew[i][0], acc[0]); acc[1] = MFMA32(Ac_[0], Bold[i][0], acc[1]); acc[0] = MFMA32(Ac_[1], Bnew[i][1], acc[0]); acc[1] = MFMA32(Ac_[1], Bold[i][1], acc[1]); \
                        Ac_[0] = An_[0]; Ac_[1] = An_[1]; } \
                        pb -= 512; } while (0)
                    if (nfast >= 16) {
#pragma unroll
                        for (int i = 0; i < 8; ++i) { Bx[i][0] = *(const LAS bf16x8*)(pb + 512 - 64 * i); Bx[i][1] = *(const LAS bf16x8*)(pb + 512 - 64 * i + 32); }
                        bf16x8 Ac_[2]; HY_LOADA(Ac_); By[0][0] = *(const LAS bf16x8*)pb; By[0][1] = *(const LAS bf16x8*)(pb + 32);
#pragma unroll 1
                        while (nfast >= 16) { HY_GROUP(Bx, By, true); HY_GROUP(By, Bx, nfast >= 32); nfast -= 16; }
                    }
#undef HY_LOADA
#undef HY_GROUP
                }
                bf16x8 A0[2], B0[NTL][2], A1[2], B1[NTL][2];
                if (nfast > 0) {
                    int rem = nfast - 1;
                    HY_LOADF(A0, B0);
#pragma unroll 1
                    while (rem >= 2) { HY_LOADF(A1, B1); HY_MMA(A0, B0); HY_LOADF(A0, B0); HY_MMA(A1, B1); rem -= 2; }
                    if (rem == 1) { HY_LOADF(A1, B1); HY_MMA(A0, B0); HY_MMA(A1, B1); } else { HY_MMA(A0, B0); }
                }
#undef HY_LOADF
#undef HY_MMA
            }
#pragma unroll 1
            for (int m = mB + 1; m <= m_hi; ++m) HY_STEP_CHK(m);
#undef HY_STEP_CHK
        }
        __syncthreads();
        if (active) {
#pragma unroll
            for (int t = 0; t < NTL; ++t) { const int a = 8 * (2 * C.wave + t) + al;
#pragma unroll
                for (int rg = 0; rg < 4; ++rg) { const int t4 = 32 * a + 8 * rg + 4 * h;
                    LAS u32x2* up = (LAS u32x2*)(C.lds + bb * SB + t4 * 2); const u32x2 uo = *up; const u32x2 gv = gpre[t][rg];
                    const float v0 = bflo(gv.x) * (acc[t][4 * rg] + skip * bflo(uo.x)), v1 = bfhi(gv.x) * (acc[t][4 * rg + 1] + skip * bfhi(uo.x));
                    const float v2 = bflo(gv.y) * (acc[t][4 * rg + 2] + skip * bflo(uo.y)), v3 = bfhi(gv.y) * (acc[t][4 * rg + 3] + skip * bfhi(uo.y));
                    const u32x2 w = {pk2(v0, v1), pk2(v2, v3)};
                    if (o == 0) *up = w;
                    else { const int row = (L == SL) ? bb * SL + t4 : NLAT + bb * CL + t4; *(u32x2*)(WSP(bf16, WS_YHT) + (size_t)c * NTOK + row) = w; } } }
        }
    }
}

constexpr int RMS_GN_OFF = 34816;
__device__ __forceinline__ void rms_stage_gain(Ctx& C, int l) { __syncthreads(); stage2048(C, (LAS float*)(C.lds + RMS_GN_OFF), INP(I_MNG) + l * DM); __syncthreads(); }
__device__ __forceinline__ void rms_unit(Ctx& C, int l, int blk) {
    constexpr int RS = 1040;
    const int row0 = 32 * blk;
    const int tok = C.tid >> 4, sub = C.tid & 15;
    const bf16* Y = WSP(bf16, WS_YCAT) + (size_t)(row0 + tok) * DM + 32 * sub;
    u32x4 raw[3][4];
#pragma unroll
    for (int gi = 0; gi < 3; ++gi)
#pragma unroll
        for (int c8 = 0; c8 < 4; ++c8) raw[gi][c8] = *(const u32x4*)(Y + 512 * (gi == 2 ? 3 : gi) + 8 * c8);
    u32x4 hy[4];
    { const bf16* yh = WSP(bf16, WS_YHT);
#pragma unroll
      for (int k = 0; k < 4; ++k) { const int idx = C.tid + 512 * k, ch = idx >> 2, tc = idx & 3; hy[k] = *(const u32x4*)(yh + (size_t)ch * NTOK + row0 + 8 * tc); } }
    __syncthreads();
#pragma unroll
    for (int k = 0; k < 4; ++k) { const int idx = C.tid + 512 * k, ch = idx >> 2, tc = idx & 3; const u32x4 v = hy[k];
        LAS bf16* d = (LAS bf16*)(C.lds + (8 * tc) * RS + ch * 2);
        d[0] = (bf16)(v.x & 0xffff); d[RS / 2] = (bf16)(v.x >> 16); d[2 * (RS / 2)] = (bf16)(v.y & 0xffff); d[3 * (RS / 2)] = (bf16)(v.y >> 16);
        d[4 * (RS / 2)] = (bf16)(v.z & 0xffff); d[5 * (RS / 2)] = (bf16)(v.z >> 16); d[6 * (RS / 2)] = (bf16)(v.w & 0xffff); d[7 * (RS / 2)] = (bf16)(v.w >> 16); }
    __syncthreads();
    const LAS float* gn = (const LAS float*)(C.lds + RMS_GN_OFF);
    unsigned char* O = WSP(unsigned char, WS_HA8) + (size_t)(row0 + tok) * DM + 32 * sub;
#pragma unroll
    for (int gq = 0; gq < 4; ++gq) {
        float f[32]; float q = 0.f;
#pragma unroll
        for (int c8 = 0; c8 < 4; ++c8) { const u32x4 v = (gq == 2) ? *(const LAS u32x4*)(C.lds + tok * RS + (32 * sub + 8 * c8) * 2) : raw[gq == 3 ? 2 : gq][c8];
            float t8[8]; cvt8(v, t8);
#pragma unroll
            for (int j = 0; j < 8; ++j) { f[8 * c8 + j] = t8[j]; q += t8[j] * t8[j]; } }
        q = row16_sum(q);
        const float rs = 1.0f / sqrtf(q * (1.0f / 512.0f) + LN_EPS);
        const LAS float* gp = gn + 512 * gq + 32 * sub;
#pragma unroll
        for (int c8 = 0; c8 < 4; ++c8) { const f32x4 g0 = *(const LAS f32x4*)(gp + 8 * c8), g1 = *(const LAS f32x4*)(gp + 8 * c8 + 4);
            u32x2 w; w.x = pk4_fp8(f[8 * c8] * rs * g0[0], f[8 * c8 + 1] * rs * g0[1], f[8 * c8 + 2] * rs * g0[2], f[8 * c8 + 3] * rs * g0[3]);
            w.y = pk4_fp8(f[8 * c8 + 4] * rs * g1[0], f[8 * c8 + 5] * rs * g1[1], f[8 * c8 + 6] * rs * g1[2], f[8 * c8 + 7] * rs * g1[3]);
            *(u32x2*)(O + 512 * gq + 8 * c8) = w; }
        __builtin_amdgcn_sched_barrier(0);
    }
}

__device__ __forceinline__ void ph_post1(Ctx& C, int l, int nrows, bool dry = false) {
    LAS float* H2 = (LAS float*)C.lds;
    LAS float* RED = (LAS float*)(C.lds + 65536);
    LAS float* SGA = (LAS float*)(C.lds + 81920);
    LAS float* PAR = (LAS float*)(C.lds + 92160);
    unsigned* ctl = WSP(unsigned, WS_CTL);
    int nit = 0, cur_mrow = -1;
    const int nit_all = nrows / 8, it0 = (int)(((long)C.bid * nit_all) / C.G), it1 = (int)(((long)(C.bid + 1) * nit_all) / C.G);
    for (int it = it0; it < it1; ++it, ++nit) {
        const int row = it * 8 + C.wave;
        const int mrow = row < NLAT ? row / SL : 4; const float* mod = WSP(float, WS_MOD) + (size_t)(l * 5 + mrow) * 12288;
        __syncthreads();
        if (mrow != cur_mrow) { stage2048(C, PAR, mod + 4096); stage2048(C, PAR + 2048, INP(I_LN1G) + l * DM); stage2048(C, PAR + 4096, INP(I_LN1B) + l * DM); stage2048(C, PAR + 6144, mod + 8192); stage2048(C, PAR + 8192, mod + 6144); cur_mrow = mrow; __syncthreads(); }
        {
            float v[32], y[32], g1[32];
            if (l == 0) row_load(src_x0(C, row), C.lane, v); else row_load_bf16(WSP(bf16, WS_X) + (size_t)row * DM, C.lane, v);
            row_load_lds(PAR, C.lane, g1);
            { const bf16* yo = WSP(bf16, WS_YO) + (size_t)row * DM;
#pragma unroll
              for (int j = 0; j < 4; ++j) { float t8[8]; cvt8(*(const u32x4*)(yo + 512 * j + 8 * C.lane), t8);
#pragma unroll
                  for (int e = 0; e < 8; ++e) y[8 * j + e] = t8[e]; } }
#pragma unroll
            for (int i = 0; i < 32; ++i) v[i] = ALPHA * v[i] + g1[i] * y[i];
            row_ln(v); row_affine_lds(v, PAR + 2048, PAR + 4096, C.lane, 0.f);
            row_store_bf16(WSP(bf16, WS_X) + (size_t)row * DM, C.lane, v);
            row_ln(v); row_affine_lds(v, PAR + 6144, PAR + 8192, C.lane, 1.0f);
            row_store_fp8(WSP(unsigned char, WS_HB8) + (size_t)row * DM, C.lane, v);
#pragma unroll
            for (int j = 0; j < 4; ++j) { *(LAS f32x4*)(H2 + C.wave * DM + 512 * j + 8 * C.lane) = (f32x4){v[8 * j], v[8 * j + 1], v[8 * j + 2], v[8 * j + 3]};
                *(LAS f32x4*)(H2 + C.wave * DM + 512 * j + 8 * C.lane + 4) = (f32x4){v[8 * j + 4], v[8 * j + 5], v[8 * j + 6], v[8 * j + 7]}; }
        }
        __syncthreads();
        {
            const int e4 = C.lane & 7, cg = C.lane >> 3, cbase = 256 * C.wave + 32 * cg;
            f32x2 acc[8][2];
#pragma unroll
            for (int r = 0; r < 8; ++r) { acc[r][0] = (f32x2){0.f, 0.f}; acc[r][1] = (f32x2){0.f, 0.f}; }
            const float* wr = INP(I_WR) + (size_t)cbase * NE + 4 * e4;
#pragma unroll 2
            for (int cq = 0; cq < 32; cq += 4) {
                f32x4 w4[4];
#pragma unroll
                for (int k = 0; k < 4; ++k) w4[k] = *(const f32x4*)(wr + (size_t)(cq + k) * NE);
#pragma unroll
                for (int r = 0; r < 8; ++r) { const f32x4 hv = *(const LAS f32x4*)(H2 + r * DM + cbase + cq);
#pragma unroll
                    for (int k = 0; k < 4; ++k) { const f32x2 hh = {hv[k], hv[k]}; acc[r][0] += hh * (f32x2){w4[k][0], w4[k][1]}; acc[r][1] += hh * (f32x2){w4[k][2], w4[k][3]}; } } }
#pragma unroll
            for (int r = 0; r < 8; ++r)
#pragma unroll
                for (int k = 0; k < 2; ++k) { float x = acc[r][k].x, y = acc[r][k].y;
                    x += dpp_f<DPP_ROR8>(x); y += dpp_f<DPP_ROR8>(y); x = xor32_sum(xor16_sum(x)); y = xor32_sum(xor16_sum(y));
                    if (cg == 0) { RED[(C.wave * 8 + r) * 32 + 4 * e4 + 2 * k] = x; RED[(C.wave * 8 + r) * 32 + 4 * e4 + 2 * k + 1] = y; } }
        }
        __syncthreads();
        if (C.tid < 256) { const int r = C.tid >> 5, e = C.tid & 31; float s = 0.f;
#pragma unroll
            for (int p = 0; p < 8; ++p) s += RED[(p * 8 + r) * 32 + e];
            SGA[(nit * 8 + r) * 32 + e] = 1.0f / (1.0f + expf(-s)); }
    }
    __syncthreads();
    if (C.tid < nit * 8 && !dry) { const int r = C.tid, rw = (it0 + (r >> 3)) * 8 + (r & 7); float best = -INFINITY; int bg = 0;
        const LAS float* sg = SGA + r * 32; const float* rb = INP(I_RB);
        for (int gq = 0; gq < 8; ++gq) { const float a = sg[4 * gq] + rb[4 * gq], b = sg[4 * gq + 1] + rb[4 * gq + 1], c = sg[4 * gq + 2] + rb[4 * gq + 2], d = sg[4 * gq + 3] + rb[4 * gq + 3];
            const float hi1 = fmaxf(a, b), lo1 = fminf(a, b), hi2 = fmaxf(c, d), lo2 = fminf(c, d);
            const float top = fmaxf(hi1, hi2), second = fmaxf(fminf(hi1, hi2), (hi1 >= hi2) ? lo1 : lo2);
            const float sc = top + second; if (sc > best) { best = sc; bg = gq; } }
        int i0 = 0; float v0 = -INFINITY;
        for (int k = 0; k < 4; ++k) { const float x = sg[4 * bg + k] + rb[4 * bg + k]; if (x > v0) { v0 = x; i0 = k; } }
        int i1 = 0; float v1 = -INFINITY;
        for (int k = 0; k < 4; ++k) { const float x = sg[4 * bg + k] + rb[4 * bg + k]; if (k != i0 && x > v1) { v1 = x; i1 = k; } }
        const int e0 = 4 * bg + i0, e1 = 4 * bg + i1; const float w0 = sg[e0], w1 = sg[e1], ws = w0 + w1;
        const int p0 = (int)atomicAdd(ctl + CW_CNT + l * 2048 + e0 * 64, 1u), p1 = (int)atomicAdd(ctl + CW_CNT + l * 2048 + e1 * 64, 1u);
        WSP(int4, WS_TOKINFO)[rw] = make_int4(e0, p0, e1, p1); WSP(f32x2, WS_TOKW)[rw] = (f32x2){w0 / ws, w1 / ws};
        WSP(int, WS_EXPTOK)[(size_t)e0 * NTOK + p0] = rw; WSP(int, WS_EXPTOK)[(size_t)e1 * NTOK + p1] = rw; }
    __syncthreads();
}

__device__ __forceinline__ int moe_tables(Ctx& C, int l) {
    LAS int* T = (LAS int*)(C.lds + LDS_TAB);
    __syncthreads();
    if (C.tid < NE) { unsigned* ctl = WSP(unsigned, WS_CTL); T[200 + C.tid] = (int)__hip_atomic_load(ctl + CW_CNT + l * 2048 + C.tid * 64, __ATOMIC_RELAXED, __HIP_MEMORY_SCOPE_AGENT); }
    __syncthreads();
    if (C.tid == 0) { int nb = 0;
        for (int e = 0; e < NE; ++e) { const int cnt = T[200 + e]; T[168 + e] = nb; const int nbk = (cnt + 255) >> 8;
            for (int k = 0; k < nbk; ++k) if (nb + k < MAXBLK) T[nb + k] = e;
            nb += nbk; }
        T[232] = nb < MAXBLK ? nb : MAXBLK; }
    __syncthreads();
    return T[232];
}

__device__ __forceinline__ void ph_post2(Ctx& C, int l, int nrows) {
    const bool last = (l == 1);
    (void)moe_tables(C, l);
    const LAS int* T = (const LAS int*)(C.lds + LDS_TAB);
    LAS float* PAR = (LAS float*)C.lds;
    const int r0 = (int)(((long)C.bid * nrows) / C.G), r1 = (int)(((long)(C.bid + 1) * nrows) / C.G);
    int cur_mrow = -1;
    for (int rb = r0 & ~7; rb < r1; rb += 8) {
        const int mrow = rb < NLAT ? rb / SL : 4; const float* mod = WSP(float, WS_MOD) + (size_t)(l * 5 + mrow) * 12288;
        if (mrow != cur_mrow) { const float* modn = WSP(float, WS_MOD) + (size_t)((last ? l : l + 1) * 5 + mrow) * 12288;
            __syncthreads(); stage2048(C, PAR, mod + 10240); stage2048(C, PAR + 2048, INP(I_LN2G) + l * DM); stage2048(C, PAR + 4096, INP(I_LN2B) + l * DM); stage2048(C, PAR + 6144, modn + 2048); stage2048(C, PAR + 8192, modn); cur_mrow = mrow; __syncthreads(); }
        const int row = rb + C.wave;
        if (row >= r0 && row < r1) {
        const int4 ti = WSP(int4, WS_TOKINFO)[row]; const f32x2 tw = WSP(f32x2, WS_TOKW)[row];
        const int s0 = T[168 + ti.x] * 256 + ti.y, s1 = T[168 + ti.z] * 256 + ti.w;
        const unsigned char* y0 = WSP(unsigned char, WS_YS) + (size_t)s0 * DM; const unsigned char* y1 = WSP(unsigned char, WS_YS) + (size_t)s1 * DM;
        float v[32], g2[32]; row_load_bf16(WSP(bf16, WS_X) + (size_t)row * DM, C.lane, v); row_load_lds(PAR, C.lane, g2);
#pragma unroll
        for (int j = 0; j < 4; ++j) { float a[8], b[8]; cvt8_fp8(*(const u32x2*)(y0 + 512 * j + 8 * C.lane), a); cvt8_fp8(*(const u32x2*)(y1 + 512 * j + 8 * C.lane), b);
#pragma unroll
            for (int e = 0; e < 8; ++e) v[8 * j + e] = ALPHA * v[8 * j + e] + g2[8 * j + e] * ((tw.x * 0.0625f) * a[e] + (tw.y * 0.0625f) * b[e]); }
        row_ln(v); row_affine_lds(v, PAR + 2048, PAR + 4096, C.lane, 0.f);
        if (last) { row_store((float*)(C.out + (size_t)row * DM), C.lane, v); }
        else { row_store_bf16(WSP(bf16, WS_X) + (size_t)row * DM, C.lane, v);
            row_ln(v); row_affine_lds(v, PAR + 6144, PAR + 8192, C.lane, 1.0f);
            if (FP8_IN) row_store_fp8(WSP(unsigned char, WS_HA8) + (size_t)row * DM, C.lane, v); else row_store_bf16(WSP(bf16, WS_HB) + (size_t)row * DM, C.lane, v); }
        }
    }
}

constexpr int N_PHASES = 20;
__global__ void __launch_bounds__(512, 2) fwd_kernel(Args args) {
    extern __shared__ __attribute__((aligned(16))) unsigned char lds_raw[];
    Ctx C0; C0.lds = (LAS unsigned char*)lds_raw; C0.tid = threadIdx.x; C0.lane = C0.tid & 63; C0.wave = __builtin_amdgcn_readfirstlane(C0.tid >> 6); C0.bid = blockIdx.x; C0.G = gridDim.x;
    C0.in = (const float GAS* const __attribute__((address_space(4)))*)((const __attribute__((address_space(4))) Args*)__builtin_amdgcn_kernarg_segment_ptr())->in; C0.out = (float GAS*)args.out; C0.ws = (unsigned char GAS*)args.ws;
    volatile LAS unsigned* MISC = (volatile LAS unsigned*)(C0.lds + LDS_MISC);
    if (C0.tid < 4) MISC[C0.tid] = 0u;
    __syncthreads();
    XcdBarrier bar; bar.bar = (unsigned*)(unsigned GAS*)(C0.ws + WS_CTL) + CW_BAR; bar.x = 0; bar.st = nullptr;
    const int lo = args.ph_lo, hi = args.ph_hi;
    if (hi - lo > 1) bar = xcd_barrier_post((unsigned*)(unsigned GAS*)(C0.ws + WS_CTL) + CW_BAR, MISC);
#ifdef ONLY
#define IN(k) ((k) == ONLY)
#define INL(j) ((j) + 2 == ONLY)
#define SEAM(k) do { } while (0)
#else
#define IN(k) (lo <= (k) && (k) < hi)
#define INL(j) IN(pb + (j))
#define SEAM(k) do { if (IN(k) && IN((k) + 1)) xcd_barrier(bar); } while (0)
#endif

    if (IN(0)) { _Pragma("unroll") for (int rep = 0; rep < NREP(0); ++rep) { if (rep) xcd_barrier(bar); FRESH(D, C0);
        if (D.bid & 1) { p0_filters(D); p0_adaln(D); } else { p0_adaln(D); p0_filters(D); }        p0_rope(D); __syncthreads(); p0_convert(D, 0, NBP); } }
    SEAM(0);
    if (IN(1)) { _Pragma("unroll") for (int rep = 0; rep < NREP(1); ++rep) { if (rep) xcd_barrier(bar); FRESH(D, C0); ph_ln_mod(D, 0, NTOK); } }
    SEAM(1);
#define LAYER_BODY(l) do { \
        const int pb = 2 + 9 * l; const bool last = (l == 1); const int nrows = last ? NLAT : NTOK; \
        if (INL(0)) { _Pragma("unroll") for (int rep = 0; rep < NREP(2 + 9 * l + 0); ++rep) { if (rep) xcd_barrier(bar); \
            FRESH(C, C0); \
            pg8::Gemm g{FP8_IN ? (const bf16*)WSP(unsigned char, WS_HA8) : WSP(bf16, WS_HB), FP8_IN ? (const bf16*)(WSP(unsigned char, WS_WIN) + (size_t)l * INW * DM) : WSP(bf16, WS_WIN) + (size_t)l * INW * DM, FP8_IN ? DM / 2 : DM}; \
            pg8::DenseOrder S; S.init(NTOK, INW, C.G, C.bid); \
            pg8::EpiBf16 E{WSP(bf16, WS_Z), INW, 11}; \
            pg8::gemm_phase<pg8::EpiBf16, pg8::DenseOrder, false, FP8_IN != 0>(C.lds, g, S, E); \
        } \
        } SEAM(pb + 0); \
        if (INL(1)) { _Pragma("unroll") for (int rep = 0; rep < NREP(2 + 9 * l + 1); ++rep) { if (rep) xcd_barrier(bar); \
            const int n_attn = last ? 256 : 272, n_gmlp = last ? 256 : 272, n_pool = last ? 512 : 544, n_hyp = last ? 1536 : 1632; \
            { FRESH(C, C0); \
                \
              volatile LAS int* qn = (volatile LAS int*)(C.lds + LDS_MISC + 32); \
              unsigned* qctr = WSP(unsigned, WS_CTL) + CW_QUEUE + (l * 2 + rep) * 64; \
              const int b0 = 256, b1 = b0 + n_gmlp, b2 = b1 + (n_attn - 256), b3 = b2 + n_pool, total = b3 + n_hyp; \
              volatile LAS int* qc = (volatile LAS int*)(C.lds + LDS_MISC + 36); \
              unsigned* cctr = WSP(unsigned, WS_CTL) + CW_QUEUE + (4 + rep) * 64; \
              int u = C.bid, cu = (last || C.bid >= CONV_SPLIT) ? NCU : C.bid;        \
              while (u < total || cu < NCU) { \
                  int nxt = total, nxc = NCU; \
                  if (C.tid == 0) { if (u < total) nxt = (int)atomicAdd(qctr, 1u) + C.G; if (cu < NCU) { nxc = (int)atomicAdd(cctr, 1u) + C.G; if (nxc >= CONV_SPLIT) nxc = NCU; } } \
                  if (u < total) { FRESH(Cu, C); if (u < b0) attn_unit(Cu, l, u); else if (u < b1) gmlp_unit(Cu, l, u - b0); else if (u < b2) attn_unit(Cu, l, 256 + u - b1); else if (u < b3) pool_unit(Cu, l, u - b2); else hyprep_unit(Cu, l, u - b3); } \
                  if (cu < NCU) { FRESH(Cu, C); conv_unit(Cu, 1, cu * 4); } \
                  __syncthreads(); if (C.tid == 0) { *qn = nxt; *qc = nxc; } __syncthreads(); u = __builtin_amdgcn_readfirstlane(*qn); cu = __builtin_amdgcn_readfirstlane(*qc); \
              } } \
        } \
        } SEAM(pb + 1); \
        if (INL(2)) { _Pragma("unroll") for (int rep = 0; rep < NREP(2 + 9 * l + 2); ++rep) { if (rep) xcd_barrier(bar); \
            { FRESH(C, C0);        \
              volatile LAS int* qc = (volatile LAS int*)(C.lds + LDS_MISC + 36); \
              unsigned* cctr = WSP(unsigned, WS_CTL) + CW_QUEUE + (6 + 2 * l + rep) * 64; \
              const int nhu = last ? 512 : 1024, ncu = last ? NCU_E : NCU_E + NCU_P; \
                \
              const int quota = (ncu + C.G - 1) / C.G, cls = C.bid % 3; \
              int hu = C.bid, cu = C.bid, nh = 0, nc = 0; \
              while (hu < nhu || cu < ncu) { \
                  const bool cv = cu < ncu && (hu >= nhu || (nc < quota && (cls == 0 || (cls == 1 && nh >= 1)))); \
                  if (cv) { \
                      int nxc = ncu; if (C.tid == 0) nxc = (int)atomicAdd(cctr, 1u) + C.G; \
                      { FRESH(Cu, C); bg_conv_unit(Cu, l, cu); } \
                      __syncthreads(); if (C.tid == 0) *qc = nxc; __syncthreads(); cu = __builtin_amdgcn_readfirstlane(*qc); ++nc; \
                  } else { FRESH(Cu, C); if (hu < 512) hyena_unit<SL>(Cu, l, hu); else hyena_unit<CL>(Cu, l, hu - 512); hu += C.G; ++nh; } \
              } } \
        } \
        } SEAM(pb + 2); \
        if (INL(3)) { _Pragma("unroll") for (int rep = 0; rep < NREP(2 + 9 * l + 3); ++rep) { if (rep) xcd_barrier(bar); FRESH(C, C0); rms_stage_gain(C, l); for (int u = C.bid; u < nrows / 32; u += C.G) { FRESH(Cu, C); rms_unit(Cu, l, u); } } \
        } SEAM(pb + 3); \
        if (INL(4)) { _Pragma("unroll") for (int rep = 0; rep < NREP(2 + 9 * l + 4); ++rep) { if (rep) xcd_barrier(bar); \
            FRESH(C, C0); \
            pg8::Gemm g{FP8_OUT ? (const bf16*)WSP(unsigned char, WS_HA8) : WSP(bf16, WS_HB), FP8_OUT ? (const bf16*)(WSP(unsigned char, WS_WOUT) + (size_t)l * DM * DM) : WSP(bf16, WS_WOUT) + (size_t)l * DM * DM, FP8_OUT ? DM / 2 : DM}; \
            pg8::DenseOrder S; S.init(nrows, DM, C.G, C.bid); \
            pg8::EpiBf16 E{WSP(bf16, WS_YO), DM, 1 << 30}; \
            pg8::gemm_phase<pg8::EpiBf16, pg8::DenseOrder, false, FP8_OUT != 0>(C.lds, g, S, E); \
        } \
        } SEAM(pb + 4); \
        if (INL(5)) { FRESH(C, C0); ph_post1(C, l, nrows); if (PROBE_P1 && l == 0) { xcd_barrier(bar); FRESH(C2, C0); ph_post1(C2, l, nrows, true); } } \
        SEAM(pb + 5); \
        if (INL(6)) { _Pragma("unroll") for (int rep = 0; rep < NREP(2 + 9 * l + 6); ++rep) { if (rep) xcd_barrier(bar); \
            FRESH(C, C0); \
            const int nblk = moe_tables(C, l); const LAS int* T = (const LAS int*)(C.lds + LDS_TAB); \
            pg8::Gemm g{(const bf16*)WSP(unsigned char, WS_HB8), (const bf16*)(WSP(unsigned char, WS_WGU) + (size_t)l * NE * 1536 * DM), DM / 2}; \
            pg8::MoeOrder S; S.nblk = nblk; S.nN = 6; S.G = C.G; S.c = C.bid; S.blk_e = T; S.bst = T + 168; S.cnt = T + 200; S.exptok = WSP(int, WS_EXPTOK); S.ntok = NTOK; \
            pg8::EpiGLU E{WSP(unsigned char, WS_HG), DE}; \
            pg8::gemm_phase<pg8::EpiGLU, pg8::MoeOrder, true, true>(C.lds, g, S, E); \
        } } \
        SEAM(pb + 6); \
        if (INL(7)) { _Pragma("unroll") for (int rep = 0; rep < NREP(2 + 9 * l + 7); ++rep) { if (rep) xcd_barrier(bar); \
            FRESH(C, C0); \
            const int nblk = moe_tables(C, l); const LAS int* T = (const LAS int*)(C.lds + LDS_TAB); \
            pg8::Gemm g{(const bf16*)WSP(unsigned char, WS_HG), (const bf16*)(WSP(unsigned char, WS_WD) + (size_t)l * NE * DM * DE), DE / 2}; \
            pg8::MoeOrder S; S.nblk = nblk; S.nN = 8; S.G = C.G; S.c = C.bid; S.blk_e = T; S.bst = T + 168; S.cnt = T + 200; S.exptok = WSP(int, WS_EXPTOK); S.ntok = NTOK; \
            pg8::EpiFp8 E{WSP(unsigned char, WS_YS), DM, 16.0f}; \
            pg8::gemm_phase<pg8::EpiFp8, pg8::MoeOrder, false, true>(C.lds, g, S, E); \
        } } \
        SEAM(pb + 7); \
        if (INL(8)) { FRESH(C, C0); ph_post2(C, l, nrows); if (PROBE_P2 && l == 1) { xcd_barrier(bar); FRESH(C2, C0); ph_post2(C2, l, nrows); } } \
        SEAM(pb + 8); \
} while (0)
    LAYER_BODY(0);
    LAYER_BODY(1);
#undef IN
#undef INL
#undef SEAM
}

extern "C" void kernel_launch(void* const* d_in, const int* in_sizes, int n_in, void* d_out, int out_size, void* d_ws, size_t ws_size, hipStream_t stream) {
    static int grid = 0;
    if (grid == 0) {
        if (n_in != 35 || out_size != NLAT * DM || ws_size < WS_END) { fprintf(stderr, "kernel_launch: unexpected shapes (n_in %d out %d ws %zu)\n", n_in, out_size, ws_size); grid = -1; return; }
        int dev = 0, cus = 0;
        if (hipGetDevice(&dev) != hipSuccess || hipDeviceGetAttribute(&cus, hipDeviceAttributeMultiprocessorCount, dev) != hipSuccess) { grid = -1; return; }
        if (hipFuncSetAttribute((const void*)fwd_kernel, hipFuncAttributeMaxDynamicSharedMemorySize, LDS_BYTES) != hipSuccess) { fprintf(stderr, "kernel_launch: hipFuncSetAttribute failed\n"); grid = -1; return; }
        int per_cu = 0;
        if (hipOccupancyMaxActiveBlocksPerMultiprocessor(&per_cu, (const void*)fwd_kernel, 512, LDS_BYTES) != hipSuccess || per_cu < 1) fprintf(stderr, "kernel_launch: occupancy query says %d\n", per_cu);
        (void)hipGetLastError();
        grid = cus;
    }
    if (grid < 0) return;
    (void)hipMemsetAsync((char*)d_ws + WS_CTL, 0, CTL_ZERO_BYTES, stream);
    Args a{};
    for (int i = 0; i < 35; ++i) a.in[i] = (const float*)d_in[i];
    a.out = (float*)d_out; a.ws = (unsigned char*)d_ws;
    if (MK_N_LAUNCHES == 1) { a.ph_lo = 0; a.ph_hi = N_PHASES; hipLaunchKernelGGL(fwd_kernel, dim3(grid), dim3(512), LDS_BYTES, stream, a); }
    else for (int p = 0; p < N_PHASES; ++p) { a.ph_lo = p; a.ph_hi = p + 1; hipLaunchKernelGGL(fwd_kernel, dim3(grid), dim3(512), LDS_BYTES, stream, a); }
}
```

```cpp
#include <hip/hip_runtime.h>
#include <cstdio>
#include <cstdint>

#ifndef DUP_MASK
#define DUP_MASK 0u
#endif
#ifndef PROBE_P1
#define PROBE_P1 0
#endif
#ifndef PROBE_P2
#define PROBE_P2 0
#endif
#ifndef FP8_IN
#define FP8_IN 1
#endif
#ifndef FP8_OUT
#define FP8_OUT 1
#endif
#ifndef PROBE_P0
#define PROBE_P0 0
#endif
#ifndef PROBE_CONV
#define PROBE_CONV 0
#endif
#ifndef DUP_SUB
#define DUP_SUB 0u
#endif
#define NSUB(k) (((DUP_SUB >> (k)) & 1u) ? 2 : 1)
#define NREP(k) (((DUP_MASK >> (k)) & 1u) ? 2 : 1)
#ifndef MK_N_LAUNCHES
#define MK_N_LAUNCHES 1
#endif

#define LAS __attribute__((address_space(3)))
#define GAS __attribute__((address_space(1)))
typedef unsigned short bf16;
typedef short bf16x8 __attribute__((ext_vector_type(8)));
typedef float f32x2 __attribute__((ext_vector_type(2)));
typedef float f32x4 __attribute__((ext_vector_type(4)));
typedef float f32x16 __attribute__((ext_vector_type(16)));
typedef unsigned u32x2 __attribute__((ext_vector_type(2)));
typedef unsigned u32x4 __attribute__((ext_vector_type(4)));
typedef __bf16 bf16x2_t __attribute__((ext_vector_type(2)));

constexpr int DM = 2048, NB = 4, SL = 4096, CL = 256, NLAT = NB * SL, NCTX = NB * CL, NTOK = NLAT + NCTX;
constexpr int INW = 3840, DE = 768, NE = 32, MAXBLK = 168;
constexpr float LN_EPS = 1e-6f, ALPHA = 1.41421356237f, LOG2E = 1.44269504089f;

constexpr size_t MiB = 1u << 20;
constexpr size_t WS_CTL = 0, CTL_ZERO_BYTES = 1 * MiB;
constexpr size_t WS_MOD = 1 * MiB;
constexpr size_t WS_ROPE = 2 * MiB;
constexpr size_t WS_TOKINFO = 2 * MiB + 65536;
constexpr size_t WS_TOKW = WS_TOKINFO + (size_t)NTOK * 16;
constexpr size_t WS_ROWSLOT = WS_TOKW + (size_t)NTOK * 8;
constexpr size_t WS_SLOTW = WS_ROWSLOT + (size_t)NTOK * 8;
static_assert(WS_SLOTW + 43008 * 4 <= 4 * MiB, "small tables");
constexpr size_t WS_POOLWT = 3 * MiB;
constexpr size_t WS_GWSB = 3 * MiB + 512 * 1024;
constexpr size_t WS_WIN = 4 * MiB;
constexpr size_t WS_WOUT = 34 * MiB;
constexpr size_t WS_WGU = 50 * MiB;
constexpr size_t WS_WD = 434 * MiB;
constexpr size_t WS_FILT = 626 * MiB;
constexpr size_t WS_FILTC = 658 * MiB;
constexpr size_t WS_X = 660 * MiB;
constexpr size_t WS_HB = 796 * MiB;
constexpr size_t WS_Z = 864 * MiB;
constexpr size_t WS_YCAT = 992 * MiB;
constexpr size_t WS_TL = 1060 * MiB;
constexpr size_t WS_TC = 1108 * MiB;
constexpr size_t WS_YHT = 1112 * MiB;
constexpr size_t WS_YO = 1129 * MiB;
constexpr size_t WS_EXPTOK = 864 * MiB;
constexpr size_t WS_HG = 1032 * MiB;
constexpr size_t WS_YS = 1095 * MiB;
constexpr size_t WS_HB8 = 1265 * MiB;
constexpr size_t WS_HA8 = 1300 * MiB;
constexpr size_t WS_END = 1334 * MiB;
constexpr int CW_BAR = 4096;
constexpr int CW_CNT = 8192;
constexpr int CW_QUEUE = 14336;
constexpr int CW_NBLK = 12288;
constexpr int CW_BLKE = 12544;
constexpr int LDS_TAB = 132096;
constexpr int LDS_BYTES = 147456;
constexpr int LDS_MISC = 147392;

__device__ __forceinline__ unsigned pk2(float lo, float hi) { f32x2 v = {lo, hi}; bf16x2_t b = __builtin_convertvector(v, bf16x2_t); return __builtin_bit_cast(unsigned, b); }
__device__ __forceinline__ unsigned pk4_fp8(float a, float b, float c, float d) { int p = 0; p = __builtin_amdgcn_cvt_pk_fp8_f32(a, b, p, false); p = __builtin_amdgcn_cvt_pk_fp8_f32(c, d, p, true); return (unsigned)p; }
__device__ __forceinline__ float bflo(unsigned w) { return __uint_as_float(w << 16); }
__device__ __forceinline__ float bfhi(unsigned w) { return __uint_as_float(w & 0xffff0000u); }
__device__ __forceinline__ float bf1(bf16 v) { return __uint_as_float(((unsigned)v) << 16); }
template <int CTRL> __device__ __forceinline__ float dpp_f(float x) { return __int_as_float(__builtin_amdgcn_update_dpp(0, __float_as_int(x), CTRL, 0xF, 0xF, true)); }
#define DPP_XOR1 0xB1
#define DPP_XOR2 0x4E
#define DPP_HMIRROR 0x141
#define DPP_MIRROR 0x140
#define DPP_ROR8 0x128
__device__ __forceinline__ float xor16_sum(float x) { const auto r = __builtin_amdgcn_permlane16_swap(__float_as_uint(x), __float_as_uint(x), false, false); return __uint_as_float(r[0]) + __uint_as_float(r[1]); }
__device__ __forceinline__ float xor32_sum(float x) { const auto r = __builtin_amdgcn_permlane32_swap(__float_as_uint(x), __float_as_uint(x), false, false); return __uint_as_float(r[0]) + __uint_as_float(r[1]); }
__device__ __forceinline__ float xor32_max(float x) { const auto r = __builtin_amdgcn_permlane32_swap(__float_as_uint(x), __float_as_uint(x), false, false); return fmaxf(__uint_as_float(r[0]), __uint_as_float(r[1])); }
__device__ __forceinline__ float row16_sum(float v) { v += dpp_f<DPP_XOR1>(v); v += dpp_f<DPP_XOR2>(v); v += dpp_f<DPP_HMIRROR>(v); v += dpp_f<DPP_MIRROR>(v); return v; }
__device__ __forceinline__ float wave_sum(float v) { return xor32_sum(xor16_sum(row16_sum(v))); }
__device__ __forceinline__ float gelu_tanh(float x) { const float y = 0.7978845608f * (x + 0.044715f * x * x * x); const float t = __expf(2.0f * y); return 0.5f * x * (2.0f - 2.0f * __builtin_amdgcn_rcpf(t + 1.0f)); }
__device__ __forceinline__ float silu_f(float x) { return x * __builtin_amdgcn_rcpf(1.0f + __expf(-x)); }
#define LDS_WAIT() asm volatile("s_waitcnt lgkmcnt(0)" ::: "memory")
#define VM_WAIT() asm volatile("s_waitcnt vmcnt(0)" ::: "memory")

namespace pg8 {
#define PG8_LAS __attribute__((address_space(3)))
typedef unsigned short bf16_t;
constexpr int BM = 256, BK = 64, HALF = 128, HTB = HALF * BK * 2, STAGE_BYTES = 8 * HTB, NXCD = 8, WGM = 8;
__host__ __device__ __forceinline__ int lds_byte(int r, int c) { const int st = (r >> 4) * 2 + (c >> 5), rr = r & 15, cc = c & 31, ob = rr * 64 + cc * 2; return st * 1024 + (ob ^ (((ob >> 9) & 1) << 5)); }
__host__ __device__ __forceinline__ void stage_rc(int b, int& R, int& C) { const int st = b / 1024, sb = b % 1024, swz = sb ^ (((sb >> 9) & 1) << 5); R = (st >> 1) * 16 + swz / 64; C = (st & 1) * 32 + (swz % 64) / 2; }
__host__ __device__ __forceinline__ int perm32(int rho) { const int n = rho >> 4, i = rho & 15; return 8 * (i >> 2) + 4 * n + (i & 3); }

struct Unit { int pm, pn, pb; const int* amap; int nvalid; };
struct Gemm { const bf16_t* A; const bf16_t* Bt; int K; };

struct DenseOrder {
    int nM, nN, nwg, G, c;
    __device__ void init(int M, int N, int G_, int c_) { nM = M / BM; nN = N / BM; nwg = nM * nN; G = G_; c = c_; }
    __device__ bool next(int i, Unit& u) const {
        const long L = (long)i * G + c; if (L >= nwg) return false;
        int wgid = (int)L; { const int q = nwg / NXCD, r = nwg % NXCD, xcd = wgid % NXCD, off = wgid / NXCD; wgid = (xcd < r ? xcd * (q + 1) : r * (q + 1) + (xcd - r) * q) + off; }
        const int nig = WGM * nN, gid = wgid / nig, fm = gid * WGM, gsz = (nM - fm) < WGM ? (nM - fm) : WGM;
        u.pm = fm + ((wgid % nig) % gsz); u.pn = (wgid % nig) / gsz; u.pb = u.pn; u.amap = nullptr; u.nvalid = 0; return true;
    }
    __device__ __forceinline__ void a_ready(const Unit&) const {}
    __device__ __forceinline__ void done(const Unit&) const {}
};
struct MoeOrder {
    int nblk, nN, G, c; const PG8_LAS int* blk_e; const PG8_LAS int* bst; const PG8_LAS int* cnt; const int* exptok; int ntok;
    __device__ bool next(int i, Unit& u) const {
        const long L = (long)i * G + c; const int nwg = nblk * nN; if (L >= nwg) return false;
        int wgid = (int)L; { const int q = nwg / NXCD, r = nwg % NXCD, xcd = wgid % NXCD, off = wgid / NXCD; wgid = (xcd < r ? xcd * (q + 1) : r * (q + 1) + (xcd - r) * q) + off; }
        const int blk = wgid / nN, pn = wgid % nN, e = blk_e[blk], p0 = (blk - bst[e]) * 256;
        u.pm = blk; u.pn = pn; u.pb = e * nN + pn; u.amap = exptok + (size_t)e * ntok + p0; u.nvalid = cnt[e] - p0; return true;
    }
    __device__ __forceinline__ void a_ready(const Unit&) const {}
    __device__ __forceinline__ void done(const Unit&) const {}
};

struct EpiBf16 {
    static constexpr bool PERM = true;
    bf16_t* O; int ldc; int gelu_from;
    __device__ __forceinline__ void operator()(const f32x4 (&acc)[2][2][4][2], const Unit& u, int wr, int wc, int fr, int fq) const {
        const int row0 = u.pm * BM + wr * 64 + fr; const int col0 = u.pn * BM + wc * 32 + 8 * fq; const bool act = u.pn >= gelu_from;
#pragma unroll
        for (int ai = 0; ai < 2; ++ai)
#pragma unroll
            for (int m = 0; m < 4; ++m) { bf16_t* rowp = O + (size_t)(row0 + ai * HALF + m * 16) * ldc + col0;
#pragma unroll
                for (int bj = 0; bj < 2; ++bj) { f32x4 v0 = acc[ai][bj][m][0], v1 = acc[ai][bj][m][1];
                    if (act) {
#pragma unroll
                        for (int j = 0; j < 4; ++j) { v0[j] = gelu_tanh(v0[j]); v1[j] = gelu_tanh(v1[j]); } }
                    u32x4 w; w.x = pk2(v0[0], v0[1]); w.y = pk2(v0[2], v0[3]); w.z = pk2(v1[0], v1[1]); w.w = pk2(v1[2], v1[3]);
                    *(u32x4*)(rowp + bj * HALF) = w; } }
    }
};
struct EpiFp8 {
    static constexpr bool PERM = true;
    unsigned char* O; int ldc; float scale;
    __device__ __forceinline__ void operator()(const f32x4 (&acc)[2][2][4][2], const Unit& u, int wr, int wc, int fr, int fq) const {
        const int row0 = u.pm * BM + wr * 64 + fr; const int col0 = u.pn * BM + wc * 32 + 8 * fq;
#pragma unroll
        for (int ai = 0; ai < 2; ++ai)
#pragma unroll
            for (int m = 0; m < 4; ++m) { unsigned char* rowp = O + (size_t)(row0 + ai * HALF + m * 16) * ldc + col0;
#pragma unroll
                for (int bj = 0; bj < 2; ++bj) { const f32x4 v0 = acc[ai][bj][m][0] * scale, v1 = acc[ai][bj][m][1] * scale;
                    u32x2 w; w.x = pk4_fp8(v0[0], v0[1], v0[2], v0[3]); w.y = pk4_fp8(v1[0], v1[1], v1[2], v1[3]);
                    *(u32x2*)(rowp + bj * HALF) = w; } }
    }
};
struct EpiF32 {
    static constexpr bool PERM = false;
    float* C; int ldc;
    __device__ __forceinline__ void operator()(const f32x4 (&acc)[2][2][4][2], const Unit& u, int wr, int wc, int fr, int fq) const {
        const int row0 = u.pm * BM + wr * 64 + fr, col0 = u.pn * BM + wc * 32 + 4 * fq;
#pragma unroll
        for (int ai = 0; ai < 2; ++ai)
#pragma unroll
            for (int m = 0; m < 4; ++m) { float* rowp = C + (size_t)(row0 + ai * HALF + m * 16) * ldc + col0;
#pragma unroll
                for (int bj = 0; bj < 2; ++bj)
#pragma unroll
                    for (int n = 0; n < 2; ++n) *(f32x4*)(rowp + bj * HALF + n * 16) = acc[ai][bj][m][n]; }
    }
};
struct EpiGLU {
    static constexpr bool PERM = true;
    unsigned char* O; int ldc;
    __device__ __forceinline__ void operator()(const f32x4 (&acc)[2][2][4][2], const Unit& u, int wr, int wc, int fr, int fq) const {
        const int row0 = u.pm * BM + wr * 64 + fr; const int col0 = u.pn * HALF + wc * 32 + 8 * fq;
#pragma unroll
        for (int ai = 0; ai < 2; ++ai)
#pragma unroll
            for (int m = 0; m < 4; ++m) { unsigned char* rowp = O + (size_t)(row0 + ai * HALF + m * 16) * ldc + col0;
                float o[8];
#pragma unroll
                for (int n = 0; n < 2; ++n)
#pragma unroll
                    for (int j = 0; j < 4; ++j) { const float g = acc[ai][0][m][n][j], up = acc[ai][1][m][n][j]; o[4 * n + j] = (g * __builtin_amdgcn_rcpf(1.0f + __expf(-g))) * up; }
                u32x2 w; w.x = pk4_fp8(o[0], o[1], o[2], o[3]); w.y = pk4_fp8(o[4], o[5], o[6], o[7]);
                *(u32x2*)rowp = w; }
    }
};
struct EpiScaleBf16 {
    static constexpr bool PERM = true;
    bf16_t* O; int ldc; const float* rs;
    __device__ __forceinline__ void operator()(const f32x4 (&acc)[2][2][4][2], const Unit& u, int wr, int wc, int fr, int fq) const {
        const int row0 = u.pm * BM + wr * 64 + fr; const int col0 = u.pn * BM + wc * 32 + 8 * fq;
#pragma unroll
        for (int ai = 0; ai < 2; ++ai)
#pragma unroll
            for (int m = 0; m < 4; ++m) { const int row = row0 + ai * HALF + m * 16; const float s = rs[row]; bf16_t* rowp = O + (size_t)row * ldc + col0;
#pragma unroll
                for (int bj = 0; bj < 2; ++bj) { const f32x4 v0 = acc[ai][bj][m][0] * s, v1 = acc[ai][bj][m][1] * s;
                    u32x4 w; w.x = pk2(v0[0], v0[1]); w.y = pk2(v0[2], v0[3]); w.z = pk2(v1[0], v1[1]); w.w = pk2(v1[2], v1[3]);
                    *(u32x4*)(rowp + bj * HALF) = w; } }
    }
};

typedef int i32x8 __attribute__((ext_vector_type(8)));
typedef int i32x4v __attribute__((ext_vector_type(4)));
template <class Epi, class Sched, bool GATHER = false, bool FP8 = false, bool ALIGN_EPI = true, bool SP2 = true>
__device__ __forceinline__ void gemm_phase(PG8_LAS unsigned char* lds, const Gemm g, const Sched& S, const Epi& E) {
    int tid_ = threadIdx.x; asm volatile("" : "+v"(tid_));
    const int tid = tid_, wid = __builtin_amdgcn_readfirstlane(tid >> 6), lane = tid & 63, wr = wid >> 2, wc = wid & 3, fr = lane & 15, fq = lane >> 4;
    int K_ = g.K; asm volatile("" : "+s"(K_));
    const int K = K_, nt = K / BK;
    unsigned voffA[2], voffB[2];
#pragma unroll
    for (int i = 0; i < 2; ++i) { int R, C; stage_rc(tid * 16 + i * 8192, R, C); const int Rb = Epi::PERM ? ((R & ~31) + perm32(R & 31)) : R;
        voffA[i] = (unsigned)(R * K + C) * 2u; voffB[i] = (unsigned)(Rb * K + C) * 2u; }
    const size_t kstep = (size_t)(BK * 2);
    const size_t hstep = (size_t)HALF * K * 2;
    const size_t tstep = 2 * hstep;
    const unsigned ldsw = (unsigned)wid * 1024u;
    const int aoff = lds_byte(wr * 64 + fr, fq * 8), boff = lds_byte(wc * 32 + fr, fq * 8);
#define PG8_SA(b, h) (((b) * 2 + (h)) * HTB)
#define PG8_SB(b, h) ((4 + (b) * 2 + (h)) * HTB)
#define PG8_STAGE(bufoff, gbase, voff) do { _Pragma("unroll") for (int _i = 0; _i < 2; ++_i) \
        __builtin_amdgcn_global_load_lds((const unsigned*)((const char*)(gbase) + (voff)[_i]), (PG8_LAS unsigned*)(lds + (bufoff) + ldsw + _i * 8192), 16, 0, 0); } while (0)
#define PG8_STAGE_G(bufoff, kbytes, o0, o1) do { \
        __builtin_amdgcn_global_load_lds((const unsigned*)((const char*)g.A + (kbytes) + (o0)), (PG8_LAS unsigned*)(lds + (bufoff) + ldsw), 16, 0, 0); \
        __builtin_amdgcn_global_load_lds((const unsigned*)((const char*)g.A + (kbytes) + (o1)), (PG8_LAS unsigned*)(lds + (bufoff) + ldsw + 8192), 16, 0, 0); } while (0)
#define PG8_LOADMAP(u, O) do { _Pragma("unroll") for (int _h = 0; _h < 2; ++_h) _Pragma("unroll") for (int _i = 0; _i < 2; ++_i) { int _R, _C; stage_rc(tid * 16 + _i * 8192, _R, _C); const int _rr = _h * HALF + _R; \
        int _t = (_rr < (u).nvalid) ? (u).amap[_rr] : 0; _t = ((unsigned)_t < 17408u) ? _t : 0; O[_h][_i] = (unsigned)(_t * K + _C) * 2u; } } while (0)
#define PG8_LD8(p) __builtin_shufflevector(*(const PG8_LAS i32x4v*)(p), *(const PG8_LAS i32x4v*)((p) + 1024), 0, 1, 2, 3, 4, 5, 6, 7)
#define PG8_LDA(dst, b, h) do { if constexpr (FP8) { _Pragma("unroll") for (int m = 0; m < 4; ++m) dst##8[m] = PG8_LD8(lds + PG8_SA(b, h) + aoff + m * 2048); } \
        else { _Pragma("unroll") for (int m = 0; m < 4; ++m) _Pragma("unroll") for (int k = 0; k < 2; ++k) dst[m][k] = *(const PG8_LAS bf16x8*)(lds + PG8_SA(b, h) + aoff + m * 2048 + k * 1024); } } while (0)
#define PG8_LDB(dst, b, h) do { if constexpr (FP8) { _Pragma("unroll") for (int n = 0; n < 2; ++n) dst##8[n] = PG8_LD8(lds + PG8_SB(b, h) + boff + n * 2048); } \
        else { _Pragma("unroll") for (int n = 0; n < 2; ++n) _Pragma("unroll") for (int k = 0; k < 2; ++k) dst[n][k] = *(const PG8_LAS bf16x8*)(lds + PG8_SB(b, h) + boff + n * 2048 + k * 1024); } } while (0)
#define PG8_MMA(ai, bj, At, Bt) do { __builtin_amdgcn_s_setprio(1); \
        if constexpr (FP8) { _Pragma("unroll") for (int m = 0; m < 4; ++m) _Pragma("unroll") for (int n = 0; n < 2; ++n) \
            asm volatile("v_mfma_scale_f32_16x16x128_f8f6f4 %0, %1, %2, %0, %3, %4 op_sel_hi:[0,0,0]" : "+v"(acc[ai][bj][m][n]) : "v"(Bt##8[n]), "v"(At##8[m]), "v"(sc_w), "v"(sc_x)); } \
        else { _Pragma("unroll") for (int m = 0; m < 4; ++m) _Pragma("unroll") for (int n = 0; n < 2; ++n) _Pragma("unroll") for (int k = 0; k < 2; ++k) \
            acc[ai][bj][m][n] = __builtin_amdgcn_mfma_f32_16x16x32_bf16(Bt[n][k], At[m][k], acc[ai][bj][m][n], 0, 0, 0); } \
        __builtin_amdgcn_s_setprio(0); } while (0)
#define PG8_WAIT_V(n) asm volatile("s_waitcnt vmcnt(" #n ")" ::: "memory")
#define PG8_WAIT_L(n) asm volatile("s_waitcnt lgkmcnt(" #n ")" ::: "memory")
#define PG8_BAR __builtin_amdgcn_s_barrier()
#define PG8_SCHED __builtin_amdgcn_sched_barrier(0)
    Unit cur, nxt; int ui = 0;
    if (!S.next(0, cur)) return;
    f32x4 acc[2][2][4][2];
#pragma unroll
    for (int a = 0; a < 2; ++a)
#pragma unroll
        for (int b = 0; b < 2; ++b)
#pragma unroll
            for (int m = 0; m < 4; ++m)
#pragma unroll
                for (int n = 0; n < 2; ++n) acc[a][b][m][n] = (f32x4){0.f, 0.f, 0.f, 0.f};
    bf16x8 At[4][2], B0[2][2], B1[2][2]; i32x8 At8[4], B08[2], B18[2];
    const int sc_w = 0x79797979, sc_x = 0x7f7f7f7f;
    const char* cA = (const char*)g.A + (size_t)cur.pm * tstep; const char* cB = (const char*)g.Bt + (size_t)cur.pb * tstep;
    unsigned cO[2][2] = {{0u, 0u}, {0u, 0u}}, nO[2][2] = {{0u, 0u}, {0u, 0u}};
    S.a_ready(cur);
    if constexpr (GATHER) { static_assert(SP2, "GATHER needs the SP2 loop"); PG8_LOADMAP(cur, cO); }
    if constexpr (SP2) {
        PG8_STAGE(PG8_SB(0, 0), cB, voffB); PG8_STAGE(PG8_SB(0, 1), cB + hstep, voffB);
        if constexpr (GATHER) { PG8_STAGE_G(PG8_SA(0, 0), 0, cO[0][0], cO[0][1]); PG8_STAGE_G(PG8_SA(0, 1), 0, cO[1][0], cO[1][1]); }
        else { PG8_STAGE(PG8_SA(0, 0), cA, voffA); PG8_STAGE(PG8_SA(0, 1), cA + hstep, voffA); }
        if (wr == 1) PG8_BAR;
        PG8_WAIT_V(2); PG8_BAR;
        PG8_STAGE(PG8_SB(1, 0), cB + kstep, voffB);
        if constexpr (GATHER) PG8_STAGE_G(PG8_SA(1, 0), kstep, cO[0][0], cO[0][1]); else PG8_STAGE(PG8_SA(1, 0), cA + kstep, voffA);
        PG8_STAGE(PG8_SB(1, 1), cB + hstep + kstep, voffB);
        PG8_WAIT_V(6); PG8_BAR;
    } else {
        PG8_STAGE(PG8_SB(0, 0), cB, voffB); PG8_STAGE(PG8_SA(0, 0), cA, voffA); PG8_STAGE(PG8_SB(0, 1), cB + hstep, voffB); PG8_STAGE(PG8_SA(0, 1), cA + hstep, voffA);
        if (wr == 1) PG8_BAR;
        PG8_WAIT_V(4); PG8_BAR;
        PG8_STAGE(PG8_SB(1, 0), cB + kstep, voffB); PG8_STAGE(PG8_SA(1, 0), cA + kstep, voffA); PG8_STAGE(PG8_SB(1, 1), cB + hstep + kstep, voffB);
        PG8_WAIT_V(6); PG8_BAR;
    }
    for (;;) {
        const bool has_next = S.next(ui + 1, nxt);
        const char* nA = has_next ? (const char*)g.A + (size_t)nxt.pm * tstep : cA; const char* nB = has_next ? (const char*)g.Bt + (size_t)nxt.pb * tstep : cB;
        if constexpr (GATHER) { if (has_next) PG8_LOADMAP(nxt, nO); else {
#pragma unroll
            for (int _h = 0; _h < 2; ++_h) { nO[_h][0] = cO[_h][0]; nO[_h][1] = cO[_h][1]; } } }
#pragma unroll 1
        for (int t = 0; t < nt; t += 2) {
            const bool last = (t == nt - 2);
            const char* a1 = cA + (size_t)(t + 1) * kstep;
            const char* a2 = last ? nA : cA + (size_t)(t + 2) * kstep; const char* b2 = last ? nB : cB + (size_t)(t + 2) * kstep;
            const char* a3 = a2 + kstep; const char* b3 = b2 + kstep;
            if (last && has_next) S.a_ready(nxt);
            if constexpr (SP2) {
            const size_t k1 = (size_t)(t + 1) * kstep, k2 = last ? (size_t)0 : (size_t)(t + 2) * kstep, k3 = k2 + kstep;
            const unsigned g00 = last ? nO[0][0] : cO[0][0], g01 = last ? nO[0][1] : cO[0][1], g10 = last ? nO[1][0] : cO[1][0], g11 = last ? nO[1][1] : cO[1][1];
            PG8_LDB(B0, 0, 0); PG8_LDB(B1, 0, 1); PG8_SCHED; PG8_LDA(At, 0, 0);
            if constexpr (GATHER) PG8_STAGE_G(PG8_SA(1, 1), k1, cO[1][0], cO[1][1]); else PG8_STAGE(PG8_SA(1, 1), a1 + hstep, voffA);
            PG8_WAIT_V(8); PG8_WAIT_L(0); PG8_BAR; PG8_MMA(0, 0, At, B0); PG8_MMA(0, 1, At, B1); PG8_BAR; PG8_SCHED;
            PG8_LDA(At, 0, 1); PG8_STAGE(PG8_SB(0, 0), b2, voffB); PG8_STAGE(PG8_SB(0, 1), b2 + hstep, voffB);
            if constexpr (GATHER) PG8_STAGE_G(PG8_SA(0, 0), k2, g00, g01); else PG8_STAGE(PG8_SA(0, 0), a2, voffA);
            PG8_WAIT_V(8); PG8_WAIT_L(0); PG8_BAR; PG8_MMA(1, 0, At, B0); PG8_MMA(1, 1, At, B1); PG8_BAR; PG8_SCHED;
            PG8_LDB(B0, 1, 0); PG8_LDB(B1, 1, 1); PG8_SCHED; PG8_LDA(At, 1, 0);
            if constexpr (GATHER) PG8_STAGE_G(PG8_SA(0, 1), k2, g10, g11); else PG8_STAGE(PG8_SA(0, 1), a2 + hstep, voffA);
            PG8_WAIT_V(8); PG8_WAIT_L(0); PG8_BAR; PG8_MMA(0, 0, At, B0); PG8_MMA(0, 1, At, B1); PG8_BAR; PG8_SCHED;
            PG8_LDA(At, 1, 1); PG8_STAGE(PG8_SB(1, 0), b3, voffB); PG8_STAGE(PG8_SB(1, 1), b3 + hstep, voffB);
            if constexpr (GATHER) PG8_STAGE_G(PG8_SA(1, 0), k3, g00, g01); else PG8_STAGE(PG8_SA(1, 0), a3, voffA);
            PG8_WAIT_V(8); PG8_WAIT_L(0); PG8_BAR; PG8_MMA(1, 0, At, B0); PG8_MMA(1, 1, At, B1); PG8_BAR; PG8_SCHED;
            } else {
            PG8_LDB(B0, 0, 0); PG8_SCHED; PG8_LDA(At, 0, 0); PG8_STAGE(PG8_SA(1, 1), a1 + hstep, voffA);
            PG8_WAIT_L(8); PG8_BAR; PG8_WAIT_L(0); PG8_MMA(0, 0, At, B0); PG8_BAR; PG8_SCHED;
            PG8_LDB(B1, 0, 1); PG8_STAGE(PG8_SB(0, 0), b2, voffB);
            PG8_BAR; PG8_WAIT_L(0); PG8_MMA(0, 1, At, B1); PG8_BAR;
            PG8_LDA(At, 0, 1); PG8_STAGE(PG8_SA(0, 0), a2, voffA);
            PG8_BAR; PG8_WAIT_L(0); PG8_MMA(1, 0, At, B0); PG8_BAR; PG8_SCHED;
            PG8_STAGE(PG8_SB(0, 1), b2 + hstep, voffB);
            PG8_WAIT_V(6); PG8_BAR; PG8_MMA(1, 1, At, B1); PG8_BAR;
            PG8_LDB(B0, 1, 0); PG8_SCHED; PG8_LDA(At, 1, 0); PG8_STAGE(PG8_SA(0, 1), a2 + hstep, voffA);
            PG8_WAIT_L(8); PG8_BAR; PG8_WAIT_L(0); PG8_MMA(0, 0, At, B0); PG8_BAR; PG8_SCHED;
            PG8_LDB(B1, 1, 1); PG8_STAGE(PG8_SB(1, 0), b3, voffB);
            PG8_BAR; PG8_WAIT_L(0); PG8_MMA(0, 1, At, B1); PG8_BAR;
            PG8_LDA(At, 1, 1); PG8_STAGE(PG8_SA(1, 0), a3, voffA);
            PG8_BAR; PG8_WAIT_L(0); PG8_MMA(1, 0, At, B0); PG8_BAR; PG8_SCHED;
            PG8_STAGE(PG8_SB(1, 1), b3 + hstep, voffB);
            PG8_WAIT_V(6); PG8_BAR; PG8_MMA(1, 1, At, B1); PG8_BAR;
            }
        }
        if constexpr (ALIGN_EPI) { if (wr == 0) PG8_BAR; }
        if constexpr (FP8) asm volatile("s_nop 15\n\ts_nop 15" ::: "memory");
        E(acc, cur, wr, wc, fr, fq); S.done(cur);
        if (!has_next) break;
#pragma unroll
        for (int a = 0; a < 2; ++a)
#pragma unroll
            for (int b = 0; b < 2; ++b)
#pragma unroll
                for (int m = 0; m < 4; ++m)
#pragma unroll
                    for (int n = 0; n < 2; ++n) acc[a][b][m][n] = (f32x4){0.f, 0.f, 0.f, 0.f};
        cur = nxt; cA = nA; cB = nB; ++ui;
        if constexpr (GATHER) {
#pragma unroll
            for (int _h = 0; _h < 2; ++_h) { cO[_h][0] = nO[_h][0]; cO[_h][1] = nO[_h][1]; } }
        if constexpr (ALIGN_EPI) { if (wr == 1) PG8_BAR; }
    }
    PG8_WAIT_V(0);
    if constexpr (!ALIGN_EPI) { if (wr == 0) PG8_BAR; }
    PG8_BAR;
#undef PG8_SA
#undef PG8_SB
#undef PG8_STAGE
#undef PG8_STAGE_G
#undef PG8_LOADMAP
#undef PG8_LDA
#undef PG8_LDB
#undef PG8_MMA
#undef PG8_LD8
#undef PG8_WAIT_V
#undef PG8_WAIT_L
#undef PG8_BAR
#undef PG8_SCHED
}
}

#define XB_TMO      128
#define XB_XCNT(j)  (256  + 64 * (j))
#define XB_XSUB(j)  (1280 + 64 * (j))
#define XB_XGEN(j)  (2304 + 64 * (j))
#define XB_TOP      3328
#define XB_TOPGEN   3392
#define XCD_BAR_WORDS 3456
#define XB_SPIN_CAP (1u << 18)
__device__ __forceinline__ unsigned xb_ld(unsigned* p)              { return __hip_atomic_load(p, __ATOMIC_RELAXED, __HIP_MEMORY_SCOPE_AGENT); }
__device__ __forceinline__ unsigned xb_add(unsigned* p, unsigned v) { return __hip_atomic_fetch_add(p, v, __ATOMIC_RELAXED, __HIP_MEMORY_SCOPE_AGENT); }
__device__ __forceinline__ unsigned xb_xcc_id() { return (unsigned)__builtin_amdgcn_s_getreg((3 << 11) | 20) & 0xFu; }
#define XB_SPIN(cond, bar) do { unsigned _sp = 0; while (cond) { __builtin_amdgcn_s_sleep(1); \
    if ((++_sp & 255u) == 0u) { if (xb_ld(&(bar)[XB_TMO])) break; if (_sp > XB_SPIN_CAP) { atomicAdd(&(bar)[XB_TMO], 1u); break; } } } } while (0)
struct XcdBarrier { unsigned* bar; unsigned x; volatile LAS unsigned* st; };
__device__ __forceinline__ XcdBarrier xcd_barrier_post(unsigned* bar, volatile LAS unsigned* st) {
    XcdBarrier b; b.bar = bar; b.x = xb_xcc_id(); b.st = st;
    if (threadIdx.x == 0) (void)xb_add(&bar[XB_XCNT(b.x)], 1u);
    return b;
}
__device__ __forceinline__ void xcd_barrier_complete(unsigned* bar, unsigned x, unsigned& nloc, unsigned& nx) {
    const unsigned G = gridDim.x * gridDim.y * gridDim.z;
    unsigned sum, cnt, mine, sp = 0u;
    for (;;) {
        sum = 0u; cnt = 0u; mine = 0u;
#pragma unroll
        for (unsigned j = 0; j < 16; ++j) { const unsigned c = xb_ld(&bar[XB_XCNT(j)]); sum += c; cnt += (c > 0u) ? 1u : 0u; mine = (j == x) ? c : mine; }
        if (sum == G) break;
        __builtin_amdgcn_s_sleep(1);
        if ((++sp & 255u) == 0u) { if (xb_ld(&bar[XB_TMO])) break; if (sp > XB_SPIN_CAP) { atomicAdd(&bar[XB_TMO], 1u); break; } }
    }
    nloc = mine > 0u ? mine : 1u; nx = cnt > 0u ? cnt : 1u;
}
__device__ __forceinline__ void xcd_barrier(const XcdBarrier& b) {
    asm volatile("s_waitcnt vmcnt(0)" ::: "memory");
    __syncthreads();
    if (threadIdx.x == 0) {
        unsigned* bar = b.bar;
        __builtin_amdgcn_s_waitcnt(0);
        unsigned nloc = b.st[0], nx = b.st[1];
        if (nloc == 0u) { xcd_barrier_complete(bar, b.x, nloc, nx); b.st[0] = nloc; b.st[1] = nx; }
        const unsigned old = xb_add(&bar[XB_XSUB(b.x)], 1u);
        const unsigned gen = old / nloc;
        if (old + 1u == (gen + 1u) * nloc) {
            __builtin_amdgcn_fence(__ATOMIC_RELEASE, "agent");
            asm volatile("s_waitcnt vmcnt(0)" ::: "memory");
            const unsigned og = xb_add(&bar[XB_TOP], 1u);
            const unsigned tg = og / nx;
            if (og + 1u == (tg + 1u) * nx) xb_add(&bar[XB_TOPGEN], 1u);
            else XB_SPIN(xb_ld(&bar[XB_TOPGEN]) == tg, bar);
            __builtin_amdgcn_fence(__ATOMIC_ACQUIRE, "agent");
            xb_add(&bar[XB_XGEN(b.x)], 1u);
            asm volatile("s_waitcnt vmcnt(0)" ::: "memory");
        } else {
            XB_SPIN(xb_ld(&bar[XB_XGEN(b.x)]) == gen, bar);
            __builtin_amdgcn_fence(__ATOMIC_ACQUIRE, "agent");
            asm volatile("s_waitcnt vmcnt(0)" ::: "memory");
        }
    }
    __syncthreads();
}

struct Args { const float* in[35]; float* out; unsigned char* ws; int ph_lo, ph_hi; };
enum { I_X = 0, I_C, I_CTX, I_CCTX, I_WADA, I_BADA, I_WIN, I_WOUT, I_MNG, I_POOLW, I_POOLS, I_SINK, I_HCW, I_HCB, I_HW1, I_HB1, I_HF1, I_HW2, I_HB2, I_HF2, I_HW3, I_HSKIP,
       I_GLG, I_GLB, I_GWS, I_GBS, I_LN1G, I_LN1B, I_LN2G, I_LN2B, I_WR, I_RB, I_WG, I_WU, I_WD };
struct Ctx {
    LAS unsigned char* lds; int tid, lane, wave, bid, G;
    const float GAS* const __attribute__((address_space(4)))* in; float GAS* out; unsigned char GAS* ws;
};
#define WSP(T, off) ((T*)(T GAS*)(C.ws + (off)))
#define INP(k) ((const float*)C.in[k])
#define FRESH(D, S) Ctx D = S; asm volatile("" : "+v"(D.tid)); D.lane = D.tid & 63; D.wave = __builtin_amdgcn_readfirstlane(D.tid >> 6); asm volatile("" : "+s"(D.bid), "+s"(D.G), "+s"(D.in), "+s"(D.ws), "+s"(D.out))

struct TrBlk { const float GAS* src; unsigned char GAS* dst; int N, K, nb, which; bool gu; };
constexpr int TRP = 144, TRBUF = 256 * TRP;
#define WG_BAR() do { LDS_WAIT(); __builtin_amdgcn_s_barrier(); asm volatile("" ::: "memory"); } while (0)
constexpr int NBL = 4976, NBP = 368;
__device__ __forceinline__ TrBlk tr_decode(Ctx& C, int L, int j) {
    const bool c0 = j < 240, c1 = !c0 && j < NBP, ce = !c0 && !c1;
    const int q = j - (c0 ? 0 : (c1 ? 240 : NBP));
    const int e = ce ? q / 144 : 0, r = ce ? q % 144 : q;
    const int which = ce ? r / 48 : 0, r2 = ce ? r % 48 : r;
    const bool gu = ce && which < 2, dn = ce && which == 2;
    const int NB = c0 ? 15 : (gu ? 3 : 8), nb = r2 % NB, kb = r2 / NB;
    const int N = c0 ? INW : (gu ? DE : DM), K = dn ? DE : DM;
    const int mat = ce ? L * NE + e : L;
    const float GAS* base = c0 ? C.in[I_WIN] : (c1 ? C.in[I_WOUT] : (which == 0 ? C.in[I_WG] : (which == 1 ? C.in[I_WU] : C.in[I_WD])));
    const size_t wsoff = c0 ? WS_WIN : (c1 ? WS_WOUT : (gu ? WS_WGU : WS_WD));
    const int nrows = c0 ? INW : (gu ? 1536 : DM);
    TrBlk t; t.N = N; t.K = K; t.nb = nb; t.which = which; t.gu = gu;
    t.src = base + (size_t)mat * K * N + (size_t)(128 * kb) * N + 256 * nb;
    t.dst = C.ws + wsoff + (size_t)mat * nrows * K + 128 * kb;
    return t;
}
__device__ __forceinline__ void tr_load(const TrBlk& t, int wave, int lane, f32x4 (&v)[16]) {
#pragma unroll
    for (int i = 0; i < 16; ++i) v[i] = __builtin_nontemporal_load((const f32x4 GAS*)((const char GAS*)t.src + (size_t)(16 * wave + i) * t.N * 4 + 16u * lane));
}
__device__ __forceinline__ void tr_pack(LAS unsigned char* buf, int wave, int lane, const f32x4 (&v)[16]) {
#pragma unroll
    for (int j = 0; j < 4; ++j) { u32x4 o;
#pragma unroll
        for (int w = 0; w < 4; ++w) o[w] = pk4_fp8(64.f * v[4 * w][j], 64.f * v[4 * w + 1][j], 64.f * v[4 * w + 2][j], 64.f * v[4 * w + 3][j]);
        *(LAS u32x4*)(buf + (4 * lane + j) * TRP + 16 * wave) = o; }
}
__device__ __forceinline__ void tr_flush(const TrBlk& t, const LAS unsigned char* buf, int wave, int lane) {
#pragma unroll
    for (int tt = 0; tt < 4; ++tt) { const int nl = 32 * wave + 8 * tt + (lane >> 3), n = 256 * t.nb + nl;
        const u32x4 o = *(const LAS u32x4*)(buf + nl * TRP + 16 * (lane & 7));
        const int drow = t.gu ? ((n >> 7) * 256 + (n & 127) + 128 * t.which) : n;
        *(u32x4 GAS*)(t.dst + (size_t)drow * t.K + 16 * (lane & 7)) = o; }
}
template <int NBK> __device__ __forceinline__ void tr_blocks(Ctx& C, int L, int b0) {
    f32x4 r0[16], r1[16], r2[16];
    LAS unsigned char* buf0 = C.lds; LAS unsigned char* buf1 = C.lds + TRBUF;
    const TrBlk t0 = tr_decode(C, L, b0), t1 = tr_decode(C, L, b0 + (NBK > 1 ? 1 : 0)), t2 = tr_decode(C, L, b0 + (NBK > 2 ? 2 : 0)), t3 = tr_decode(C, L, b0 + (NBK > 3 ? 3 : 0));
    tr_load(t0, C.wave, C.lane, r0); if (NBK > 1) tr_load(t1, C.wave, C.lane, r1); if (NBK > 2) tr_load(t2, C.wave, C.lane, r2);
    WG_BAR();
    tr_pack(buf0, C.wave, C.lane, r0);
    if (NBK > 3) tr_load(t3, C.wave, C.lane, r0);
    WG_BAR(); tr_flush(t0, buf0, C.wave, C.lane);
    if (NBK > 1) { tr_pack(buf1, C.wave, C.lane, r1); WG_BAR(); tr_flush(t1, buf1, C.wave, C.lane); }
    if (NBK > 2) { tr_pack(buf0, C.wave, C.lane, r2); WG_BAR(); tr_flush(t2, buf0, C.wave, C.lane); }
    if (NBK > 3) { tr_pack(buf1, C.wave, C.lane, r0); WG_BAR(); tr_flush(t3, buf1, C.wave, C.lane); }
}
__device__ __forceinline__ void p0_convert(Ctx& C, int L, int nblocks) {
#pragma unroll 1
    for (int j = C.bid; j < nblocks; j += C.G) tr_blocks<1>(C, L, j);
    __syncthreads();
}
constexpr int NCU = NBL / 4;
#ifndef TAILQ
#define TAILQ 224
#endif
#ifndef CONV_SPLIT
#define CONV_SPLIT 0
#endif
__device__ __forceinline__ void conv_unit(Ctx& C, int L, int b0) { tr_blocks<4>(C, L, b0); }
constexpr int NCU_E = (NBL - NBP) / 4, NCU_P = NBP / 4;
__device__ __forceinline__ void bg_conv_unit(Ctx& C, int l, int cu) {
    const bool e = cu < NCU_E; conv_unit(C, e ? l : 1, e ? NBP + cu * 4 : (cu - NCU_E) * 4);
}
__device__ __forceinline__ void p0_adaln(Ctx& C) {
    LAS float* sc = (LAS float*)C.lds;
    LAS float* red = (LAS float*)(C.lds + 40960);
    float* MOD = WSP(float, WS_MOD);
    for (int u = C.bid; u < 256; u += C.G) {
        const int l = u >> 7, colbase = (u & 127) * 96;
        __syncthreads();
        for (int i = C.tid; i < 5 * DM; i += 512) { const int r = i >> 11, k = i & 2047; const float v = r < 4 ? INP(I_C)[r * DM + k] : INP(I_CCTX)[k]; sc[i] = silu_f(v); }
        __syncthreads();
        float acc[5][2];
#pragma unroll
        for (int r = 0; r < 5; ++r) { acc[r][0] = 0.f; acc[r][1] = 0.f; }
        const int ln = C.lane < 48 ? C.lane : 47;
        const float* wp = INP(I_WADA) + ((size_t)l * DM + C.wave * 256) * 12288 + colbase + 2 * ln;
#pragma unroll 1
        for (int k0 = 0; k0 < 256; k0 += 16) { f32x2 wv[16];
#pragma unroll
            for (int k = 0; k < 16; ++k) wv[k] = *(const f32x2*)(wp + (size_t)(k0 + k) * 12288);
#pragma unroll
            for (int k = 0; k < 16; ++k)
#pragma unroll
                for (int r = 0; r < 5; ++r) { const float s = sc[r * DM + C.wave * 256 + k0 + k]; acc[r][0] += s * wv[k].x; acc[r][1] += s * wv[k].y; } }
        if (C.lane < 48) {
#pragma unroll
            for (int r = 0; r < 5; ++r) { red[(C.wave * 5 + r) * 96 + 2 * C.lane] = acc[r][0]; red[(C.wave * 5 + r) * 96 + 2 * C.lane + 1] = acc[r][1]; } }
        __syncthreads();
        for (int i = C.tid; i < 480; i += 512) { const int r = i / 96, cc = i % 96; float s = INP(I_BADA)[l * 12288 + colbase + cc];
#pragma unroll
            for (int w = 0; w < 8; ++w) s += red[(w * 5 + r) * 96 + cc];
            MOD[(size_t)(l * 5 + r) * 12288 + colbase + cc] = s; }
    }
    __syncthreads();
}
__device__ __forceinline__ void p0_filters(Ctx& C) {
    LAS float* feat = (LAS float*)C.lds;
    LAS float* h1 = (LAS float*)(C.lds + 4096);
    LAS float* h2 = (LAS float*)(C.lds + 8192);
    for (int u2 = C.bid; u2 < 528 + 0 * C.G; u2 += C.G) {
        const int u = 2 * (u2 % 264) + (u2 / 264);
        int l, L, tb; bf16* dst;
        if (u < 512) { l = u >> 8; tb = u & 255; L = SL; dst = WSP(bf16, WS_FILT) + (size_t)l * 2 * 512 * 8192; }
        else { l = 0; tb = u - 512; L = CL; dst = WSP(bf16, WS_FILTC); }
        const float invLm1 = 1.0f / (float)(L - 1);
        __syncthreads();
        LAS float* w1s = (LAS float*)(C.lds + 12288);
        LAS float* w2s = (LAS float*)(C.lds + 12288 + 33 * 64 * 4);
        for (int i = C.tid; i < 33 * 64; i += 512) w1s[i] = INP(I_HW1)[l * 33 * 64 + i];
        for (int i = C.tid; i < 64 * 64; i += 512) w2s[i] = INP(I_HW2)[l * 64 * 64 + i];
        for (int i = C.tid; i < 16 * 33; i += 512) { const int p = i / 33, j = i % 33; const int t = 16 * tb + p; float v;
            if (j == 0) v = (float)t * invLm1;
            else { const int fi = (j - 1) & 15; const float fr = 1e-4f + (float)fi * ((15.0f - 1e-4f) / 15.0f); const float ang = (6.283185307179586f / (float)L) * (float)t * fr; v = (j <= 16) ? cosf(ang) : -sinf(ang); }
            feat[i] = v; }
        __syncthreads();
        for (int i = C.tid; i < 1024; i += 512) { const int p = i >> 6, hh = i & 63; float s = INP(I_HB1)[l * 64 + hh];
#pragma unroll
            for (int j = 0; j < 33; ++j) s += feat[p * 33 + j] * w1s[j * 64 + hh];
            h1[i] = sinf(INP(I_HF1)[l * 64 + hh] * s); }
        __syncthreads();
        for (int i = C.tid; i < 1024; i += 512) { const int p = i >> 6, hh = i & 63; float s = INP(I_HB2)[l * 64 + hh];
#pragma unroll 16
            for (int j = 0; j < 64; ++j) s += h1[p * 64 + j] * w2s[j * 64 + hh];
            h2[i] = sinf(INP(I_HF2)[l * 64 + hh] * s); }
        __syncthreads();
        float acc[16][4];
#pragma unroll
        for (int p = 0; p < 16; ++p) { acc[p][0] = 0.f; acc[p][1] = 0.f; acc[p][2] = 0.f; acc[p][3] = 0.f; }
#pragma unroll 4
        for (int k = 0; k < 64; ++k) { const f32x4 w = *(const f32x4*)(INP(I_HW3) + (size_t)(l * 64 + k) * 2048 + 4 * C.tid);
#pragma unroll
            for (int p = 0; p < 16; ++p) { const float h = h2[p * 64 + k]; acc[p][0] += h * w[0]; acc[p][1] += h * w[1]; acc[p][2] += h * w[2]; acc[p][3] += h * w[3]; } }
#pragma unroll
        for (int j = 0; j < 4; ++j) { const int col = 4 * C.tid + j, o = col >> 10, dir = (col >> 9) & 1, c = col & 511;
            const float delta = 4.605170186f * (1.0f / 1.5f + (float)c * ((1.0f / 0.3f - 1.0f / 1.5f) / 511.0f));
            bf16* d = dst + (size_t)(o * 512 + c) * (2 * L);
            float val[16];
#pragma unroll
            for (int p = 0; p < 16; ++p) { const int t = 16 * tb + p; val[p] = acc[p][j] * __expf(-(float)t * invLm1 * delta); }
            if (dir == 0) {
                u32x4 w0, w1; w0.x = pk2(val[15], val[14]); w0.y = pk2(val[13], val[12]); w0.z = pk2(val[11], val[10]); w0.w = pk2(val[9], val[8]);
                w1.x = pk2(val[7], val[6]); w1.y = pk2(val[5], val[4]); w1.z = pk2(val[3], val[2]); w1.w = pk2(val[1], val[0]);
                u32x4* q = (u32x4*)(d + L - 16 * (tb + 1)); q[0] = w0; q[1] = w1;
            } else if (tb == 0) {
#pragma unroll
                for (int p = 1; p < 16; ++p) d[L - 1 + p] = (bf16)(pk2(val[p], 0.f) & 0xffffu);
            } else {
                typedef u32x4 __attribute__((aligned(2))) u32x4_u;
                u32x4 w0, w1; w0.x = pk2(val[0], val[1]); w0.y = pk2(val[2], val[3]); w0.z = pk2(val[4], val[5]); w0.w = pk2(val[6], val[7]);
                w1.x = pk2(val[8], val[9]); w1.y = pk2(val[10], val[11]); w1.z = pk2(val[12], val[13]); w1.w = pk2(val[14], val[15]);
                u32x4_u* q = (u32x4_u*)(d + L - 1 + 16 * tb); q[0] = w0; q[1] = w1;
            }
            if (dir == 1 && 16 * (tb + 1) == L) d[2 * L - 1] = 0; }
    }
    __syncthreads();
}
__device__ __forceinline__ void p0_rope(Ctx& C) {
    { const int idx = C.bid * 512 + C.tid;
      for (int e = idx; e < 131072; e += C.G * 512) { const f32x2 v = *(const f32x2*)(INP(I_GWS) + 2 * (size_t)e); WSP(unsigned, WS_GWSB)[e] = pk2(v.x, v.y); } }
    { const int idx = C.bid * 512 + C.tid;
      for (int e = idx; e < 131072; e += C.G * 512) { const int i = e & 127, j = (e >> 7) & 127, lg = e >> 14, l = lg >> 2, gi = lg & 3;
          const float v = INP(I_POOLW)[(size_t)lg * 16384 + i * 128 + j] * INP(I_POOLS)[l * 512 + 128 * gi + j];
          WSP(bf16, WS_POOLWT)[e] = (bf16)(pk2(v, 0.f) & 0xffffu); } }
    if (C.bid == (C.G > 200 ? 200 : 0)) { f32x2* R = WSP(f32x2, WS_ROPE);
        for (int i = C.tid; i < 1024; i += 512) { const int pos = i >> 4, fi = i & 15; const float inv = powf(10000.0f, -(float)fi / 16.0f); const float a = (float)pos * inv; R[i] = (f32x2){cosf(a), sinf(a)}; } }
}

__device__ __forceinline__ const float* src_x0(Ctx& C, int row) {
    return row < NLAT ? INP(I_X) + (size_t)row * DM : INP(I_CTX) + (size_t)(row - NLAT) * DM;
}
__device__ __forceinline__ void row_load(const float* p, int lane, float (&v)[32]) {
#pragma unroll
    for (int j = 0; j < 4; ++j) { const f32x4 a = *(const f32x4*)(p + 512 * j + 8 * lane), b = *(const f32x4*)(p + 512 * j + 8 * lane + 4);
        v[8 * j] = a[0]; v[8 * j + 1] = a[1]; v[8 * j + 2] = a[2]; v[8 * j + 3] = a[3]; v[8 * j + 4] = b[0]; v[8 * j + 5] = b[1]; v[8 * j + 6] = b[2]; v[8 * j + 7] = b[3]; }
}
__device__ __forceinline__ void row_load_bf16(const bf16* p, int lane, float (&v)[32]) {
#pragma unroll
    for (int j = 0; j < 4; ++j) { const u32x4 r = *(const u32x4*)(p + 512 * j + 8 * lane);
        v[8 * j] = __uint_as_float(r.x << 16); v[8 * j + 1] = __uint_as_float(r.x & 0xffff0000u); v[8 * j + 2] = __uint_as_float(r.y << 16); v[8 * j + 3] = __uint_as_float(r.y & 0xffff0000u);
        v[8 * j + 4] = __uint_as_float(r.z << 16); v[8 * j + 5] = __uint_as_float(r.z & 0xffff0000u); v[8 * j + 6] = __uint_as_float(r.w << 16); v[8 * j + 7] = __uint_as_float(r.w & 0xffff0000u); }
}
__device__ __forceinline__ void row_store(float* p, int lane, const float (&v)[32]) {
#pragma unroll
    for (int j = 0; j < 4; ++j) { *(f32x4*)(p + 512 * j + 8 * lane) = (f32x4){v[8 * j], v[8 * j + 1], v[8 * j + 2], v[8 * j + 3]}; *(f32x4*)(p + 512 * j + 8 * lane + 4) = (f32x4){v[8 * j + 4], v[8 * j + 5], v[8 * j + 6], v[8 * j + 7]}; }
}
__device__ __forceinline__ void row_store_bf16(bf16* p, int lane, const float (&v)[32]) {
#pragma unroll
    for (int j = 0; j < 4; ++j) { u32x4 w; w.x = pk2(v[8 * j], v[8 * j + 1]); w.y = pk2(v[8 * j + 2], v[8 * j + 3]); w.z = pk2(v[8 * j + 4], v[8 * j + 5]); w.w = pk2(v[8 * j + 6], v[8 * j + 7]); *(u32x4*)(p + 512 * j + 8 * lane) = w; }
}
__device__ __forceinline__ void row_store_fp8(unsigned char* p, int lane, const float (&v)[32]) {
#pragma unroll
    for (int j = 0; j < 4; ++j) { u32x2 w; w.x = pk4_fp8(v[8 * j], v[8 * j + 1], v[8 * j + 2], v[8 * j + 3]); w.y = pk4_fp8(v[8 * j + 4], v[8 * j + 5], v[8 * j + 6], v[8 * j + 7]); *(u32x2*)(p + 512 * j + 8 * lane) = w; }
}
__device__ __forceinline__ void row_ln(float (&v)[32]) {
    float s = 0.f;
#pragma unroll
    for (int i = 0; i < 32; ++i) s += v[i];
    const float mean = wave_sum(s) * (1.0f / DM); float q = 0.f;
#pragma unroll
    for (int i = 0; i < 32; ++i) { v[i] -= mean; q += v[i] * v[i]; }
    const float rstd = 1.0f / sqrtf(wave_sum(q) * (1.0f / DM) + LN_EPS);
#pragma unroll
    for (int i = 0; i < 32; ++i) v[i] *= rstd;
}
__device__ __forceinline__ void row_affine(float (&v)[32], const float* mul, const float* add, int lane, float mul_off) {
    float a[32], b[32]; row_load(mul, lane, a); row_load(add, lane, b);
#pragma unroll
    for (int i = 0; i < 32; ++i) v[i] = v[i] * (a[i] + mul_off) + b[i];
}
__device__ __forceinline__ void row_load_lds(const LAS float* p, int lane, float (&v)[32]) {
#pragma unroll
    for (int j = 0; j < 4; ++j) { const f32x4 a = *(const LAS f32x4*)(p + 512 * j + 8 * lane), b = *(const LAS f32x4*)(p + 512 * j + 8 * lane + 4);
        v[8 * j] = a[0]; v[8 * j + 1] = a[1]; v[8 * j + 2] = a[2]; v[8 * j + 3] = a[3]; v[8 * j + 4] = b[0]; v[8 * j + 5] = b[1]; v[8 * j + 6] = b[2]; v[8 * j + 7] = b[3]; }
}
__device__ __forceinline__ void row_affine_lds(float (&v)[32], const LAS float* mul, const LAS float* add, int lane, float mul_off) {
    float a[32], b[32]; row_load_lds(mul, lane, a); row_load_lds(add, lane, b);
#pragma unroll
    for (int i = 0; i < 32; ++i) v[i] = v[i] * (a[i] + mul_off) + b[i];
}
__device__ __forceinline__ void stage2048(Ctx& C, LAS float* dst, const float* src) { *(LAS f32x4*)(dst + 4 * C.tid) = *(const f32x4*)(src + 4 * C.tid); }
__device__ __forceinline__ void ph_ln_mod(Ctx& C, int l, int nrows) {
    LAS float* PAR = (LAS float*)C.lds;
    const int r0 = (int)(((long)C.bid * nrows) / C.G), r1 = (int)(((long)(C.bid + 1) * nrows) / C.G);
    int cur_mrow = -1;
    for (int rb = r0 & ~7; rb < r1; rb += 8) {
        const int mrow = rb < NLAT ? rb / SL : 4; const float* mod = WSP(float, WS_MOD) + (size_t)(l * 5 + mrow) * 12288;
        if (mrow != cur_mrow) { __syncthreads(); stage2048(C, PAR, mod + 2048); stage2048(C, PAR + 2048, mod); cur_mrow = mrow; __syncthreads(); }
        const int row = rb + C.wave;
        if (row >= r0 && row < r1) {
            float v[32]; row_load(src_x0(C, row), C.lane, v); row_ln(v); row_affine_lds(v, PAR, PAR + 2048, C.lane, 1.0f);
            if (FP8_IN) row_store_fp8(WSP(unsigned char, WS_HA8) + (size_t)row * DM, C.lane, v); else row_store_bf16(WSP(bf16, WS_HB) + (size_t)row * DM, C.lane, v);
        }
    }
    __syncthreads();
}

__device__ __forceinline__ void cvt8(const u32x4 r, float (&f)[8]) { f[0] = bflo(r.x); f[1] = bfhi(r.x); f[2] = bflo(r.y); f[3] = bfhi(r.y); f[4] = bflo(r.z); f[5] = bfhi(r.z); f[6] = bflo(r.w); f[7] = bfhi(r.w); }
__device__ __forceinline__ void cvt8_fp8(const u32x2 r, float (&f)[8]) { const f32x2 a = __builtin_amdgcn_cvt_pk_f32_fp8((int)r.x, false), b = __builtin_amdgcn_cvt_pk_f32_fp8((int)r.x, true), c = __builtin_amdgcn_cvt_pk_f32_fp8((int)r.y, false), d = __builtin_amdgcn_cvt_pk_f32_fp8((int)r.y, true);
    f[0] = a.x; f[1] = a.y; f[2] = b.x; f[3] = b.y; f[4] = c.x; f[5] = c.y; f[6] = d.x; f[7] = d.y; }
__device__ __forceinline__ bf16x8 pack8(const float (&f)[8]) { u32x4 w; w.x = pk2(f[0], f[1]); w.y = pk2(f[2], f[3]); w.z = pk2(f[4], f[5]); w.w = pk2(f[6], f[7]); return __builtin_bit_cast(bf16x8, w); }
#define MFMA32(a, b, c) __builtin_amdgcn_mfma_f32_32x32x16_bf16((a), (b), (c), 0, 0, 0)

__device__ __forceinline__ void attn_unit(Ctx& C, int l, int uidx) {
    constexpr int KS = 144, VS = 272, VT_OFF = 128 * KS;
    const bool isctx = uidx >= 256;
    int b, kh, nb;
    if (!isctx) { b = uidx >> 6; kh = (uidx >> 5) & 1; nb = uidx & 31; } else { const int v = uidx - 256; b = v >> 2; kh = (v >> 1) & 1; nb = v & 1; }
    const int rowbase = isctx ? NLAT + b * CL : b * SL, crow = NLAT + b * CL;
    const int g = C.wave >> 1, th = C.wave & 1, head = kh * 4 + g, r32 = C.lane & 31, h = C.lane >> 5;
    const bf16* Z = WSP(bf16, WS_Z); const f32x2* ROPE = WSP(f32x2, WS_ROPE);
    bf16x8 Qf[2][4];
#pragma unroll
    for (int qb = 0; qb < 2; ++qb) {
        const int tq = 128 * nb + 64 * th + 32 * qb + r32;
        const bf16* qp = Z + (size_t)(rowbase + tq) * INW + 512 + 64 * head + 8 * h;
        float f[4][8];
#pragma unroll
        for (int s = 0; s < 4; ++s) cvt8(*(const u32x4*)(qp + 16 * s), f[s]);
        if (!isctx) {
            const int pr = tq >> 6, pc = tq & 63;
#pragma unroll
            for (int j = 0; j < 8; ++j) {
                const f32x2 cr = ROPE[pr * 16 + 8 * h + j], cc = ROPE[pc * 16 + 8 * h + j];
                const float a0 = f[0][j], b0 = f[1][j]; f[0][j] = a0 * cr.x - b0 * cr.y; f[1][j] = b0 * cr.x + a0 * cr.y;
                const float a1 = f[2][j], b1 = f[3][j]; f[2][j] = a1 * cc.x - b1 * cc.y; f[3][j] = b1 * cc.x + a1 * cc.y; }
        }
#pragma unroll
        for (int s = 0; s < 4; ++s) {
#pragma unroll
            for (int j = 0; j < 8; ++j) f[s][j] *= 0.125f * LOG2E;
            Qf[qb][s] = pack8(f[s]); }
    }
    float m_[2], l_[2]; f32x16 O[2][2];
    { const float sk = INP(I_SINK)[l * 8 + head] * LOG2E; m_[0] = sk; m_[1] = sk; l_[0] = 1.f; l_[1] = 1.f; }
#pragma unroll
    for (int a = 0; a < 2; ++a)
#pragma unroll
        for (int q = 0; q < 2; ++q)
#pragma unroll
            for (int i = 0; i < 16; ++i) O[a][q][i] = 0.f;
#define AT_VALID(tt_) ((tt_) >= 3 || ((nb - 1 + (tt_)) >= 0 && (nb - 1 + (tt_)) < SL / 128))
#define AT_KROW0(tt_) (((tt_) < 3) ? rowbase + 128 * (nb - 1 + (tt_)) : crow + 128 * ((tt_) - 3))
#define AT_PREFETCH(tt_) do { const int krow0_ = AT_KROW0(tt_); _Pragma("unroll") for (int r = 0; r < 2; ++r) { const int idx = C.tid + 512 * r, key = idx >> 3, cd = idx & 7; \
        const bf16* kp = Z + (size_t)(krow0_ + key) * INW + 1024 + 64 * kh; kraw[r] = *(const u32x4*)(kp + 8 * cd); if ((tt_) < 3) kpar[r] = *(const u32x4*)(kp + 8 * (cd ^ 2)); \
        vraw[r] = *(const u32x4*)(kp + 128 + 8 * cd); } } while (0)
    __syncthreads();
    u32x4 kraw[2], kpar[2], vraw[2];
    kpar[0] = (u32x4){0u, 0u, 0u, 0u}; kpar[1] = kpar[0];
    int tt = isctx ? 3 : (nb == 0 ? 1 : 0);
    AT_PREFETCH(tt);
    while (tt < 5) {
        int ntt = tt + 1; if (ntt < 3 && !AT_VALID(ntt)) ntt = 3;
        const bool band = tt < 3; const int kb = nb - 1 + tt;
        LDS_WAIT(); __builtin_amdgcn_s_barrier(); asm volatile("" ::: "memory");
#pragma unroll
        for (int r = 0; r < 2; ++r) {
            const int idx = C.tid + 512 * r, key = idx >> 3, cd = idx & 7;
            u32x4 raw = kraw[r];
            if (band) {
                float x[8], y[8]; cvt8(raw, x); cvt8(kpar[r], y);
                const int tk = 128 * kb + key, pos = (cd & 4) ? (tk & 63) : (tk >> 6), i0 = 8 * (cd & 1); const bool isb = (cd >> 1) & 1;
#pragma unroll
                for (int j = 0; j < 8; ++j) { const f32x2 cs = ROPE[pos * 16 + i0 + j]; x[j] = isb ? (x[j] * cs.x + y[j] * cs.y) : (x[j] * cs.x - y[j] * cs.y); }
                raw = __builtin_bit_cast(u32x4, pack8(x));
            }
            *(LAS u32x4*)(C.lds + key * KS + cd * 16) = raw;
            const u32x4 vr = vraw[r];
            LAS bf16* vt = (LAS bf16*)(C.lds + VT_OFF + (8 * cd) * VS + key * 2);
            vt[0] = (bf16)(vr.x & 0xffff); vt[VS / 2] = (bf16)(vr.x >> 16); vt[2 * (VS / 2)] = (bf16)(vr.y & 0xffff); vt[3 * (VS / 2)] = (bf16)(vr.y >> 16);
            vt[4 * (VS / 2)] = (bf16)(vr.z & 0xffff); vt[5 * (VS / 2)] = (bf16)(vr.z >> 16); vt[6 * (VS / 2)] = (bf16)(vr.w & 0xffff); vt[7 * (VS / 2)] = (bf16)(vr.w >> 16);
        }
        if (ntt < 5) AT_PREFETCH(ntt);
        LDS_WAIT(); __builtin_amdgcn_s_barrier(); asm volatile("" ::: "memory");
        const int sub_lo = (tt == 0) ? 2 * th : 0, sub_hi = (tt == 2) ? 2 * th + 1 : 3;
        for (int sub = sub_lo; sub <= sub_hi; ++sub) {
            bf16x8 Kf[4];
#pragma unroll
            for (int s = 0; s < 4; ++s) Kf[s] = *(const LAS bf16x8*)(C.lds + (32 * sub + r32) * KS + (16 * s + 8 * h) * 2);
            bf16x8 Pf[2][2];
#pragma unroll
            for (int qb = 0; qb < 2; ++qb) {
                f32x16 S;
#pragma unroll
                for (int i = 0; i < 16; ++i) S[i] = 0.f;
#pragma unroll
                for (int s = 0; s < 4; ++s) S = MFMA32(Kf[s], Qf[qb][s], S);
                const int tq = 128 * nb + 64 * th + 32 * qb + r32;
                float mx = -INFINITY;
#pragma unroll
                for (int i = 0; i < 16; ++i) { float x = S[i];
                    if (tt == 0 || tt == 2) { const int kpos = 128 * kb + 32 * sub + (i & 3) + 8 * (i >> 2) + 4 * h; const int dq = tq - kpos; if (dq > 128 || dq < -128) x = -INFINITY; }
                    S[i] = x; mx = fmaxf(mx, x); }
                mx = xor32_max(mx);
                const float mnew = fmaxf(m_[qb], mx), alpha = __builtin_amdgcn_exp2f(m_[qb] - mnew);
                float rs = 0.f; float p[16];
#pragma unroll
                for (int i = 0; i < 16; ++i) { p[i] = __builtin_amdgcn_exp2f(S[i] - mnew); rs += p[i]; }
                rs = xor32_sum(rs);
                l_[qb] = l_[qb] * alpha + rs; m_[qb] = mnew;
#pragma unroll
                for (int i = 0; i < 16; ++i) { O[0][qb][i] *= alpha; O[1][qb][i] *= alpha; }
#pragma unroll
                for (int s2 = 0; s2 < 2; ++s2) { float t8[8];
#pragma unroll
                    for (int j = 0; j < 8; ++j) t8[j] = p[8 * s2 + j];
                    Pf[qb][s2] = pack8(t8); }
            }
#pragma unroll
            for (int db = 0; db < 2; ++db)
#pragma unroll
                for (int s2 = 0; s2 < 2; ++s2) {
                    const LAS unsigned char* vp = C.lds + VT_OFF + (32 * db + r32) * VS + (32 * sub + 16 * s2 + 4 * h) * 2;
                    const u32x2 v0 = *(const LAS u32x2*)vp, v1 = *(const LAS u32x2*)(vp + 16);
                    const u32x4 vv = {v0.x, v0.y, v1.x, v1.y}; const bf16x8 Vf = __builtin_bit_cast(bf16x8, vv);
                    O[db][0] = MFMA32(Vf, Pf[0][s2], O[db][0]); O[db][1] = MFMA32(Vf, Pf[1][s2], O[db][1]);
                }
        }
        tt = ntt;
    }
#undef AT_VALID
#undef AT_KROW0
#undef AT_PREFETCH
    bf16* Y = WSP(bf16, WS_YCAT);
#pragma unroll
    for (int qb = 0; qb < 2; ++qb) {
        const int tq = 128 * nb + 64 * th + 32 * qb + r32; const float inv = 1.0f / l_[qb];
        bf16* yp = Y + (size_t)(rowbase + tq) * DM + 512 + 64 * head;
#pragma unroll
        for (int db = 0; db < 2; ++db)
#pragma unroll
            for (int rg = 0; rg < 4; ++rg) { u32x2 w; w.x = pk2(O[db][qb][4 * rg] * inv, O[db][qb][4 * rg + 1] * inv); w.y = pk2(O[db][qb][4 * rg + 2] * inv, O[db][qb][4 * rg + 3] * inv);
                *(u32x2*)(yp + 32 * db + 8 * rg + 4 * h) = w; }
    }
}

__device__ __forceinline__ void gmlp_unit(Ctx& C, int l, int uidx) {
    constexpr int VS = 272;
    const int ck = uidx >> 1, hf = uidx & 1, row0 = 128 * ck;
    const bf16* Z = WSP(bf16, WS_Z);
    const int gl = C.wave >> 1, ph = C.wave & 1, g = 4 * hf + gl, r32 = C.lane & 31, h = C.lane >> 5;
    bf16x8 Wf[2][8]; u32x2 upre[2][2][4];
    { const bf16* wsb = WSP(bf16, WS_GWSB) + ((size_t)(l * 8 + g) * 128 + 64 * ph + r32) * 128 + 8 * h;
#pragma unroll
      for (int pb = 0; pb < 2; ++pb)
#pragma unroll
          for (int s = 0; s < 8; ++s) Wf[pb][s] = *(const bf16x8*)(wsb + (size_t)(32 * pb) * 128 + 16 * s);
#pragma unroll
      for (int pb = 0; pb < 2; ++pb) { const bf16* up = Z + (size_t)(row0 + 64 * ph + 32 * pb + r32) * INW + 2816 + 64 * g + 4 * h;
#pragma unroll
          for (int cb = 0; cb < 2; ++cb)
#pragma unroll
              for (int rg = 0; rg < 4; ++rg) upre[pb][cb][rg] = *(const u32x2*)(up + 32 * cb + 8 * rg); } }
    __syncthreads();
    {
        const int tok = C.tid >> 2, part = C.tid & 3;
        const bf16* zp = Z + (size_t)(row0 + tok) * INW + 3328 + 128 * part;
        const bf16* zq = Z + (size_t)(row0 + tok) * INW + 3328 + 256 * hf + 64 * part;
        u32x4 r1[16], r2[8];
#pragma unroll
        for (int c8 = 0; c8 < 16; ++c8) r1[c8] = *(const u32x4*)(zp + 8 * c8);
#pragma unroll
        for (int c8 = 0; c8 < 8; ++c8) r2[c8] = *(const u32x4*)(zq + 8 * c8);
        float s = 0.f, q = 0.f;
#pragma unroll
        for (int c8 = 0; c8 < 16; ++c8) { float f[8]; cvt8(r1[c8], f);
#pragma unroll
            for (int j = 0; j < 8; ++j) { s += f[j]; q += f[j] * f[j]; } }
        s += dpp_f<DPP_XOR1>(s); s += dpp_f<DPP_XOR2>(s); q += dpp_f<DPP_XOR1>(q); q += dpp_f<DPP_XOR2>(q);
        const float mean = s * (1.0f / 512.0f); const float var = fmaxf(q * (1.0f / 512.0f) - mean * mean, 0.f); const float rstd = 1.0f / sqrtf(var + LN_EPS);
        const float* lg = INP(I_GLG) + l * 512 + 256 * hf + 64 * part; const float* lb = INP(I_GLB) + l * 512 + 256 * hf + 64 * part;
#pragma unroll
        for (int c8 = 0; c8 < 8; ++c8) { float f[8]; cvt8(r2[c8], f);
            const f32x4 g0 = *(const f32x4*)(lg + 8 * c8), g1 = *(const f32x4*)(lg + 8 * c8 + 4), b0 = *(const f32x4*)(lb + 8 * c8), b1 = *(const f32x4*)(lb + 8 * c8 + 4);
            const float gg[8] = {g0[0], g0[1], g0[2], g0[3], g1[0], g1[1], g1[2], g1[3]}, bb[8] = {b0[0], b0[1], b0[2], b0[3], b1[0], b1[1], b1[2], b1[3]};
#pragma unroll
            for (int j = 0; j < 8; ++j) { const float vn = (f[j] - mean) * rstd * gg[j] + bb[j];
                *(LAS bf16*)(C.lds + (64 * part + 8 * c8 + j) * VS + tok * 2) = (bf16)(pk2(vn, 0.f) & 0xffffu); } }
    }
    __syncthreads();
    f32x16 acc[2][2];
#pragma unroll
    for (int a = 0; a < 2; ++a)
#pragma unroll
        for (int b = 0; b < 2; ++b)
#pragma unroll
            for (int i = 0; i < 16; ++i) acc[a][b][i] = 0.f;
#pragma unroll
    for (int s = 0; s < 8; ++s) {
        bf16x8 Vf[2];
#pragma unroll
        for (int cb = 0; cb < 2; ++cb) Vf[cb] = *(const LAS bf16x8*)(C.lds + (64 * gl + 32 * cb + r32) * VS + (16 * s + 8 * h) * 2);
#pragma unroll
        for (int cb = 0; cb < 2; ++cb)
#pragma unroll
            for (int pb = 0; pb < 2; ++pb) acc[cb][pb] = MFMA32(Vf[cb], Wf[pb][s], acc[cb][pb]);
    }
    bf16* Y = WSP(bf16, WS_YCAT);
#pragma unroll
    for (int pb = 0; pb < 2; ++pb) { const int p = 64 * ph + 32 * pb + r32; const float bs = INP(I_GBS)[(l * 8 + g) * 128 + p];
        bf16* yp = Y + (size_t)(row0 + p) * DM + 1536 + 64 * g + 4 * h;
#pragma unroll
        for (int cb = 0; cb < 2; ++cb)
#pragma unroll
            for (int rg = 0; rg < 4; ++rg) { const u32x2 uv = upre[pb][cb][rg];
                u32x2 w; w.x = pk2(bflo(uv.x) * (acc[cb][pb][4 * rg] + bs), bfhi(uv.x) * (acc[cb][pb][4 * rg + 1] + bs)); w.y = pk2(bflo(uv.y) * (acc[cb][pb][4 * rg + 2] + bs), bfhi(uv.y) * (acc[cb][pb][4 * rg + 3] + bs));
                *(u32x2*)(yp + 32 * cb + 8 * rg) = w; } }
}

__device__ __forceinline__ void pool_unit(Ctx& C, int l, int blk) {
    constexpr int RS = 1040, DT_OFF = 48 * RS;
    const int row0 = 32 * blk;
    const int s0 = row0 < NLAT ? (row0 / SL) * SL : NLAT + ((row0 - NLAT) / CL) * CL, L = row0 < NLAT ? SL : CL, t0 = row0 - s0;
    const bf16* Z = WSP(bf16, WS_Z);
    __syncthreads();
    for (int idx = C.tid; idx < 48 * 64; idx += 512) { const int r = idx >> 6, ch = idx & 63, t = t0 - 8 + r; u32x4 v = {0u, 0u, 0u, 0u};
        if (t >= 0 && t < L) v = *(const u32x4*)(Z + (size_t)(s0 + t) * INW + 8 * ch);
        *(LAS u32x4*)(C.lds + r * RS + ch * 16) = v; }
    __syncthreads();
    {
        const int c8 = C.tid & 63, tg = C.tid >> 6, hw = 1 << (c8 >> 4);
#pragma unroll 1
        for (int k = 0; k < 4; ++k) { const int tt = 4 * tg + k, t = t0 + tt; const int lo = max(t - hw, 0), hi = min(t + hw, L);
            float sacc[8];
#pragma unroll
            for (int j = 0; j < 8; ++j) sacc[j] = 0.f;
            for (int q = lo; q < hi; ++q) { float f[8]; cvt8(*(const LAS u32x4*)(C.lds + (q - t0 + 8) * RS + c8 * 16), f);
#pragma unroll
                for (int j = 0; j < 8; ++j) sacc[j] += f[j]; }
            float cf[8]; cvt8(*(const LAS u32x4*)(C.lds + (tt + 8) * RS + c8 * 16), cf); const float inv = 1.0f / (float)(hi - lo);
#pragma unroll
            for (int j = 0; j < 8; ++j) sacc[j] = sacc[j] * inv - cf[j];
            *(LAS bf16x8*)(C.lds + DT_OFF + tt * RS + c8 * 16) = pack8(sacc); }
    }
    __syncthreads();
    const int gi = C.wave >> 1, oh = C.wave & 1, r32 = C.lane & 31, h = C.lane >> 5;
    f32x16 acc[2];
#pragma unroll
    for (int a = 0; a < 2; ++a)
#pragma unroll
        for (int i = 0; i < 16; ++i) acc[a][i] = 0.f;
    const bf16* wt = WSP(bf16, WS_POOLWT) + (size_t)((l * 4 + gi) * 128 + 64 * oh + r32) * 128 + 8 * h;
#pragma unroll
    for (int s = 0; s < 8; ++s) {
        const bf16x8 Bf = *(const LAS bf16x8*)(C.lds + DT_OFF + r32 * RS + (128 * gi + 16 * s + 8 * h) * 2);
#pragma unroll
        for (int rb = 0; rb < 2; ++rb) { const bf16x8 Af = *(const bf16x8*)(wt + (size_t)(32 * rb) * 128 + 16 * s); acc[rb] = MFMA32(Af, Bf, acc[rb]); }
    }
    bf16* yp = WSP(bf16, WS_YCAT) + (size_t)(row0 + r32) * DM + 128 * gi + 64 * oh;
#pragma unroll
    for (int rb = 0; rb < 2; ++rb)
#pragma unroll
        for (int rg = 0; rg < 4; ++rg) { u32x2 w; w.x = pk2(acc[rb][4 * rg], acc[rb][4 * rg + 1]); w.y = pk2(acc[rb][4 * rg + 2], acc[rb][4 * rg + 3]); *(u32x2*)(yp + 32 * rb + 8 * rg + 4 * h) = w; }
}

__device__ __forceinline__ void hyprep_unit(Ctx& C, int l, int uidx) {
    constexpr int RS = 528;
    int seq, tb, cb, L, rowbase; bf16* T;
    if (uidx < 1536) { seq = uidx / 384; const int rem = uidx % 384; tb = rem / 6; cb = rem % 6; L = SL; rowbase = seq * SL; T = WSP(bf16, WS_TL); }
    else { const int v = uidx - 1536; seq = v / 24; const int rem = v % 24; tb = rem / 6; cb = rem % 6; L = CL; rowbase = NLAT + seq * CL; T = WSP(bf16, WS_TC); }
    const int t0 = 64 * tb; const bf16* Z = WSP(bf16, WS_Z);
    __syncthreads();
    for (int idx = C.tid; idx < 66 * 32; idx += 512) { const int r = idx >> 5, ch = idx & 31, t = t0 - 1 + r; u32x4 v = {0u, 0u, 0u, 0u};
        if (t >= 0 && t < L) v = *(const u32x4*)(Z + (size_t)(rowbase + t) * INW + 1280 + 256 * cb + 8 * ch);
        *(LAS u32x4*)(C.lds + r * RS + ch * 16) = v; }
    __syncthreads();
    const int c = C.tid & 255, hf = C.tid >> 8, ch = 256 * cb + c, comp = ch >> 9, cc = ch & 511;
    const float w0 = INP(I_HCW)[(l * 3 + 0) * 1536 + ch], w1 = INP(I_HCW)[(l * 3 + 1) * 1536 + ch], w2 = INP(I_HCW)[(l * 3 + 2) * 1536 + ch], bias = INP(I_HCB)[l * 1536 + ch];
    bf16* dst = T + ((size_t)(comp * 512 + cc) * 4 + seq) * L + t0 + 32 * hf;
    float zm = bf1(*(const LAS bf16*)(C.lds + (32 * hf) * RS + c * 2)), zc = bf1(*(const LAS bf16*)(C.lds + (32 * hf + 1) * RS + c * 2));
#pragma unroll
    for (int k = 0; k < 4; ++k) { float o[8];
#pragma unroll
        for (int e = 0; e < 8; ++e) { const float zn = bf1(*(const LAS bf16*)(C.lds + (32 * hf + 8 * k + e + 2) * RS + c * 2)); o[e] = bias + w0 * zm + w1 * zc + w2 * zn; zm = zc; zc = zn; }
        u32x4 w; w.x = pk2(o[0], o[1]); w.y = pk2(o[2], o[3]); w.z = pk2(o[4], o[5]); w.w = pk2(o[6], o[7]); *(u32x4*)(dst + 8 * k) = w; }
}

template <int L>
__device__ __forceinline__ void hyena_unit(Ctx& C, int l, int c) {
    constexpr int NBLK = L / 32, NTILE = NBLK / 8, NTL = (NTILE >= 16) ? 2 : 1;
    constexpr int SB = 2 * L + 16, Z_OFF = 4 * SB, R_OFF = Z_OFF + 64, CSZ = 4 * L;
    const bf16* T = (L == SL) ? WSP(bf16, WS_TL) : WSP(bf16, WS_TC);
    const int r32 = C.lane & 31, h = C.lane >> 5;
    const bool active = (2 * C.wave < NTILE);
    const int qi = (r32 + 1) >> 2, ri = (r32 + 1) & 3, pcp = (4 - ri) & 3;
    const int laneA = R_OFF + pcp * CSZ + (pcp ? 8 + 64 * pcp : 0) - 8 * (qi + (ri ? 1 : 0)) + 16 * h;
    const int al = r32 >> 2, bb = r32 & 3;
    const int laneB = bb * SB + 16 * h;
    for (int o = 0; o < 2; ++o) {
        __syncthreads();
        if (o == 0) { const bf16* src = T + (size_t)(2 * 512 + c) * 4 * L;
            for (int idx = C.tid; idx < 4 * L / 8; idx += 512) { const int b = idx / (L / 8), tc = idx % (L / 8); *(LAS u32x4*)(C.lds + b * SB + tc * 16) = *(const u32x4*)(src + 8 * idx); }
            if (C.tid < 4) *(LAS u32x4*)(C.lds + Z_OFF + 16 * C.tid) = (u32x4){0u, 0u, 0u, 0u}; }
        { const bf16* fsrc = (L == SL) ? WSP(bf16, WS_FILT) + (size_t)((l * 2 + o) * 512 + c) * (2 * L) : WSP(bf16, WS_FILTC) + (size_t)(o * 512 + c) * (2 * L);
          for (int idx = C.tid; idx < L / 4; idx += 512) *(LAS u32x4*)(C.lds + R_OFF + 16 * idx) = *(const u32x4*)(fsrc + 8 * idx); }
        __syncthreads();
        for (int idx = C.tid; idx < 3 * (L / 2); idx += 512) { const int p = 1 + idx / (L / 2), w = idx % (L / 2); unsigned short e[4];
#pragma unroll
            for (int k = 0; k < 4; ++k) { const int n = 4 * w + p + k; e[k] = n < 2 * L ? *(const LAS bf16*)(C.lds + R_OFF + 2 * n) : (bf16)0; }
            *(LAS u32x2*)(C.lds + R_OFF + p * CSZ + 8 + 64 * p + 8 * w) = (u32x2){(unsigned)e[0] | ((unsigned)e[1] << 16), (unsigned)e[2] | ((unsigned)e[3] << 16)}; }
        __syncthreads();
        f32x16 acc[NTL];
#pragma unroll
        for (int t = 0; t < NTL; ++t)
#pragma unroll
            for (int i = 0; i < 16; ++i) acc[t][i] = 0.f;
        u32x2 gpre[NTL][4]; float skip = 0.f;
        if (active) { skip = INP(I_HSKIP)[(l * 2 + o) * 512 + c]; const bf16* gate_ = T + (size_t)(o * 512 + c) * 4 * L + (size_t)bb * L;
#pragma unroll
            for (int t = 0; t < NTL; ++t)
#pragma unroll
                for (int rg = 0; rg < 4; ++rg) gpre[t][rg] = *(const u32x2*)(gate_ + 32 * (8 * (2 * C.wave + t) + al) + 8 * rg + 4 * h); }
        if (active) {
            const int a0 = 8 * (2 * C.wave);
            const int m_lo = a0 - (NBLK - 1), m_hi = a0 + 8 * (NTL - 1) + 7;
            const int mA = m_hi - (NBLK - 1), mB = a0;
            int off8 = 8; asm volatile("" : "+v"(off8));
#define HY_STEP_CHK(m_) do { bf16x8 Af_[2]; \
                _Pragma("unroll") for (int s = 0; s < 2; ++s) { const LAS unsigned char* ap = C.lds + laneA + 2 * (L - 32 * (m_) + 16 * s); const u32x2 x0 = *(const LAS u32x2*)ap, x1 = *(const LAS u32x2*)(ap + off8); \
                    const u32x4 xx = {x0.x, x0.y, x1.x, x1.y}; Af_[s] = __builtin_bit_cast(bf16x8, xx); } \
                _Pragma("unroll") for (int t = 0; t < NTL; ++t) { const int q = a0 + 8 * t + al - (m_); const bool ok = (q >= 0) && (q < NBLK); \
                    _Pragma("unroll") for (int s = 0; s < 2; ++s) { const int addr = ok ? (laneB + 64 * q + 32 * s) : Z_OFF; const bf16x8 Bf_ = *(const LAS bf16x8*)(C.lds + addr); acc[t] = MFMA32(Af_[s], Bf_, acc[t]); } } } while (0)
#pragma unroll 1
            for (int m = m_lo; m < mA; ++m) HY_STEP_CHK(m);
            {
                int o1 = 8, o2 = 32, o3 = 40; asm volatile("" : "+v"(o1), "+v"(o2), "+v"(o3));
                const LAS unsigned char* pa0 = C.lds + laneA + 2 * (L - 32 * mA); const LAS unsigned char* pa1 = pa0 + o1; const LAS unsigned char* pa2 = pa0 + o2; const LAS unsigned char* pa3 = pa0 + o3;
                const LAS unsigned char* pb = C.lds + laneB + 64 * (a0 + al - mA);
#define HY_LOADF(Af_, Bf_) do { { const u32x2 x0 = *(const LAS u32x2*)pa0, x1 = *(const LAS u32x2*)pa1, x2 = *(const LAS u32x2*)pa2, x3 = *(const LAS u32x2*)pa3; \
                    const u32x4 xa = {x0.x, x0.y, x1.x, x1.y}, xb = {x2.x, x2.y, x3.x, x3.y}; Af_[0] = __builtin_bit_cast(bf16x8, xa); Af_[1] = __builtin_bit_cast(bf16x8, xb); } \
                _Pragma("unroll") for (int t = 0; t < NTL; ++t) _Pragma("unroll") for (int s = 0; s < 2; ++s) Bf_[t][s] = *(const LAS bf16x8*)(pb + 512 * t + 32 * s); \
                pa0 -= 64; pa1 -= 64; pa2 -= 64; pa3 -= 64; pb -= 64; asm volatile("" : "+v"(pa0), "+v"(pa1), "+v"(pa2), "+v"(pa3)); } while (0)
#define HY_MMA(Af_, Bf_) do { _Pragma("unroll") for (int s = 0; s < 2; ++s) _Pragma("unroll") for (int t = 0; t < NTL; ++t) acc[t] = MFMA32(Af_[s], Bf_[t][s], acc[t]); } while (0)
                int nfast = mB - mA + 1;
                if constexpr (NTL == 2) {
                    bf16x8 Bx[8][2], By[8][2];
#define HY_LOADA(Af_) do { const u32x2 x0 = *(const LAS u32x2*)pa0, x1 = *(const LAS u32x2*)pa1, x2 = *(const LAS u32x2*)pa2, x3 = *(const LAS u32x2*)pa3; \
                        const u32x4 xa = {x0.x, x0.y, x1.x, x1.y}, xb = {x2.x, x2.y, x3.x, x3.y}; Af_[0] = __builtin_bit_cast(bf16x8, xa); Af_[1] = __builtin_bit_cast(bf16x8, xb); \
                        pa0 -= 64; pa1 -= 64; pa2 -= 64; pa3 -= 64; asm volatile("" : "+v"(pa0), "+v"(pa1), "+v"(pa2), "+v"(pa3)); } while (0)
#define HY_GROUP(Bold, Bnew, more) do { _Pragma("unroll") for (int i = 0; i < 8; ++i) { bf16x8 An_[2] = {Ac_[0], Ac_[1]}; \
                        if (i < 7) { HY_LOADA(An_); Bnew[i + 1][0] = *(const LAS bf16x8*)(pb - 64 * (i + 1)); Bnew[i + 1][1] = *(const LAS bf16x8*)(pb - 64 * (i + 1) + 32); } \
                        else if (more) { HY_LOADA(An_); Bold[0][0] = *(const LAS bf16x8*)(pb - 512); Bold[0][1] = *(const LAS bf16x8*)(pb - 512 + 32); }        \
                        acc[0] = MFMA32(Ac_[0], Bnew[i][0], acc[0]); acc[1] = MFMA32(Ac_[0], Bold[i][0], acc[1]); acc[0] = MFMA32(Ac_[1], Bnew[i][1], acc[0]); acc[1] = MFMA32(Ac_[1], Bold[i][1], acc[1]); \
                        Ac_[0] = An_[0]; Ac_[1] = An_[1]; } \
                        pb -= 512; } while (0)
                    if (nfast >= 16) {
#pragma unroll
                        for (int i = 0; i < 8; ++i) { Bx[i][0] = *(const LAS bf16x8*)(pb + 512 - 64 * i); Bx[i][1] = *(const LAS bf16x8*)(pb + 512 - 64 * i + 32); }
                        bf16x8 Ac_[2]; HY_LOADA(Ac_); By[0][0] = *(const LAS bf16x8*)pb; By[0][1] = *(const LAS bf16x8*)(pb + 32);
#pragma unroll 1
                        while (nfast >= 16) { HY_GROUP(Bx, By, true); HY_GROUP(By, Bx, nfast >= 32); nfast -= 16; }
                    }
#undef HY_LOADA
#undef HY_GROUP
                }
                bf16x8 A0[2], B0[NTL][2], A1[2], B1[NTL][2];
                if (nfast > 0) {
                    int rem = nfast - 1;
                    HY_LOADF(A0, B0);
#pragma unroll 1
                    while (rem >= 2) { HY_LOADF(A1, B1); HY_MMA(A0, B0); HY_LOADF(A0, B0); HY_MMA(A1, B1); rem -= 2; }
                    if (rem == 1) { HY_LOADF(A1, B1); HY_MMA(A0, B0); HY_MMA(A1, B1); } else { HY_MMA(A0, B0); }
                }
#undef HY_LOADF
#undef HY_MMA
            }
#pragma unroll 1
            for (int m = mB + 1; m <= m_hi; ++m) HY_STEP_CHK(m);
#undef HY_STEP_CHK
        }
        __syncthreads();
        if (active) {
#pragma unroll
            for (int t = 0; t < NTL; ++t) { const int a = 8 * (2 * C.wave + t) + al;
#pragma unroll
                for (int rg = 0; rg < 4; ++rg) { const int t4 = 32 * a + 8 * rg + 4 * h;
                    LAS u32x2* up = (LAS u32x2*)(C.lds + bb * SB + t4 * 2); const u32x2 uo = *up; const u32x2 gv = gpre[t][rg];
                    const float v0 = bflo(gv.x) * (acc[t][4 * rg] + skip * bflo(uo.x)), v1 = bfhi(gv.x) * (acc[t][4 * rg + 1] + skip * bfhi(uo.x));
                    const float v2 = bflo(gv.y) * (acc[t][4 * rg + 2] + skip * bflo(uo.y)), v3 = bfhi(gv.y) * (acc[t][4 * rg + 3] + skip * bfhi(uo.y));
                    const u32x2 w = {pk2(v0, v1), pk2(v2, v3)};
                    if (o == 0) *up = w;
                    else { const int row = (L == SL) ? bb * SL + t4 : NLAT + bb * CL + t4; *(u32x2*)(WSP(bf16, WS_YHT) + (size_t)c * NTOK + row) = w; } } }
        }
    }
}

constexpr int RMS_GN_OFF = 34816;
__device__ __forceinline__ void rms_stage_gain(Ctx& C, int l) { __syncthreads(); stage2048(C, (LAS float*)(C.lds + RMS_GN_OFF), INP(I_MNG) + l * DM); __syncthreads(); }
__device__ __forceinline__ void rms_unit(Ctx& C, int l, int blk) {
    constexpr int RS = 1040;
    const int row0 = 32 * blk;
    const int tok = C.tid >> 4, sub = C.tid & 15;
    const bf16* Y = WSP(bf16, WS_YCAT) + (size_t)(row0 + tok) * DM + 32 * sub;
    u32x4 raw[3][4];
#pragma unroll
    for (int gi = 0; gi < 3; ++gi)
#pragma unroll
        for (int c8 = 0; c8 < 4; ++c8) raw[gi][c8] = *(const u32x4*)(Y + 512 * (gi == 2 ? 3 : gi) + 8 * c8);
    u32x4 hy[4];
    { const bf16* yh = WSP(bf16, WS_YHT);
#pragma unroll
      for (int k = 0; k < 4; ++k) { const int idx = C.tid + 512 * k, ch = idx >> 2, tc = idx & 3; hy[k] = *(const u32x4*)(yh + (size_t)ch * NTOK + row0 + 8 * tc); } }
    __syncthreads();
#pragma unroll
    for (int k = 0; k < 4; ++k) { const int idx = C.tid + 512 * k, ch = idx >> 2, tc = idx & 3; const u32x4 v = hy[k];
        LAS bf16* d = (LAS bf16*)(C.lds + (8 * tc) * RS + ch * 2);
        d[0] = (bf16)(v.x & 0xffff); d[RS / 2] = (bf16)(v.x >> 16); d[2 * (RS / 2)] = (bf16)(v.y & 0xffff); d[3 * (RS / 2)] = (bf16)(v.y >> 16);
        d[4 * (RS / 2)] = (bf16)(v.z & 0xffff); d[5 * (RS / 2)] = (bf16)(v.z >> 16); d[6 * (RS / 2)] = (bf16)(v.w & 0xffff); d[7 * (RS / 2)] = (bf16)(v.w >> 16); }
    __syncthreads();
    const LAS float* gn = (const LAS float*)(C.lds + RMS_GN_OFF);
    unsigned char* O = WSP(unsigned char, WS_HA8) + (size_t)(row0 + tok) * DM + 32 * sub;
#pragma unroll
    for (int gq = 0; gq < 4; ++gq) {
        float f[32]; float q = 0.f;
#pragma unroll
        for (int c8 = 0; c8 < 4; ++c8) { const u32x4 v = (gq == 2) ? *(const LAS u32x4*)(C.lds + tok * RS + (32 * sub + 8 * c8) * 2) : raw[gq == 3 ? 2 : gq][c8];
            float t8[8]; cvt8(v, t8);
#pragma unroll
            for (int j = 0; j < 8; ++j) { f[8 * c8 + j] = t8[j]; q += t8[j] * t8[j]; } }
        q = row16_sum(q);
        const float rs = 1.0f / sqrtf(q * (1.0f / 512.0f) + LN_EPS);
        const LAS float* gp = gn + 512 * gq + 32 * sub;
#pragma unroll
        for (int c8 = 0; c8 < 4; ++c8) { const f32x4 g0 = *(const LAS f32x4*)(gp + 8 * c8), g1 = *(const LAS f32x4*)(gp + 8 * c8 + 4);
            u32x2 w; w.x = pk4_fp8(f[8 * c8] * rs * g0[0], f[8 * c8 + 1] * rs * g0[1], f[8 * c8 + 2] * rs * g0[2], f[8 * c8 + 3] * rs * g0[3]);
            w.y = pk4_fp8(f[8 * c8 + 4] * rs * g1[0], f[8 * c8 + 5] * rs * g1[1], f[8 * c8 + 6] * rs * g1[2], f[8 * c8 + 7] * rs * g1[3]);
            *(u32x2*)(O + 512 * gq + 8 * c8) = w; }
        __builtin_amdgcn_sched_barrier(0);
    }
}

__device__ __forceinline__ void ph_post1(Ctx& C, int l, int nrows, bool dry = false) {
    LAS float* H2 = (LAS float*)C.lds;
    LAS float* RED = (LAS float*)(C.lds + 65536);
    LAS float* SGA = (LAS float*)(C.lds + 81920);
    LAS float* PAR = (LAS float*)(C.lds + 92160);
    unsigned* ctl = WSP(unsigned, WS_CTL);
    int nit = 0, cur_mrow = -1;
    const int nit_all = nrows / 8, it0 = (int)(((long)C.bid * nit_all) / C.G), it1 = (int)(((long)(C.bid + 1) * nit_all) / C.G);
    for (int it = it0; it < it1; ++it, ++nit) {
        const int row = it * 8 + C.wave;
        const int mrow = row < NLAT ? row / SL : 4; const float* mod = WSP(float, WS_MOD) + (size_t)(l * 5 + mrow) * 12288;
        __syncthreads();
        if (mrow != cur_mrow) { stage2048(C, PAR, mod + 4096); stage2048(C, PAR + 2048, INP(I_LN1G) + l * DM); stage2048(C, PAR + 4096, INP(I_LN1B) + l * DM); stage2048(C, PAR + 6144, mod + 8192); stage2048(C, PAR + 8192, mod + 6144); cur_mrow = mrow; __syncthreads(); }
        {
            float v[32], y[32], g1[32];
            if (l == 0) row_load(src_x0(C, row), C.lane, v); else row_load_bf16(WSP(bf16, WS_X) + (size_t)row * DM, C.lane, v);
            row_load_lds(PAR, C.lane, g1);
            { const bf16* yo = WSP(bf16, WS_YO) + (size_t)row * DM;
#pragma unroll
              for (int j = 0; j < 4; ++j) { float t8[8]; cvt8(*(const u32x4*)(yo + 512 * j + 8 * C.lane), t8);
#pragma unroll
                  for (int e = 0; e < 8; ++e) y[8 * j + e] = t8[e]; } }
#pragma unroll
            for (int i = 0; i < 32; ++i) v[i] = ALPHA * v[i] + g1[i] * y[i];
            row_ln(v); row_affine_lds(v, PAR + 2048, PAR + 4096, C.lane, 0.f);
            row_store_bf16(WSP(bf16, WS_X) + (size_t)row * DM, C.lane, v);
            row_ln(v); row_affine_lds(v, PAR + 6144, PAR + 8192, C.lane, 1.0f);
            row_store_fp8(WSP(unsigned char, WS_HB8) + (size_t)row * DM, C.lane, v);
#pragma unroll
            for (int j = 0; j < 4; ++j) { *(LAS f32x4*)(H2 + C.wave * DM + 512 * j + 8 * C.lane) = (f32x4){v[8 * j], v[8 * j + 1], v[8 * j + 2], v[8 * j + 3]};
                *(LAS f32x4*)(H2 + C.wave * DM + 512 * j + 8 * C.lane + 4) = (f32x4){v[8 * j + 4], v[8 * j + 5], v[8 * j + 6], v[8 * j + 7]}; }
        }
        __syncthreads();
        {
            const int e4 = C.lane & 7, cg = C.lane >> 3, cbase = 256 * C.wave + 32 * cg;
            f32x2 acc[8][2];
#pragma unroll
            for (int r = 0; r < 8; ++r) { acc[r][0] = (f32x2){0.f, 0.f}; acc[r][1] = (f32x2){0.f, 0.f}; }
            const float* wr = INP(I_WR) + (size_t)cbase * NE + 4 * e4;
#pragma unroll 2
            for (int cq = 0; cq < 32; cq += 4) {
                f32x4 w4[4];
#pragma unroll
                for (int k = 0; k < 4; ++k) w4[k] = *(const f32x4*)(wr + (size_t)(cq + k) * NE);
#pragma unroll
                for (int r = 0; r < 8; ++r) { const f32x4 hv = *(const LAS f32x4*)(H2 + r * DM + cbase + cq);
#pragma unroll
                    for (int k = 0; k < 4; ++k) { const f32x2 hh = {hv[k], hv[k]}; acc[r][0] += hh * (f32x2){w4[k][0], w4[k][1]}; acc[r][1] += hh * (f32x2){w4[k][2], w4[k][3]}; } } }
#pragma unroll
            for (int r = 0; r < 8; ++r)
#pragma unroll
                for (int k = 0; k < 2; ++k) { float x = acc[r][k].x, y = acc[r][k].y;
                    x += dpp_f<DPP_ROR8>(x); y += dpp_f<DPP_ROR8>(y); x = xor32_sum(xor16_sum(x)); y = xor32_sum(xor16_sum(y));
                    if (cg == 0) { RED[(C.wave * 8 + r) * 32 + 4 * e4 + 2 * k] = x; RED[(C.wave * 8 + r) * 32 + 4 * e4 + 2 * k + 1] = y; } }
        }
        __syncthreads();
        if (C.tid < 256) { const int r = C.tid >> 5, e = C.tid & 31; float s = 0.f;
#pragma unroll
            for (int p = 0; p < 8; ++p) s += RED[(p * 8 + r) * 32 + e];
            SGA[(nit * 8 + r) * 32 + e] = 1.0f / (1.0f + expf(-s)); }
    }
    __syncthreads();
    if (C.tid < nit * 8 && !dry) { const int r = C.tid, rw = (it0 + (r >> 3)) * 8 + (r & 7); float best = -INFINITY; int bg = 0;
        const LAS float* sg = SGA + r * 32; const float* rb = INP(I_RB);
        for (int gq = 0; gq < 8; ++gq) { const float a = sg[4 * gq] + rb[4 * gq], b = sg[4 * gq + 1] + rb[4 * gq + 1], c = sg[4 * gq + 2] + rb[4 * gq + 2], d = sg[4 * gq + 3] + rb[4 * gq + 3];
            const float hi1 = fmaxf(a, b), lo1 = fminf(a, b), hi2 = fmaxf(c, d), lo2 = fminf(c, d);
            const float top = fmaxf(hi1, hi2), second = fmaxf(fminf(hi1, hi2), (hi1 >= hi2) ? lo1 : lo2);
            const float sc = top + second; if (sc > best) { best = sc; bg = gq; } }
        int i0 = 0; float v0 = -INFINITY;
        for (int k = 0; k < 4; ++k) { const float x = sg[4 * bg + k] + rb[4 * bg + k]; if (x > v0) { v0 = x; i0 = k; } }
        int i1 = 0; float v1 = -INFINITY;
        for (int k = 0; k < 4; ++k) { const float x = sg[4 * bg + k] + rb[4 * bg + k]; if (k != i0 && x > v1) { v1 = x; i1 = k; } }
        const int e0 = 4 * bg + i0, e1 = 4 * bg + i1; const float w0 = sg[e0], w1 = sg[e1], ws = w0 + w1;
        const int p0 = (int)atomicAdd(ctl + CW_CNT + l * 2048 + e0 * 64, 1u), p1 = (int)atomicAdd(ctl + CW_CNT + l * 2048 + e1 * 64, 1u);
        WSP(int4, WS_TOKINFO)[rw] = make_int4(e0, p0, e1, p1); WSP(f32x2, WS_TOKW)[rw] = (f32x2){w0 / ws, w1 / ws};
        WSP(int, WS_EXPTOK)[(size_t)e0 * NTOK + p0] = rw; WSP(int, WS_EXPTOK)[(size_t)e1 * NTOK + p1] = rw; }
    __syncthreads();
}

__device__ __forceinline__ int moe_tables(Ctx& C, int l) {
    LAS int* T = (LAS int*)(C.lds + LDS_TAB);
    __syncthreads();
    if (C.tid < NE) { unsigned* ctl = WSP(unsigned, WS_CTL); T[200 + C.tid] = (int)__hip_atomic_load(ctl + CW_CNT + l * 2048 + C.tid * 64, __ATOMIC_RELAXED, __HIP_MEMORY_SCOPE_AGENT); }
    __syncthreads();
    if (C.tid == 0) { int nb = 0;
        for (int e = 0; e < NE; ++e) { const int cnt = T[200 + e]; T[168 + e] = nb; const int nbk = (cnt + 255) >> 8;
            for (int k = 0; k < nbk; ++k) if (nb + k < MAXBLK) T[nb + k] = e;
            nb += nbk; }
        T[232] = nb < MAXBLK ? nb : MAXBLK; }
    __syncthreads();
    return T[232];
}

__device__ __forceinline__ void ph_post2(Ctx& C, int l, int nrows) {
    const bool last = (l == 1);
    (void)moe_tables(C, l);
    const LAS int* T = (const LAS int*)(C.lds + LDS_TAB);
    LAS float* PAR = (LAS float*)C.lds;
    const int r0 = (int)(((long)C.bid * nrows) / C.G), r1 = (int)(((long)(C.bid + 1) * nrows) / C.G);
    int cur_mrow = -1;
    for (int rb = r0 & ~7; rb < r1; rb += 8) {
        const int mrow = rb < NLAT ? rb / SL : 4; const float* mod = WSP(float, WS_MOD) + (size_t)(l * 5 + mrow) * 12288;
        if (mrow != cur_mrow) { const float* modn = WSP(float, WS_MOD) + (size_t)((last ? l : l + 1) * 5 + mrow) * 12288;
            __syncthreads(); stage2048(C, PAR, mod + 10240); stage2048(C, PAR + 2048, INP(I_LN2G) + l * DM); stage2048(C, PAR + 4096, INP(I_LN2B) + l * DM); stage2048(C, PAR + 6144, modn + 2048); stage2048(C, PAR + 8192, modn); cur_mrow = mrow; __syncthreads(); }
        const int row = rb + C.wave;
        if (row >= r0 && row < r1) {
        const int4 ti = WSP(int4, WS_TOKINFO)[row]; const f32x2 tw = WSP(f32x2, WS_TOKW)[row];
        const int s0 = T[168 + ti.x] * 256 + ti.y, s1 = T[168 + ti.z] * 256 + ti.w;
        const unsigned char* y0 = WSP(unsigned char, WS_YS) + (size_t)s0 * DM; const unsigned char* y1 = WSP(unsigned char, WS_YS) + (size_t)s1 * DM;
        float v[32], g2[32]; row_load_bf16(WSP(bf16, WS_X) + (size_t)row * DM, C.lane, v); row_load_lds(PAR, C.lane, g2);
#pragma unroll
        for (int j = 0; j < 4; ++j) { float a[8], b[8]; cvt8_fp8(*(const u32x2*)(y0 + 512 * j + 8 * C.lane), a); cvt8_fp8(*(const u32x2*)(y1 + 512 * j + 8 * C.lane), b);
#pragma unroll
            for (int e = 0; e < 8; ++e) v[8 * j + e] = ALPHA * v[8 * j + e] + g2[8 * j + e] * ((tw.x * 0.0625f) * a[e] + (tw.y * 0.0625f) * b[e]); }
        row_ln(v); row_affine_lds(v, PAR + 2048, PAR + 4096, C.lane, 0.f);
        if (last) { row_store((float*)(C.out + (size_t)row * DM), C.lane, v); }
        else { row_store_bf16(WSP(bf16, WS_X) + (size_t)row * DM, C.lane, v);
            row_ln(v); row_affine_lds(v, PAR + 6144, PAR + 8192, C.lane, 1.0f);
            if (FP8_IN) row_store_fp8(WSP(unsigned char, WS_HA8) + (size_t)row * DM, C.lane, v); else row_store_bf16(WSP(bf16, WS_HB) + (size_t)row * DM, C.lane, v); }
        }
    }
}

constexpr int N_PHASES = 20;
__global__ void __launch_bounds__(512, 2) fwd_kernel(Args args) {
    extern __shared__ __attribute__((aligned(16))) unsigned char lds_raw[];
    Ctx C0; C0.lds = (LAS unsigned char*)lds_raw; C0.tid = threadIdx.x; C0.lane = C0.tid & 63; C0.wave = __builtin_amdgcn_readfirstlane(C0.tid >> 6); C0.bid = blockIdx.x; C0.G = gridDim.x;
    C0.in = (const float GAS* const __attribute__((address_space(4)))*)((const __attribute__((address_space(4))) Args*)__builtin_amdgcn_kernarg_segment_ptr())->in; C0.out = (float GAS*)args.out; C0.ws = (unsigned char GAS*)args.ws;
    volatile LAS unsigned* MISC = (volatile LAS unsigned*)(C0.lds + LDS_MISC);
    if (C0.tid < 4) MISC[C0.tid] = 0u;
    __syncthreads();
    XcdBarrier bar; bar.bar = (unsigned*)(unsigned GAS*)(C0.ws + WS_CTL) + CW_BAR; bar.x = 0; bar.st = nullptr;
    const int lo = args.ph_lo, hi = args.ph_hi;
    if (hi - lo > 1) bar = xcd_barrier_post((unsigned*)(unsigned GAS*)(C0.ws + WS_CTL) + CW_BAR, MISC);
#ifdef ONLY
#define IN(k) ((k) == ONLY)
#define INL(j) ((j) + 2 == ONLY)
#define SEAM(k) do { } while (0)
#else
#define IN(k) (lo <= (k) && (k) < hi)
#define INL(j) IN(pb + (j))
#define SEAM(k) do { if (IN(k) && IN((k) + 1)) xcd_barrier(bar); } while (0)
#endif

    if (IN(0)) { _Pragma("unroll") for (int rep = 0; rep < NREP(0); ++rep) { if (rep) xcd_barrier(bar); FRESH(D, C0);
        if (D.bid & 1) { p0_filters(D); p0_adaln(D); } else { p0_adaln(D); p0_filters(D); }        p0_rope(D); __syncthreads(); p0_convert(D, 0, NBP); } }
    SEAM(0);
    if (IN(1)) { _Pragma("unroll") for (int rep = 0; rep < NREP(1); ++rep) { if (rep) xcd_barrier(bar); FRESH(D, C0); ph_ln_mod(D, 0, NTOK); } }
    SEAM(1);
#define LAYER_BODY(l) do { \
        const int pb = 2 + 9 * l; const bool last = (l == 1); const int nrows = last ? NLAT : NTOK; \
        if (INL(0)) { _Pragma("unroll") for (int rep = 0; rep < NREP(2 + 9 * l + 0); ++rep) { if (rep) xcd_barrier(bar); \
            FRESH(C, C0); \
            pg8::Gemm g{FP8_IN ? (const bf16*)WSP(unsigned char, WS_HA8) : WSP(bf16, WS_HB), FP8_IN ? (const bf16*)(WSP(unsigned char, WS_WIN) + (size_t)l * INW * DM) : WSP(bf16, WS_WIN) + (size_t)l * INW * DM, FP8_IN ? DM / 2 : DM}; \
            pg8::DenseOrder S; S.init(NTOK, INW, C.G, C.bid); \
            pg8::EpiBf16 E{WSP(bf16, WS_Z), INW, 11}; \
            pg8::gemm_phase<pg8::EpiBf16, pg8::DenseOrder, false, FP8_IN != 0>(C.lds, g, S, E); \
        } \
        } SEAM(pb + 0); \
        if (INL(1)) { _Pragma("unroll") for (int rep = 0; rep < NREP(2 + 9 * l + 1); ++rep) { if (rep) xcd_barrier(bar); \
            const int n_attn = last ? 256 : 272, n_gmlp = last ? 256 : 272, n_pool = last ? 512 : 544, n_hyp = last ? 1536 : 1632; \
            { FRESH(C, C0); \
                \
              volatile LAS int* qn = (volatile LAS int*)(C.lds + LDS_MISC + 32); \
              unsigned* qctr = WSP(unsigned, WS_CTL) + CW_QUEUE + (l * 2 + rep) * 64; \
              const int b0 = 256, b1 = b0 + n_gmlp, b2 = b1 + (n_attn - 256), b3 = b2 + n_pool, total = b3 + n_hyp; \
              volatile LAS int* qc = (volatile LAS int*)(C.lds + LDS_MISC + 36); \
              unsigned* cctr = WSP(unsigned, WS_CTL) + CW_QUEUE + (4 + rep) * 64; \
              int u = C.bid, cu = (last || C.bid >= CONV_SPLIT) ? NCU : C.bid;        \
              while (u < total || cu < NCU) { \
                  int nxt = total, nxc = NCU; \
                  if (C.tid == 0) { if (u < total) nxt = (int)atomicAdd(qctr, 1u) + C.G; if (cu < NCU) { nxc = (int)atomicAdd(cctr, 1u) + C.G; if (nxc >= CONV_SPLIT) nxc = NCU; } } \
                  if (u < total) { FRESH(Cu, C); if (u < b0) attn_unit(Cu, l, u); else if (u < b1) gmlp_unit(Cu, l, u - b0); else if (u < b2) attn_unit(Cu, l, 256 + u - b1); else if (u < b3) pool_unit(Cu, l, u - b2); else hyprep_unit(Cu, l, u - b3); } \
                  if (cu < NCU) { FRESH(Cu, C); conv_unit(Cu, 1, cu * 4); } \
                  __syncthreads(); if (C.tid == 0) { *qn = nxt; *qc = nxc; } __syncthreads(); u = __builtin_amdgcn_readfirstlane(*qn); cu = __builtin_amdgcn_readfirstlane(*qc); \
              } } \
        } \
        } SEAM(pb + 1); \
        if (INL(2)) { _Pragma("unroll") for (int rep = 0; rep < NREP(2 + 9 * l + 2); ++rep) { if (rep) xcd_barrier(bar); \
            { FRESH(C, C0);        \
              volatile LAS int* qc = (volatile LAS int*)(C.lds + LDS_MISC + 36); \
              unsigned* cctr = WSP(unsigned, WS_CTL) + CW_QUEUE + (6 + 2 * l + rep) * 64; \
              const int nhu = (rep && PROBE_CONV == 1) ? 0 : (last ? 512 : 1024), ncu = (rep && PROBE_CONV == 2) ? 0 : (last ? NCU_E : NCU_E + NCU_P - TAILQ); \
                \
              const int quota = (ncu + C.G - 1) / C.G, cls = C.bid % 3; \
              int hu = C.bid, cu = C.bid, nh = 0, nc = 0; \
              while (hu < nhu || cu < ncu) { \
                  const bool cv = cu < ncu && (hu >= nhu || (nc < quota && (cls == 0 || (cls == 1 && nh >= 1)))); \
                  if (cv) { \
                      int nxc = ncu; if (C.tid == 0) nxc = (int)atomicAdd(cctr, 1u) + C.G; \
                      { FRESH(Cu, C); bg_conv_unit(Cu, l, cu); } \
                      __syncthreads(); if (C.tid == 0) *qc = nxc; __syncthreads(); cu = __builtin_amdgcn_readfirstlane(*qc); ++nc; \
                  } else { FRESH(Cu, C); if (hu < 512) hyena_unit<SL>(Cu, l, hu); else hyena_unit<CL>(Cu, l, hu - 512); hu += C.G; ++nh; } \
              } } \
        } \
        } SEAM(pb + 2); \
        if (INL(3)) { _Pragma("unroll") for (int rep = 0; rep < NREP(2 + 9 * l + 3); ++rep) { if (rep) xcd_barrier(bar); FRESH(C, C0); rms_stage_gain(C, l); for (int u = C.bid; u < nrows / 32; u += C.G) { FRESH(Cu, C); rms_unit(Cu, l, u); } } \
        } SEAM(pb + 3); \
        if (INL(4)) { _Pragma("unroll") for (int rep = 0; rep < NREP(2 + 9 * l + 4); ++rep) { if (rep) xcd_barrier(bar); \
            FRESH(C, C0); \
            pg8::Gemm g{FP8_OUT ? (const bf16*)WSP(unsigned char, WS_HA8) : WSP(bf16, WS_HB), FP8_OUT ? (const bf16*)(WSP(unsigned char, WS_WOUT) + (size_t)l * DM * DM) : WSP(bf16, WS_WOUT) + (size_t)l * DM * DM, FP8_OUT ? DM / 2 : DM}; \
            pg8::DenseOrder S; S.init(nrows, DM, C.G, C.bid); \
            pg8::EpiBf16 E{WSP(bf16, WS_YO), DM, 1 << 30}; \
            pg8::gemm_phase<pg8::EpiBf16, pg8::DenseOrder, false, FP8_OUT != 0>(C.lds, g, S, E); \
            if (!last && rep == 0 && TAILQ > 0) {        \
                FRESH(Ct, C0); \
                volatile LAS int* qc = (volatile LAS int*)(Ct.lds + LDS_MISC + 36); \
                unsigned* tctr = WSP(unsigned, WS_CTL) + CW_QUEUE + 12 * 64; \
                for (;;) { \
                    __syncthreads(); if (Ct.tid == 0) *qc = NCU_E + NCU_P - TAILQ + (int)atomicAdd(tctr, 1u); __syncthreads(); \
                    const int cu = __builtin_amdgcn_readfirstlane(*qc); if (cu >= NCU_E + NCU_P) break; \
                    FRESH(Cu, Ct); bg_conv_unit(Cu, 0, cu); \
                } } \
        } \
        } SEAM(pb + 4); \
        if (INL(5)) { FRESH(C, C0); ph_post1(C, l, nrows); if (PROBE_P1 && l == 0) { xcd_barrier(bar); FRESH(C2, C0); ph_post1(C2, l, nrows, true); } } \
        SEAM(pb + 5); \
        if (INL(6)) { _Pragma("unroll") for (int rep = 0; rep < NREP(2 + 9 * l + 6); ++rep) { if (rep) xcd_barrier(bar); \
            FRESH(C, C0); \
            const int nblk = moe_tables(C, l); const LAS int* T = (const LAS int*)(C.lds + LDS_TAB); \
            pg8::Gemm g{(const bf16*)WSP(unsigned char, WS_HB8), (const bf16*)(WSP(unsigned char, WS_WGU) + (size_t)l * NE * 1536 * DM), DM / 2}; \
            pg8::MoeOrder S; S.nblk = nblk; S.nN = 6; S.G = C.G; S.c = C.bid; S.blk_e = T; S.bst = T + 168; S.cnt = T + 200; S.exptok = WSP(int, WS_EXPTOK); S.ntok = NTOK; \
            pg8::EpiGLU E{WSP(unsigned char, WS_HG), DE}; \
            pg8::gemm_phase<pg8::EpiGLU, pg8::MoeOrder, true, true>(C.lds, g, S, E); \
        } } \
        SEAM(pb + 6); \
        if (INL(7)) { _Pragma("unroll") for (int rep = 0; rep < NREP(2 + 9 * l + 7); ++rep) { if (rep) xcd_barrier(bar); \
            FRESH(C, C0); \
            const int nblk = moe_tables(C, l); const LAS int* T = (const LAS int*)(C.lds + LDS_TAB); \
            pg8::Gemm g{(const bf16*)WSP(unsigned char, WS_HG), (const bf16*)(WSP(unsigned char, WS_WD) + (size_t)l * NE * DM * DE), DE / 2}; \
            pg8::MoeOrder S; S.nblk = nblk; S.nN = 8; S.G = C.G; S.c = C.bid; S.blk_e = T; S.bst = T + 168; S.cnt = T + 200; S.exptok = WSP(int, WS_EXPTOK); S.ntok = NTOK; \
            pg8::EpiFp8 E{WSP(unsigned char, WS_YS), DM, 16.0f}; \
            pg8::gemm_phase<pg8::EpiFp8, pg8::MoeOrder, false, true>(C.lds, g, S, E); \
        } } \
        SEAM(pb + 7); \
        if (INL(8)) { FRESH(C, C0); ph_post2(C, l, nrows); if (PROBE_P2 && l == 1) { xcd_barrier(bar); FRESH(C2, C0); ph_post2(C2, l, nrows); } } \
        SEAM(pb + 8); \
} while (0)
    LAYER_BODY(0);
    LAYER_BODY(1);
#undef IN
#undef INL
#undef SEAM
}

extern "C" void kernel_launch(void* const* d_in, const int* in_sizes, int n_in, void* d_out, int out_size, void* d_ws, size_t ws_size, hipStream_t stream) {
    static int grid = 0;
    if (grid == 0) {
        if (n_in != 35 || out_size != NLAT * DM || ws_size < WS_END) { fprintf(stderr, "kernel_launch: unexpected shapes (n_in %d out %d ws %zu)\n", n_in, out_size, ws_size); grid = -1; return; }
        int dev = 0, cus = 0;
        if (hipGetDevice(&dev) != hipSuccess || hipDeviceGetAttribute(&cus, hipDeviceAttributeMultiprocessorCount, dev) != hipSuccess) { grid = -1; return; }
        if (hipFuncSetAttribute((const void*)fwd_kernel, hipFuncAttributeMaxDynamicSharedMemorySize, LDS_BYTES) != hipSuccess) { fprintf(stderr, "kernel_launch: hipFuncSetAttribute failed\n"); grid = -1; return; }
        int per_cu = 0;
        if (hipOccupancyMaxActiveBlocksPerMultiprocessor(&per_cu, (const void*)fwd_kernel, 512, LDS_BYTES) != hipSuccess || per_cu < 1) fprintf(stderr, "kernel_launch: occupancy query says %d\n", per_cu);
        (void)hipGetLastError();
        grid = cus;
    }
    if (grid < 0) return;
    (void)hipMemsetAsync((char*)d_ws + WS_CTL, 0, CTL_ZERO_BYTES, stream);
    Args a{};
    for (int i = 0; i < 35; ++i) a.in[i] = (const float*)d_in[i];
    a.out = (float*)d_out; a.ws = (unsigned char*)d_ws;
    if (MK_N_LAUNCHES == 1) { a.ph_lo = 0; a.ph_hi = N_PHASES; hipLaunchKernelGGL(fwd_kernel, dim3(grid), dim3(512), LDS_BYTES, stream, a); }
    else for (int p = 0; p < N_PHASES; ++p) { a.ph_lo = p; a.ph_hi = p + 1; hipLaunchKernelGGL(fwd_kernel, dim3(grid), dim3(512), LDS_BYTES, stream, a); }
}
```

```cpp
#include <hip/hip_runtime.h>
#include <cstdio>
#include <cstdint>

#ifndef DUP_MASK
#define DUP_MASK 0u
#endif
#ifndef PROBE_P1
#define PROBE_P1 0
#endif
#ifndef PROBE_P2
#define PROBE_P2 0
#endif
#ifndef FP8_IN
#define FP8_IN 1
#endif
#ifndef FP8_OUT
#define FP8_OUT 1
#endif
#ifndef PROBE_P0
#define PROBE_P0 0
#endif
#ifndef PROBE_CONV
#define PROBE_CONV 0
#endif
#ifndef DUP_SUB
#define DUP_SUB 0u
#endif
#define NSUB(k) (((DUP_SUB >> (k)) & 1u) ? 2 : 1)
#define NREP(k) (((DUP_MASK >> (k)) & 1u) ? 2 : 1)
#ifndef MK_N_LAUNCHES
#define MK_N_LAUNCHES 1
#endif

#define LAS __attribute__((address_space(3)))
#define GAS __attribute__((address_space(1)))
typedef unsigned short bf16;
typedef short bf16x8 __attribute__((ext_vector_type(8)));
typedef float f32x2 __attribute__((ext_vector_type(2)));
typedef float f32x4 __attribute__((ext_vector_type(4)));
typedef float f32x16 __attribute__((ext_vector_type(16)));
typedef unsigned u32x2 __attribute__((ext_vector_type(2)));
typedef unsigned u32x4 __attribute__((ext_vector_type(4)));
typedef __bf16 bf16x2_t __attribute__((ext_vector_type(2)));

constexpr int DM = 2048, NB = 4, SL = 4096, CL = 256, NLAT = NB * SL, NCTX = NB * CL, NTOK = NLAT + NCTX;
constexpr int INW = 3840, DE = 768, NE = 32, MAXBLK = 168;
constexpr float LN_EPS = 1e-6f, ALPHA = 1.41421356237f, LOG2E = 1.44269504089f;

constexpr size_t MiB = 1u << 20;
constexpr size_t WS_CTL = 0, CTL_ZERO_BYTES = 1 * MiB;
constexpr size_t WS_MOD = 1 * MiB;
constexpr size_t WS_ROPE = 2 * MiB;
constexpr size_t WS_TOKINFO = 2 * MiB + 65536;
constexpr size_t WS_TOKW = WS_TOKINFO + (size_t)NTOK * 16;
constexpr size_t WS_ROWSLOT = WS_TOKW + (size_t)NTOK * 8;
constexpr size_t WS_SLOTW = WS_ROWSLOT + (size_t)NTOK * 8;
static_assert(WS_SLOTW + 43008 * 4 <= 4 * MiB, "small tables");
constexpr size_t WS_POOLWT = 3 * MiB;
constexpr size_t WS_GWSB = 3 * MiB + 512 * 1024;
constexpr size_t WS_WIN = 4 * MiB;
constexpr size_t WS_WOUT = 34 * MiB;
constexpr size_t WS_WGU = 50 * MiB;
constexpr size_t WS_WD = 434 * MiB;
constexpr size_t WS_FILT = 626 * MiB;
constexpr size_t WS_FILTC = 658 * MiB;
constexpr size_t WS_X = 660 * MiB;
constexpr size_t WS_HB = 796 * MiB;
constexpr size_t WS_Z = 864 * MiB;
constexpr size_t WS_YCAT = 992 * MiB;
constexpr size_t WS_TL = 1060 * MiB;
constexpr size_t WS_TC = 1108 * MiB;
constexpr size_t WS_YHT = 1112 * MiB;
constexpr size_t WS_YO = 1129 * MiB;
constexpr size_t WS_EXPTOK = 864 * MiB;
constexpr size_t WS_HG = 1032 * MiB;
constexpr size_t WS_YS = 1095 * MiB;
constexpr size_t WS_HB8 = 1265 * MiB;
constexpr size_t WS_HA8 = 1300 * MiB;
constexpr size_t WS_END = 1334 * MiB;
constexpr int CW_BAR = 4096;
constexpr int CW_CNT = 8192;
constexpr int CW_QUEUE = 14336;
constexpr int CW_NBLK = 12288;
constexpr int CW_BLKE = 12544;
constexpr int LDS_TAB = 132096;
constexpr int LDS_BYTES = 147456;
constexpr int LDS_MISC = 147392;

__device__ __forceinline__ unsigned pk2(float lo, float hi) { f32x2 v = {lo, hi}; bf16x2_t b = __builtin_convertvector(v, bf16x2_t); return __builtin_bit_cast(unsigned, b); }
__device__ __forceinline__ unsigned pk4_fp8(float a, float b, float c, float d) { int p = 0; p = __builtin_amdgcn_cvt_pk_fp8_f32(a, b, p, false); p = __builtin_amdgcn_cvt_pk_fp8_f32(c, d, p, true); return (unsigned)p; }
__device__ __forceinline__ float bflo(unsigned w) { return __uint_as_float(w << 16); }
__device__ __forceinline__ float bfhi(unsigned w) { return __uint_as_float(w & 0xffff0000u); }
__device__ __forceinline__ float bf1(bf16 v) { return __uint_as_float(((unsigned)v) << 16); }
template <int CTRL> __device__ __forceinline__ float dpp_f(float x) { return __int_as_float(__builtin_amdgcn_update_dpp(0, __float_as_int(x), CTRL, 0xF, 0xF, true)); }
#define DPP_XOR1 0xB1
#define DPP_XOR2 0x4E
#define DPP_HMIRROR 0x141
#define DPP_MIRROR 0x140
#define DPP_ROR8 0x128
__device__ __forceinline__ float xor16_sum(float x) { const auto r = __builtin_amdgcn_permlane16_swap(__float_as_uint(x), __float_as_uint(x), false, false); return __uint_as_float(r[0]) + __uint_as_float(r[1]); }
__device__ __forceinline__ float xor32_sum(float x) { const auto r = __builtin_amdgcn_permlane32_swap(__float_as_uint(x), __float_as_uint(x), false, false); return __uint_as_float(r[0]) + __uint_as_float(r[1]); }
__device__ __forceinline__ float xor32_max(float x) { const auto r = __builtin_amdgcn_permlane32_swap(__float_as_uint(x), __float_as_uint(x), false, false); return fmaxf(__uint_as_float(r[0]), __uint_as_float(r[1])); }
__device__ __forceinline__ float row16_sum(float v) { v += dpp_f<DPP_XOR1>(v); v += dpp_f<DPP_XOR2>(v); v += dpp_f<DPP_HMIRROR>(v); v += dpp_f<DPP_MIRROR>(v); return v; }
__device__ __forceinline__ float wave_sum(float v) { return xor32_sum(xor16_sum(row16_sum(v))); }
__device__ __forceinline__ float gelu_tanh(float x) { const float y = 0.7978845608f * (x + 0.044715f * x * x * x); const float t = __expf(2.0f * y); return 0.5f * x * (2.0f - 2.0f * __builtin_amdgcn_rcpf(t + 1.0f)); }
__device__ __forceinline__ float silu_f(float x) { return x * __builtin_amdgcn_rcpf(1.0f + __expf(-x)); }
#define LDS_WAIT() asm volatile("s_waitcnt lgkmcnt(0)" ::: "memory")
#define VM_WAIT() asm volatile("s_waitcnt vmcnt(0)" ::: "memory")

namespace pg8 {
#define PG8_LAS __attribute__((address_space(3)))
typedef unsigned short bf16_t;
constexpr int BM = 256, BK = 64, HALF = 128, HTB = HALF * BK * 2, STAGE_BYTES = 8 * HTB, NXCD = 8, WGM = 8;
__host__ __device__ __forceinline__ int lds_byte(int r, int c) { const int st = (r >> 4) * 2 + (c >> 5), rr = r & 15, cc = c & 31, ob = rr * 64 + cc * 2; return st * 1024 + (ob ^ (((ob >> 9) & 1) << 5)); }
__host__ __device__ __forceinline__ void stage_rc(int b, int& R, int& C) { const int st = b / 1024, sb = b % 1024, swz = sb ^ (((sb >> 9) & 1) << 5); R = (st >> 1) * 16 + swz / 64; C = (st & 1) * 32 + (swz % 64) / 2; }
__host__ __device__ __forceinline__ int perm32(int rho) { const int n = rho >> 4, i = rho & 15; return 8 * (i >> 2) + 4 * n + (i & 3); }

struct Unit { int pm, pn, pb; const int* amap; int nvalid; };
struct Gemm { const bf16_t* A; const bf16_t* Bt; int K; };

struct DenseOrder {
    int nM, nN, nwg, G, c;
    __device__ void init(int M, int N, int G_, int c_) { nM = M / BM; nN = N / BM; nwg = nM * nN; G = G_; c = c_; }
    __device__ bool next(int i, Unit& u) const {
        const long L = (long)i * G + c; if (L >= nwg) return false;
        int wgid = (int)L; { const int q = nwg / NXCD, r = nwg % NXCD, xcd = wgid % NXCD, off = wgid / NXCD; wgid = (xcd < r ? xcd * (q + 1) : r * (q + 1) + (xcd - r) * q) + off; }
        const int nig = WGM * nN, gid = wgid / nig, fm = gid * WGM, gsz = (nM - fm) < WGM ? (nM - fm) : WGM;
        u.pm = fm + ((wgid % nig) % gsz); u.pn = (wgid % nig) / gsz; u.pb = u.pn; u.amap = nullptr; u.nvalid = 0; return true;
    }
    __device__ __forceinline__ void a_ready(const Unit&) const {}
    __device__ __forceinline__ void done(const Unit&) const {}
};
struct MoeOrder {
    int nblk, nN, G, c; const PG8_LAS int* blk_e; const PG8_LAS int* bst; const PG8_LAS int* cnt; const int* exptok; int ntok;
    __device__ bool next(int i, Unit& u) const {
        const long L = (long)i * G + c; const int nwg = nblk * nN; if (L >= nwg) return false;
        int wgid = (int)L; { const int q = nwg / NXCD, r = nwg % NXCD, xcd = wgid % NXCD, off = wgid / NXCD; wgid = (xcd < r ? xcd * (q + 1) : r * (q + 1) + (xcd - r) * q) + off; }
        const int blk = wgid / nN, pn = wgid % nN, e = blk_e[blk], p0 = (blk - bst[e]) * 256;
        u.pm = blk; u.pn = pn; u.pb = e * nN + pn; u.amap = exptok + (size_t)e * ntok + p0; u.nvalid = cnt[e] - p0; return true;
    }
    __device__ __forceinline__ void a_ready(const Unit&) const {}
    __device__ __forceinline__ void done(const Unit&) const {}
};

struct EpiBf16 {
    static constexpr bool PERM = true;
    bf16_t* O; int ldc; int gelu_from;
    __device__ __forceinline__ void operator()(const f32x4 (&acc)[2][2][4][2], const Unit& u, int wr, int wc, int fr, int fq) const {
        const int row0 = u.pm * BM + wr * 64 + fr; const int col0 = u.pn * BM + wc * 32 + 8 * fq; const bool act = u.pn >= gelu_from;
#pragma unroll
        for (int ai = 0; ai < 2; ++ai)
#pragma unroll
            for (int m = 0; m < 4; ++m) { bf16_t* rowp = O + (size_t)(row0 + ai * HALF + m * 16) * ldc + col0;
#pragma unroll
                for (int bj = 0; bj < 2; ++bj) { f32x4 v0 = acc[ai][bj][m][0], v1 = acc[ai][bj][m][1];
                    if (act) {
#pragma unroll
                        for (int j = 0; j < 4; ++j) { v0[j] = gelu_tanh(v0[j]); v1[j] = gelu_tanh(v1[j]); } }
                    u32x4 w; w.x = pk2(v0[0], v0[1]); w.y = pk2(v0[2], v0[3]); w.z = pk2(v1[0], v1[1]); w.w = pk2(v1[2], v1[3]);
                    *(u32x4*)(rowp + bj * HALF) = w; } }
    }
};
struct EpiFp8 {
    static constexpr bool PERM = true;
    unsigned char* O; int ldc; float scale;
    __device__ __forceinline__ void operator()(const f32x4 (&acc)[2][2][4][2], const Unit& u, int wr, int wc, int fr, int fq) const {
        const int row0 = u.pm * BM + wr * 64 + fr; const int col0 = u.pn * BM + wc * 32 + 8 * fq;
#pragma unroll
        for (int ai = 0; ai < 2; ++ai)
#pragma unroll
            for (int m = 0; m < 4; ++m) { unsigned char* rowp = O + (size_t)(row0 + ai * HALF + m * 16) * ldc + col0;
#pragma unroll
                for (int bj = 0; bj < 2; ++bj) { const f32x4 v0 = acc[ai][bj][m][0] * scale, v1 = acc[ai][bj][m][1] * scale;
                    u32x2 w; w.x = pk4_fp8(v0[0], v0[1], v0[2], v0[3]); w.y = pk4_fp8(v1[0], v1[1], v1[2], v1[3]);
                    *(u32x2*)(rowp + bj * HALF) = w; } }
    }
};
struct EpiF32 {
    static constexpr bool PERM = false;
    float* C; int ldc;
    __device__ __forceinline__ void operator()(const f32x4 (&acc)[2][2][4][2], const Unit& u, int wr, int wc, int fr, int fq) const {
        const int row0 = u.pm * BM + wr * 64 + fr, col0 = u.pn * BM + wc * 32 + 4 * fq;
#pragma unroll
        for (int ai = 0; ai < 2; ++ai)
#pragma unroll
            for (int m = 0; m < 4; ++m) { float* rowp = C + (size_t)(row0 + ai * HALF + m * 16) * ldc + col0;
#pragma unroll
                for (int bj = 0; bj < 2; ++bj)
#pragma unroll
                    for (int n = 0; n < 2; ++n) *(f32x4*)(rowp + bj * HALF + n * 16) = acc[ai][bj][m][n]; }
    }
};
struct EpiGLU {
    static constexpr bool PERM = true;
    unsigned char* O; int ldc;
    __device__ __forceinline__ void operator()(const f32x4 (&acc)[2][2][4][2], const Unit& u, int wr, int wc, int fr, int fq) const {
        const int row0 = u.pm * BM + wr * 64 + fr; const int col0 = u.pn * HALF + wc * 32 + 8 * fq;
#pragma unroll
        for (int ai = 0; ai < 2; ++ai)
#pragma unroll
            for (int m = 0; m < 4; ++m) { unsigned char* rowp = O + (size_t)(row0 + ai * HALF + m * 16) * ldc + col0;
                float o[8];
#pragma unroll
                for (int n = 0; n < 2; ++n)
#pragma unroll
                    for (int j = 0; j < 4; ++j) { const float g = acc[ai][0][m][n][j], up = acc[ai][1][m][n][j]; o[4 * n + j] = (g * __builtin_amdgcn_rcpf(1.0f + __expf(-g))) * up; }
                u32x2 w; w.x = pk4_fp8(o[0], o[1], o[2], o[3]); w.y = pk4_fp8(o[4], o[5], o[6], o[7]);
                *(u32x2*)rowp = w; }
    }
};
struct EpiScaleBf16 {
    static constexpr bool PERM = true;
    bf16_t* O; int ldc; const float* rs;
    __device__ __forceinline__ void operator()(const f32x4 (&acc)[2][2][4][2], const Unit& u, int wr, int wc, int fr, int fq) const {
        const int row0 = u.pm * BM + wr * 64 + fr; const int col0 = u.pn * BM + wc * 32 + 8 * fq;
#pragma unroll
        for (int ai = 0; ai < 2; ++ai)
#pragma unroll
            for (int m = 0; m < 4; ++m) { const int row = row0 + ai * HALF + m * 16; const float s = rs[row]; bf16_t* rowp = O + (size_t)row * ldc + col0;
#pragma unroll
                for (int bj = 0; bj < 2; ++bj) { const f32x4 v0 = acc[ai][bj][m][0] * s, v1 = acc[ai][bj][m][1] * s;
                    u32x4 w; w.x = pk2(v0[0], v0[1]); w.y = pk2(v0[2], v0[3]); w.z = pk2(v1[0], v1[1]); w.w = pk2(v1[2], v1[3]);
                    *(u32x4*)(rowp + bj * HALF) = w; } }
    }
};

typedef int i32x8 __attribute__((ext_vector_type(8)));
typedef int i32x4v __attribute__((ext_vector_type(4)));
template <class Epi, class Sched, bool GATHER = false, bool FP8 = false, bool ALIGN_EPI = true, bool SP2 = true>
__device__ __forceinline__ void gemm_phase(PG8_LAS unsigned char* lds, const Gemm g, const Sched& S, const Epi& E) {
    int tid_ = threadIdx.x; asm volatile("" : "+v"(tid_));
    const int tid = tid_, wid = __builtin_amdgcn_readfirstlane(tid >> 6), lane = tid & 63, wr = wid >> 2, wc = wid & 3, fr = lane & 15, fq = lane >> 4;
    int K_ = g.K; asm volatile("" : "+s"(K_));
    const int K = K_, nt = K / BK;
    unsigned voffA[2], voffB[2];
#pragma unroll
    for (int i = 0; i < 2; ++i) { int R, C; stage_rc(tid * 16 + i * 8192, R, C); const int Rb = Epi::PERM ? ((R & ~31) + perm32(R & 31)) : R;
        voffA[i] = (unsigned)(R * K + C) * 2u; voffB[i] = (unsigned)(Rb * K + C) * 2u; }
    const size_t kstep = (size_t)(BK * 2);
    const size_t hstep = (size_t)HALF * K * 2;
    const size_t tstep = 2 * hstep;
    const unsigned ldsw = (unsigned)wid * 1024u;
    const int aoff = lds_byte(wr * 64 + fr, fq * 8), boff = lds_byte(wc * 32 + fr, fq * 8);
#define PG8_SA(b, h) (((b) * 2 + (h)) * HTB)
#define PG8_SB(b, h) ((4 + (b) * 2 + (h)) * HTB)
#define PG8_STAGE(bufoff, gbase, voff) do { _Pragma("unroll") for (int _i = 0; _i < 2; ++_i) \
        __builtin_amdgcn_global_load_lds((const unsigned*)((const char*)(gbase) + (voff)[_i]), (PG8_LAS unsigned*)(lds + (bufoff) + ldsw + _i * 8192), 16, 0, 0); } while (0)
#define PG8_STAGE_G(bufoff, kbytes, o0, o1) do { \
        __builtin_amdgcn_global_load_lds((const unsigned*)((const char*)g.A + (kbytes) + (o0)), (PG8_LAS unsigned*)(lds + (bufoff) + ldsw), 16, 0, 0); \
        __builtin_amdgcn_global_load_lds((const unsigned*)((const char*)g.A + (kbytes) + (o1)), (PG8_LAS unsigned*)(lds + (bufoff) + ldsw + 8192), 16, 0, 0); } while (0)
#define PG8_LOADMAP(u, O) do { _Pragma("unroll") for (int _h = 0; _h < 2; ++_h) _Pragma("unroll") for (int _i = 0; _i < 2; ++_i) { int _R, _C; stage_rc(tid * 16 + _i * 8192, _R, _C); const int _rr = _h * HALF + _R; \
        int _t = (_rr < (u).nvalid) ? (u).amap[_rr] : 0; _t = ((unsigned)_t < 17408u) ? _t : 0; O[_h][_i] = (unsigned)(_t * K + _C) * 2u; } } while (0)
#define PG8_LD8(p) __builtin_shufflevector(*(const PG8_LAS i32x4v*)(p), *(const PG8_LAS i32x4v*)((p) + 1024), 0, 1, 2, 3, 4, 5, 6, 7)
#define PG8_LDA(dst, b, h) do { if constexpr (FP8) { _Pragma("unroll") for (int m = 0; m < 4; ++m) dst##8[m] = PG8_LD8(lds + PG8_SA(b, h) + aoff + m * 2048); } \
        else { _Pragma("unroll") for (int m = 0; m < 4; ++m) _Pragma("unroll") for (int k = 0; k < 2; ++k) dst[m][k] = *(const PG8_LAS bf16x8*)(lds + PG8_SA(b, h) + aoff + m * 2048 + k * 1024); } } while (0)
#define PG8_LDB(dst, b, h) do { if constexpr (FP8) { _Pragma("unroll") for (int n = 0; n < 2; ++n) dst##8[n] = PG8_LD8(lds + PG8_SB(b, h) + boff + n * 2048); } \
        else { _Pragma("unroll") for (int n = 0; n < 2; ++n) _Pragma("unroll") for (int k = 0; k < 2; ++k) dst[n][k] = *(const PG8_LAS bf16x8*)(lds + PG8_SB(b, h) + boff + n * 2048 + k * 1024); } } while (0)
#define PG8_MMA(ai, bj, At, Bt) do { __builtin_amdgcn_s_setprio(1); \
        if constexpr (FP8) { _Pragma("unroll") for (int m = 0; m < 4; ++m) _Pragma("unroll") for (int n = 0; n < 2; ++n) \
            asm volatile("v_mfma_scale_f32_16x16x128_f8f6f4 %0, %1, %2, %0, %3, %4 op_sel_hi:[0,0,0]" : "+v"(acc[ai][bj][m][n]) : "v"(Bt##8[n]), "v"(At##8[m]), "v"(sc_w), "v"(sc_x)); } \
        else { _Pragma("unroll") for (int m = 0; m < 4; ++m) _Pragma("unroll") for (int n = 0; n < 2; ++n) _Pragma("unroll") for (int k = 0; k < 2; ++k) \
            acc[ai][bj][m][n] = __builtin_amdgcn_mfma_f32_16x16x32_bf16(Bt[n][k], At[m][k], acc[ai][bj][m][n], 0, 0, 0); } \
        __builtin_amdgcn_s_setprio(0); } while (0)
#define PG8_WAIT_V(n) asm volatile("s_waitcnt vmcnt(" #n ")" ::: "memory")
#define PG8_WAIT_L(n) asm volatile("s_waitcnt lgkmcnt(" #n ")" ::: "memory")
#define PG8_BAR __builtin_amdgcn_s_barrier()
#define PG8_SCHED __builtin_amdgcn_sched_barrier(0)
    Unit cur, nxt; int ui = 0;
    if (!S.next(0, cur)) return;
    f32x4 acc[2][2][4][2];
#pragma unroll
    for (int a = 0; a < 2; ++a)
#pragma unroll
        for (int b = 0; b < 2; ++b)
#pragma unroll
            for (int m = 0; m < 4; ++m)
#pragma unroll
                for (int n = 0; n < 2; ++n) acc[a][b][m][n] = (f32x4){0.f, 0.f, 0.f, 0.f};
    bf16x8 At[4][2], B0[2][2], B1[2][2]; i32x8 At8[4], B08[2], B18[2];
    const int sc_w = 0x79797979, sc_x = 0x7f7f7f7f;
    const char* cA = (const char*)g.A + (size_t)cur.pm * tstep; const char* cB = (const char*)g.Bt + (size_t)cur.pb * tstep;
    unsigned cO[2][2] = {{0u, 0u}, {0u, 0u}}, nO[2][2] = {{0u, 0u}, {0u, 0u}};
    S.a_ready(cur);
    if constexpr (GATHER) { static_assert(SP2, "GATHER needs the SP2 loop"); PG8_LOADMAP(cur, cO); }
    if constexpr (SP2) {
        PG8_STAGE(PG8_SB(0, 0), cB, voffB); PG8_STAGE(PG8_SB(0, 1), cB + hstep, voffB);
        if constexpr (GATHER) { PG8_STAGE_G(PG8_SA(0, 0), 0, cO[0][0], cO[0][1]); PG8_STAGE_G(PG8_SA(0, 1), 0, cO[1][0], cO[1][1]); }
        else { PG8_STAGE(PG8_SA(0, 0), cA, voffA); PG8_STAGE(PG8_SA(0, 1), cA + hstep, voffA); }
        if (wr == 1) PG8_BAR;
        PG8_WAIT_V(2); PG8_BAR;
        PG8_STAGE(PG8_SB(1, 0), cB + kstep, voffB);
        if constexpr (GATHER) PG8_STAGE_G(PG8_SA(1, 0), kstep, cO[0][0], cO[0][1]); else PG8_STAGE(PG8_SA(1, 0), cA + kstep, voffA);
        PG8_STAGE(PG8_SB(1, 1), cB + hstep + kstep, voffB);
        PG8_WAIT_V(6); PG8_BAR;
    } else {
        PG8_STAGE(PG8_SB(0, 0), cB, voffB); PG8_STAGE(PG8_SA(0, 0), cA, voffA); PG8_STAGE(PG8_SB(0, 1), cB + hstep, voffB); PG8_STAGE(PG8_SA(0, 1), cA + hstep, voffA);
        if (wr == 1) PG8_BAR;
        PG8_WAIT_V(4); PG8_BAR;
        PG8_STAGE(PG8_SB(1, 0), cB + kstep, voffB); PG8_STAGE(PG8_SA(1, 0), cA + kstep, voffA); PG8_STAGE(PG8_SB(1, 1), cB + hstep + kstep, voffB);
        PG8_WAIT_V(6); PG8_BAR;
    }
    for (;;) {
        const bool has_next = S.next(ui + 1, nxt);
        const char* nA = has_next ? (const char*)g.A + (size_t)nxt.pm * tstep : cA; const char* nB = has_next ? (const char*)g.Bt + (size_t)nxt.pb * tstep : cB;
        if constexpr (GATHER) { if (has_next) PG8_LOADMAP(nxt, nO); else {
#pragma unroll
            for (int _h = 0; _h < 2; ++_h) { nO[_h][0] = cO[_h][0]; nO[_h][1] = cO[_h][1]; } } }
#pragma unroll 1
        for (int t = 0; t < nt; t += 2) {
            const bool last = (t == nt - 2);
            const char* a1 = cA + (size_t)(t + 1) * kstep;
            const char* a2 = last ? nA : cA + (size_t)(t + 2) * kstep; const char* b2 = last ? nB : cB + (size_t)(t + 2) * kstep;
            const char* a3 = a2 + kstep; const char* b3 = b2 + kstep;
            if (last && has_next) S.a_ready(nxt);
            if constexpr (SP2) {
            const size_t k1 = (size_t)(t + 1) * kstep, k2 = last ? (size_t)0 : (size_t)(t + 2) * kstep, k3 = k2 + kstep;
            const unsigned g00 = last ? nO[0][0] : cO[0][0], g01 = last ? nO[0][1] : cO[0][1], g10 = last ? nO[1][0] : cO[1][0], g11 = last ? nO[1][1] : cO[1][1];
            PG8_LDB(B0, 0, 0); PG8_LDB(B1, 0, 1); PG8_SCHED; PG8_LDA(At, 0, 0);
            if constexpr (GATHER) PG8_STAGE_G(PG8_SA(1, 1), k1, cO[1][0], cO[1][1]); else PG8_STAGE(PG8_SA(1, 1), a1 + hstep, voffA);
            PG8_WAIT_V(8); PG8_WAIT_L(0); PG8_BAR; PG8_MMA(0, 0, At, B0); PG8_MMA(0, 1, At, B1); PG8_BAR; PG8_SCHED;
            PG8_LDA(At, 0, 1); PG8_STAGE(PG8_SB(0, 0), b2, voffB); PG8_STAGE(PG8_SB(0, 1), b2 + hstep, voffB);
            if constexpr (GATHER) PG8_STAGE_G(PG8_SA(0, 0), k2, g00, g01); else PG8_STAGE(PG8_SA(0, 0), a2, voffA);
            PG8_WAIT_V(8); PG8_WAIT_L(0); PG8_BAR; PG8_MMA(1, 0, At, B0); PG8_MMA(1, 1, At, B1); PG8_BAR; PG8_SCHED;
            PG8_LDB(B0, 1, 0); PG8_LDB(B1, 1, 1); PG8_SCHED; PG8_LDA(At, 1, 0);
            if constexpr (GATHER) PG8_STAGE_G(PG8_SA(0, 1), k2, g10, g11); else PG8_STAGE(PG8_SA(0, 1), a2 + hstep, voffA);
            PG8_WAIT_V(8); PG8_WAIT_L(0); PG8_BAR; PG8_MMA(0, 0, At, B0); PG8_MMA(0, 1, At, B1); PG8_BAR; PG8_SCHED;
            PG8_LDA(At, 1, 1); PG8_STAGE(PG8_SB(1, 0), b3, voffB); PG8_STAGE(PG8_SB(1, 1), b3 + hstep, voffB);
            if constexpr (GATHER) PG8_STAGE_G(PG8_SA(1, 0), k3, g00, g01); else PG8_STAGE(PG8_SA(1, 0), a3, voffA);
            PG8_WAIT_V(8); PG8_WAIT_L(0); PG8_BAR; PG8_MMA(1, 0, At, B0); PG8_MMA(1, 1, At, B1); PG8_BAR; PG8_SCHED;
            } else {
            PG8_LDB(B0, 0, 0); PG8_SCHED; PG8_LDA(At, 0, 0); PG8_STAGE(PG8_SA(1, 1), a1 + hstep, voffA);
            PG8_WAIT_L(8); PG8_BAR; PG8_WAIT_L(0); PG8_MMA(0, 0, At, B0); PG8_BAR; PG8_SCHED;
            PG8_LDB(B1, 0, 1); PG8_STAGE(PG8_SB(0, 0), b2, voffB);
            PG8_BAR; PG8_WAIT_L(0); PG8_MMA(0, 1, At, B1); PG8_BAR;
            PG8_LDA(At, 0, 1); PG8_STAGE(PG8_SA(0, 0), a2, voffA);
            PG8_BAR; PG8_WAIT_L(0); PG8_MMA(1, 0, At, B0); PG8_BAR; PG8_SCHED;
            PG8_STAGE(PG8_SB(0, 1), b2 + hstep, voffB);
            PG8_WAIT_V(6); PG8_BAR; PG8_MMA(1, 1, At, B1); PG8_BAR;
            PG8_LDB(B0, 1, 0); PG8_SCHED; PG8_LDA(At, 1, 0); PG8_STAGE(PG8_SA(0, 1), a2 + hstep, voffA);
            PG8_WAIT_L(8); PG8_BAR; PG8_WAIT_L(0); PG8_MMA(0, 0, At, B0); PG8_BAR; PG8_SCHED;
            PG8_LDB(B1, 1, 1); PG8_STAGE(PG8_SB(1, 0), b3, voffB);
            PG8_BAR; PG8_WAIT_L(0); PG8_MMA(0, 1, At, B1); PG8_BAR;
            PG8_LDA(At, 1, 1); PG8_STAGE(PG8_SA(1, 0), a3, voffA);
            PG8_BAR; PG8_WAIT_L(0); PG8_MMA(1, 0, At, B0); PG8_BAR; PG8_SCHED;
            PG8_STAGE(PG8_SB(1, 1), b3 + hstep, voffB);
            PG8_WAIT_V(6); PG8_BAR; PG8_MMA(1, 1, At, B1); PG8_BAR;
            }
        }
        if constexpr (ALIGN_EPI) { if (wr == 0) PG8_BAR; }
        if constexpr (FP8) asm volatile("s_nop 15\n\ts_nop 15" ::: "memory");
        E(acc, cur, wr, wc, fr, fq); S.done(cur);
        if (!has_next) break;
#pragma unroll
        for (int a = 0; a < 2; ++a)
#pragma unroll
            for (int b = 0; b < 2; ++b)
#pragma unroll
                for (int m = 0; m < 4; ++m)
#pragma unroll
                    for (int n = 0; n < 2; ++n) acc[a][b][m][n] = (f32x4){0.f, 0.f, 0.f, 0.f};
        cur = nxt; cA = nA; cB = nB; ++ui;
        if constexpr (GATHER) {
#pragma unroll
            for (int _h = 0; _h < 2; ++_h) { cO[_h][0] = nO[_h][0]; cO[_h][1] = nO[_h][1]; } }
        if constexpr (ALIGN_EPI) { if (wr == 1) PG8_BAR; }
    }
    PG8_WAIT_V(0);
    if constexpr (!ALIGN_EPI) { if (wr == 0) PG8_BAR; }
    PG8_BAR;
#undef PG8_SA
#undef PG8_SB
#undef PG8_STAGE
#undef PG8_STAGE_G
#undef PG8_LOADMAP
#undef PG8_LDA
#undef PG8_LDB
#undef PG8_MMA
#undef PG8_LD8
#undef PG8_WAIT_V
#undef PG8_WAIT_L
#undef PG8_BAR
#undef PG8_SCHED
}
}

#define XB_TMO      128
#define XB_XCNT(j)  (256  + 64 * (j))
#define XB_XSUB(j)  (1280 + 64 * (j))
#define XB_XGEN(j)  (2304 + 64 * (j))
#define XB_TOP      3328
#define XB_TOPGEN   3392
#define XCD_BAR_WORDS 3456
#define XB_SPIN_CAP (1u << 18)
__device__ __forceinline__ unsigned xb_ld(unsigned* p)              { return __hip_atomic_load(p, __ATOMIC_RELAXED, __HIP_MEMORY_SCOPE_AGENT); }
__device__ __forceinline__ unsigned xb_add(unsigned* p, unsigned v) { return __hip_atomic_fetch_add(p, v, __ATOMIC_RELAXED, __HIP_MEMORY_SCOPE_AGENT); }
__device__ __forceinline__ unsigned xb_xcc_id() { return (unsigned)__builtin_amdgcn_s_getreg((3 << 11) | 20) & 0xFu; }
#define XB_SPIN(cond, bar) do { unsigned _sp = 0; while (cond) { __builtin_amdgcn_s_sleep(1); \
    if ((++_sp & 255u) == 0u) { if (xb_ld(&(bar)[XB_TMO])) break; if (_sp > XB_SPIN_CAP) { atomicAdd(&(bar)[XB_TMO], 1u); break; } } } } while (0)
struct XcdBarrier { unsigned* bar; unsigned x; volatile LAS unsigned* st; };
__device__ __forceinline__ XcdBarrier xcd_barrier_post(unsigned* bar, volatile LAS unsigned* st) {
    XcdBarrier b; b.bar = bar; b.x = xb_xcc_id(); b.st = st;
    if (threadIdx.x == 0) (void)xb_add(&bar[XB_XCNT(b.x)], 1u);
    return b;
}
__device__ __forceinline__ void xcd_barrier_complete(unsigned* bar, unsigned x, unsigned& nloc, unsigned& nx) {
    const unsigned G = gridDim.x * gridDim.y * gridDim.z;
    unsigned sum, cnt, mine, sp = 0u;
    for (;;) {
        sum = 0u; cnt = 0u; mine = 0u;
#pragma unroll
        for (unsigned j = 0; j < 16; ++j) { const unsigned c = xb_ld(&bar[XB_XCNT(j)]); sum += c; cnt += (c > 0u) ? 1u : 0u; mine = (j == x) ? c : mine; }
        if (sum == G) break;
        __builtin_amdgcn_s_sleep(1);
        if ((++sp & 255u) == 0u) { if (xb_ld(&bar[XB_TMO])) break; if (sp > XB_SPIN_CAP) { atomicAdd(&bar[XB_TMO], 1u); break; } }
    }
    nloc = mine > 0u ? mine : 1u; nx = cnt > 0u ? cnt : 1u;
}
__device__ __forceinline__ void xcd_barrier(const XcdBarrier& b) {
    asm volatile("s_waitcnt vmcnt(0)" ::: "memory");
    __syncthreads();
    if (threadIdx.x == 0) {
        unsigned* bar = b.bar;
        __builtin_amdgcn_s_waitcnt(0);
        unsigned nloc = b.st[0], nx = b.st[1];
        if (nloc == 0u) { xcd_barrier_complete(bar, b.x, nloc, nx); b.st[0] = nloc; b.st[1] = nx; }
        const unsigned old = xb_add(&bar[XB_XSUB(b.x)], 1u);
        const unsigned gen = old / nloc;
        if (old + 1u == (gen + 1u) * nloc) {
            __builtin_amdgcn_fence(__ATOMIC_RELEASE, "agent");
            asm volatile("s_waitcnt vmcnt(0)" ::: "memory");
            const unsigned og = xb_add(&bar[XB_TOP], 1u);
            const unsigned tg = og / nx;
            if (og + 1u == (tg + 1u) * nx) xb_add(&bar[XB_TOPGEN], 1u);
            else XB_SPIN(xb_ld(&bar[XB_TOPGEN]) == tg, bar);
            __builtin_amdgcn_fence(__ATOMIC_ACQUIRE, "agent");
            xb_add(&bar[XB_XGEN(b.x)], 1u);
            asm volatile("s_waitcnt vmcnt(0)" ::: "memory");
        } else {
            XB_SPIN(xb_ld(&bar[XB_XGEN(b.x)]) == gen, bar);
            __builtin_amdgcn_fence(__ATOMIC_ACQUIRE, "agent");
            asm volatile("s_waitcnt vmcnt(0)" ::: "memory");
        }
    }
    __syncthreads();
}

struct Args { const float* in[35]; float* out; unsigned char* ws; int ph_lo, ph_hi; };
enum { I_X = 0, I_C, I_CTX, I_CCTX, I_WADA, I_BADA, I_WIN, I_WOUT, I_MNG, I_POOLW, I_POOLS, I_SINK, I_HCW, I_HCB, I_HW1, I_HB1, I_HF1, I_HW2, I_HB2, I_HF2, I_HW3, I_HSKIP,
       I_GLG, I_GLB, I_GWS, I_GBS, I_LN1G, I_LN1B, I_LN2G, I_LN2B, I_WR, I_RB, I_WG, I_WU, I_WD };
struct Ctx {
    LAS unsigned char* lds; int tid, lane, wave, bid, G;
    const float GAS* const __attribute__((address_space(4)))* in; float GAS* out; unsigned char GAS* ws;
};
#define WSP(T, off) ((T*)(T GAS*)(C.ws + (off)))
#define INP(k) ((const float*)C.in[k])
#define FRESH(D, S) Ctx D = S; asm volatile("" : "+v"(D.tid)); D.lane = D.tid & 63; D.wave = __builtin_amdgcn_readfirstlane(D.tid >> 6); asm volatile("" : "+s"(D.bid), "+s"(D.G), "+s"(D.in), "+s"(D.ws), "+s"(D.out))

struct TrBlk { const float GAS* src; unsigned char GAS* dst; int N, K, nb, which; bool gu; };
constexpr int TRP = 144, TRBUF = 256 * TRP;
#define WG_BAR() do { LDS_WAIT(); __builtin_amdgcn_s_barrier(); asm volatile("" ::: "memory"); } while (0)
constexpr int NBL = 4976, NBP = 368;
__device__ __forceinline__ TrBlk tr_decode(Ctx& C, int L, int j) {
    const bool c0 = j < 240, c1 = !c0 && j < NBP, ce = !c0 && !c1;
    const int q = j - (c0 ? 0 : (c1 ? 240 : NBP));
    const int e = ce ? q / 144 : 0, r = ce ? q % 144 : q;
    const int which = ce ? r / 48 : 0, r2 = ce ? r % 48 : r;
    const bool gu = ce && which < 2, dn = ce && which == 2;
    const int NB = c0 ? 15 : (gu ? 3 : 8), nb = r2 % NB, kb = r2 / NB;
    const int N = c0 ? INW : (gu ? DE : DM), K = dn ? DE : DM;
    const int mat = ce ? L * NE + e : L;
    const float GAS* base = c0 ? C.in[I_WIN] : (c1 ? C.in[I_WOUT] : (which == 0 ? C.in[I_WG] : (which == 1 ? C.in[I_WU] : C.in[I_WD])));
    const size_t wsoff = c0 ? WS_WIN : (c1 ? WS_WOUT : (gu ? WS_WGU : WS_WD));
    const int nrows = c0 ? INW : (gu ? 1536 : DM);
    TrBlk t; t.N = N; t.K = K; t.nb = nb; t.which = which; t.gu = gu;
    t.src = base + (size_t)mat * K * N + (size_t)(128 * kb) * N + 256 * nb;
    t.dst = C.ws + wsoff + (size_t)mat * nrows * K + 128 * kb;
    return t;
}
__device__ __forceinline__ void tr_load(const TrBlk& t, int wave, int lane, f32x4 (&v)[16]) {
#pragma unroll
    for (int i = 0; i < 16; ++i) v[i] = __builtin_nontemporal_load((const f32x4 GAS*)((const char GAS*)t.src + (size_t)(16 * wave + i) * t.N * 4 + 16u * lane));
}
__device__ __forceinline__ void tr_pack(LAS unsigned char* buf, int wave, int lane, const f32x4 (&v)[16]) {
#pragma unroll
    for (int j = 0; j < 4; ++j) { u32x4 o;
#pragma unroll
        for (int w = 0; w < 4; ++w) o[w] = pk4_fp8(64.f * v[4 * w][j], 64.f * v[4 * w + 1][j], 64.f * v[4 * w + 2][j], 64.f * v[4 * w + 3][j]);
        *(LAS u32x4*)(buf + (4 * lane + j) * TRP + 16 * wave) = o; }
}
__device__ __forceinline__ void tr_flush(const TrBlk& t, const LAS unsigned char* buf, int wave, int lane) {
#pragma unroll
    for (int tt = 0; tt < 4; ++tt) { const int nl = 32 * wave + 8 * tt + (lane >> 3), n = 256 * t.nb + nl;
        const u32x4 o = *(const LAS u32x4*)(buf + nl * TRP + 16 * (lane & 7));
        const int drow = t.gu ? ((n >> 7) * 256 + (n & 127) + 128 * t.which) : n;
        *(u32x4 GAS*)(t.dst + (size_t)drow * t.K + 16 * (lane & 7)) = o; }
}
template <int NBK> __device__ __forceinline__ void tr_blocks(Ctx& C, int L, int b0) {
    f32x4 r0[16], r1[16], r2[16];
    LAS unsigned char* buf0 = C.lds; LAS unsigned char* buf1 = C.lds + TRBUF;
    const TrBlk t0 = tr_decode(C, L, b0), t1 = tr_decode(C, L, b0 + (NBK > 1 ? 1 : 0)), t2 = tr_decode(C, L, b0 + (NBK > 2 ? 2 : 0)), t3 = tr_decode(C, L, b0 + (NBK > 3 ? 3 : 0));
    tr_load(t0, C.wave, C.lane, r0); if (NBK > 1) tr_load(t1, C.wave, C.lane, r1); if (NBK > 2) tr_load(t2, C.wave, C.lane, r2);
    WG_BAR();
    tr_pack(buf0, C.wave, C.lane, r0);
    if (NBK > 3) tr_load(t3, C.wave, C.lane, r0);
    WG_BAR(); tr_flush(t0, buf0, C.wave, C.lane);
    if (NBK > 1) { tr_pack(buf1, C.wave, C.lane, r1); WG_BAR(); tr_flush(t1, buf1, C.wave, C.lane); }
    if (NBK > 2) { tr_pack(buf0, C.wave, C.lane, r2); WG_BAR(); tr_flush(t2, buf0, C.wave, C.lane); }
    if (NBK > 3) { tr_pack(buf1, C.wave, C.lane, r0); WG_BAR(); tr_flush(t3, buf1, C.wave, C.lane); }
}
__device__ __forceinline__ void p0_convert(Ctx& C, int L, int nblocks) {
#pragma unroll 1
    for (int j = C.bid; j < nblocks; j += C.G) tr_blocks<1>(C, L, j);
    __syncthreads();
}
#ifndef UB
#define UB 2
#endif
constexpr int NCU = NBL / UB;
#ifndef TAILQ
#define TAILQ (224 * 4 / UB)
#endif
#ifndef CONV_SPLIT
#define CONV_SPLIT 0
#endif
__device__ __forceinline__ void conv_unit(Ctx& C, int L, int b0) { tr_blocks<UB>(C, L, b0); }
constexpr int NCU_E = (NBL - NBP) / UB, NCU_P = NBP / UB;
__device__ __forceinline__ void bg_conv_unit(Ctx& C, int l, int cu) {
    const bool e = cu < NCU_E; conv_unit(C, e ? l : 1, e ? NBP + cu * UB : (cu - NCU_E) * UB);
}
__device__ __forceinline__ void p0_adaln(Ctx& C) {
    LAS float* sc = (LAS float*)C.lds;
    LAS float* red = (LAS float*)(C.lds + 40960);
    float* MOD = WSP(float, WS_MOD);
    for (int u = C.bid; u < 256; u += C.G) {
        const int l = u >> 7, colbase = (u & 127) * 96;
        __syncthreads();
        for (int i = C.tid; i < 5 * DM; i += 512) { const int r = i >> 11, k = i & 2047; const float v = r < 4 ? INP(I_C)[r * DM + k] : INP(I_CCTX)[k]; sc[i] = silu_f(v); }
        __syncthreads();
        float acc[5][2];
#pragma unroll
        for (int r = 0; r < 5; ++r) { acc[r][0] = 0.f; acc[r][1] = 0.f; }
        const int ln = C.lane < 48 ? C.lane : 47;
        const float* wp = INP(I_WADA) + ((size_t)l * DM + C.wave * 256) * 12288 + colbase + 2 * ln;
#pragma unroll 1
        for (int k0 = 0; k0 < 256; k0 += 16) { f32x2 wv[16];
#pragma unroll
            for (int k = 0; k < 16; ++k) wv[k] = *(const f32x2*)(wp + (size_t)(k0 + k) * 12288);
#pragma unroll
            for (int k = 0; k < 16; ++k)
#pragma unroll
                for (int r = 0; r < 5; ++r) { const float s = sc[r * DM + C.wave * 256 + k0 + k]; acc[r][0] += s * wv[k].x; acc[r][1] += s * wv[k].y; } }
        if (C.lane < 48) {
#pragma unroll
            for (int r = 0; r < 5; ++r) { red[(C.wave * 5 + r) * 96 + 2 * C.lane] = acc[r][0]; red[(C.wave * 5 + r) * 96 + 2 * C.lane + 1] = acc[r][1]; } }
        __syncthreads();
        for (int i = C.tid; i < 480; i += 512) { const int r = i / 96, cc = i % 96; float s = INP(I_BADA)[l * 12288 + colbase + cc];
#pragma unroll
            for (int w = 0; w < 8; ++w) s += red[(w * 5 + r) * 96 + cc];
            MOD[(size_t)(l * 5 + r) * 12288 + colbase + cc] = s; }
    }
    __syncthreads();
}
__device__ __forceinline__ void p0_filters(Ctx& C) {
    LAS float* feat = (LAS float*)C.lds;
    LAS float* h1 = (LAS float*)(C.lds + 4096);
    LAS float* h2 = (LAS float*)(C.lds + 8192);
    for (int u2 = C.bid; u2 < 528 + 0 * C.G; u2 += C.G) {
        const int u = 2 * (u2 % 264) + (u2 / 264);
        int l, L, tb; bf16* dst;
        if (u < 512) { l = u >> 8; tb = u & 255; L = SL; dst = WSP(bf16, WS_FILT) + (size_t)l * 2 * 512 * 8192; }
        else { l = 0; tb = u - 512; L = CL; dst = WSP(bf16, WS_FILTC); }
        const float invLm1 = 1.0f / (float)(L - 1);
        __syncthreads();
        LAS float* w1s = (LAS float*)(C.lds + 12288);
        LAS float* w2s = (LAS float*)(C.lds + 12288 + 33 * 64 * 4);
        for (int i = C.tid; i < 33 * 64; i += 512) w1s[i] = INP(I_HW1)[l * 33 * 64 + i];
        for (int i = C.tid; i < 64 * 64; i += 512) w2s[i] = INP(I_HW2)[l * 64 * 64 + i];
        for (int i = C.tid; i < 16 * 33; i += 512) { const int p = i / 33, j = i % 33; const int t = 16 * tb + p; float v;
            if (j == 0) v = (float)t * invLm1;
            else { const int fi = (j - 1) & 15; const float fr = 1e-4f + (float)fi * ((15.0f - 1e-4f) / 15.0f); const float ang = (6.283185307179586f / (float)L) * (float)t * fr; v = (j <= 16) ? cosf(ang) : -sinf(ang); }
            feat[i] = v; }
        __syncthreads();
        for (int i = C.tid; i < 1024; i += 512) { const int p = i >> 6, hh = i & 63; float s = INP(I_HB1)[l * 64 + hh];
#pragma unroll
            for (int j = 0; j < 33; ++j) s += feat[p * 33 + j] * w1s[j * 64 + hh];
            h1[i] = sinf(INP(I_HF1)[l * 64 + hh] * s); }
        __syncthreads();
        for (int i = C.tid; i < 1024; i += 512) { const int p = i >> 6, hh = i & 63; float s = INP(I_HB2)[l * 64 + hh];
#pragma unroll 16
            for (int j = 0; j < 64; ++j) s += h1[p * 64 + j] * w2s[j * 64 + hh];
            h2[i] = sinf(INP(I_HF2)[l * 64 + hh] * s); }
        __syncthreads();
        float acc[16][4];
#pragma unroll
        for (int p = 0; p < 16; ++p) { acc[p][0] = 0.f; acc[p][1] = 0.f; acc[p][2] = 0.f; acc[p][3] = 0.f; }
#pragma unroll 4
        for (int k = 0; k < 64; ++k) { const f32x4 w = *(const f32x4*)(INP(I_HW3) + (size_t)(l * 64 + k) * 2048 + 4 * C.tid);
#pragma unroll
            for (int p = 0; p < 16; ++p) { const float h = h2[p * 64 + k]; acc[p][0] += h * w[0]; acc[p][1] += h * w[1]; acc[p][2] += h * w[2]; acc[p][3] += h * w[3]; } }
#pragma unroll
        for (int j = 0; j < 4; ++j) { const int col = 4 * C.tid + j, o = col >> 10, dir = (col >> 9) & 1, c = col & 511;
            const float delta = 4.605170186f * (1.0f / 1.5f + (float)c * ((1.0f / 0.3f - 1.0f / 1.5f) / 511.0f));
            bf16* d = dst + (size_t)(o * 512 + c) * (2 * L);
            float val[16];
#pragma unroll
            for (int p = 0; p < 16; ++p) { const int t = 16 * tb + p; val[p] = acc[p][j] * __expf(-(float)t * invLm1 * delta); }
            if (dir == 0) {
                u32x4 w0, w1; w0.x = pk2(val[15], val[14]); w0.y = pk2(val[13], val[12]); w0.z = pk2(val[11], val[10]); w0.w = pk2(val[9], val[8]);
                w1.x = pk2(val[7], val[6]); w1.y = pk2(val[5], val[4]); w1.z = pk2(val[3], val[2]); w1.w = pk2(val[1], val[0]);
                u32x4* q = (u32x4*)(d + L - 16 * (tb + 1)); q[0] = w0; q[1] = w1;
            } else if (tb == 0) {
#pragma unroll
                for (int p = 1; p < 16; ++p) d[L - 1 + p] = (bf16)(pk2(val[p], 0.f) & 0xffffu);
            } else {
                typedef u32x4 __attribute__((aligned(2))) u32x4_u;
                u32x4 w0, w1; w0.x = pk2(val[0], val[1]); w0.y = pk2(val[2], val[3]); w0.z = pk2(val[4], val[5]); w0.w = pk2(val[6], val[7]);
                w1.x = pk2(val[8], val[9]); w1.y = pk2(val[10], val[11]); w1.z = pk2(val[12], val[13]); w1.w = pk2(val[14], val[15]);
                u32x4_u* q = (u32x4_u*)(d + L - 1 + 16 * tb); q[0] = w0; q[1] = w1;
            }
            if (dir == 1 && 16 * (tb + 1) == L) d[2 * L - 1] = 0; }
    }
    __syncthreads();
}
__device__ __forceinline__ void p0_rope(Ctx& C) {
    { const int idx = C.bid * 512 + C.tid;
      for (int e = idx; e < 131072; e += C.G * 512) { const f32x2 v = *(const f32x2*)(INP(I_GWS) + 2 * (size_t)e); WSP(unsigned, WS_GWSB)[e] = pk2(v.x, v.y); } }
    { const int idx = C.bid * 512 + C.tid;
      for (int e = idx; e < 131072; e += C.G * 512) { const int i = e & 127, j = (e >> 7) & 127, lg = e >> 14, l = lg >> 2, gi = lg & 3;
          const float v = INP(I_POOLW)[(size_t)lg * 16384 + i * 128 + j] * INP(I_POOLS)[l * 512 + 128 * gi + j];
          WSP(bf16, WS_POOLWT)[e] = (bf16)(pk2(v, 0.f) & 0xffffu); } }
    if (C.bid == (C.G > 200 ? 200 : 0)) { f32x2* R = WSP(f32x2, WS_ROPE);
        for (int i = C.tid; i < 1024; i += 512) { const int pos = i >> 4, fi = i & 15; const float inv = powf(10000.0f, -(float)fi / 16.0f); const float a = (float)pos * inv; R[i] = (f32x2){cosf(a), sinf(a)}; } }
}

__device__ __forceinline__ const float* src_x0(Ctx& C, int row) {
    return row < NLAT ? INP(I_X) + (size_t)row * DM : INP(I_CTX) + (size_t)(row - NLAT) * DM;
}
__device__ __forceinline__ void row_load(const float* p, int lane, float (&v)[32]) {
#pragma unroll
    for (int j = 0; j < 4; ++j) { const f32x4 a = *(const f32x4*)(p + 512 * j + 8 * lane), b = *(const f32x4*)(p + 512 * j + 8 * lane + 4);
        v[8 * j] = a[0]; v[8 * j + 1] = a[1]; v[8 * j + 2] = a[2]; v[8 * j + 3] = a[3]; v[8 * j + 4] = b[0]; v[8 * j + 5] = b[1]; v[8 * j + 6] = b[2]; v[8 * j + 7] = b[3]; }
}
__device__ __forceinline__ void row_load_bf16(const bf16* p, int lane, float (&v)[32]) {
#pragma unroll
    for (int j = 0; j < 4; ++j) { const u32x4 r = *(const u32x4*)(p + 512 * j + 8 * lane);
        v[8 * j] = __uint_as_float(r.x << 16); v[8 * j + 1] = __uint_as_float(r.x & 0xffff0000u); v[8 * j + 2] = __uint_as_float(r.y << 16); v[8 * j + 3] = __uint_as_float(r.y & 0xffff0000u);
        v[8 * j + 4] = __uint_as_float(r.z << 16); v[8 * j + 5] = __uint_as_float(r.z & 0xffff0000u); v[8 * j + 6] = __uint_as_float(r.w << 16); v[8 * j + 7] = __uint_as_float(r.w & 0xffff0000u); }
}
__device__ __forceinline__ void row_store(float* p, int lane, const float (&v)[32]) {
#pragma unroll
    for (int j = 0; j < 4; ++j) { *(f32x4*)(p + 512 * j + 8 * lane) = (f32x4){v[8 * j], v[8 * j + 1], v[8 * j + 2], v[8 * j + 3]}; *(f32x4*)(p + 512 * j + 8 * lane + 4) = (f32x4){v[8 * j + 4], v[8 * j + 5], v[8 * j + 6], v[8 * j + 7]}; }
}
__device__ __forceinline__ void row_store_bf16(bf16* p, int lane, const float (&v)[32]) {
#pragma unroll
    for (int j = 0; j < 4; ++j) { u32x4 w; w.x = pk2(v[8 * j], v[8 * j + 1]); w.y = pk2(v[8 * j + 2], v[8 * j + 3]); w.z = pk2(v[8 * j + 4], v[8 * j + 5]); w.w = pk2(v[8 * j + 6], v[8 * j + 7]); *(u32x4*)(p + 512 * j + 8 * lane) = w; }
}
__device__ __forceinline__ void row_store_fp8(unsigned char* p, int lane, const float (&v)[32]) {
#pragma unroll
    for (int j = 0; j < 4; ++j) { u32x2 w; w.x = pk4_fp8(v[8 * j], v[8 * j + 1], v[8 * j + 2], v[8 * j + 3]); w.y = pk4_fp8(v[8 * j + 4], v[8 * j + 5], v[8 * j + 6], v[8 * j + 7]); *(u32x2*)(p + 512 * j + 8 * lane) = w; }
}
__device__ __forceinline__ void row_ln(float (&v)[32]) {
    float s = 0.f;
#pragma unroll
    for (int i = 0; i < 32; ++i) s += v[i];
    const float mean = wave_sum(s) * (1.0f / DM); float q = 0.f;
#pragma unroll
    for (int i = 0; i < 32; ++i) { v[i] -= mean; q += v[i] * v[i]; }
    const float rstd = 1.0f / sqrtf(wave_sum(q) * (1.0f / DM) + LN_EPS);
#pragma unroll
    for (int i = 0; i < 32; ++i) v[i] *= rstd;
}
__device__ __forceinline__ void row_affine(float (&v)[32], const float* mul, const float* add, int lane, float mul_off) {
    float a[32], b[32]; row_load(mul, lane, a); row_load(add, lane, b);
#pragma unroll
    for (int i = 0; i < 32; ++i) v[i] = v[i] * (a[i] + mul_off) + b[i];
}
__device__ __forceinline__ void row_load_lds(const LAS float* p, int lane, float (&v)[32]) {
#pragma unroll
    for (int j = 0; j < 4; ++j) { const f32x4 a = *(const LAS f32x4*)(p + 512 * j + 8 * lane), b = *(const LAS f32x4*)(p + 512 * j + 8 * lane + 4);
        v[8 * j] = a[0]; v[8 * j + 1] = a[1]; v[8 * j + 2] = a[2]; v[8 * j + 3] = a[3]; v[8 * j + 4] = b[0]; v[8 * j + 5] = b[1]; v[8 * j + 6] = b[2]; v[8 * j + 7] = b[3]; }
}
__device__ __forceinline__ void row_affine_lds(float (&v)[32], const LAS float* mul, const LAS float* add, int lane, float mul_off) {
    float a[32], b[32]; row_load_lds(mul, lane, a); row_load_lds(add, lane, b);
#pragma unroll
    for (int i = 0; i < 32; ++i) v[i] = v[i] * (a[i] + mul_off) + b[i];
}
__device__ __forceinline__ void stage2048(Ctx& C, LAS float* dst, const float* src) { *(LAS f32x4*)(dst + 4 * C.tid) = *(const f32x4*)(src + 4 * C.tid); }
__device__ __forceinline__ void ph_ln_mod(Ctx& C, int l, int nrows) {
    LAS float* PAR = (LAS float*)C.lds;
    const int r0 = (int)(((long)C.bid * nrows) / C.G), r1 = (int)(((long)(C.bid + 1) * nrows) / C.G);
    int cur_mrow = -1;
    for (int rb = r0 & ~7; rb < r1; rb += 8) {
        const int mrow = rb < NLAT ? rb / SL : 4; const float* mod = WSP(float, WS_MOD) + (size_t)(l * 5 + mrow) * 12288;
        if (mrow != cur_mrow) { __syncthreads(); stage2048(C, PAR, mod + 2048); stage2048(C, PAR + 2048, mod); cur_mrow = mrow; __syncthreads(); }
        const int row = rb + C.wave;
        if (row >= r0 && row < r1) {
            float v[32]; row_load(src_x0(C, row), C.lane, v); row_ln(v); row_affine_lds(v, PAR, PAR + 2048, C.lane, 1.0f);
            if (FP8_IN) row_store_fp8(WSP(unsigned char, WS_HA8) + (size_t)row * DM, C.lane, v); else row_store_bf16(WSP(bf16, WS_HB) + (size_t)row * DM, C.lane, v);
        }
    }
    __syncthreads();
}

__device__ __forceinline__ void cvt8(const u32x4 r, float (&f)[8]) { f[0] = bflo(r.x); f[1] = bfhi(r.x); f[2] = bflo(r.y); f[3] = bfhi(r.y); f[4] = bflo(r.z); f[5] = bfhi(r.z); f[6] = bflo(r.w); f[7] = bfhi(r.w); }
__device__ __forceinline__ void cvt8_fp8(const u32x2 r, float (&f)[8]) { const f32x2 a = __builtin_amdgcn_cvt_pk_f32_fp8((int)r.x, false), b = __builtin_amdgcn_cvt_pk_f32_fp8((int)r.x, true), c = __builtin_amdgcn_cvt_pk_f32_fp8((int)r.y, false), d = __builtin_amdgcn_cvt_pk_f32_fp8((int)r.y, true);
    f[0] = a.x; f[1] = a.y; f[2] = b.x; f[3] = b.y; f[4] = c.x; f[5] = c.y; f[6] = d.x; f[7] = d.y; }
__device__ __forceinline__ bf16x8 pack8(const float (&f)[8]) { u32x4 w; w.x = pk2(f[0], f[1]); w.y = pk2(f[2], f[3]); w.z = pk2(f[4], f[5]); w.w = pk2(f[6], f[7]); return __builtin_bit_cast(bf16x8, w); }
#define MFMA32(a, b, c) __builtin_amdgcn_mfma_f32_32x32x16_bf16((a), (b), (c), 0, 0, 0)

__device__ __forceinline__ void attn_unit(Ctx& C, int l, int uidx) {
    constexpr int KS = 144, VS = 272, VT_OFF = 128 * KS;
    const bool isctx = uidx >= 256;
    int b, kh, nb;
    if (!isctx) { b = uidx >> 6; kh = (uidx >> 5) & 1; nb = uidx & 31; } else { const int v = uidx - 256; b = v >> 2; kh = (v >> 1) & 1; nb = v & 1; }
    const int rowbase = isctx ? NLAT + b * CL : b * SL, crow = NLAT + b * CL;
    const int g = C.wave >> 1, th = C.wave & 1, head = kh * 4 + g, r32 = C.lane & 31, h = C.lane >> 5;
    const bf16* Z = WSP(bf16, WS_Z); const f32x2* ROPE = WSP(f32x2, WS_ROPE);
    bf16x8 Qf[2][4];
#pragma unroll
    for (int qb = 0; qb < 2; ++qb) {
        const int tq = 128 * nb + 64 * th + 32 * qb + r32;
        const bf16* qp = Z + (size_t)(rowbase + tq) * INW + 512 + 64 * head + 8 * h;
        float f[4][8];
#pragma unroll
        for (int s = 0; s < 4; ++s) cvt8(*(const u32x4*)(qp + 16 * s), f[s]);
        if (!isctx) {
            const int pr = tq >> 6, pc = tq & 63;
#pragma unroll
            for (int j = 0; j < 8; ++j) {
                const f32x2 cr = ROPE[pr * 16 + 8 * h + j], cc = ROPE[pc * 16 + 8 * h + j];
                const float a0 = f[0][j], b0 = f[1][j]; f[0][j] = a0 * cr.x - b0 * cr.y; f[1][j] = b0 * cr.x + a0 * cr.y;
                const float a1 = f[2][j], b1 = f[3][j]; f[2][j] = a1 * cc.x - b1 * cc.y; f[3][j] = b1 * cc.x + a1 * cc.y; }
        }
#pragma unroll
        for (int s = 0; s < 4; ++s) {
#pragma unroll
            for (int j = 0; j < 8; ++j) f[s][j] *= 0.125f * LOG2E;
            Qf[qb][s] = pack8(f[s]); }
    }
    float m_[2], l_[2]; f32x16 O[2][2];
    { const float sk = INP(I_SINK)[l * 8 + head] * LOG2E; m_[0] = sk; m_[1] = sk; l_[0] = 1.f; l_[1] = 1.f; }
#pragma unroll
    for (int a = 0; a < 2; ++a)
#pragma unroll
        for (int q = 0; q < 2; ++q)
#pragma unroll
            for (int i = 0; i < 16; ++i) O[a][q][i] = 0.f;
#define AT_VALID(tt_) ((tt_) >= 3 || ((nb - 1 + (tt_)) >= 0 && (nb - 1 + (tt_)) < SL / 128))
#define AT_KROW0(tt_) (((tt_) < 3) ? rowbase + 128 * (nb - 1 + (tt_)) : crow + 128 * ((tt_) - 3))
#define AT_PREFETCH(tt_) do { const int krow0_ = AT_KROW0(tt_); _Pragma("unroll") for (int r = 0; r < 2; ++r) { const int idx = C.tid + 512 * r, key = idx >> 3, cd = idx & 7; \
        const bf16* kp = Z + (size_t)(krow0_ + key) * INW + 1024 + 64 * kh; kraw[r] = *(const u32x4*)(kp + 8 * cd); if ((tt_) < 3) kpar[r] = *(const u32x4*)(kp + 8 * (cd ^ 2)); \
        vraw[r] = *(const u32x4*)(kp + 128 + 8 * cd); } } while (0)
    __syncthreads();
    u32x4 kraw[2], kpar[2], vraw[2];
    kpar[0] = (u32x4){0u, 0u, 0u, 0u}; kpar[1] = kpar[0];
    int tt = isctx ? 3 : (nb == 0 ? 1 : 0);
    AT_PREFETCH(tt);
    while (tt < 5) {
        int ntt = tt + 1; if (ntt < 3 && !AT_VALID(ntt)) ntt = 3;
        const bool band = tt < 3; const int kb = nb - 1 + tt;
        LDS_WAIT(); __builtin_amdgcn_s_barrier(); asm volatile("" ::: "memory");
#pragma unroll
        for (int r = 0; r < 2; ++r) {
            const int idx = C.tid + 512 * r, key = idx >> 3, cd = idx & 7;
            u32x4 raw = kraw[r];
            if (band) {
                float x[8], y[8]; cvt8(raw, x); cvt8(kpar[r], y);
                const int tk = 128 * kb + key, pos = (cd & 4) ? (tk & 63) : (tk >> 6), i0 = 8 * (cd & 1); const bool isb = (cd >> 1) & 1;
#pragma unroll
                for (int j = 0; j < 8; ++j) { const f32x2 cs = ROPE[pos * 16 + i0 + j]; x[j] = isb ? (x[j] * cs.x + y[j] * cs.y) : (x[j] * cs.x - y[j] * cs.y); }
                raw = __builtin_bit_cast(u32x4, pack8(x));
            }
            *(LAS u32x4*)(C.lds + key * KS + cd * 16) = raw;
            const u32x4 vr = vraw[r];
            LAS bf16* vt = (LAS bf16*)(C.lds + VT_OFF + (8 * cd) * VS + key * 2);
            vt[0] = (bf16)(vr.x & 0xffff); vt[VS / 2] = (bf16)(vr.x >> 16); vt[2 * (VS / 2)] = (bf16)(vr.y & 0xffff); vt[3 * (VS / 2)] = (bf16)(vr.y >> 16);
            vt[4 * (VS / 2)] = (bf16)(vr.z & 0xffff); vt[5 * (VS / 2)] = (bf16)(vr.z >> 16); vt[6 * (VS / 2)] = (bf16)(vr.w & 0xffff); vt[7 * (VS / 2)] = (bf16)(vr.w >> 16);
        }
        if (ntt < 5) AT_PREFETCH(ntt);
        LDS_WAIT(); __builtin_amdgcn_s_barrier(); asm volatile("" ::: "memory");
        const int sub_lo = (tt == 0) ? 2 * th : 0, sub_hi = (tt == 2) ? 2 * th + 1 : 3;
        for (int sub = sub_lo; sub <= sub_hi; ++sub) {
            bf16x8 Kf[4];
#pragma unroll
            for (int s = 0; s < 4; ++s) Kf[s] = *(const LAS bf16x8*)(C.lds + (32 * sub + r32) * KS + (16 * s + 8 * h) * 2);
            bf16x8 Pf[2][2];
#pragma unroll
            for (int qb = 0; qb < 2; ++qb) {
                f32x16 S;
#pragma unroll
                for (int i = 0; i < 16; ++i) S[i] = 0.f;
#pragma unroll
                for (int s = 0; s < 4; ++s) S = MFMA32(Kf[s], Qf[qb][s], S);
                const int tq = 128 * nb + 64 * th + 32 * qb + r32;
                float mx = -INFINITY;
#pragma unroll
                for (int i = 0; i < 16; ++i) { float x = S[i];
                    if (tt == 0 || tt == 2) { const int kpos = 128 * kb + 32 * sub + (i & 3) + 8 * (i >> 2) + 4 * h; const int dq = tq - kpos; if (dq > 128 || dq < -128) x = -INFINITY; }
                    S[i] = x; mx = fmaxf(mx, x); }
                mx = xor32_max(mx);
                const float mnew = fmaxf(m_[qb], mx), alpha = __builtin_amdgcn_exp2f(m_[qb] - mnew);
                float rs = 0.f; float p[16];
#pragma unroll
                for (int i = 0; i < 16; ++i) { p[i] = __builtin_amdgcn_exp2f(S[i] - mnew); rs += p[i]; }
                rs = xor32_sum(rs);
                l_[qb] = l_[qb] * alpha + rs; m_[qb] = mnew;
#pragma unroll
                for (int i = 0; i < 16; ++i) { O[0][qb][i] *= alpha; O[1][qb][i] *= alpha; }
#pragma unroll
                for (int s2 = 0; s2 < 2; ++s2) { float t8[8];
#pragma unroll
                    for (int j = 0; j < 8; ++j) t8[j] = p[8 * s2 + j];
                    Pf[qb][s2] = pack8(t8); }
            }
#pragma unroll
            for (int db = 0; db < 2; ++db)
#pragma unroll
                for (int s2 = 0; s2 < 2; ++s2) {
                    const LAS unsigned char* vp = C.lds + VT_OFF + (32 * db + r32) * VS + (32 * sub + 16 * s2 + 4 * h) * 2;
                    const u32x2 v0 = *(const LAS u32x2*)vp, v1 = *(const LAS u32x2*)(vp + 16);
                    const u32x4 vv = {v0.x, v0.y, v1.x, v1.y}; const bf16x8 Vf = __builtin_bit_cast(bf16x8, vv);
                    O[db][0] = MFMA32(Vf, Pf[0][s2], O[db][0]); O[db][1] = MFMA32(Vf, Pf[1][s2], O[db][1]);
                }
        }
        tt = ntt;
    }
#undef AT_VALID
#undef AT_KROW0
#undef AT_PREFETCH
    bf16* Y = WSP(bf16, WS_YCAT);
#pragma unroll
    for (int qb = 0; qb < 2; ++qb) {
        const int tq = 128 * nb + 64 * th + 32 * qb + r32; const float inv = 1.0f / l_[qb];
        bf16* yp = Y + (size_t)(rowbase + tq) * DM + 512 + 64 * head;
#pragma unroll
        for (int db = 0; db < 2; ++db)
#pragma unroll
            for (int rg = 0; rg < 4; ++rg) { u32x2 w; w.x = pk2(O[db][qb][4 * rg] * inv, O[db][qb][4 * rg + 1] * inv); w.y = pk2(O[db][qb][4 * rg + 2] * inv, O[db][qb][4 * rg + 3] * inv);
                *(u32x2*)(yp + 32 * db + 8 * rg + 4 * h) = w; }
    }
}

__device__ __forceinline__ void gmlp_unit(Ctx& C, int l, int uidx) {
    constexpr int VS = 272;
    const int ck = uidx >> 1, hf = uidx & 1, row0 = 128 * ck;
    const bf16* Z = WSP(bf16, WS_Z);
    const int gl = C.wave >> 1, ph = C.wave & 1, g = 4 * hf + gl, r32 = C.lane & 31, h = C.lane >> 5;
    bf16x8 Wf[2][8]; u32x2 upre[2][2][4];
    { const bf16* wsb = WSP(bf16, WS_GWSB) + ((size_t)(l * 8 + g) * 128 + 64 * ph + r32) * 128 + 8 * h;
#pragma unroll
      for (int pb = 0; pb < 2; ++pb)
#pragma unroll
          for (int s = 0; s < 8; ++s) Wf[pb][s] = *(const bf16x8*)(wsb + (size_t)(32 * pb) * 128 + 16 * s);
#pragma unroll
      for (int pb = 0; pb < 2; ++pb) { const bf16* up = Z + (size_t)(row0 + 64 * ph + 32 * pb + r32) * INW + 2816 + 64 * g + 4 * h;
#pragma unroll
          for (int cb = 0; cb < 2; ++cb)
#pragma unroll
              for (int rg = 0; rg < 4; ++rg) upre[pb][cb][rg] = *(const u32x2*)(up + 32 * cb + 8 * rg); } }
    __syncthreads();
    {
        const int tok = C.tid >> 2, part = C.tid & 3;
        const bf16* zp = Z + (size_t)(row0 + tok) * INW + 3328 + 128 * part;
        const bf16* zq = Z + (size_t)(row0 + tok) * INW + 3328 + 256 * hf + 64 * part;
        u32x4 r1[16], r2[8];
#pragma unroll
        for (int c8 = 0; c8 < 16; ++c8) r1[c8] = *(const u32x4*)(zp + 8 * c8);
#pragma unroll
        for (int c8 = 0; c8 < 8; ++c8) r2[c8] = *(const u32x4*)(zq + 8 * c8);
        float s = 0.f, q = 0.f;
#pragma unroll
        for (int c8 = 0; c8 < 16; ++c8) { float f[8]; cvt8(r1[c8], f);
#pragma unroll
            for (int j = 0; j < 8; ++j) { s += f[j]; q += f[j] * f[j]; } }
        s += dpp_f<DPP_XOR1>(s); s += dpp_f<DPP_XOR2>(s); q += dpp_f<DPP_XOR1>(q); q += dpp_f<DPP_XOR2>(q);
        const float mean = s * (1.0f / 512.0f); const float var = fmaxf(q * (1.0f / 512.0f) - mean * mean, 0.f); const float rstd = 1.0f / sqrtf(var + LN_EPS);
        const float* lg = INP(I_GLG) + l * 512 + 256 * hf + 64 * part; const float* lb = INP(I_GLB) + l * 512 + 256 * hf + 64 * part;
#pragma unroll
        for (int c8 = 0; c8 < 8; ++c8) { float f[8]; cvt8(r2[c8], f);
            const f32x4 g0 = *(const f32x4*)(lg + 8 * c8), g1 = *(const f32x4*)(lg + 8 * c8 + 4), b0 = *(const f32x4*)(lb + 8 * c8), b1 = *(const f32x4*)(lb + 8 * c8 + 4);
            const float gg[8] = {g0[0], g0[1], g0[2], g0[3], g1[0], g1[1], g1[2], g1[3]}, bb[8] = {b0[0], b0[1], b0[2], b0[3], b1[0], b1[1], b1[2], b1[3]};
#pragma unroll
            for (int j = 0; j < 8; ++j) { const float vn = (f[j] - mean) * rstd * gg[j] + bb[j];
                *(LAS bf16*)(C.lds + (64 * part + 8 * c8 + j) * VS + tok * 2) = (bf16)(pk2(vn, 0.f) & 0xffffu); } }
    }
    __syncthreads();
    f32x16 acc[2][2];
#pragma unroll
    for (int a = 0; a < 2; ++a)
#pragma unroll
        for (int b = 0; b < 2; ++b)
#pragma unroll
            for (int i = 0; i < 16; ++i) acc[a][b][i] = 0.f;
#pragma unroll
    for (int s = 0; s < 8; ++s) {
        bf16x8 Vf[2];
#pragma unroll
        for (int cb = 0; cb < 2; ++cb) Vf[cb] = *(const LAS bf16x8*)(C.lds + (64 * gl + 32 * cb + r32) * VS + (16 * s + 8 * h) * 2);
#pragma unroll
        for (int cb = 0; cb < 2; ++cb)
#pragma unroll
            for (int pb = 0; pb < 2; ++pb) acc[cb][pb] = MFMA32(Vf[cb], Wf[pb][s], acc[cb][pb]);
    }
    bf16* Y = WSP(bf16, WS_YCAT);
#pragma unroll
    for (int pb = 0; pb < 2; ++pb) { const int p = 64 * ph + 32 * pb + r32; const float bs = INP(I_GBS)[(l * 8 + g) * 128 + p];
        bf16* yp = Y + (size_t)(row0 + p) * DM + 1536 + 64 * g + 4 * h;
#pragma unroll
        for (int cb = 0; cb < 2; ++cb)
#pragma unroll
            for (int rg = 0; rg < 4; ++rg) { const u32x2 uv = upre[pb][cb][rg];
                u32x2 w; w.x = pk2(bflo(uv.x) * (acc[cb][pb][4 * rg] + bs), bfhi(uv.x) * (acc[cb][pb][4 * rg + 1] + bs)); w.y = pk2(bflo(uv.y) * (acc[cb][pb][4 * rg + 2] + bs), bfhi(uv.y) * (acc[cb][pb][4 * rg + 3] + bs));
                *(u32x2*)(yp + 32 * cb + 8 * rg) = w; } }
}

__device__ __forceinline__ void pool_unit(Ctx& C, int l, int blk) {
    constexpr int RS = 1040, DT_OFF = 48 * RS;
    const int row0 = 32 * blk;
    const int s0 = row0 < NLAT ? (row0 / SL) * SL : NLAT + ((row0 - NLAT) / CL) * CL, L = row0 < NLAT ? SL : CL, t0 = row0 - s0;
    const bf16* Z = WSP(bf16, WS_Z);
    __syncthreads();
    for (int idx = C.tid; idx < 48 * 64; idx += 512) { const int r = idx >> 6, ch = idx & 63, t = t0 - 8 + r; u32x4 v = {0u, 0u, 0u, 0u};
        if (t >= 0 && t < L) v = *(const u32x4*)(Z + (size_t)(s0 + t) * INW + 8 * ch);
        *(LAS u32x4*)(C.lds + r * RS + ch * 16) = v; }
    __syncthreads();
    {
        const int c8 = C.tid & 63, tg = C.tid >> 6, hw = 1 << (c8 >> 4);
#pragma unroll 1
        for (int k = 0; k < 4; ++k) { const int tt = 4 * tg + k, t = t0 + tt; const int lo = max(t - hw, 0), hi = min(t + hw, L);
            float sacc[8];
#pragma unroll
            for (int j = 0; j < 8; ++j) sacc[j] = 0.f;
            for (int q = lo; q < hi; ++q) { float f[8]; cvt8(*(const LAS u32x4*)(C.lds + (q - t0 + 8) * RS + c8 * 16), f);
#pragma unroll
                for (int j = 0; j < 8; ++j) sacc[j] += f[j]; }
            float cf[8]; cvt8(*(const LAS u32x4*)(C.lds + (tt + 8) * RS + c8 * 16), cf); const float inv = 1.0f / (float)(hi - lo);
#pragma unroll
            for (int j = 0; j < 8; ++j) sacc[j] = sacc[j] * inv - cf[j];
            *(LAS bf16x8*)(C.lds + DT_OFF + tt * RS + c8 * 16) = pack8(sacc); }
    }
    __syncthreads();
    const int gi = C.wave >> 1, oh = C.wave & 1, r32 = C.lane & 31, h = C.lane >> 5;
    f32x16 acc[2];
#pragma unroll
    for (int a = 0; a < 2; ++a)
#pragma unroll
        for (int i = 0; i < 16; ++i) acc[a][i] = 0.f;
    const bf16* wt = WSP(bf16, WS_POOLWT) + (size_t)((l * 4 + gi) * 128 + 64 * oh + r32) * 128 + 8 * h;
#pragma unroll
    for (int s = 0; s < 8; ++s) {
        const bf16x8 Bf = *(const LAS bf16x8*)(C.lds + DT_OFF + r32 * RS + (128 * gi + 16 * s + 8 * h) * 2);
#pragma unroll
        for (int rb = 0; rb < 2; ++rb) { const bf16x8 Af = *(const bf16x8*)(wt + (size_t)(32 * rb) * 128 + 16 * s); acc[rb] = MFMA32(Af, Bf, acc[rb]); }
    }
    bf16* yp = WSP(bf16, WS_YCAT) + (size_t)(row0 + r32) * DM + 128 * gi + 64 * oh;
#pragma unroll
    for (int rb = 0; rb < 2; ++rb)
#pragma unroll
        for (int rg = 0; rg < 4; ++rg) { u32x2 w; w.x = pk2(acc[rb][4 * rg], acc[rb][4 * rg + 1]); w.y = pk2(acc[rb][4 * rg + 2], acc[rb][4 * rg + 3]); *(u32x2*)(yp + 32 * rb + 8 * rg + 4 * h) = w; }
}

__device__ __forceinline__ void hyprep_unit(Ctx& C, int l, int uidx) {
    constexpr int RS = 528;
    int seq, tb, cb, L, rowbase; bf16* T;
    if (uidx < 1536) { seq = uidx / 384; const int rem = uidx % 384; tb = rem / 6; cb = rem % 6; L = SL; rowbase = seq * SL; T = WSP(bf16, WS_TL); }
    else { const int v = uidx - 1536; seq = v / 24; const int rem = v % 24; tb = rem / 6; cb = rem % 6; L = CL; rowbase = NLAT + seq * CL; T = WSP(bf16, WS_TC); }
    const int t0 = 64 * tb; const bf16* Z = WSP(bf16, WS_Z);
    __syncthreads();
    for (int idx = C.tid; idx < 66 * 32; idx += 512) { const int r = idx >> 5, ch = idx & 31, t = t0 - 1 + r; u32x4 v = {0u, 0u, 0u, 0u};
        if (t >= 0 && t < L) v = *(const u32x4*)(Z + (size_t)(rowbase + t) * INW + 1280 + 256 * cb + 8 * ch);
        *(LAS u32x4*)(C.lds + r * RS + ch * 16) = v; }
    __syncthreads();
    const int c = C.tid & 255, hf = C.tid >> 8, ch = 256 * cb + c, comp = ch >> 9, cc = ch & 511;
    const float w0 = INP(I_HCW)[(l * 3 + 0) * 1536 + ch], w1 = INP(I_HCW)[(l * 3 + 1) * 1536 + ch], w2 = INP(I_HCW)[(l * 3 + 2) * 1536 + ch], bias = INP(I_HCB)[l * 1536 + ch];
    bf16* dst = T + ((size_t)(comp * 512 + cc) * 4 + seq) * L + t0 + 32 * hf;
    float zm = bf1(*(const LAS bf16*)(C.lds + (32 * hf) * RS + c * 2)), zc = bf1(*(const LAS bf16*)(C.lds + (32 * hf + 1) * RS + c * 2));
#pragma unroll
    for (int k = 0; k < 4; ++k) { float o[8];
#pragma unroll
        for (int e = 0; e < 8; ++e) { const float zn = bf1(*(const LAS bf16*)(C.lds + (32 * hf + 8 * k + e + 2) * RS + c * 2)); o[e] = bias + w0 * zm + w1 * zc + w2 * zn; zm = zc; zc = zn; }
        u32x4 w; w.x = pk2(o[0], o[1]); w.y = pk2(o[2], o[3]); w.z = pk2(o[4], o[5]); w.w = pk2(o[6], o[7]); *(u32x4*)(dst + 8 * k) = w; }
}

template <int L>
__device__ __forceinline__ void hyena_unit(Ctx& C, int l, int c) {
    constexpr int NBLK = L / 32, NTILE = NBLK / 8, NTL = (NTILE >= 16) ? 2 : 1;
    constexpr int SB = 2 * L + 16, Z_OFF = 4 * SB, R_OFF = Z_OFF + 64, CSZ = 4 * L;
    const bf16* T = (L == SL) ? WSP(bf16, WS_TL) : WSP(bf16, WS_TC);
    const int r32 = C.lane & 31, h = C.lane >> 5;
    const bool active = (2 * C.wave < NTILE);
    const int qi = (r32 + 1) >> 2, ri = (r32 + 1) & 3, pcp = (4 - ri) & 3;
    const int laneA = R_OFF + pcp * CSZ + (pcp ? 8 + 64 * pcp : 0) - 8 * (qi + (ri ? 1 : 0)) + 16 * h;
    const int al = r32 >> 2, bb = r32 & 3;
    const int laneB = bb * SB + 16 * h;
    for (int o = 0; o < 2; ++o) {
        __syncthreads();
        if (o == 0) { const bf16* src = T + (size_t)(2 * 512 + c) * 4 * L;
            for (int idx = C.tid; idx < 4 * L / 8; idx += 512) { const int b = idx / (L / 8), tc = idx % (L / 8); *(LAS u32x4*)(C.lds + b * SB + tc * 16) = *(const u32x4*)(src + 8 * idx); }
            if (C.tid < 4) *(LAS u32x4*)(C.lds + Z_OFF + 16 * C.tid) = (u32x4){0u, 0u, 0u, 0u}; }
        { const bf16* fsrc = (L == SL) ? WSP(bf16, WS_FILT) + (size_t)((l * 2 + o) * 512 + c) * (2 * L) : WSP(bf16, WS_FILTC) + (size_t)(o * 512 + c) * (2 * L);
          for (int idx = C.tid; idx < L / 4; idx += 512) *(LAS u32x4*)(C.lds + R_OFF + 16 * idx) = *(const u32x4*)(fsrc + 8 * idx); }
        __syncthreads();
        for (int idx = C.tid; idx < 3 * (L / 2); idx += 512) { const int p = 1 + idx / (L / 2), w = idx % (L / 2); unsigned short e[4];
#pragma unroll
            for (int k = 0; k < 4; ++k) { const int n = 4 * w + p + k; e[k] = n < 2 * L ? *(const LAS bf16*)(C.lds + R_OFF + 2 * n) : (bf16)0; }
            *(LAS u32x2*)(C.lds + R_OFF + p * CSZ + 8 + 64 * p + 8 * w) = (u32x2){(unsigned)e[0] | ((unsigned)e[1] << 16), (unsigned)e[2] | ((unsigned)e[3] << 16)}; }
        __syncthreads();
        f32x16 acc[NTL];
#pragma unroll
        for (int t = 0; t < NTL; ++t)
#pragma unroll
            for (int i = 0; i < 16; ++i) acc[t][i] = 0.f;
        u32x2 gpre[NTL][4]; float skip = 0.f;
        if (active) { skip = INP(I_HSKIP)[(l * 2 + o) * 512 + c]; const bf16* gate_ = T + (size_t)(o * 512 + c) * 4 * L + (size_t)bb * L;
#pragma unroll
            for (int t = 0; t < NTL; ++t)
#pragma unroll
                for (int rg = 0; rg < 4; ++rg) gpre[t][rg] = *(const u32x2*)(gate_ + 32 * (8 * (2 * C.wave + t) + al) + 8 * rg + 4 * h); }
        if (active) {
            const int a0 = 8 * (2 * C.wave);
            const int m_lo = a0 - (NBLK - 1), m_hi = a0 + 8 * (NTL - 1) + 7;
            const int mA = m_hi - (NBLK - 1), mB = a0;
            int off8 = 8; asm volatile("" : "+v"(off8));
#define HY_STEP_CHK(m_) do { bf16x8 Af_[2]; \
                _Pragma("unroll") for (int s = 0; s < 2; ++s) { const LAS unsigned char* ap = C.lds + laneA + 2 * (L - 32 * (m_) + 16 * s); const u32x2 x0 = *(const LAS u32x2*)ap, x1 = *(const LAS u32x2*)(ap + off8); \
                    const u32x4 xx = {x0.x, x0.y, x1.x, x1.y}; Af_[s] = __builtin_bit_cast(bf16x8, xx); } \
                _Pragma("unroll") for (int t = 0; t < NTL; ++t) { const int q = a0 + 8 * t + al - (m_); const bool ok = (q >= 0) && (q < NBLK); \
                    _Pragma("unroll") for (int s = 0; s < 2; ++s) { const int addr = ok ? (laneB + 64 * q + 32 * s) : Z_OFF; const bf16x8 Bf_ = *(const LAS bf16x8*)(C.lds + addr); acc[t] = MFMA32(Af_[s], Bf_, acc[t]); } } } while (0)
#pragma unroll 1
            for (int m = m_lo; m < mA; ++m) HY_STEP_CHK(m);
            {
                int o1 = 8, o2 = 32, o3 = 40; asm volatile("" : "+v"(o1), "+v"(o2), "+v"(o3));
                const LAS unsigned char* pa0 = C.lds + laneA + 2 * (L - 32 * mA); const LAS unsigned char* pa1 = pa0 + o1; const LAS unsigned char* pa2 = pa0 + o2; const LAS unsigned char* pa3 = pa0 + o3;
                const LAS unsigned char* pb = C.lds + laneB + 64 * (a0 + al - mA);
#define HY_LOADF(Af_, Bf_) do { { const u32x2 x0 = *(const LAS u32x2*)pa0, x1 = *(const LAS u32x2*)pa1, x2 = *(const LAS u32x2*)pa2, x3 = *(const LAS u32x2*)pa3; \
                    const u32x4 xa = {x0.x, x0.y, x1.x, x1.y}, xb = {x2.x, x2.y, x3.x, x3.y}; Af_[0] = __builtin_bit_cast(bf16x8, xa); Af_[1] = __builtin_bit_cast(bf16x8, xb); } \
                _Pragma("unroll") for (int t = 0; t < NTL; ++t) _Pragma("unroll") for (int s = 0; s < 2; ++s) Bf_[t][s] = *(const LAS bf16x8*)(pb + 512 * t + 32 * s); \
                pa0 -= 64; pa1 -= 64; pa2 -= 64; pa3 -= 64; pb -= 64; asm volatile("" : "+v"(pa0), "+v"(pa1), "+v"(pa2), "+v"(pa3)); } while (0)
#define HY_MMA(Af_, Bf_) do { _Pragma("unroll") for (int s = 0; s < 2; ++s) _Pragma("unroll") for (int t = 0; t < NTL; ++t) acc[t] = MFMA32(Af_[s], Bf_[t][s], acc[t]); } while (0)
                int nfast = mB - mA + 1;
                if constexpr (NTL == 2) {
                    bf16x8 Bx[8][2], By[8][2];
#define HY_LOADA(Af_) do { const u32x2 x0 = *(const LAS u32x2*)pa0, x1 = *(const LAS u32x2*)pa1, x2 = *(const LAS u32x2*)pa2, x3 = *(const LAS u32x2*)pa3; \
                        const u32x4 xa = {x0.x, x0.y, x1.x, x1.y}, xb = {x2.x, x2.y, x3.x, x3.y}; Af_[0] = __builtin_bit_cast(bf16x8, xa); Af_[1] = __builtin_bit_cast(bf16x8, xb); \
                        pa0 -= 64; pa1 -= 64; pa2 -= 64; pa3 -= 64; asm volatile("" : "+v"(pa0), "+v"(pa1), "+v"(pa2), "+v"(pa3)); } while (0)
#define HY_GROUP(Bold, Bnew, more) do { _Pragma("unroll") for (int i = 0; i < 8; ++i) { bf16x8 An_[2] = {Ac_[0], Ac_[1]}; \
                        if (i < 7) { HY_LOADA(An_); Bnew[i + 1][0] = *(const LAS bf16x8*)(pb - 64 * (i + 1)); Bnew[i + 1][1] = *(const LAS bf16x8*)(pb - 64 * (i + 1) + 32); } \
                        else if (more) { HY_LOADA(An_); Bold[0][0] = *(const LAS bf16x8*)(pb - 512); Bold[0][1] = *(const LAS bf16x8*)(pb - 512 + 32); }        \
                        acc[0] = MFMA32(Ac_[0], Bnew[i][0], acc[0]); acc[1] = MFMA32(Ac_[0], Bold[i][0], acc[1]); acc[0] = MFMA32(Ac_[1], Bnew[i][1], acc[0]); acc[1] = MFMA32(Ac_[1], Bold[i][1], acc[1]); \
                        Ac_[0] = An_[0]; Ac_[1] = An_[1]; } \
                        pb -= 512; } while (0)
                    if (nfast >= 16) {
#pragma unroll
                        for (int i = 0; i < 8; ++i) { Bx[i][0] = *(const LAS bf16x8*)(pb + 512 - 64 * i); Bx[i][1] = *(const LAS bf16x8*)(pb + 512 - 64 * i + 32); }
                        bf16x8 Ac_[2]; HY_LOADA(Ac_); By[0][0] = *(const LAS bf16x8*)pb; By[0][1] = *(const LAS bf16x8*)(pb + 32);
#pragma unroll 1
                        while (nfast >= 16) { HY_GROUP(Bx, By, true); HY_GROUP(By, Bx, nfast >= 32); nfast -= 16; }
                    }
#undef HY_LOADA
#undef HY_GROUP
                }
                bf16x8 A0[2], B0[NTL][2], A1[2], B1[NTL][2];
                if (nfast > 0) {
                    int rem = nfast - 1;
                    HY_LOADF(A0, B0);
#pragma unroll 1
                    while (rem >= 2) { HY_LOADF(A1, B1); HY_MMA(A0, B0); HY_LOADF(A0, B0); HY_MMA(A1, B1); rem -= 2; }
                    if (rem == 1) { HY_LOADF(A1, B1); HY_MMA(A0, B0); HY_MMA(A1, B1); } else { HY_MMA(A0, B0); }
                }
#undef HY_LOADF
#undef HY_MMA
            }
#pragma unroll 1
            for (int m = mB + 1; m <= m_hi; ++m) HY_STEP_CHK(m);
#undef HY_STEP_CHK
        }
        __syncthreads();
        if (active) {
#pragma unroll
            for (int t = 0; t < NTL; ++t) { const int a = 8 * (2 * C.wave + t) + al;
#pragma unroll
                for (int rg = 0; rg < 4; ++rg) { const int t4 = 32 * a + 8 * rg + 4 * h;
                    LAS u32x2* up = (LAS u32x2*)(C.lds + bb * SB + t4 * 2); const u32x2 uo = *up; const u32x2 gv = gpre[t][rg];
                    const float v0 = bflo(gv.x) * (acc[t][4 * rg] + skip * bflo(uo.x)), v1 = bfhi(gv.x) * (acc[t][4 * rg + 1] + skip * bfhi(uo.x));
                    const float v2 = bflo(gv.y) * (acc[t][4 * rg + 2] + skip * bflo(uo.y)), v3 = bfhi(gv.y) * (acc[t][4 * rg + 3] + skip * bfhi(uo.y));
                    const u32x2 w = {pk2(v0, v1), pk2(v2, v3)};
                    if (o == 0) *up = w;
                    else { const int row = (L == SL) ? bb * SL + t4 : NLAT + bb * CL + t4; *(u32x2*)(WSP(bf16, WS_YHT) + (size_t)c * NTOK + row) = w; } } }
        }
    }
}

constexpr int RMS_GN_OFF = 34816;
__device__ __forceinline__ void rms_stage_gain(Ctx& C, int l) { __syncthreads(); stage2048(C, (LAS float*)(C.lds + RMS_GN_OFF), INP(I_MNG) + l * DM); __syncthreads(); }
__device__ __forceinline__ void rms_unit(Ctx& C, int l, int blk) {
    constexpr int RS = 1040;
    const int row0 = 32 * blk;
    const int tok = C.tid >> 4, sub = C.tid & 15;
    const bf16* Y = WSP(bf16, WS_YCAT) + (size_t)(row0 + tok) * DM + 32 * sub;
    u32x4 raw[3][4];
#pragma unroll
    for (int gi = 0; gi < 3; ++gi)
#pragma unroll
        for (int c8 = 0; c8 < 4; ++c8) raw[gi][c8] = *(const u32x4*)(Y + 512 * (gi == 2 ? 3 : gi) + 8 * c8);
    u32x4 hy[4];
    { const bf16* yh = WSP(bf16, WS_YHT);
#pragma unroll
      for (int k = 0; k < 4; ++k) { const int idx = C.tid + 512 * k, ch = idx >> 2, tc = idx & 3; hy[k] = *(const u32x4*)(yh + (size_t)ch * NTOK + row0 + 8 * tc); } }
    __syncthreads();
#pragma unroll
    for (int k = 0; k < 4; ++k) { const int idx = C.tid + 512 * k, ch = idx >> 2, tc = idx & 3; const u32x4 v = hy[k];
        LAS bf16* d = (LAS bf16*)(C.lds + (8 * tc) * RS + ch * 2);
        d[0] = (bf16)(v.x & 0xffff); d[RS / 2] = (bf16)(v.x >> 16); d[2 * (RS / 2)] = (bf16)(v.y & 0xffff); d[3 * (RS / 2)] = (bf16)(v.y >> 16);
        d[4 * (RS / 2)] = (bf16)(v.z & 0xffff); d[5 * (RS / 2)] = (bf16)(v.z >> 16); d[6 * (RS / 2)] = (bf16)(v.w & 0xffff); d[7 * (RS / 2)] = (bf16)(v.w >> 16); }
    __syncthreads();
    const LAS float* gn = (const LAS float*)(C.lds + RMS_GN_OFF);
    unsigned char* O = WSP(unsigned char, WS_HA8) + (size_t)(row0 + tok) * DM + 32 * sub;
#pragma unroll
    for (int gq = 0; gq < 4; ++gq) {
        float f[32]; float q = 0.f;
#pragma unroll
        for (int c8 = 0; c8 < 4; ++c8) { const u32x4 v = (gq == 2) ? *(const LAS u32x4*)(C.lds + tok * RS + (32 * sub + 8 * c8) * 2) : raw[gq == 3 ? 2 : gq][c8];
            float t8[8]; cvt8(v, t8);
#pragma unroll
            for (int j = 0; j < 8; ++j) { f[8 * c8 + j] = t8[j]; q += t8[j] * t8[j]; } }
        q = row16_sum(q);
        const float rs = 1.0f / sqrtf(q * (1.0f / 512.0f) + LN_EPS);
        const LAS float* gp = gn + 512 * gq + 32 * sub;
#pragma unroll
        for (int c8 = 0; c8 < 4; ++c8) { const f32x4 g0 = *(const LAS f32x4*)(gp + 8 * c8), g1 = *(const LAS f32x4*)(gp + 8 * c8 + 4);
            u32x2 w; w.x = pk4_fp8(f[8 * c8] * rs * g0[0], f[8 * c8 + 1] * rs * g0[1], f[8 * c8 + 2] * rs * g0[2], f[8 * c8 + 3] * rs * g0[3]);
            w.y = pk4_fp8(f[8 * c8 + 4] * rs * g1[0], f[8 * c8 + 5] * rs * g1[1], f[8 * c8 + 6] * rs * g1[2], f[8 * c8 + 7] * rs * g1[3]);
            *(u32x2*)(O + 512 * gq + 8 * c8) = w; }
        __builtin_amdgcn_sched_barrier(0);
    }
}

__device__ __forceinline__ void ph_post1(Ctx& C, int l, int nrows, bool dry = false) {
    LAS float* H2 = (LAS float*)C.lds;
    LAS float* RED = (LAS float*)(C.lds + 65536);
    LAS float* SGA = (LAS float*)(C.lds + 81920);
    LAS float* PAR = (LAS float*)(C.lds + 92160);
    unsigned* ctl = WSP(unsigned, WS_CTL);
    int nit = 0, cur_mrow = -1;
    const int nit_all = nrows / 8, it0 = (int)(((long)C.bid * nit_all) / C.G), it1 = (int)(((long)(C.bid + 1) * nit_all) / C.G);
    for (int it = it0; it < it1; ++it, ++nit) {
        const int row = it * 8 + C.wave;
        const int mrow = row < NLAT ? row / SL : 4; const float* mod = WSP(float, WS_MOD) + (size_t)(l * 5 + mrow) * 12288;
        __syncthreads();
        if (mrow != cur_mrow) { stage2048(C, PAR, mod + 4096); stage2048(C, PAR + 2048, INP(I_LN1G) + l * DM); stage2048(C, PAR + 4096, INP(I_LN1B) + l * DM); stage2048(C, PAR + 6144, mod + 8192); stage2048(C, PAR + 8192, mod + 6144); cur_mrow = mrow; __syncthreads(); }
        {
            float v[32], y[32], g1[32];
            if (l == 0) row_load(src_x0(C, row), C.lane, v); else row_load_bf16(WSP(bf16, WS_X) + (size_t)row * DM, C.lane, v);
            row_load_lds(PAR, C.lane, g1);
            { const bf16* yo = WSP(bf16, WS_YO) + (size_t)row * DM;
#pragma unroll
              for (int j = 0; j < 4; ++j) { float t8[8]; cvt8(*(const u32x4*)(yo + 512 * j + 8 * C.lane), t8);
#pragma unroll
                  for (int e = 0; e < 8; ++e) y[8 * j + e] = t8[e]; } }
#pragma unroll
            for (int i = 0; i < 32; ++i) v[i] = ALPHA * v[i] + g1[i] * y[i];
            row_ln(v); row_affine_lds(v, PAR + 2048, PAR + 4096, C.lane, 0.f);
            row_store_bf16(WSP(bf16, WS_X) + (size_t)row * DM, C.lane, v);
            row_ln(v); row_affine_lds(v, PAR + 6144, PAR + 8192, C.lane, 1.0f);
            row_store_fp8(WSP(unsigned char, WS_HB8) + (size_t)row * DM, C.lane, v);
#pragma unroll
            for (int j = 0; j < 4; ++j) { *(LAS f32x4*)(H2 + C.wave * DM + 512 * j + 8 * C.lane) = (f32x4){v[8 * j], v[8 * j + 1], v[8 * j + 2], v[8 * j + 3]};
                *(LAS f32x4*)(H2 + C.wave * DM + 512 * j + 8 * C.lane + 4) = (f32x4){v[8 * j + 4], v[8 * j + 5], v[8 * j + 6], v[8 * j + 7]}; }
        }
        __syncthreads();
        {
            const int e4 = C.lane & 7, cg = C.lane >> 3, cbase = 256 * C.wave + 32 * cg;
            f32x2 acc[8][2];
#pragma unroll
            for (int r = 0; r < 8; ++r) { acc[r][0] = (f32x2){0.f, 0.f}; acc[r][1] = (f32x2){0.f, 0.f}; }
            const float* wr = INP(I_WR) + (size_t)cbase * NE + 4 * e4;
#pragma unroll 2
            for (int cq = 0; cq < 32; cq += 4) {
                f32x4 w4[4];
#pragma unroll
                for (int k = 0; k < 4; ++k) w4[k] = *(const f32x4*)(wr + (size_t)(cq + k) * NE);
#pragma unroll
                for (int r = 0; r < 8; ++r) { const f32x4 hv = *(const LAS f32x4*)(H2 + r * DM + cbase + cq);
#pragma unroll
                    for (int k = 0; k < 4; ++k) { const f32x2 hh = {hv[k], hv[k]}; acc[r][0] += hh * (f32x2){w4[k][0], w4[k][1]}; acc[r][1] += hh * (f32x2){w4[k][2], w4[k][3]}; } } }
#pragma unroll
            for (int r = 0; r < 8; ++r)
#pragma unroll
                for (int k = 0; k < 2; ++k) { float x = acc[r][k].x, y = acc[r][k].y;
                    x += dpp_f<DPP_ROR8>(x); y += dpp_f<DPP_ROR8>(y); x = xor32_sum(xor16_sum(x)); y = xor32_sum(xor16_sum(y));
                    if (cg == 0) { RED[(C.wave * 8 + r) * 32 + 4 * e4 + 2 * k] = x; RED[(C.wave * 8 + r) * 32 + 4 * e4 + 2 * k + 1] = y; } }
        }
        __syncthreads();
        if (C.tid < 256) { const int r = C.tid >> 5, e = C.tid & 31; float s = 0.f;
#pragma unroll
            for (int p = 0; p < 8; ++p) s += RED[(p * 8 + r) * 32 + e];
            SGA[(nit * 8 + r) * 32 + e] = 1.0f / (1.0f + expf(-s)); }
    }
    __syncthreads();
    if (C.tid < nit * 8 && !dry) { const int r = C.tid, rw = (it0 + (r >> 3)) * 8 + (r & 7); float best = -INFINITY; int bg = 0;
        const LAS float* sg = SGA + r * 32; const float* rb = INP(I_RB);
        for (int gq = 0; gq < 8; ++gq) { const float a = sg[4 * gq] + rb[4 * gq], b = sg[4 * gq + 1] + rb[4 * gq + 1], c = sg[4 * gq + 2] + rb[4 * gq + 2], d = sg[4 * gq + 3] + rb[4 * gq + 3];
            const float hi1 = fmaxf(a, b), lo1 = fminf(a, b), hi2 = fmaxf(c, d), lo2 = fminf(c, d);
            const float top = fmaxf(hi1, hi2), second = fmaxf(fminf(hi1, hi2), (hi1 >= hi2) ? lo1 : lo2);
            const float sc = top + second; if (sc > best) { best = sc; bg = gq; } }
        int i0 = 0; float v0 = -INFINITY;
        for (int k = 0; k < 4; ++k) { const float x = sg[4 * bg + k] + rb[4 * bg + k]; if (x > v0) { v0 = x; i0 = k; } }
        int i1 = 0; float v1 = -INFINITY;
        for (int k = 0; k < 4; ++k) { const float x = sg[4 * bg + k] + rb[4 * bg + k]; if (k != i0 && x > v1) { v1 = x; i1 = k; } }
        const int e0 = 4 * bg + i0, e1 = 4 * bg + i1; const float w0 = sg[e0], w1 = sg[e1], ws = w0 + w1;
        const int p0 = (int)atomicAdd(ctl + CW_CNT + l * 2048 + e0 * 64, 1u), p1 = (int)atomicAdd(ctl + CW_CNT + l * 2048 + e1 * 64, 1u);
        WSP(int4, WS_TOKINFO)[rw] = make_int4(e0, p0, e1, p1); WSP(f32x2, WS_TOKW)[rw] = (f32x2){w0 / ws, w1 / ws};
        WSP(int, WS_EXPTOK)[(size_t)e0 * NTOK + p0] = rw; WSP(int, WS_EXPTOK)[(size_t)e1 * NTOK + p1] = rw; }
    __syncthreads();
}

__device__ __forceinline__ int moe_tables(Ctx& C, int l) {
    LAS int* T = (LAS int*)(C.lds + LDS_TAB);
    __syncthreads();
    if (C.tid < NE) { unsigned* ctl = WSP(unsigned, WS_CTL); T[200 + C.tid] = (int)__hip_atomic_load(ctl + CW_CNT + l * 2048 + C.tid * 64, __ATOMIC_RELAXED, __HIP_MEMORY_SCOPE_AGENT); }
    __syncthreads();
    if (C.tid == 0) { int nb = 0;
        for (int e = 0; e < NE; ++e) { const int cnt = T[200 + e]; T[168 + e] = nb; const int nbk = (cnt + 255) >> 8;
            for (int k = 0; k < nbk; ++k) if (nb + k < MAXBLK) T[nb + k] = e;
            nb += nbk; }
        T[232] = nb < MAXBLK ? nb : MAXBLK; }
    __syncthreads();
    return T[232];
}

__device__ __forceinline__ void ph_post2(Ctx& C, int l, int nrows) {
    const bool last = (l == 1);
    (void)moe_tables(C, l);
    const LAS int* T = (const LAS int*)(C.lds + LDS_TAB);
    LAS float* PAR = (LAS float*)C.lds;
    const int r0 = (int)(((long)C.bid * nrows) / C.G), r1 = (int)(((long)(C.bid + 1) * nrows) / C.G);
    int cur_mrow = -1;
    for (int rb = r0 & ~7; rb < r1; rb += 8) {
        const int mrow = rb < NLAT ? rb / SL : 4; const float* mod = WSP(float, WS_MOD) + (size_t)(l * 5 + mrow) * 12288;
        if (mrow != cur_mrow) { const float* modn = WSP(float, WS_MOD) + (size_t)((last ? l : l + 1) * 5 + mrow) * 12288;
            __syncthreads(); stage2048(C, PAR, mod + 10240); stage2048(C, PAR + 2048, INP(I_LN2G) + l * DM); stage2048(C, PAR + 4096, INP(I_LN2B) + l * DM); stage2048(C, PAR + 6144, modn + 2048); stage2048(C, PAR + 8192, modn); cur_mrow = mrow; __syncthreads(); }
        const int row = rb + C.wave;
        if (row >= r0 && row < r1) {
        const int4 ti = WSP(int4, WS_TOKINFO)[row]; const f32x2 tw = WSP(f32x2, WS_TOKW)[row];
        const int s0 = T[168 + ti.x] * 256 + ti.y, s1 = T[168 + ti.z] * 256 + ti.w;
        const unsigned char* y0 = WSP(unsigned char, WS_YS) + (size_t)s0 * DM; const unsigned char* y1 = WSP(unsigned char, WS_YS) + (size_t)s1 * DM;
        float v[32], g2[32]; row_load_bf16(WSP(bf16, WS_X) + (size_t)row * DM, C.lane, v); row_load_lds(PAR, C.lane, g2);
#pragma unroll
        for (int j = 0; j < 4; ++j) { float a[8], b[8]; cvt8_fp8(*(const u32x2*)(y0 + 512 * j + 8 * C.lane), a); cvt8_fp8(*(const u32x2*)(y1 + 512 * j + 8 * C.lane), b);
#pragma unroll
            for (int e = 0; e < 8; ++e) v[8 * j + e] = ALPHA * v[8 * j + e] + g2[8 * j + e] * ((tw.x * 0.0625f) * a[e] + (tw.y * 0.0625f) * b[e]); }
        row_ln(v); row_affine_lds(v, PAR + 2048, PAR + 4096, C.lane, 0.f);
        if (last) { row_store((float*)(C.out + (size_t)row * DM), C.lane, v); }
        else { row_store_bf16(WSP(bf16, WS_X) + (size_t)row * DM, C.lane, v);
            row_ln(v); row_affine_lds(v, PAR + 6144, PAR + 8192, C.lane, 1.0f);
            if (FP8_IN) row_store_fp8(WSP(unsigned char, WS_HA8) + (size_t)row * DM, C.lane, v); else row_store_bf16(WSP(bf16, WS_HB) + (size_t)row * DM, C.lane, v); }
        }
    }
}

constexpr int N_PHASES = 20;
__global__ void __launch_bounds__(512, 2) fwd_kernel(Args args) {
    extern __shared__ __attribute__((aligned(16))) unsigned char lds_raw[];
    Ctx C0; C0.lds = (LAS unsigned char*)lds_raw; C0.tid = threadIdx.x; C0.lane = C0.tid & 63; C0.wave = __builtin_amdgcn_readfirstlane(C0.tid >> 6); C0.bid = blockIdx.x; C0.G = gridDim.x;
    C0.in = (const float GAS* const __attribute__((address_space(4)))*)((const __attribute__((address_space(4))) Args*)__builtin_amdgcn_kernarg_segment_ptr())->in; C0.out = (float GAS*)args.out; C0.ws = (unsigned char GAS*)args.ws;
    volatile LAS unsigned* MISC = (volatile LAS unsigned*)(C0.lds + LDS_MISC);
    if (C0.tid < 4) MISC[C0.tid] = 0u;
    __syncthreads();
    XcdBarrier bar; bar.bar = (unsigned*)(unsigned GAS*)(C0.ws + WS_CTL) + CW_BAR; bar.x = 0; bar.st = nullptr;
    const int lo = args.ph_lo, hi = args.ph_hi;
    if (hi - lo > 1) bar = xcd_barrier_post((unsigned*)(unsigned GAS*)(C0.ws + WS_CTL) + CW_BAR, MISC);
#ifdef ONLY
#define IN(k) ((k) == ONLY)
#define INL(j) ((j) + 2 == ONLY)
#define SEAM(k) do { } while (0)
#else
#define IN(k) (lo <= (k) && (k) < hi)
#define INL(j) IN(pb + (j))
#define SEAM(k) do { if (IN(k) && IN((k) + 1)) xcd_barrier(bar); } while (0)
#endif

    if (IN(0)) { _Pragma("unroll") for (int rep = 0; rep < NREP(0); ++rep) { if (rep) xcd_barrier(bar); FRESH(D, C0);
        if (D.bid & 1) { p0_filters(D); p0_adaln(D); } else { p0_adaln(D); p0_filters(D); }        p0_rope(D); __syncthreads(); p0_convert(D, 0, NBP); } }
    SEAM(0);
    if (IN(1)) { _Pragma("unroll") for (int rep = 0; rep < NREP(1); ++rep) { if (rep) xcd_barrier(bar); FRESH(D, C0); ph_ln_mod(D, 0, NTOK); } }
    SEAM(1);
#define LAYER_BODY(l) do { \
        const int pb = 2 + 9 * l; const bool last = (l == 1); const int nrows = last ? NLAT : NTOK; \
        if (INL(0)) { _Pragma("unroll") for (int rep = 0; rep < NREP(2 + 9 * l + 0); ++rep) { if (rep) xcd_barrier(bar); \
            FRESH(C, C0); \
            pg8::Gemm g{FP8_IN ? (const bf16*)WSP(unsigned char, WS_HA8) : WSP(bf16, WS_HB), FP8_IN ? (const bf16*)(WSP(unsigned char, WS_WIN) + (size_t)l * INW * DM) : WSP(bf16, WS_WIN) + (size_t)l * INW * DM, FP8_IN ? DM / 2 : DM}; \
            pg8::DenseOrder S; S.init(NTOK, INW, C.G, C.bid); \
            pg8::EpiBf16 E{WSP(bf16, WS_Z), INW, 11}; \
            pg8::gemm_phase<pg8::EpiBf16, pg8::DenseOrder, false, FP8_IN != 0>(C.lds, g, S, E); \
        } \
        } SEAM(pb + 0); \
        if (INL(1)) { _Pragma("unroll") for (int rep = 0; rep < NREP(2 + 9 * l + 1); ++rep) { if (rep) xcd_barrier(bar); \
            const int n_attn = last ? 256 : 272, n_gmlp = last ? 256 : 272, n_pool = last ? 512 : 544, n_hyp = last ? 1536 : 1632; \
            { FRESH(C, C0); \
                \
              volatile LAS int* qn = (volatile LAS int*)(C.lds + LDS_MISC + 32); \
              unsigned* qctr = WSP(unsigned, WS_CTL) + CW_QUEUE + (l * 2 + rep) * 64; \
              const int b0 = 256, b1 = b0 + n_gmlp, b2 = b1 + (n_attn - 256), b3 = b2 + n_pool, total = b3 + n_hyp; \
              volatile LAS int* qc = (volatile LAS int*)(C.lds + LDS_MISC + 36); \
              unsigned* cctr = WSP(unsigned, WS_CTL) + CW_QUEUE + (4 + rep) * 64; \
              int u = C.bid, cu = (last || C.bid >= CONV_SPLIT) ? NCU : C.bid;        \
              while (u < total || cu < NCU) { \
                  int nxt = total, nxc = NCU; \
                  if (C.tid == 0) { if (u < total) nxt = (int)atomicAdd(qctr, 1u) + C.G; if (cu < NCU) { nxc = (int)atomicAdd(cctr, 1u) + C.G; if (nxc >= CONV_SPLIT) nxc = NCU; } } \
                  if (u < total) { FRESH(Cu, C); if (u < b0) attn_unit(Cu, l, u); else if (u < b1) gmlp_unit(Cu, l, u - b0); else if (u < b2) attn_unit(Cu, l, 256 + u - b1); else if (u < b3) pool_unit(Cu, l, u - b2); else hyprep_unit(Cu, l, u - b3); } \
                  if (cu < NCU) { FRESH(Cu, C); conv_unit(Cu, 1, cu * UB); } \
                  __syncthreads(); if (C.tid == 0) { *qn = nxt; *qc = nxc; } __syncthreads(); u = __builtin_amdgcn_readfirstlane(*qn); cu = __builtin_amdgcn_readfirstlane(*qc); \
              } } \
        } \
        } SEAM(pb + 1); \
        if (INL(2)) { _Pragma("unroll") for (int rep = 0; rep < NREP(2 + 9 * l + 2); ++rep) { if (rep) xcd_barrier(bar); \
            { FRESH(C, C0);        \
              volatile LAS int* qc = (volatile LAS int*)(C.lds + LDS_MISC + 36); \
              unsigned* cctr = WSP(unsigned, WS_CTL) + CW_QUEUE + (6 + 2 * l + rep) * 64; \
              const int nhu = (rep && PROBE_CONV == 1) ? 0 : (last ? 512 : 1024), ncu = (rep && PROBE_CONV == 2) ? 0 : (last ? NCU_E : NCU_E + NCU_P - TAILQ); \
                \
              const int quota = (ncu + C.G - 1) / C.G, cls = C.bid % 3; \
              int hu = C.bid, cu = C.bid, nh = 0, nc = 0; \
              while (hu < nhu || cu < ncu) { \
                  const bool cv = cu < ncu && (hu >= nhu || (nc < quota && (cls == 0 || (cls == 1 && nh >= 1)))); \
                  if (cv) { \
                      int nxc = ncu; if (C.tid == 0) nxc = (int)atomicAdd(cctr, 1u) + C.G; \
                      { FRESH(Cu, C); bg_conv_unit(Cu, l, cu); } \
                      __syncthreads(); if (C.tid == 0) *qc = nxc; __syncthreads(); cu = __builtin_amdgcn_readfirstlane(*qc); ++nc; \
                  } else { FRESH(Cu, C); if (hu < 512) hyena_unit<SL>(Cu, l, hu); else hyena_unit<CL>(Cu, l, hu - 512); hu += C.G; ++nh; } \
              } } \
        } \
        } SEAM(pb + 2); \
        if (INL(3)) { _Pragma("unroll") for (int rep = 0; rep < NREP(2 + 9 * l + 3); ++rep) { if (rep) xcd_barrier(bar); FRESH(C, C0); rms_stage_gain(C, l); for (int u = C.bid; u < nrows / 32; u += C.G) { FRESH(Cu, C); rms_unit(Cu, l, u); } } \
        } SEAM(pb + 3); \
        if (INL(4)) { _Pragma("unroll") for (int rep = 0; rep < NREP(2 + 9 * l + 4); ++rep) { if (rep) xcd_barrier(bar); \
            FRESH(C, C0); \
            pg8::Gemm g{FP8_OUT ? (const bf16*)WSP(unsigned char, WS_HA8) : WSP(bf16, WS_HB), FP8_OUT ? (const bf16*)(WSP(unsigned char, WS_WOUT) + (size_t)l * DM * DM) : WSP(bf16, WS_WOUT) + (size_t)l * DM * DM, FP8_OUT ? DM / 2 : DM}; \
            pg8::DenseOrder S; S.init(nrows, DM, C.G, C.bid); \
            pg8::EpiBf16 E{WSP(bf16, WS_YO), DM, 1 << 30}; \
            pg8::gemm_phase<pg8::EpiBf16, pg8::DenseOrder, false, FP8_OUT != 0>(C.lds, g, S, E); \
            if (!last && rep == 0 && TAILQ > 0) {        \
                FRESH(Ct, C0); \
                volatile LAS int* qc = (volatile LAS int*)(Ct.lds + LDS_MISC + 36); \
                unsigned* tctr = WSP(unsigned, WS_CTL) + CW_QUEUE + 12 * 64; \
                for (;;) { \
                    __syncthreads(); if (Ct.tid == 0) *qc = NCU_E + NCU_P - TAILQ + (int)atomicAdd(tctr, 1u); __syncthreads(); \
                    const int cu = __builtin_amdgcn_readfirstlane(*qc); if (cu >= NCU_E + NCU_P) break; \
                    FRESH(Cu, Ct); bg_conv_unit(Cu, 0, cu); \
                } } \
        } \
        } SEAM(pb + 4); \
        if (INL(5)) { FRESH(C, C0); ph_post1(C, l, nrows); if (PROBE_P1 && l == 0) { xcd_barrier(bar); FRESH(C2, C0); ph_post1(C2, l, nrows, true); } } \
        SEAM(pb + 5); \
        if (INL(6)) { _Pragma("unroll") for (int rep = 0; rep < NREP(2 + 9 * l + 6); ++rep) { if (rep) xcd_barrier(bar); \
            FRESH(C, C0); \
            const int nblk = moe_tables(C, l); const LAS int* T = (const LAS int*)(C.lds + LDS_TAB); \
            pg8::Gemm g{(const bf16*)WSP(unsigned char, WS_HB8), (const bf16*)(WSP(unsigned char, WS_WGU) + (size_t)l * NE * 1536 * DM), DM / 2}; \
            pg8::MoeOrder S; S.nblk = nblk; S.nN = 6; S.G = C.G; S.c = C.bid; S.blk_e = T; S.bst = T + 168; S.cnt = T + 200; S.exptok = WSP(int, WS_EXPTOK); S.ntok = NTOK; \
            pg8::EpiGLU E{WSP(unsigned char, WS_HG), DE}; \
            pg8::gemm_phase<pg8::EpiGLU, pg8::MoeOrder, true, true>(C.lds, g, S, E); \
        } } \
        SEAM(pb + 6); \
        if (INL(7)) { _Pragma("unroll") for (int rep = 0; rep < NREP(2 + 9 * l + 7); ++rep) { if (rep) xcd_barrier(bar); \
            FRESH(C, C0); \
            const int nblk = moe_tables(C, l); const LAS int* T = (const LAS int*)(C.lds + LDS_TAB); \
            pg8::Gemm g{(const bf16*)WSP(unsigned char, WS_HG), (const bf16*)(WSP(unsigned char, WS_WD) + (size_t)l * NE * DM * DE), DE / 2}; \
            pg8::MoeOrder S; S.nblk = nblk; S.nN = 8; S.G = C.G; S.c = C.bid; S.blk_e = T; S.bst = T + 168; S.cnt = T + 200; S.exptok = WSP(int, WS_EXPTOK); S.ntok = NTOK; \
            pg8::EpiFp8 E{WSP(unsigned char, WS_YS), DM, 16.0f}; \
            pg8::gemm_phase<pg8::EpiFp8, pg8::MoeOrder, false, true>(C.lds, g, S, E); \
        } } \
        SEAM(pb + 7); \
        if (INL(8)) { FRESH(C, C0); ph_post2(C, l, nrows); if (PROBE_P2 && l == 1) { xcd_barrier(bar); FRESH(C2, C0); ph_post2(C2, l, nrows); } } \
        SEAM(pb + 8); \
} while (0)
    LAYER_BODY(0);
    LAYER_BODY(1);
#undef IN
#undef INL
#undef SEAM
}

extern "C" void kernel_launch(void* const* d_in, const int* in_sizes, int n_in, void* d_out, int out_size, void* d_ws, size_t ws_size, hipStream_t stream) {
    static int grid = 0;
    if (grid == 0) {
        if (n_in != 35 || out_size != NLAT * DM || ws_size < WS_END) { fprintf(stderr, "kernel_launch: unexpected shapes (n_in %d out %d ws %zu)\n", n_in, out_size, ws_size); grid = -1; return; }
        int dev = 0, cus = 0;
        if (hipGetDevice(&dev) != hipSuccess || hipDeviceGetAttribute(&cus, hipDeviceAttributeMultiprocessorCount, dev) != hipSuccess) { grid = -1; return; }
        if (hipFuncSetAttribute((const void*)fwd_kernel, hipFuncAttributeMaxDynamicSharedMemorySize, LDS_BYTES) != hipSuccess) { fprintf(stderr, "kernel_launch: hipFuncSetAttribute failed\n"); grid = -1; return; }
        int per_cu = 0;
        if (hipOccupancyMaxActiveBlocksPerMultiprocessor(&per_cu, (const void*)fwd_kernel, 512, LDS_BYTES) != hipSuccess || per_cu < 1) fprintf(stderr, "kernel_launch: occupancy query says %d\n", per_cu);
        (void)hipGetLastError();
        grid = cus;
    }
    if (grid < 0) return;
    (void)hipMemsetAsync((char*)d_ws + WS_CTL, 0, CTL_ZERO_BYTES, stream);
    Args a{};
    for (int i = 0; i < 35; ++i) a.in[i] = (const float*)d_in[i];
    a.out = (float*)d_out; a.ws = (unsigned char*)d_ws;
    if (MK_N_LAUNCHES == 1) { a.ph_lo = 0; a.ph_hi = N_PHASES; hipLaunchKernelGGL(fwd_kernel, dim3(grid), dim3(512), LDS_BYTES, stream, a); }
    else for (int p = 0; p < N_PHASES; ++p) { a.ph_lo = p; a.ph_hi = p + 1; hipLaunchKernelGGL(fwd_kernel, dim3(grid), dim3(512), LDS_BYTES, stream, a); }
}
```

```cpp
#include <hip/hip_runtime.h>
#include <cstdio>
#include <cstdint>

#ifndef DUP_MASK
#define DUP_MASK 0u
#endif
#ifndef PROBE_P1
#define PROBE_P1 0
#endif
#ifndef PROBE_P2
#define PROBE_P2 0
#endif
#ifndef FP8_IN
#define FP8_IN 1
#endif
#ifndef FP8_OUT
#define FP8_OUT 1
#endif
#ifndef PROBE_P0
#define PROBE_P0 0
#endif
#ifndef PROBE_CONV
#define PROBE_CONV 0
#endif
#ifndef DUP_SUB
#define DUP_SUB 0u
#endif
#define NSUB(k) (((DUP_SUB >> (k)) & 1u) ? 2 : 1)
#define NREP(k) (((DUP_MASK >> (k)) & 1u) ? 2 : 1)
#ifndef MK_N_LAUNCHES
#define MK_N_LAUNCHES 1
#endif

#define LAS __attribute__((address_space(3)))
#define GAS __attribute__((address_space(1)))
typedef unsigned short bf16;
typedef short bf16x8 __attribute__((ext_vector_type(8)));
typedef float f32x2 __attribute__((ext_vector_type(2)));
typedef float f32x4 __attribute__((ext_vector_type(4)));
typedef float f32x16 __attribute__((ext_vector_type(16)));
typedef unsigned u32x2 __attribute__((ext_vector_type(2)));
typedef unsigned u32x4 __attribute__((ext_vector_type(4)));
typedef __bf16 bf16x2_t __attribute__((ext_vector_type(2)));

constexpr int DM = 2048, NB = 4, SL = 4096, CL = 256, NLAT = NB * SL, NCTX = NB * CL, NTOK = NLAT + NCTX;
constexpr int INW = 3840, DE = 768, NE = 32, MAXBLK = 168;
constexpr float LN_EPS = 1e-6f, ALPHA = 1.41421356237f, LOG2E = 1.44269504089f;

constexpr size_t MiB = 1u << 20;
constexpr size_t WS_CTL = 0, CTL_ZERO_BYTES = 1 * MiB;
constexpr size_t WS_MOD = 1 * MiB;
constexpr size_t WS_ROPE = 2 * MiB;
constexpr size_t WS_TOKINFO = 2 * MiB + 65536;
constexpr size_t WS_TOKW = WS_TOKINFO + (size_t)NTOK * 16;
constexpr size_t WS_ROWSLOT = WS_TOKW + (size_t)NTOK * 8;
constexpr size_t WS_SLOTW = WS_ROWSLOT + (size_t)NTOK * 8;
static_assert(WS_SLOTW + 43008 * 4 <= 4 * MiB, "small tables");
constexpr size_t WS_POOLWT = 3 * MiB;
constexpr size_t WS_GWSB = 3 * MiB + 512 * 1024;
constexpr size_t WS_WIN = 4 * MiB;
constexpr size_t WS_WOUT = 34 * MiB;
constexpr size_t WS_WGU = 50 * MiB;
constexpr size_t WS_WD = 434 * MiB;
constexpr size_t WS_FILT = 626 * MiB;
constexpr size_t WS_FILTC = 658 * MiB;
constexpr size_t WS_X = 660 * MiB;
constexpr size_t WS_HB = 796 * MiB;
constexpr size_t WS_Z = 864 * MiB;
constexpr size_t WS_YCAT = 992 * MiB;
constexpr size_t WS_TL = 1060 * MiB;
constexpr size_t WS_TC = 1108 * MiB;
constexpr size_t WS_YHT = 1112 * MiB;
constexpr size_t WS_YO = 1129 * MiB;
constexpr size_t WS_EXPTOK = 864 * MiB;
constexpr size_t WS_HG = 1032 * MiB;
constexpr size_t WS_YS = 1095 * MiB;
constexpr size_t WS_HB8 = 1265 * MiB;
constexpr size_t WS_HA8 = 1300 * MiB;
constexpr size_t WS_END = 1334 * MiB;
constexpr int CW_BAR = 4096;
constexpr int CW_CNT = 8192;
constexpr int CW_QUEUE = 14336;
constexpr int CW_NBLK = 12288;
constexpr int CW_BLKE = 12544;
constexpr int LDS_TAB = 132096;
constexpr int LDS_BYTES = 147456;
constexpr int LDS_MISC = 147392;

__device__ __forceinline__ unsigned pk2(float lo, float hi) { f32x2 v = {lo, hi}; bf16x2_t b = __builtin_convertvector(v, bf16x2_t); return __builtin_bit_cast(unsigned, b); }
__device__ __forceinline__ unsigned pk4_fp8(float a, float b, float c, float d) { int p = 0; p = __builtin_amdgcn_cvt_pk_fp8_f32(a, b, p, false); p = __builtin_amdgcn_cvt_pk_fp8_f32(c, d, p, true); return (unsigned)p; }
__device__ __forceinline__ float bflo(unsigned w) { return __uint_as_float(w << 16); }
__device__ __forceinline__ float bfhi(unsigned w) { return __uint_as_float(w & 0xffff0000u); }
__device__ __forceinline__ float bf1(bf16 v) { return __uint_as_float(((unsigned)v) << 16); }
template <int CTRL> __device__ __forceinline__ float dpp_f(float x) { return __int_as_float(__builtin_amdgcn_update_dpp(0, __float_as_int(x), CTRL, 0xF, 0xF, true)); }
#define DPP_XOR1 0xB1
#define DPP_XOR2 0x4E
#define DPP_HMIRROR 0x141
#define DPP_MIRROR 0x140
#define DPP_ROR8 0x128
__device__ __forceinline__ float xor16_sum(float x) { const auto r = __builtin_amdgcn_permlane16_swap(__float_as_uint(x), __float_as_uint(x), false, false); return __uint_as_float(r[0]) + __uint_as_float(r[1]); }
__device__ __forceinline__ float xor32_sum(float x) { const auto r = __builtin_amdgcn_permlane32_swap(__float_as_uint(x), __float_as_uint(x), false, false); return __uint_as_float(r[0]) + __uint_as_float(r[1]); }
__device__ __forceinline__ float xor32_max(float x) { const auto r = __builtin_amdgcn_permlane32_swap(__float_as_uint(x), __float_as_uint(x), false, false); return fmaxf(__uint_as_float(r[0]), __uint_as_float(r[1])); }
__device__ __forceinline__ float row16_sum(float v) { v += dpp_f<DPP_XOR1>(v); v += dpp_f<DPP_XOR2>(v); v += dpp_f<DPP_HMIRROR>(v); v += dpp_f<DPP_MIRROR>(v); return v; }
__device__ __forceinline__ float wave_sum(float v) { return xor32_sum(xor16_sum(row16_sum(v))); }
__device__ __forceinline__ float gelu_tanh(float x) { const float y = 0.7978845608f * (x + 0.044715f * x * x * x); const float t = __expf(2.0f * y); return 0.5f * x * (2.0f - 2.0f * __builtin_amdgcn_rcpf(t + 1.0f)); }
__device__ __forceinline__ float silu_f(float x) { return x * __builtin_amdgcn_rcpf(1.0f + __expf(-x)); }
#define LDS_WAIT() asm volatile("s_waitcnt lgkmcnt(0)" ::: "memory")
#define VM_WAIT() asm volatile("s_waitcnt vmcnt(0)" ::: "memory")

namespace pg8 {
#define PG8_LAS __attribute__((address_space(3)))
typedef unsigned short bf16_t;
constexpr int BM = 256, BK = 64, HALF = 128, HTB = HALF * BK * 2, STAGE_BYTES = 8 * HTB, NXCD = 8, WGM = 8;
__host__ __device__ __forceinline__ int lds_byte(int r, int c) { const int st = (r >> 4) * 2 + (c >> 5), rr = r & 15, cc = c & 31, ob = rr * 64 + cc * 2; return st * 1024 + (ob ^ (((ob >> 9) & 1) << 5)); }
__host__ __device__ __forceinline__ void stage_rc(int b, int& R, int& C) { const int st = b / 1024, sb = b % 1024, swz = sb ^ (((sb >> 9) & 1) << 5); R = (st >> 1) * 16 + swz / 64; C = (st & 1) * 32 + (swz % 64) / 2; }
__host__ __device__ __forceinline__ int perm32(int rho) { const int n = rho >> 4, i = rho & 15; return 8 * (i >> 2) + 4 * n + (i & 3); }

struct Unit { int pm, pn, pb; const int* amap; int nvalid; };
struct Gemm { const bf16_t* A; const bf16_t* Bt; int K; };

struct DenseOrder {
    int nM, nN, nwg, G, c;
    __device__ void init(int M, int N, int G_, int c_) { nM = M / BM; nN = N / BM; nwg = nM * nN; G = G_; c = c_; }
    __device__ bool next(int i, Unit& u) const {
        const long L = (long)i * G + c; if (L >= nwg) return false;
        int wgid = (int)L; { const int q = nwg / NXCD, r = nwg % NXCD, xcd = wgid % NXCD, off = wgid / NXCD; wgid = (xcd < r ? xcd * (q + 1) : r * (q + 1) + (xcd - r) * q) + off; }
        const int nig = WGM * nN, gid = wgid / nig, fm = gid * WGM, gsz = (nM - fm) < WGM ? (nM - fm) : WGM;
        u.pm = fm + ((wgid % nig) % gsz); u.pn = (wgid % nig) / gsz; u.pb = u.pn; u.amap = nullptr; u.nvalid = 0; return true;
    }
    __device__ __forceinline__ void a_ready(const Unit&) const {}
    __device__ __forceinline__ void done(const Unit&) const {}
};
struct MoeOrder {
    int nblk, nN, G, c; const PG8_LAS int* blk_e; const PG8_LAS int* bst; const PG8_LAS int* cnt; const int* exptok; int ntok;
    __device__ bool next(int i, Unit& u) const {
        const long L = (long)i * G + c; const int nwg = nblk * nN; if (L >= nwg) return false;
        int wgid = (int)L; { const int q = nwg / NXCD, r = nwg % NXCD, xcd = wgid % NXCD, off = wgid / NXCD; wgid = (xcd < r ? xcd * (q + 1) : r * (q + 1) + (xcd - r) * q) + off; }
        const int blk = wgid / nN, pn = wgid % nN, e = blk_e[blk], p0 = (blk - bst[e]) * 256;
        u.pm = blk; u.pn = pn; u.pb = e * nN + pn; u.amap = exptok + (size_t)e * ntok + p0; u.nvalid = cnt[e] - p0; return true;
    }
    __device__ __forceinline__ void a_ready(const Unit&) const {}
    __device__ __forceinline__ void done(const Unit&) const {}
};

struct EpiBf16 {
    static constexpr bool PERM = true;
    bf16_t* O; int ldc; int gelu_from;
    __device__ __forceinline__ void operator()(const f32x4 (&acc)[2][2][4][2], const Unit& u, int wr, int wc, int fr, int fq) const {
        const int row0 = u.pm * BM + wr * 64 + fr; const int col0 = u.pn * BM + wc * 32 + 8 * fq; const bool act = u.pn >= gelu_from;
#pragma unroll
        for (int ai = 0; ai < 2; ++ai)
#pragma unroll
            for (int m = 0; m < 4; ++m) { bf16_t* rowp = O + (size_t)(row0 + ai * HALF + m * 16) * ldc + col0;
#pragma unroll
                for (int bj = 0; bj < 2; ++bj) { f32x4 v0 = acc[ai][bj][m][0], v1 = acc[ai][bj][m][1];
                    if (act) {
#pragma unroll
                        for (int j = 0; j < 4; ++j) { v0[j] = gelu_tanh(v0[j]); v1[j] = gelu_tanh(v1[j]); } }
                    u32x4 w; w.x = pk2(v0[0], v0[1]); w.y = pk2(v0[2], v0[3]); w.z = pk2(v1[0], v1[1]); w.w = pk2(v1[2], v1[3]);
                    *(u32x4*)(rowp + bj * HALF) = w; } }
    }
};
struct EpiFp8 {
    static constexpr bool PERM = true;
    unsigned char* O; int ldc; float scale;
    __device__ __forceinline__ void operator()(const f32x4 (&acc)[2][2][4][2], const Unit& u, int wr, int wc, int fr, int fq) const {
        const int row0 = u.pm * BM + wr * 64 + fr; const int col0 = u.pn * BM + wc * 32 + 8 * fq;
#pragma unroll
        for (int ai = 0; ai < 2; ++ai)
#pragma unroll
            for (int m = 0; m < 4; ++m) { unsigned char* rowp = O + (size_t)(row0 + ai * HALF + m * 16) * ldc + col0;
#pragma unroll
                for (int bj = 0; bj < 2; ++bj) { const f32x4 v0 = acc[ai][bj][m][0] * scale, v1 = acc[ai][bj][m][1] * scale;
                    u32x2 w; w.x = pk4_fp8(v0[0], v0[1], v0[2], v0[3]); w.y = pk4_fp8(v1[0], v1[1], v1[2], v1[3]);
                    *(u32x2*)(rowp + bj * HALF) = w; } }
    }
};
struct EpiF32 {
    static constexpr bool PERM = false;
    float* C; int ldc;
    __device__ __forceinline__ void operator()(const f32x4 (&acc)[2][2][4][2], const Unit& u, int wr, int wc, int fr, int fq) const {
        const int row0 = u.pm * BM + wr * 64 + fr, col0 = u.pn * BM + wc * 32 + 4 * fq;
#pragma unroll
        for (int ai = 0; ai < 2; ++ai)
#pragma unroll
            for (int m = 0; m < 4; ++m) { float* rowp = C + (size_t)(row0 + ai * HALF + m * 16) * ldc + col0;
#pragma unroll
                for (int bj = 0; bj < 2; ++bj)
#pragma unroll
                    for (int n = 0; n < 2; ++n) *(f32x4*)(rowp + bj * HALF + n * 16) = acc[ai][bj][m][n]; }
    }
};
struct EpiGLU {
    static constexpr bool PERM = true;
    unsigned char* O; int ldc;
    __device__ __forceinline__ void operator()(const f32x4 (&acc)[2][2][4][2], const Unit& u, int wr, int wc, int fr, int fq) const {
        const int row0 = u.pm * BM + wr * 64 + fr; const int col0 = u.pn * HALF + wc * 32 + 8 * fq;
#pragma unroll
        for (int ai = 0; ai < 2; ++ai)
#pragma unroll
            for (int m = 0; m < 4; ++m) { unsigned char* rowp = O + (size_t)(row0 + ai * HALF + m * 16) * ldc + col0;
                float o[8];
#pragma unroll
                for (int n = 0; n < 2; ++n)
#pragma unroll
                    for (int j = 0; j < 4; ++j) { const float g = acc[ai][0][m][n][j], up = acc[ai][1][m][n][j]; o[4 * n + j] = (g * __builtin_amdgcn_rcpf(1.0f + __expf(-g))) * up; }
                u32x2 w; w.x = pk4_fp8(o[0], o[1], o[2], o[3]); w.y = pk4_fp8(o[4], o[5], o[6], o[7]);
                *(u32x2*)rowp = w; }
    }
};
struct EpiScaleBf16 {
    static constexpr bool PERM = true;
    bf16_t* O; int ldc; const float* rs;
    __device__ __forceinline__ void operator()(const f32x4 (&acc)[2][2][4][2], const Unit& u, int wr, int wc, int fr, int fq) const {
        const int row0 = u.pm * BM + wr * 64 + fr; const int col0 = u.pn * BM + wc * 32 + 8 * fq;
#pragma unroll
        for (int ai = 0; ai < 2; ++ai)
#pragma unroll
            for (int m = 0; m < 4; ++m) { const int row = row0 + ai * HALF + m * 16; const float s = rs[row]; bf16_t* rowp = O + (size_t)row * ldc + col0;
#pragma unroll
                for (int bj = 0; bj < 2; ++bj) { const f32x4 v0 = acc[ai][bj][m][0] * s, v1 = acc[ai][bj][m][1] * s;
                    u32x4 w; w.x = pk2(v0[0], v0[1]); w.y = pk2(v0[2], v0[3]); w.z = pk2(v1[0], v1[1]); w.w = pk2(v1[2], v1[3]);
                    *(u32x4*)(rowp + bj * HALF) = w; } }
    }
};

typedef int i32x8 __attribute__((ext_vector_type(8)));
typedef int i32x4v __attribute__((ext_vector_type(4)));
template <class Epi, class Sched, bool GATHER = false, bool FP8 = false, bool ALIGN_EPI = true, bool SP2 = true>
__device__ __forceinline__ void gemm_phase(PG8_LAS unsigned char* lds, const Gemm g, const Sched& S, const Epi& E) {
    int tid_ = threadIdx.x; asm volatile("" : "+v"(tid_));
    const int tid = tid_, wid = __builtin_amdgcn_readfirstlane(tid >> 6), lane = tid & 63, wr = wid >> 2, wc = wid & 3, fr = lane & 15, fq = lane >> 4;
    int K_ = g.K; asm volatile("" : "+s"(K_));
    const int K = K_, nt = K / BK;
    unsigned voffA[2], voffB[2];
#pragma unroll
    for (int i = 0; i < 2; ++i) { int R, C; stage_rc(tid * 16 + i * 8192, R, C); const int Rb = Epi::PERM ? ((R & ~31) + perm32(R & 31)) : R;
        voffA[i] = (unsigned)(R * K + C) * 2u; voffB[i] = (unsigned)(Rb * K + C) * 2u; }
    const size_t kstep = (size_t)(BK * 2);
    const size_t hstep = (size_t)HALF * K * 2;
    const size_t tstep = 2 * hstep;
    const unsigned ldsw = (unsigned)wid * 1024u;
    const int aoff = lds_byte(wr * 64 + fr, fq * 8), boff = lds_byte(wc * 32 + fr, fq * 8);
#define PG8_SA(b, h) (((b) * 2 + (h)) * HTB)
#define PG8_SB(b, h) ((4 + (b) * 2 + (h)) * HTB)
#define PG8_STAGE(bufoff, gbase, voff) do { _Pragma("unroll") for (int _i = 0; _i < 2; ++_i) \
        __builtin_amdgcn_global_load_lds((const unsigned*)((const char*)(gbase) + (voff)[_i]), (PG8_LAS unsigned*)(lds + (bufoff) + ldsw + _i * 8192), 16, 0, 0); } while (0)
#define PG8_STAGE_G(bufoff, kbytes, o0, o1) do { \
        __builtin_amdgcn_global_load_lds((const unsigned*)((const char*)g.A + (kbytes) + (o0)), (PG8_LAS unsigned*)(lds + (bufoff) + ldsw), 16, 0, 0); \
        __builtin_amdgcn_global_load_lds((const unsigned*)((const char*)g.A + (kbytes) + (o1)), (PG8_LAS unsigned*)(lds + (bufoff) + ldsw + 8192), 16, 0, 0); } while (0)
#define PG8_LOADMAP(u, O) do { _Pragma("unroll") for (int _h = 0; _h < 2; ++_h) _Pragma("unroll") for (int _i = 0; _i < 2; ++_i) { int _R, _C; stage_rc(tid * 16 + _i * 8192, _R, _C); const int _rr = _h * HALF + _R; \
        int _t = (_rr < (u).nvalid) ? (u).amap[_rr] : 0; _t = ((unsigned)_t < 17408u) ? _t : 0; O[_h][_i] = (unsigned)(_t * K + _C) * 2u; } } while (0)
#define PG8_LD8(p) __builtin_shufflevector(*(const PG8_LAS i32x4v*)(p), *(const PG8_LAS i32x4v*)((p) + 1024), 0, 1, 2, 3, 4, 5, 6, 7)
#define PG8_LDA(dst, b, h) do { if constexpr (FP8) { _Pragma("unroll") for (int m = 0; m < 4; ++m) dst##8[m] = PG8_LD8(lds + PG8_SA(b, h) + aoff + m * 2048); } \
        else { _Pragma("unroll") for (int m = 0; m < 4; ++m) _Pragma("unroll") for (int k = 0; k < 2; ++k) dst[m][k] = *(const PG8_LAS bf16x8*)(lds + PG8_SA(b, h) + aoff + m * 2048 + k * 1024); } } while (0)
#define PG8_LDB(dst, b, h) do { if constexpr (FP8) { _Pragma("unroll") for (int n = 0; n < 2; ++n) dst##8[n] = PG8_LD8(lds + PG8_SB(b, h) + boff + n * 2048); } \
        else { _Pragma("unroll") for (int n = 0; n < 2; ++n) _Pragma("unroll") for (int k = 0; k < 2; ++k) dst[n][k] = *(const PG8_LAS bf16x8*)(lds + PG8_SB(b, h) + boff + n * 2048 + k * 1024); } } while (0)
#define PG8_MMA(ai, bj, At, Bt) do { __builtin_amdgcn_s_setprio(1); \
        if constexpr (FP8) { _Pragma("unroll") for (int m = 0; m < 4; ++m) _Pragma("unroll") for (int n = 0; n < 2; ++n) \
            asm volatile("v_mfma_scale_f32_16x16x128_f8f6f4 %0, %1, %2, %0, %3, %4 op_sel_hi:[0,0,0]" : "+v"(acc[ai][bj][m][n]) : "v"(Bt##8[n]), "v"(At##8[m]), "v"(sc_w), "v"(sc_x)); } \
        else { _Pragma("unroll") for (int m = 0; m < 4; ++m) _Pragma("unroll") for (int n = 0; n < 2; ++n) _Pragma("unroll") for (int k = 0; k < 2; ++k) \
            acc[ai][bj][m][n] = __builtin_amdgcn_mfma_f32_16x16x32_bf16(Bt[n][k], At[m][k], acc[ai][bj][m][n], 0, 0, 0); } \
        __builtin_amdgcn_s_setprio(0); } while (0)
#define PG8_WAIT_V(n) asm volatile("s_waitcnt vmcnt(" #n ")" ::: "memory")
#define PG8_WAIT_L(n) asm volatile("s_waitcnt lgkmcnt(" #n ")" ::: "memory")
#define PG8_BAR __builtin_amdgcn_s_barrier()
#define PG8_SCHED __builtin_amdgcn_sched_barrier(0)
    Unit cur, nxt; int ui = 0;
    if (!S.next(0, cur)) return;
    f32x4 acc[2][2][4][2];
#pragma unroll
    for (int a = 0; a < 2; ++a)
#pragma unroll
        for (int b = 0; b < 2; ++b)
#pragma unroll
            for (int m = 0; m < 4; ++m)
#pragma unroll
                for (int n = 0; n < 2; ++n) acc[a][b][m][n] = (f32x4){0.f, 0.f, 0.f, 0.f};
    bf16x8 At[4][2], B0[2][2], B1[2][2]; i32x8 At8[4], B08[2], B18[2];
    const int sc_w = 0x79797979, sc_x = 0x7f7f7f7f;
    const char* cA = (const char*)g.A + (size_t)cur.pm * tstep; const char* cB = (const char*)g.Bt + (size_t)cur.pb * tstep;
    unsigned cO[2][2] = {{0u, 0u}, {0u, 0u}}, nO[2][2] = {{0u, 0u}, {0u, 0u}};
    S.a_ready(cur);
    if constexpr (GATHER) { static_assert(SP2, "GATHER needs the SP2 loop"); PG8_LOADMAP(cur, cO); }
    if constexpr (SP2) {
        PG8_STAGE(PG8_SB(0, 0), cB, voffB); PG8_STAGE(PG8_SB(0, 1), cB + hstep, voffB);
        if constexpr (GATHER) { PG8_STAGE_G(PG8_SA(0, 0), 0, cO[0][0], cO[0][1]); PG8_STAGE_G(PG8_SA(0, 1), 0, cO[1][0], cO[1][1]); }
        else { PG8_STAGE(PG8_SA(0, 0), cA, voffA); PG8_STAGE(PG8_SA(0, 1), cA + hstep, voffA); }
        if (wr == 1) PG8_BAR;
        PG8_WAIT_V(2); PG8_BAR;
        PG8_STAGE(PG8_SB(1, 0), cB + kstep, voffB);
        if constexpr (GATHER) PG8_STAGE_G(PG8_SA(1, 0), kstep, cO[0][0], cO[0][1]); else PG8_STAGE(PG8_SA(1, 0), cA + kstep, voffA);
        PG8_STAGE(PG8_SB(1, 1), cB + hstep + kstep, voffB);
        PG8_WAIT_V(6); PG8_BAR;
    } else {
        PG8_STAGE(PG8_SB(0, 0), cB, voffB); PG8_STAGE(PG8_SA(0, 0), cA, voffA); PG8_STAGE(PG8_SB(0, 1), cB + hstep, voffB); PG8_STAGE(PG8_SA(0, 1), cA + hstep, voffA);
        if (wr == 1) PG8_BAR;
        PG8_WAIT_V(4); PG8_BAR;
        PG8_STAGE(PG8_SB(1, 0), cB + kstep, voffB); PG8_STAGE(PG8_SA(1, 0), cA + kstep, voffA); PG8_STAGE(PG8_SB(1, 1), cB + hstep + kstep, voffB);
        PG8_WAIT_V(6); PG8_BAR;
    }
    for (;;) {
        const bool has_next = S.next(ui + 1, nxt);
        const char* nA = has_next ? (const char*)g.A + (size_t)nxt.pm * tstep : cA; const char* nB = has_next ? (const char*)g.Bt + (size_t)nxt.pb * tstep : cB;
        if constexpr (GATHER) { if (has_next) PG8_LOADMAP(nxt, nO); else {
#pragma unroll
            for (int _h = 0; _h < 2; ++_h) { nO[_h][0] = cO[_h][0]; nO[_h][1] = cO[_h][1]; } } }
#pragma unroll 1
        for (int t = 0; t < nt; t += 2) {
            const bool last = (t == nt - 2);
            const char* a1 = cA + (size_t)(t + 1) * kstep;
            const char* a2 = last ? nA : cA + (size_t)(t + 2) * kstep; const char* b2 = last ? nB : cB + (size_t)(t + 2) * kstep;
            const char* a3 = a2 + kstep; const char* b3 = b2 + kstep;
            if (last && has_next) S.a_ready(nxt);
            if constexpr (SP2) {
            const size_t k1 = (size_t)(t + 1) * kstep, k2 = last ? (size_t)0 : (size_t)(t + 2) * kstep, k3 = k2 + kstep;
            const unsigned g00 = last ? nO[0][0] : cO[0][0], g01 = last ? nO[0][1] : cO[0][1], g10 = last ? nO[1][0] : cO[1][0], g11 = last ? nO[1][1] : cO[1][1];
            PG8_LDB(B0, 0, 0); PG8_LDB(B1, 0, 1); PG8_SCHED; PG8_LDA(At, 0, 0);
            if constexpr (GATHER) PG8_STAGE_G(PG8_SA(1, 1), k1, cO[1][0], cO[1][1]); else PG8_STAGE(PG8_SA(1, 1), a1 + hstep, voffA);
            PG8_WAIT_V(8); PG8_WAIT_L(0); PG8_BAR; PG8_MMA(0, 0, At, B0); PG8_MMA(0, 1, At, B1); PG8_BAR; PG8_SCHED;
            PG8_LDA(At, 0, 1); PG8_STAGE(PG8_SB(0, 0), b2, voffB); PG8_STAGE(PG8_SB(0, 1), b2 + hstep, voffB);
            if constexpr (GATHER) PG8_STAGE_G(PG8_SA(0, 0), k2, g00, g01); else PG8_STAGE(PG8_SA(0, 0), a2, voffA);
            PG8_WAIT_V(8); PG8_WAIT_L(0); PG8_BAR; PG8_MMA(1, 0, At, B0); PG8_MMA(1, 1, At, B1); PG8_BAR; PG8_SCHED;
            PG8_LDB(B0, 1, 0); PG8_LDB(B1, 1, 1); PG8_SCHED; PG8_LDA(At, 1, 0);
            if constexpr (GATHER) PG8_STAGE_G(PG8_SA(0, 1), k2, g10, g11); else PG8_STAGE(PG8_SA(0, 1), a2 + hstep, voffA);
            PG8_WAIT_V(8); PG8_WAIT_L(0); PG8_BAR; PG8_MMA(0, 0, At, B0); PG8_MMA(0, 1, At, B1); PG8_BAR; PG8_SCHED;
            PG8_LDA(At, 1, 1); PG8_STAGE(PG8_SB(1, 0), b3, voffB); PG8_STAGE(PG8_SB(1, 1), b3 + hstep, voffB);
            if constexpr (GATHER) PG8_STAGE_G(PG8_SA(1, 0), k3, g00, g01); else PG8_STAGE(PG8_SA(1, 0), a3, voffA);
            PG8_WAIT_V(8); PG8_WAIT_L(0); PG8_BAR; PG8_MMA(1, 0, At, B0); PG8_MMA(1, 1, At, B1); PG8_BAR; PG8_SCHED;
            } else {
            PG8_LDB(B0, 0, 0); PG8_SCHED; PG8_LDA(At, 0, 0); PG8_STAGE(PG8_SA(1, 1), a1 + hstep, voffA);
            PG8_WAIT_L(8); PG8_BAR; PG8_WAIT_L(0); PG8_MMA(0, 0, At, B0); PG8_BAR; PG8_SCHED;
            PG8_LDB(B1, 0, 1); PG8_STAGE(PG8_SB(0, 0), b2, voffB);
            PG8_BAR; PG8_WAIT_L(0); PG8_MMA(0, 1, At, B1); PG8_BAR;
            PG8_LDA(At, 0, 1); PG8_STAGE(PG8_SA(0, 0), a2, voffA);
            PG8_BAR; PG8_WAIT_L(0); PG8_MMA(1, 0, At, B0); PG8_BAR; PG8_SCHED;
            PG8_STAGE(PG8_SB(0, 1), b2 + hstep, voffB);
            PG8_WAIT_V(6); PG8_BAR; PG8_MMA(1, 1, At, B1); PG8_BAR;
            PG8_LDB(B0, 1, 0); PG8_SCHED; PG8_LDA(At, 1, 0); PG8_STAGE(PG8_SA(0, 1), a2 + hstep, voffA);
            PG8_WAIT_L(8); PG8_BAR; PG8_WAIT_L(0); PG8_MMA(0, 0, At, B0); PG8_BAR; PG8_SCHED;
            PG8_LDB(B1, 1, 1); PG8_STAGE(PG8_SB(1, 0), b3, voffB);
            PG8_BAR; PG8_WAIT_L(0); PG8_MMA(0, 1, At, B1); PG8_BAR;
            PG8_LDA(At, 1, 1); PG8_STAGE(PG8_SA(1, 0), a3, voffA);
            PG8_BAR; PG8_WAIT_L(0); PG8_MMA(1, 0, At, B0); PG8_BAR; PG8_SCHED;
            PG8_STAGE(PG8_SB(1, 1), b3 + hstep, voffB);
            PG8_WAIT_V(6); PG8_BAR; PG8_MMA(1, 1, At, B1); PG8_BAR;
            }
        }
        if constexpr (ALIGN_EPI) { if (wr == 0) PG8_BAR; }
        if constexpr (FP8) asm volatile("s_nop 15\n\ts_nop 15" ::: "memory");
        E(acc, cur, wr, wc, fr, fq); S.done(cur);
        if (!has_next) break;
#pragma unroll
        for (int a = 0; a < 2; ++a)
#pragma unroll
            for (int b = 0; b < 2; ++b)
#pragma unroll
                for (int m = 0; m < 4; ++m)
#pragma unroll
                    for (int n = 0; n < 2; ++n) acc[a][b][m][n] = (f32x4){0.f, 0.f, 0.f, 0.f};
        cur = nxt; cA = nA; cB = nB; ++ui;
        if constexpr (GATHER) {
#pragma unroll
            for (int _h = 0; _h < 2; ++_h) { cO[_h][0] = nO[_h][0]; cO[_h][1] = nO[_h][1]; } }
        if constexpr (ALIGN_EPI) { if (wr == 1) PG8_BAR; }
    }
    PG8_WAIT_V(0);
    if constexpr (!ALIGN_EPI) { if (wr == 0) PG8_BAR; }
    PG8_BAR;
#undef PG8_SA
#undef PG8_SB
#undef PG8_STAGE
#undef PG8_STAGE_G
#undef PG8_LOADMAP
#undef PG8_LDA
#undef PG8_LDB
#undef PG8_MMA
#undef PG8_LD8
#undef PG8_WAIT_V
#undef PG8_WAIT_L
#undef PG8_BAR
#undef PG8_SCHED
}
}

#define XB_TMO      128
#define XB_XCNT(j)  (256  + 64 * (j))
#define XB_XSUB(j)  (1280 + 64 * (j))
#define XB_XGEN(j)  (2304 + 64 * (j))
#define XB_TOP      3328
#define XB_TOPGEN   3392
#define XCD_BAR_WORDS 3456
#define XB_SPIN_CAP (1u << 18)
__device__ __forceinline__ unsigned xb_ld(unsigned* p)              { return __hip_atomic_load(p, __ATOMIC_RELAXED, __HIP_MEMORY_SCOPE_AGENT); }
__device__ __forceinline__ unsigned xb_add(unsigned* p, unsigned v) { return __hip_atomic_fetch_add(p, v, __ATOMIC_RELAXED, __HIP_MEMORY_SCOPE_AGENT); }
__device__ __forceinline__ unsigned xb_xcc_id() { return (unsigned)__builtin_amdgcn_s_getreg((3 << 11) | 20) & 0xFu; }
#define XB_SPIN(cond, bar) do { unsigned _sp = 0; while (cond) { __builtin_amdgcn_s_sleep(1); \
    if ((++_sp & 255u) == 0u) { if (xb_ld(&(bar)[XB_TMO])) break; if (_sp > XB_SPIN_CAP) { atomicAdd(&(bar)[XB_TMO], 1u); break; } } } } while (0)
struct XcdBarrier { unsigned* bar; unsigned x; volatile LAS unsigned* st; };
__device__ __forceinline__ XcdBarrier xcd_barrier_post(unsigned* bar, volatile LAS unsigned* st) {
    XcdBarrier b; b.bar = bar; b.x = xb_xcc_id(); b.st = st;
    if (threadIdx.x == 0) (void)xb_add(&bar[XB_XCNT(b.x)], 1u);
    return b;
}
__device__ __forceinline__ void xcd_barrier_complete(unsigned* bar, unsigned x, unsigned& nloc, unsigned& nx) {
    const unsigned G = gridDim.x * gridDim.y * gridDim.z;
    unsigned sum, cnt, mine, sp = 0u;
    for (;;) {
        sum = 0u; cnt = 0u; mine = 0u;
#pragma unroll
        for (unsigned j = 0; j < 16; ++j) { const unsigned c = xb_ld(&bar[XB_XCNT(j)]); sum += c; cnt += (c > 0u) ? 1u : 0u; mine = (j == x) ? c : mine; }
        if (sum == G) break;
        __builtin_amdgcn_s_sleep(1);
        if ((++sp & 255u) == 0u) { if (xb_ld(&bar[XB_TMO])) break; if (sp > XB_SPIN_CAP) { atomicAdd(&bar[XB_TMO], 1u); break; } }
    }
    nloc = mine > 0u ? mine : 1u; nx = cnt > 0u ? cnt : 1u;
}
__device__ __forceinline__ void xcd_barrier(const XcdBarrier& b) {
    asm volatile("s_waitcnt vmcnt(0)" ::: "memory");
    __syncthreads();
    if (threadIdx.x == 0) {
        unsigned* bar = b.bar;
        __builtin_amdgcn_s_waitcnt(0);
        unsigned nloc = b.st[0], nx = b.st[1];
        if (nloc == 0u) { xcd_barrier_complete(bar, b.x, nloc, nx); b.st[0] = nloc; b.st[1] = nx; }
        const unsigned old = xb_add(&bar[XB_XSUB(b.x)], 1u);
        const unsigned gen = old / nloc;
        if (old + 1u == (gen + 1u) * nloc) {
            __builtin_amdgcn_fence(__ATOMIC_RELEASE, "agent");
            asm volatile("s_waitcnt vmcnt(0)" ::: "memory");
            const unsigned og = xb_add(&bar[XB_TOP], 1u);
            const unsigned tg = og / nx;
            if (og + 1u == (tg + 1u) * nx) xb_add(&bar[XB_TOPGEN], 1u);
            else XB_SPIN(xb_ld(&bar[XB_TOPGEN]) == tg, bar);
            __builtin_amdgcn_fence(__ATOMIC_ACQUIRE, "agent");
            xb_add(&bar[XB_XGEN(b.x)], 1u);
            asm volatile("s_waitcnt vmcnt(0)" ::: "memory");
        } else {
            XB_SPIN(xb_ld(&bar[XB_XGEN(b.x)]) == gen, bar);
            __builtin_amdgcn_fence(__ATOMIC_ACQUIRE, "agent");
            asm volatile("s_waitcnt vmcnt(0)" ::: "memory");
        }
    }
    __syncthreads();
}

struct Args { const float* in[35]; float* out; unsigned char* ws; int ph_lo, ph_hi; };
enum { I_X = 0, I_C, I_CTX, I_CCTX, I_WADA, I_BADA, I_WIN, I_WOUT, I_MNG, I_POOLW, I_POOLS, I_SINK, I_HCW, I_HCB, I_HW1, I_HB1, I_HF1, I_HW2, I_HB2, I_HF2, I_HW3, I_HSKIP,
       I_GLG, I_GLB, I_GWS, I_GBS, I_LN1G, I_LN1B, I_LN2G, I_LN2B, I_WR, I_RB, I_WG, I_WU, I_WD };
struct Ctx {
    LAS unsigned char* lds; int tid, lane, wave, bid, G;
    const float GAS* const __attribute__((address_space(4)))* in; float GAS* out; unsigned char GAS* ws;
};
#define WSP(T, off) ((T*)(T GAS*)(C.ws + (off)))
#define INP(k) ((const float*)C.in[k])
#define FRESH(D, S) Ctx D = S; asm volatile("" : "+v"(D.tid)); D.lane = D.tid & 63; D.wave = __builtin_amdgcn_readfirstlane(D.tid >> 6); asm volatile("" : "+s"(D.bid), "+s"(D.G), "+s"(D.in), "+s"(D.ws), "+s"(D.out))

struct TrBlk { const float GAS* src; unsigned char GAS* dst; int N, K, nb, which; bool gu; };
constexpr int TRP = 144, TRBUF = 256 * TRP;
#define WG_BAR() do { LDS_WAIT(); __builtin_amdgcn_s_barrier(); asm volatile("" ::: "memory"); } while (0)
constexpr int NBL = 4976, NBP = 368;
__device__ __forceinline__ TrBlk tr_decode(Ctx& C, int L, int j) {
    const bool c0 = j < 240, c1 = !c0 && j < NBP, ce = !c0 && !c1;
    const int q = j - (c0 ? 0 : (c1 ? 240 : NBP));
    const int e = ce ? q / 144 : 0, r = ce ? q % 144 : q;
    const int which = ce ? r / 48 : 0, r2 = ce ? r % 48 : r;
    const bool gu = ce && which < 2, dn = ce && which == 2;
    const int NB = c0 ? 15 : (gu ? 3 : 8), nb = r2 % NB, kb = r2 / NB;
    const int N = c0 ? INW : (gu ? DE : DM), K = dn ? DE : DM;
    const int mat = ce ? L * NE + e : L;
    const float GAS* base = c0 ? C.in[I_WIN] : (c1 ? C.in[I_WOUT] : (which == 0 ? C.in[I_WG] : (which == 1 ? C.in[I_WU] : C.in[I_WD])));
    const size_t wsoff = c0 ? WS_WIN : (c1 ? WS_WOUT : (gu ? WS_WGU : WS_WD));
    const int nrows = c0 ? INW : (gu ? 1536 : DM);
    TrBlk t; t.N = N; t.K = K; t.nb = nb; t.which = which; t.gu = gu;
    t.src = base + (size_t)mat * K * N + (size_t)(128 * kb) * N + 256 * nb;
    t.dst = C.ws + wsoff + (size_t)mat * nrows * K + 128 * kb;
    return t;
}
__device__ __forceinline__ void tr_load(const TrBlk& t, int wave, int lane, f32x4 (&v)[16]) {
#pragma unroll
    for (int i = 0; i < 16; ++i) v[i] = __builtin_nontemporal_load((const f32x4 GAS*)((const char GAS*)t.src + (size_t)(16 * wave + i) * t.N * 4 + 16u * lane));
}
__device__ __forceinline__ void tr_pack(LAS unsigned char* buf, int wave, int lane, const f32x4 (&v)[16]) {
#pragma unroll
    for (int j = 0; j < 4; ++j) { u32x4 o;
#pragma unroll
        for (int w = 0; w < 4; ++w) o[w] = pk4_fp8(64.f * v[4 * w][j], 64.f * v[4 * w + 1][j], 64.f * v[4 * w + 2][j], 64.f * v[4 * w + 3][j]);
        *(LAS u32x4*)(buf + (4 * lane + j) * TRP + 16 * wave) = o; }
}
__device__ __forceinline__ void tr_flush(const TrBlk& t, const LAS unsigned char* buf, int wave, int lane) {
#pragma unroll
    for (int tt = 0; tt < 4; ++tt) { const int nl = 32 * wave + 8 * tt + (lane >> 3), n = 256 * t.nb + nl;
        const u32x4 o = *(const LAS u32x4*)(buf + nl * TRP + 16 * (lane & 7));
        const int drow = t.gu ? ((n >> 7) * 256 + (n & 127) + 128 * t.which) : n;
        __builtin_nontemporal_store(o, (u32x4 GAS*)(t.dst + (size_t)drow * t.K + 16 * (lane & 7))); }
}
template <int NBK> __device__ __forceinline__ void tr_blocks(Ctx& C, int L, int b0) {
    f32x4 r0[16], r1[16], r2[16];
    LAS unsigned char* buf0 = C.lds; LAS unsigned char* buf1 = C.lds + TRBUF;
    const TrBlk t0 = tr_decode(C, L, b0), t1 = tr_decode(C, L, b0 + (NBK > 1 ? 1 : 0)), t2 = tr_decode(C, L, b0 + (NBK > 2 ? 2 : 0)), t3 = tr_decode(C, L, b0 + (NBK > 3 ? 3 : 0));
    tr_load(t0, C.wave, C.lane, r0); if (NBK > 1) tr_load(t1, C.wave, C.lane, r1); if (NBK > 2) tr_load(t2, C.wave, C.lane, r2);
    WG_BAR();
    tr_pack(buf0, C.wave, C.lane, r0);
    if (NBK > 3) tr_load(t3, C.wave, C.lane, r0);
    WG_BAR(); tr_flush(t0, buf0, C.wave, C.lane);
    if (NBK > 1) { tr_pack(buf1, C.wave, C.lane, r1); WG_BAR(); tr_flush(t1, buf1, C.wave, C.lane); }
    if (NBK > 2) { tr_pack(buf0, C.wave, C.lane, r2); WG_BAR(); tr_flush(t2, buf0, C.wave, C.lane); }
    if (NBK > 3) { tr_pack(buf1, C.wave, C.lane, r0); WG_BAR(); tr_flush(t3, buf1, C.wave, C.lane); }
}
__device__ __forceinline__ void p0_convert(Ctx& C, int L, int nblocks) {
#pragma unroll 1
    for (int j = C.bid; j < nblocks; j += C.G) tr_blocks<1>(C, L, j);
    __syncthreads();
}
#ifndef UB
#define UB 2
#endif
constexpr int NCU = NBL / UB;
#ifndef TAILQ
#define TAILQ (224 * 4 / UB)
#endif
#ifndef CONV_SPLIT
#define CONV_SPLIT 0
#endif
__device__ __forceinline__ void conv_unit(Ctx& C, int L, int b0) { tr_blocks<UB>(C, L, b0); }
constexpr int NCU_E = (NBL - NBP) / UB, NCU_P = NBP / UB;
__device__ __forceinline__ void bg_conv_unit(Ctx& C, int l, int cu) {
    const bool e = cu < NCU_E; conv_unit(C, e ? l : 1, e ? NBP + cu * UB : (cu - NCU_E) * UB);
}
__device__ __forceinline__ void p0_adaln(Ctx& C) {
    LAS float* sc = (LAS float*)C.lds;
    LAS float* red = (LAS float*)(C.lds + 40960);
    float* MOD = WSP(float, WS_MOD);
    for (int u = C.bid; u < 256; u += C.G) {
        const int l = u >> 7, colbase = (u & 127) * 96;
        __syncthreads();
        for (int i = C.tid; i < 5 * DM; i += 512) { const int r = i >> 11, k = i & 2047; const float v = r < 4 ? INP(I_C)[r * DM + k] : INP(I_CCTX)[k]; sc[i] = silu_f(v); }
        __syncthreads();
        float acc[5][2];
#pragma unroll
        for (int r = 0; r < 5; ++r) { acc[r][0] = 0.f; acc[r][1] = 0.f; }
        const int ln = C.lane < 48 ? C.lane : 47;
        const float* wp = INP(I_WADA) + ((size_t)l * DM + C.wave * 256) * 12288 + colbase + 2 * ln;
#pragma unroll 1
        for (int k0 = 0; k0 < 256; k0 += 16) { f32x2 wv[16];
#pragma unroll
            for (int k = 0; k < 16; ++k) wv[k] = *(const f32x2*)(wp + (size_t)(k0 + k) * 12288);
#pragma unroll
            for (int k = 0; k < 16; ++k)
#pragma unroll
                for (int r = 0; r < 5; ++r) { const float s = sc[r * DM + C.wave * 256 + k0 + k]; acc[r][0] += s * wv[k].x; acc[r][1] += s * wv[k].y; } }
        if (C.lane < 48) {
#pragma unroll
            for (int r = 0; r < 5; ++r) { red[(C.wave * 5 + r) * 96 + 2 * C.lane] = acc[r][0]; red[(C.wave * 5 + r) * 96 + 2 * C.lane + 1] = acc[r][1]; } }
        __syncthreads();
        for (int i = C.tid; i < 480; i += 512) { const int r = i / 96, cc = i % 96; float s = INP(I_BADA)[l * 12288 + colbase + cc];
#pragma unroll
            for (int w = 0; w < 8; ++w) s += red[(w * 5 + r) * 96 + cc];
            MOD[(size_t)(l * 5 + r) * 12288 + colbase + cc] = s; }
    }
    __syncthreads();
}
__device__ __forceinline__ void p0_filters(Ctx& C) {
    LAS float* feat = (LAS float*)C.lds;
    LAS float* h1 = (LAS float*)(C.lds + 4096);
    LAS float* h2 = (LAS float*)(C.lds + 8192);
    for (int u2 = C.bid; u2 < 528 + 0 * C.G; u2 += C.G) {
        const int u = 2 * (u2 % 264) + (u2 / 264);
        int l, L, tb; bf16* dst;
        if (u < 512) { l = u >> 8; tb = u & 255; L = SL; dst = WSP(bf16, WS_FILT) + (size_t)l * 2 * 512 * 8192; }
        else { l = 0; tb = u - 512; L = CL; dst = WSP(bf16, WS_FILTC); }
        const float invLm1 = 1.0f / (float)(L - 1);
        __syncthreads();
        LAS float* w1s = (LAS float*)(C.lds + 12288);
        LAS float* w2s = (LAS float*)(C.lds + 12288 + 33 * 64 * 4);
        for (int i = C.tid; i < 33 * 64; i += 512) w1s[i] = INP(I_HW1)[l * 33 * 64 + i];
        for (int i = C.tid; i < 64 * 64; i += 512) w2s[i] = INP(I_HW2)[l * 64 * 64 + i];
        for (int i = C.tid; i < 16 * 33; i += 512) { const int p = i / 33, j = i % 33; const int t = 16 * tb + p; float v;
            if (j == 0) v = (float)t * invLm1;
            else { const int fi = (j - 1) & 15; const float fr = 1e-4f + (float)fi * ((15.0f - 1e-4f) / 15.0f); const float ang = (6.283185307179586f / (float)L) * (float)t * fr; v = (j <= 16) ? cosf(ang) : -sinf(ang); }
            feat[i] = v; }
        __syncthreads();
        for (int i = C.tid; i < 1024; i += 512) { const int p = i >> 6, hh = i & 63; float s = INP(I_HB1)[l * 64 + hh];
#pragma unroll
            for (int j = 0; j < 33; ++j) s += feat[p * 33 + j] * w1s[j * 64 + hh];
            h1[i] = sinf(INP(I_HF1)[l * 64 + hh] * s); }
        __syncthreads();
        for (int i = C.tid; i < 1024; i += 512) { const int p = i >> 6, hh = i & 63; float s = INP(I_HB2)[l * 64 + hh];
#pragma unroll 16
            for (int j = 0; j < 64; ++j) s += h1[p * 64 + j] * w2s[j * 64 + hh];
            h2[i] = sinf(INP(I_HF2)[l * 64 + hh] * s); }
        __syncthreads();
        float acc[16][4];
#pragma unroll
        for (int p = 0; p < 16; ++p) { acc[p][0] = 0.f; acc[p][1] = 0.f; acc[p][2] = 0.f; acc[p][3] = 0.f; }
#pragma unroll 4
        for (int k = 0; k < 64; ++k) { const f32x4 w = *(const f32x4*)(INP(I_HW3) + (size_t)(l * 64 + k) * 2048 + 4 * C.tid);
#pragma unroll
            for (int p = 0; p < 16; ++p) { const float h = h2[p * 64 + k]; acc[p][0] += h * w[0]; acc[p][1] += h * w[1]; acc[p][2] += h * w[2]; acc[p][3] += h * w[3]; } }
#pragma unroll
        for (int j = 0; j < 4; ++j) { const int col = 4 * C.tid + j, o = col >> 10, dir = (col >> 9) & 1, c = col & 511;
            const float delta = 4.605170186f * (1.0f / 1.5f + (float)c * ((1.0f / 0.3f - 1.0f / 1.5f) / 511.0f));
            bf16* d = dst + (size_t)(o * 512 + c) * (2 * L);
            float val[16];
#pragma unroll
            for (int p = 0; p < 16; ++p) { const int t = 16 * tb + p; val[p] = acc[p][j] * __expf(-(float)t * invLm1 * delta); }
            if (dir == 0) {
                u32x4 w0, w1; w0.x = pk2(val[15], val[14]); w0.y = pk2(val[13], val[12]); w0.z = pk2(val[11], val[10]); w0.w = pk2(val[9], val[8]);
                w1.x = pk2(val[7], val[6]); w1.y = pk2(val[5], val[4]); w1.z = pk2(val[3], val[2]); w1.w = pk2(val[1], val[0]);
                u32x4* q = (u32x4*)(d + L - 16 * (tb + 1)); q[0] = w0; q[1] = w1;
            } else if (tb == 0) {
#pragma unroll
                for (int p = 1; p < 16; ++p) d[L - 1 + p] = (bf16)(pk2(val[p], 0.f) & 0xffffu);
            } else {
                typedef u32x4 __attribute__((aligned(2))) u32x4_u;
                u32x4 w0, w1; w0.x = pk2(val[0], val[1]); w0.y = pk2(val[2], val[3]); w0.z = pk2(val[4], val[5]); w0.w = pk2(val[6], val[7]);
                w1.x = pk2(val[8], val[9]); w1.y = pk2(val[10], val[11]); w1.z = pk2(val[12], val[13]); w1.w = pk2(val[14], val[15]);
                u32x4_u* q = (u32x4_u*)(d + L - 1 + 16 * tb); q[0] = w0; q[1] = w1;
            }
            if (dir == 1 && 16 * (tb + 1) == L) d[2 * L - 1] = 0; }
    }
    __syncthreads();
}
__device__ __forceinline__ void p0_rope(Ctx& C) {
    { const int idx = C.bid * 512 + C.tid;
      for (int e = idx; e < 131072; e += C.G * 512) { const f32x2 v = *(const f32x2*)(INP(I_GWS) + 2 * (size_t)e); WSP(unsigned, WS_GWSB)[e] = pk2(v.x, v.y); } }
    { const int idx = C.bid * 512 + C.tid;
      for (int e = idx; e < 131072; e += C.G * 512) { const int i = e & 127, j = (e >> 7) & 127, lg = e >> 14, l = lg >> 2, gi = lg & 3;
          const float v = INP(I_POOLW)[(size_t)lg * 16384 + i * 128 + j] * INP(I_POOLS)[l * 512 + 128 * gi + j];
          WSP(bf16, WS_POOLWT)[e] = (bf16)(pk2(v, 0.f) & 0xffffu); } }
    if (C.bid == (C.G > 200 ? 200 : 0)) { f32x2* R = WSP(f32x2, WS_ROPE);
        for (int i = C.tid; i < 1024; i += 512) { const int pos = i >> 4, fi = i & 15; const float inv = powf(10000.0f, -(float)fi / 16.0f); const float a = (float)pos * inv; R[i] = (f32x2){cosf(a), sinf(a)}; } }
}

__device__ __forceinline__ const float* src_x0(Ctx& C, int row) {
    return row < NLAT ? INP(I_X) + (size_t)row * DM : INP(I_CTX) + (size_t)(row - NLAT) * DM;
}
__device__ __forceinline__ void row_load(const float* p, int lane, float (&v)[32]) {
#pragma unroll
    for (int j = 0; j < 4; ++j) { const f32x4 a = *(const f32x4*)(p + 512 * j + 8 * lane), b = *(const f32x4*)(p + 512 * j + 8 * lane + 4);
        v[8 * j] = a[0]; v[8 * j + 1] = a[1]; v[8 * j + 2] = a[2]; v[8 * j + 3] = a[3]; v[8 * j + 4] = b[0]; v[8 * j + 5] = b[1]; v[8 * j + 6] = b[2]; v[8 * j + 7] = b[3]; }
}
__device__ __forceinline__ void row_load_bf16(const bf16* p, int lane, float (&v)[32]) {
#pragma unroll
    for (int j = 0; j < 4; ++j) { const u32x4 r = *(const u32x4*)(p + 512 * j + 8 * lane);
        v[8 * j] = __uint_as_float(r.x << 16); v[8 * j + 1] = __uint_as_float(r.x & 0xffff0000u); v[8 * j + 2] = __uint_as_float(r.y << 16); v[8 * j + 3] = __uint_as_float(r.y & 0xffff0000u);
        v[8 * j + 4] = __uint_as_float(r.z << 16); v[8 * j + 5] = __uint_as_float(r.z & 0xffff0000u); v[8 * j + 6] = __uint_as_float(r.w << 16); v[8 * j + 7] = __uint_as_float(r.w & 0xffff0000u); }
}
__device__ __forceinline__ void row_store(float* p, int lane, const float (&v)[32]) {
#pragma unroll
    for (int j = 0; j < 4; ++j) { *(f32x4*)(p + 512 * j + 8 * lane) = (f32x4){v[8 * j], v[8 * j + 1], v[8 * j + 2], v[8 * j + 3]}; *(f32x4*)(p + 512 * j + 8 * lane + 4) = (f32x4){v[8 * j + 4], v[8 * j + 5], v[8 * j + 6], v[8 * j + 7]}; }
}
__device__ __forceinline__ void row_store_bf16(bf16* p, int lane, const float (&v)[32]) {
#pragma unroll
    for (int j = 0; j < 4; ++j) { u32x4 w; w.x = pk2(v[8 * j], v[8 * j + 1]); w.y = pk2(v[8 * j + 2], v[8 * j + 3]); w.z = pk2(v[8 * j + 4], v[8 * j + 5]); w.w = pk2(v[8 * j + 6], v[8 * j + 7]); *(u32x4*)(p + 512 * j + 8 * lane) = w; }
}
__device__ __forceinline__ void row_store_fp8(unsigned char* p, int lane, const float (&v)[32]) {
#pragma unroll
    for (int j = 0; j < 4; ++j) { u32x2 w; w.x = pk4_fp8(v[8 * j], v[8 * j + 1], v[8 * j + 2], v[8 * j + 3]); w.y = pk4_fp8(v[8 * j + 4], v[8 * j + 5], v[8 * j + 6], v[8 * j + 7]); *(u32x2*)(p + 512 * j + 8 * lane) = w; }
}
__device__ __forceinline__ void row_ln(float (&v)[32]) {
    float s = 0.f;
#pragma unroll
    for (int i = 0; i < 32; ++i) s += v[i];
    const float mean = wave_sum(s) * (1.0f / DM); float q = 0.f;
#pragma unroll
    for (int i = 0; i < 32; ++i) { v[i] -= mean; q += v[i] * v[i]; }
    const float rstd = 1.0f / sqrtf(wave_sum(q) * (1.0f / DM) + LN_EPS);
#pragma unroll
    for (int i = 0; i < 32; ++i) v[i] *= rstd;
}
__device__ __forceinline__ void row_affine(float (&v)[32], const float* mul, const float* add, int lane, float mul_off) {
    float a[32], b[32]; row_load(mul, lane, a); row_load(add, lane, b);
#pragma unroll
    for (int i = 0; i < 32; ++i) v[i] = v[i] * (a[i] + mul_off) + b[i];
}
__device__ __forceinline__ void row_load_lds(const LAS float* p, int lane, float (&v)[32]) {
#pragma unroll
    for (int j = 0; j < 4; ++j) { const f32x4 a = *(const LAS f32x4*)(p + 512 * j + 8 * lane), b = *(const LAS f32x4*)(p + 512 * j + 8 * lane + 4);
        v[8 * j] = a[0]; v[8 * j + 1] = a[1]; v[8 * j + 2] = a[2]; v[8 * j + 3] = a[3]; v[8 * j + 4] = b[0]; v[8 * j + 5] = b[1]; v[8 * j + 6] = b[2]; v[8 * j + 7] = b[3]; }
}
__device__ __forceinline__ void row_affine_lds(float (&v)[32], const LAS float* mul, const LAS float* add, int lane, float mul_off) {
    float a[32], b[32]; row_load_lds(mul, lane, a); row_load_lds(add, lane, b);
#pragma unroll
    for (int i = 0; i < 32; ++i) v[i] = v[i] * (a[i] + mul_off) + b[i];
}
__device__ __forceinline__ void stage2048(Ctx& C, LAS float* dst, const float* src) { *(LAS f32x4*)(dst + 4 * C.tid) = *(const f32x4*)(src + 4 * C.tid); }
__device__ __forceinline__ void ph_ln_mod(Ctx& C, int l, int nrows) {
    LAS float* PAR = (LAS float*)C.lds;
    const int r0 = (int)(((long)C.bid * nrows) / C.G), r1 = (int)(((long)(C.bid + 1) * nrows) / C.G);
    int cur_mrow = -1;
    for (int rb = r0 & ~7; rb < r1; rb += 8) {
        const int mrow = rb < NLAT ? rb / SL : 4; const float* mod = WSP(float, WS_MOD) + (size_t)(l * 5 + mrow) * 12288;
        if (mrow != cur_mrow) { __syncthreads(); stage2048(C, PAR, mod + 2048); stage2048(C, PAR + 2048, mod); cur_mrow = mrow; __syncthreads(); }
        const int row = rb + C.wave;
        if (row >= r0 && row < r1) {
            float v[32]; row_load(src_x0(C, row), C.lane, v); row_ln(v); row_affine_lds(v, PAR, PAR + 2048, C.lane, 1.0f);
            if (FP8_IN) row_store_fp8(WSP(unsigned char, WS_HA8) + (size_t)row * DM, C.lane, v); else row_store_bf16(WSP(bf16, WS_HB) + (size_t)row * DM, C.lane, v);
        }
    }
    __syncthreads();
}

__device__ __forceinline__ void cvt8(const u32x4 r, float (&f)[8]) { f[0] = bflo(r.x); f[1] = bfhi(r.x); f[2] = bflo(r.y); f[3] = bfhi(r.y); f[4] = bflo(r.z); f[5] = bfhi(r.z); f[6] = bflo(r.w); f[7] = bfhi(r.w); }
__device__ __forceinline__ void cvt8_fp8(const u32x2 r, float (&f)[8]) { const f32x2 a = __builtin_amdgcn_cvt_pk_f32_fp8((int)r.x, false), b = __builtin_amdgcn_cvt_pk_f32_fp8((int)r.x, true), c = __builtin_amdgcn_cvt_pk_f32_fp8((int)r.y, false), d = __builtin_amdgcn_cvt_pk_f32_fp8((int)r.y, true);
    f[0] = a.x; f[1] = a.y; f[2] = b.x; f[3] = b.y; f[4] = c.x; f[5] = c.y; f[6] = d.x; f[7] = d.y; }
__device__ __forceinline__ bf16x8 pack8(const float (&f)[8]) { u32x4 w; w.x = pk2(f[0], f[1]); w.y = pk2(f[2], f[3]); w.z = pk2(f[4], f[5]); w.w = pk2(f[6], f[7]); return __builtin_bit_cast(bf16x8, w); }
#define MFMA32(a, b, c) __builtin_amdgcn_mfma_f32_32x32x16_bf16((a), (b), (c), 0, 0, 0)

__device__ __forceinline__ void attn_unit(Ctx& C, int l, int uidx) {
    constexpr int KS = 144, VS = 272, VT_OFF = 128 * KS;
    const bool isctx = uidx >= 256;
    int b, kh, nb;
    if (!isctx) { b = uidx >> 6; kh = (uidx >> 5) & 1; nb = uidx & 31; } else { const int v = uidx - 256; b = v >> 2; kh = (v >> 1) & 1; nb = v & 1; }
    const int rowbase = isctx ? NLAT + b * CL : b * SL, crow = NLAT + b * CL;
    const int g = C.wave >> 1, th = C.wave & 1, head = kh * 4 + g, r32 = C.lane & 31, h = C.lane >> 5;
    const bf16* Z = WSP(bf16, WS_Z); const f32x2* ROPE = WSP(f32x2, WS_ROPE);
    bf16x8 Qf[2][4];
#pragma unroll
    for (int qb = 0; qb < 2; ++qb) {
        const int tq = 128 * nb + 64 * th + 32 * qb + r32;
        const bf16* qp = Z + (size_t)(rowbase + tq) * INW + 512 + 64 * head + 8 * h;
        float f[4][8];
#pragma unroll
        for (int s = 0; s < 4; ++s) cvt8(*(const u32x4*)(qp + 16 * s), f[s]);
        if (!isctx) {
            const int pr = tq >> 6, pc = tq & 63;
#pragma unroll
            for (int j = 0; j < 8; ++j) {
                const f32x2 cr = ROPE[pr * 16 + 8 * h + j], cc = ROPE[pc * 16 + 8 * h + j];
                const float a0 = f[0][j], b0 = f[1][j]; f[0][j] = a0 * cr.x - b0 * cr.y; f[1][j] = b0 * cr.x + a0 * cr.y;
                const float a1 = f[2][j], b1 = f[3][j]; f[2][j] = a1 * cc.x - b1 * cc.y; f[3][j] = b1 * cc.x + a1 * cc.y; }
        }
#pragma unroll
        for (int s = 0; s < 4; ++s) {
#pragma unroll
            for (int j = 0; j < 8; ++j) f[s][j] *= 0.125f * LOG2E;
            Qf[qb][s] = pack8(f[s]); }
    }
    float m_[2], l_[2]; f32x16 O[2][2];
    { const float sk = INP(I_SINK)[l * 8 + head] * LOG2E; m_[0] = sk; m_[1] = sk; l_[0] = 1.f; l_[1] = 1.f; }
#pragma unroll
    for (int a = 0; a < 2; ++a)
#pragma unroll
        for (int q = 0; q < 2; ++q)
#pragma unroll
            for (int i = 0; i < 16; ++i) O[a][q][i] = 0.f;
#define AT_VALID(tt_) ((tt_) >= 3 || ((nb - 1 + (tt_)) >= 0 && (nb - 1 + (tt_)) < SL / 128))
#define AT_KROW0(tt_) (((tt_) < 3) ? rowbase + 128 * (nb - 1 + (tt_)) : crow + 128 * ((tt_) - 3))
#define AT_PREFETCH(tt_) do { const int krow0_ = AT_KROW0(tt_); _Pragma("unroll") for (int r = 0; r < 2; ++r) { const int idx = C.tid + 512 * r, key = idx >> 3, cd = idx & 7; \
        const bf16* kp = Z + (size_t)(krow0_ + key) * INW + 1024 + 64 * kh; kraw[r] = *(const u32x4*)(kp + 8 * cd); if ((tt_) < 3) kpar[r] = *(const u32x4*)(kp + 8 * (cd ^ 2)); \
        vraw[r] = *(const u32x4*)(kp + 128 + 8 * cd); } } while (0)
    __syncthreads();
    u32x4 kraw[2], kpar[2], vraw[2];
    kpar[0] = (u32x4){0u, 0u, 0u, 0u}; kpar[1] = kpar[0];
    int tt = isctx ? 3 : (nb == 0 ? 1 : 0);
    AT_PREFETCH(tt);
    while (tt < 5) {
        int ntt = tt + 1; if (ntt < 3 && !AT_VALID(ntt)) ntt = 3;
        const bool band = tt < 3; const int kb = nb - 1 + tt;
        LDS_WAIT(); __builtin_amdgcn_s_barrier(); asm volatile("" ::: "memory");
#pragma unroll
        for (int r = 0; r < 2; ++r) {
            const int idx = C.tid + 512 * r, key = idx >> 3, cd = idx & 7;
            u32x4 raw = kraw[r];
            if (band) {
                float x[8], y[8]; cvt8(raw, x); cvt8(kpar[r], y);
                const int tk = 128 * kb + key, pos = (cd & 4) ? (tk & 63) : (tk >> 6), i0 = 8 * (cd & 1); const bool isb = (cd >> 1) & 1;
#pragma unroll
                for (int j = 0; j < 8; ++j) { const f32x2 cs = ROPE[pos * 16 + i0 + j]; x[j] = isb ? (x[j] * cs.x + y[j] * cs.y) : (x[j] * cs.x - y[j] * cs.y); }
                raw = __builtin_bit_cast(u32x4, pack8(x));
            }
            *(LAS u32x4*)(C.lds + key * KS + cd * 16) = raw;
            const u32x4 vr = vraw[r];
            LAS bf16* vt = (LAS bf16*)(C.lds + VT_OFF + (8 * cd) * VS + key * 2);
            vt[0] = (bf16)(vr.x & 0xffff); vt[VS / 2] = (bf16)(vr.x >> 16); vt[2 * (VS / 2)] = (bf16)(vr.y & 0xffff); vt[3 * (VS / 2)] = (bf16)(vr.y >> 16);
            vt[4 * (VS / 2)] = (bf16)(vr.z & 0xffff); vt[5 * (VS / 2)] = (bf16)(vr.z >> 16); vt[6 * (VS / 2)] = (bf16)(vr.w & 0xffff); vt[7 * (VS / 2)] = (bf16)(vr.w >> 16);
        }
        if (ntt < 5) AT_PREFETCH(ntt);
        LDS_WAIT(); __builtin_amdgcn_s_barrier(); asm volatile("" ::: "memory");
        const int sub_lo = (tt == 0) ? 2 * th : 0, sub_hi = (tt == 2) ? 2 * th + 1 : 3;
        for (int sub = sub_lo; sub <= sub_hi; ++sub) {
            bf16x8 Kf[4];
#pragma unroll
            for (int s = 0; s < 4; ++s) Kf[s] = *(const LAS bf16x8*)(C.lds + (32 * sub + r32) * KS + (16 * s + 8 * h) * 2);
            bf16x8 Pf[2][2];
#pragma unroll
            for (int qb = 0; qb < 2; ++qb) {
                f32x16 S;
#pragma unroll
                for (int i = 0; i < 16; ++i) S[i] = 0.f;
#pragma unroll
                for (int s = 0; s < 4; ++s) S = MFMA32(Kf[s], Qf[qb][s], S);
                const int tq = 128 * nb + 64 * th + 32 * qb + r32;
                float mx = -INFINITY;
#pragma unroll
                for (int i = 0; i < 16; ++i) { float x = S[i];
                    if (tt == 0 || tt == 2) { const int kpos = 128 * kb + 32 * sub + (i & 3) + 8 * (i >> 2) + 4 * h; const int dq = tq - kpos; if (dq > 128 || dq < -128) x = -INFINITY; }
                    S[i] = x; mx = fmaxf(mx, x); }
                mx = xor32_max(mx);
                const float mnew = fmaxf(m_[qb], mx), alpha = __builtin_amdgcn_exp2f(m_[qb] - mnew);
                float rs = 0.f; float p[16];
#pragma unroll
                for (int i = 0; i < 16; ++i) { p[i] = __builtin_amdgcn_exp2f(S[i] - mnew); rs += p[i]; }
                rs = xor32_sum(rs);
                l_[qb] = l_[qb] * alpha + rs; m_[qb] = mnew;
#pragma unroll
                for (int i = 0; i < 16; ++i) { O[0][qb][i] *= alpha; O[1][qb][i] *= alpha; }
#pragma unroll
                for (int s2 = 0; s2 < 2; ++s2) { float t8[8];
#pragma unroll
                    for (int j = 0; j < 8; ++j) t8[j] = p[8 * s2 + j];
                    Pf[qb][s2] = pack8(t8); }
            }
#pragma unroll
            for (int db = 0; db < 2; ++db)
#pragma unroll
                for (int s2 = 0; s2 < 2; ++s2) {
                    const LAS unsigned char* vp = C.lds + VT_OFF + (32 * db + r32) * VS + (32 * sub + 16 * s2 + 4 * h) * 2;
                    const u32x2 v0 = *(const LAS u32x2*)vp, v1 = *(const LAS u32x2*)(vp + 16);
                    const u32x4 vv = {v0.x, v0.y, v1.x, v1.y}; const bf16x8 Vf = __builtin_bit_cast(bf16x8, vv);
                    O[db][0] = MFMA32(Vf, Pf[0][s2], O[db][0]); O[db][1] = MFMA32(Vf, Pf[1][s2], O[db][1]);
                }
        }
        tt = ntt;
    }
#undef AT_VALID
#undef AT_KROW0
#undef AT_PREFETCH
    bf16* Y = WSP(bf16, WS_YCAT);
#pragma unroll
    for (int qb = 0; qb < 2; ++qb) {
        const int tq = 128 * nb + 64 * th + 32 * qb + r32; const float inv = 1.0f / l_[qb];
        bf16* yp = Y + (size_t)(rowbase + tq) * DM + 512 + 64 * head;
#pragma unroll
        for (int db = 0; db < 2; ++db)
#pragma unroll
            for (int rg = 0; rg < 4; ++rg) { u32x2 w; w.x = pk2(O[db][qb][4 * rg] * inv, O[db][qb][4 * rg + 1] * inv); w.y = pk2(O[db][qb][4 * rg + 2] * inv, O[db][qb][4 * rg + 3] * inv);
                *(u32x2*)(yp + 32 * db + 8 * rg + 4 * h) = w; }
    }
}

__device__ __forceinline__ void gmlp_unit(Ctx& C, int l, int uidx) {
    constexpr int VS = 272;
    const int ck = uidx >> 1, hf = uidx & 1, row0 = 128 * ck;
    const bf16* Z = WSP(bf16, WS_Z);
    const int gl = C.wave >> 1, ph = C.wave & 1, g = 4 * hf + gl, r32 = C.lane & 31, h = C.lane >> 5;
    bf16x8 Wf[2][8]; u32x2 upre[2][2][4];
    { const bf16* wsb = WSP(bf16, WS_GWSB) + ((size_t)(l * 8 + g) * 128 + 64 * ph + r32) * 128 + 8 * h;
#pragma unroll
      for (int pb = 0; pb < 2; ++pb)
#pragma unroll
          for (int s = 0; s < 8; ++s) Wf[pb][s] = *(const bf16x8*)(wsb + (size_t)(32 * pb) * 128 + 16 * s);
#pragma unroll
      for (int pb = 0; pb < 2; ++pb) { const bf16* up = Z + (size_t)(row0 + 64 * ph + 32 * pb + r32) * INW + 2816 + 64 * g + 4 * h;
#pragma unroll
          for (int cb = 0; cb < 2; ++cb)
#pragma unroll
              for (int rg = 0; rg < 4; ++rg) upre[pb][cb][rg] = *(const u32x2*)(up + 32 * cb + 8 * rg); } }
    __syncthreads();
    {
        const int tok = C.tid >> 2, part = C.tid & 3;
        const bf16* zp = Z + (size_t)(row0 + tok) * INW + 3328 + 128 * part;
        const bf16* zq = Z + (size_t)(row0 + tok) * INW + 3328 + 256 * hf + 64 * part;
        u32x4 r1[16], r2[8];
#pragma unroll
        for (int c8 = 0; c8 < 16; ++c8) r1[c8] = *(const u32x4*)(zp + 8 * c8);
#pragma unroll
        for (int c8 = 0; c8 < 8; ++c8) r2[c8] = *(const u32x4*)(zq + 8 * c8);
        float s = 0.f, q = 0.f;
#pragma unroll
        for (int c8 = 0; c8 < 16; ++c8) { float f[8]; cvt8(r1[c8], f);
#pragma unroll
            for (int j = 0; j < 8; ++j) { s += f[j]; q += f[j] * f[j]; } }
        s += dpp_f<DPP_XOR1>(s); s += dpp_f<DPP_XOR2>(s); q += dpp_f<DPP_XOR1>(q); q += dpp_f<DPP_XOR2>(q);
        const float mean = s * (1.0f / 512.0f); const float var = fmaxf(q * (1.0f / 512.0f) - mean * mean, 0.f); const float rstd = 1.0f / sqrtf(var + LN_EPS);
        const float* lg = INP(I_GLG) + l * 512 + 256 * hf + 64 * part; const float* lb = INP(I_GLB) + l * 512 + 256 * hf + 64 * part;
#pragma unroll
        for (int c8 = 0; c8 < 8; ++c8) { float f[8]; cvt8(r2[c8], f);
            const f32x4 g0 = *(const f32x4*)(lg + 8 * c8), g1 = *(const f32x4*)(lg + 8 * c8 + 4), b0 = *(const f32x4*)(lb + 8 * c8), b1 = *(const f32x4*)(lb + 8 * c8 + 4);
            const float gg[8] = {g0[0], g0[1], g0[2], g0[3], g1[0], g1[1], g1[2], g1[3]}, bb[8] = {b0[0], b0[1], b0[2], b0[3], b1[0], b1[1], b1[2], b1[3]};
#pragma unroll
            for (int j = 0; j < 8; ++j) { const float vn = (f[j] - mean) * rstd * gg[j] + bb[j];
                *(LAS bf16*)(C.lds + (64 * part + 8 * c8 + j) * VS + tok * 2) = (bf16)(pk2(vn, 0.f) & 0xffffu); } }
    }
    __syncthreads();
    f32x16 acc[2][2];
#pragma unroll
    for (int a = 0; a < 2; ++a)
#pragma unroll
        for (int b = 0; b < 2; ++b)
#pragma unroll
            for (int i = 0; i < 16; ++i) acc[a][b][i] = 0.f;
#pragma unroll
    for (int s = 0; s < 8; ++s) {
        bf16x8 Vf[2];
#pragma unroll
        for (int cb = 0; cb < 2; ++cb) Vf[cb] = *(const LAS bf16x8*)(C.lds + (64 * gl + 32 * cb + r32) * VS + (16 * s + 8 * h) * 2);
#pragma unroll
        for (int cb = 0; cb < 2; ++cb)
#pragma unroll
            for (int pb = 0; pb < 2; ++pb) acc[cb][pb] = MFMA32(Vf[cb], Wf[pb][s], acc[cb][pb]);
    }
    bf16* Y = WSP(bf16, WS_YCAT);
#pragma unroll
    for (int pb = 0; pb < 2; ++pb) { const int p = 64 * ph + 32 * pb + r32; const float bs = INP(I_GBS)[(l * 8 + g) * 128 + p];
        bf16* yp = Y + (size_t)(row0 + p) * DM + 1536 + 64 * g + 4 * h;
#pragma unroll
        for (int cb = 0; cb < 2; ++cb)
#pragma unroll
            for (int rg = 0; rg < 4; ++rg) { const u32x2 uv = upre[pb][cb][rg];
                u32x2 w; w.x = pk2(bflo(uv.x) * (acc[cb][pb][4 * rg] + bs), bfhi(uv.x) * (acc[cb][pb][4 * rg + 1] + bs)); w.y = pk2(bflo(uv.y) * (acc[cb][pb][4 * rg + 2] + bs), bfhi(uv.y) * (acc[cb][pb][4 * rg + 3] + bs));
                *(u32x2*)(yp + 32 * cb + 8 * rg) = w; } }
}

__device__ __forceinline__ void pool_unit(Ctx& C, int l, int blk) {
    constexpr int RS = 1040, DT_OFF = 48 * RS;
    const int row0 = 32 * blk;
    const int s0 = row0 < NLAT ? (row0 / SL) * SL : NLAT + ((row0 - NLAT) / CL) * CL, L = row0 < NLAT ? SL : CL, t0 = row0 - s0;
    const bf16* Z = WSP(bf16, WS_Z);
    __syncthreads();
    for (int idx = C.tid; idx < 48 * 64; idx += 512) { const int r = idx >> 6, ch = idx & 63, t = t0 - 8 + r; u32x4 v = {0u, 0u, 0u, 0u};
        if (t >= 0 && t < L) v = *(const u32x4*)(Z + (size_t)(s0 + t) * INW + 8 * ch);
        *(LAS u32x4*)(C.lds + r * RS + ch * 16) = v; }
    __syncthreads();
    {
        const int c8 = C.tid & 63, tg = C.tid >> 6, hw = 1 << (c8 >> 4);
#pragma unroll 1
        for (int k = 0; k < 4; ++k) { const int tt = 4 * tg + k, t = t0 + tt; const int lo = max(t - hw, 0), hi = min(t + hw, L);
            float sacc[8];
#pragma unroll
            for (int j = 0; j < 8; ++j) sacc[j] = 0.f;
            for (int q = lo; q < hi; ++q) { float f[8]; cvt8(*(const LAS u32x4*)(C.lds + (q - t0 + 8) * RS + c8 * 16), f);
#pragma unroll
                for (int j = 0; j < 8; ++j) sacc[j] += f[j]; }
            float cf[8]; cvt8(*(const LAS u32x4*)(C.lds + (tt + 8) * RS + c8 * 16), cf); const float inv = 1.0f / (float)(hi - lo);
#pragma unroll
            for (int j = 0; j < 8; ++j) sacc[j] = sacc[j] * inv - cf[j];
            *(LAS bf16x8*)(C.lds + DT_OFF + tt * RS + c8 * 16) = pack8(sacc); }
    }
    __syncthreads();
    const int gi = C.wave >> 1, oh = C.wave & 1, r32 = C.lane & 31, h = C.lane >> 5;
    f32x16 acc[2];
#pragma unroll
    for (int a = 0; a < 2; ++a)
#pragma unroll
        for (int i = 0; i < 16; ++i) acc[a][i] = 0.f;
    const bf16* wt = WSP(bf16, WS_POOLWT) + (size_t)((l * 4 + gi) * 128 + 64 * oh + r32) * 128 + 8 * h;
#pragma unroll
    for (int s = 0; s < 8; ++s) {
        const bf16x8 Bf = *(const LAS bf16x8*)(C.lds + DT_OFF + r32 * RS + (128 * gi + 16 * s + 8 * h) * 2);
#pragma unroll
        for (int rb = 0; rb < 2; ++rb) { const bf16x8 Af = *(const bf16x8*)(wt + (size_t)(32 * rb) * 128 + 16 * s); acc[rb] = MFMA32(Af, Bf, acc[rb]); }
    }
    bf16* yp = WSP(bf16, WS_YCAT) + (size_t)(row0 + r32) * DM + 128 * gi + 64 * oh;
#pragma unroll
    for (int rb = 0; rb < 2; ++rb)
#pragma unroll
        for (int rg = 0; rg < 4; ++rg) { u32x2 w; w.x = pk2(acc[rb][4 * rg], acc[rb][4 * rg + 1]); w.y = pk2(acc[rb][4 * rg + 2], acc[rb][4 * rg + 3]); *(u32x2*)(yp + 32 * rb + 8 * rg + 4 * h) = w; }
}

__device__ __forceinline__ void hyprep_unit(Ctx& C, int l, int uidx) {
    constexpr int RS = 528;
    int seq, tb, cb, L, rowbase; bf16* T;
    if (uidx < 1536) { seq = uidx / 384; const int rem = uidx % 384; tb = rem / 6; cb = rem % 6; L = SL; rowbase = seq * SL; T = WSP(bf16, WS_TL); }
    else { const int v = uidx - 1536; seq = v / 24; const int rem = v % 24; tb = rem / 6; cb = rem % 6; L = CL; rowbase = NLAT + seq * CL; T = WSP(bf16, WS_TC); }
    const int t0 = 64 * tb; const bf16* Z = WSP(bf16, WS_Z);
    __syncthreads();
    for (int idx = C.tid; idx < 66 * 32; idx += 512) { const int r = idx >> 5, ch = idx & 31, t = t0 - 1 + r; u32x4 v = {0u, 0u, 0u, 0u};
        if (t >= 0 && t < L) v = *(const u32x4*)(Z + (size_t)(rowbase + t) * INW + 1280 + 256 * cb + 8 * ch);
        *(LAS u32x4*)(C.lds + r * RS + ch * 16) = v; }
    __syncthreads();
    const int c = C.tid & 255, hf = C.tid >> 8, ch = 256 * cb + c, comp = ch >> 9, cc = ch & 511;
    const float w0 = INP(I_HCW)[(l * 3 + 0) * 1536 + ch], w1 = INP(I_HCW)[(l * 3 + 1) * 1536 + ch], w2 = INP(I_HCW)[(l * 3 + 2) * 1536 + ch], bias = INP(I_HCB)[l * 1536 + ch];
    bf16* dst = T + ((size_t)(comp * 512 + cc) * 4 + seq) * L + t0 + 32 * hf;
    float zm = bf1(*(const LAS bf16*)(C.lds + (32 * hf) * RS + c * 2)), zc = bf1(*(const LAS bf16*)(C.lds + (32 * hf + 1) * RS + c * 2));
#pragma unroll
    for (int k = 0; k < 4; ++k) { float o[8];
#pragma unroll
        for (int e = 0; e < 8; ++e) { const float zn = bf1(*(const LAS bf16*)(C.lds + (32 * hf + 8 * k + e + 2) * RS + c * 2)); o[e] = bias + w0 * zm + w1 * zc + w2 * zn; zm = zc; zc = zn; }
        u32x4 w; w.x = pk2(o[0], o[1]); w.y = pk2(o[2], o[3]); w.z = pk2(o[4], o[5]); w.w = pk2(o[6], o[7]); *(u32x4*)(dst + 8 * k) = w; }
}

template <int L>
__device__ __forceinline__ void hyena_unit(Ctx& C, int l, int c) {
    constexpr int NBLK = L / 32, NTILE = NBLK / 8, NTL = (NTILE >= 16) ? 2 : 1;
    constexpr int SB = 2 * L + 16, Z_OFF = 4 * SB, R_OFF = Z_OFF + 64, CSZ = 4 * L;
    const bf16* T = (L == SL) ? WSP(bf16, WS_TL) : WSP(bf16, WS_TC);
    const int r32 = C.lane & 31, h = C.lane >> 5;
    const bool active = (2 * C.wave < NTILE);
    const int qi = (r32 + 1) >> 2, ri = (r32 + 1) & 3, pcp = (4 - ri) & 3;
    const int laneA = R_OFF + pcp * CSZ + (pcp ? 8 + 64 * pcp : 0) - 8 * (qi + (ri ? 1 : 0)) + 16 * h;
    const int al = r32 >> 2, bb = r32 & 3;
    const int laneB = bb * SB + 16 * h;
    for (int o = 0; o < 2; ++o) {
        __syncthreads();
        if (o == 0) { const bf16* src = T + (size_t)(2 * 512 + c) * 4 * L;
            for (int idx = C.tid; idx < 4 * L / 8; idx += 512) { const int b = idx / (L / 8), tc = idx % (L / 8); *(LAS u32x4*)(C.lds + b * SB + tc * 16) = *(const u32x4*)(src + 8 * idx); }
            if (C.tid < 4) *(LAS u32x4*)(C.lds + Z_OFF + 16 * C.tid) = (u32x4){0u, 0u, 0u, 0u}; }
        { const bf16* fsrc = (L == SL) ? WSP(bf16, WS_FILT) + (size_t)((l * 2 + o) * 512 + c) * (2 * L) : WSP(bf16, WS_FILTC) + (size_t)(o * 512 + c) * (2 * L);
          for (int idx = C.tid; idx < L / 4; idx += 512) *(LAS u32x4*)(C.lds + R_OFF + 16 * idx) = *(const u32x4*)(fsrc + 8 * idx); }
        __syncthreads();
        for (int idx = C.tid; idx < 3 * (L / 2); idx += 512) { const int p = 1 + idx / (L / 2), w = idx % (L / 2); unsigned short e[4];
#pragma unroll
            for (int k = 0; k < 4; ++k) { const int n = 4 * w + p + k; e[k] = n < 2 * L ? *(const LAS bf16*)(C.lds + R_OFF + 2 * n) : (bf16)0; }
            *(LAS u32x2*)(C.lds + R_OFF + p * CSZ + 8 + 64 * p + 8 * w) = (u32x2){(unsigned)e[0] | ((unsigned)e[1] << 16), (unsigned)e[2] | ((unsigned)e[3] << 16)}; }
        __syncthreads();
        f32x16 acc[NTL];
#pragma unroll
        for (int t = 0; t < NTL; ++t)
#pragma unroll
            for (int i = 0; i < 16; ++i) acc[t][i] = 0.f;
        u32x2 gpre[NTL][4]; float skip = 0.f;
        if (active) { skip = INP(I_HSKIP)[(l * 2 + o) * 512 + c]; const bf16* gate_ = T + (size_t)(o * 512 + c) * 4 * L + (size_t)bb * L;
#pragma unroll
            for (int t = 0; t < NTL; ++t)
#pragma unroll
                for (int rg = 0; rg < 4; ++rg) gpre[t][rg] = *(const u32x2*)(gate_ + 32 * (8 * (2 * C.wave + t) + al) + 8 * rg + 4 * h); }
        if (active) {
            const int a0 = 8 * (2 * C.wave);
            const int m_lo = a0 - (NBLK - 1), m_hi = a0 + 8 * (NTL - 1) + 7;
            const int mA = m_hi - (NBLK - 1), mB = a0;
            int off8 = 8; asm volatile("" : "+v"(off8));
#define HY_STEP_CHK(m_) do { bf16x8 Af_[2]; \
                _Pragma("unroll") for (int s = 0; s < 2; ++s) { const LAS unsigned char* ap = C.lds + laneA + 2 * (L - 32 * (m_) + 16 * s); const u32x2 x0 = *(const LAS u32x2*)ap, x1 = *(const LAS u32x2*)(ap + off8); \
                    const u32x4 xx = {x0.x, x0.y, x1.x, x1.y}; Af_[s] = __builtin_bit_cast(bf16x8, xx); } \
                _Pragma("unroll") for (int t = 0; t < NTL; ++t) { const int q = a0 + 8 * t + al - (m_); const bool ok = (q >= 0) && (q < NBLK); \
                    _Pragma("unroll") for (int s = 0; s < 2; ++s) { const int addr = ok ? (laneB + 64 * q + 32 * s) : Z_OFF; const bf16x8 Bf_ = *(const LAS bf16x8*)(C.lds + addr); acc[t] = MFMA32(Af_[s], Bf_, acc[t]); } } } while (0)
#pragma unroll 1
            for (int m = m_lo; m < mA; ++m) HY_STEP_CHK(m);
            {
                int o1 = 8, o2 = 32, o3 = 40; asm volatile("" : "+v"(o1), "+v"(o2), "+v"(o3));
                const LAS unsigned char* pa0 = C.lds + laneA + 2 * (L - 32 * mA); const LAS unsigned char* pa1 = pa0 + o1; const LAS unsigned char* pa2 = pa0 + o2; const LAS unsigned char* pa3 = pa0 + o3;
                const LAS unsigned char* pb = C.lds + laneB + 64 * (a0 + al - mA);
#define HY_LOADF(Af_, Bf_) do { { const u32x2 x0 = *(const LAS u32x2*)pa0, x1 = *(const LAS u32x2*)pa1, x2 = *(const LAS u32x2*)pa2, x3 = *(const LAS u32x2*)pa3; \
                    const u32x4 xa = {x0.x, x0.y, x1.x, x1.y}, xb = {x2.x, x2.y, x3.x, x3.y}; Af_[0] = __builtin_bit_cast(bf16x8, xa); Af_[1] = __builtin_bit_cast(bf16x8, xb); } \
                _Pragma("unroll") for (int t = 0; t < NTL; ++t) _Pragma("unroll") for (int s = 0; s < 2; ++s) Bf_[t][s] = *(const LAS bf16x8*)(pb + 512 * t + 32 * s); \
                pa0 -= 64; pa1 -= 64; pa2 -= 64; pa3 -= 64; pb -= 64; asm volatile("" : "+v"(pa0), "+v"(pa1), "+v"(pa2), "+v"(pa3)); } while (0)
#define HY_MMA(Af_, Bf_) do { _Pragma("unroll") for (int s = 0; s < 2; ++s) _Pragma("unroll") for (int t = 0; t < NTL; ++t) acc[t] = MFMA32(Af_[s], Bf_[t][s], acc[t]); } while (0)
                int nfast = mB - mA + 1;
                if constexpr (NTL == 2) {
                    bf16x8 Bx[8][2], By[8][2];
#define HY_LOADA(Af_) do { const u32x2 x0 = *(const LAS u32x2*)pa0, x1 = *(const LAS u32x2*)pa1, x2 = *(const LAS u32x2*)pa2, x3 = *(const LAS u32x2*)pa3; \
                        const u32x4 xa = {x0.x, x0.y, x1.x, x1.y}, xb = {x2.x, x2.y, x3.x, x3.y}; Af_[0] = __builtin_bit_cast(bf16x8, xa); Af_[1] = __builtin_bit_cast(bf16x8, xb); \
                        pa0 -= 64; pa1 -= 64; pa2 -= 64; pa3 -= 64; asm volatile("" : "+v"(pa0), "+v"(pa1), "+v"(pa2), "+v"(pa3)); } while (0)
#define HY_GROUP(Bold, Bnew, more) do { _Pragma("unroll") for (int i = 0; i < 8; ++i) { bf16x8 An_[2] = {Ac_[0], Ac_[1]}; \
                        if (i < 7) { HY_LOADA(An_); Bnew[i + 1][0] = *(const LAS bf16x8*)(pb - 64 * (i + 1)); Bnew[i + 1][1] = *(const LAS bf16x8*)(pb - 64 * (i + 1) + 32); } \
                        else if (more) { HY_LOADA(An_); Bold[0][0] = *(const LAS bf16x8*)(pb - 512); Bold[0][1] = *(const LAS bf16x8*)(pb - 512 + 32); }        \
                        acc[0] = MFMA32(Ac_[0], Bnew[i][0], acc[0]); acc[1] = MFMA32(Ac_[0], Bold[i][0], acc[1]); acc[0] = MFMA32(Ac_[1], Bnew[i][1], acc[0]); acc[1] = MFMA32(Ac_[1], Bold[i][1], acc[1]); \
                        Ac_[0] = An_[0]; Ac_[1] = An_[1]; } \
                        pb -= 512; } while (0)
                    if (nfast >= 16) {
#pragma unroll
                        for (int i = 0; i < 8; ++i) { Bx[i][0] = *(const LAS bf16x8*)(pb + 512 - 64 * i); Bx[i][1] = *(const LAS bf16x8*)(pb + 512 - 64 * i + 32); }
                        bf16x8 Ac_[2]; HY_LOADA(Ac_); By[0][0] = *(const LAS bf16x8*)pb; By[0][1] = *(const LAS bf16x8*)(pb + 32);
#pragma unroll 1
                        while (nfast >= 16) { HY_GROUP(Bx, By, true); HY_GROUP(By, Bx, nfast >= 32); nfast -= 16; }
                    }
#undef HY_LOADA
#undef HY_GROUP
                }
                bf16x8 A0[2], B0[NTL][2], A1[2], B1[NTL][2];
                if (nfast > 0) {
                    int rem = nfast - 1;
                    HY_LOADF(A0, B0);
#pragma unroll 1
                    while (rem >= 2) { HY_LOADF(A1, B1); HY_MMA(A0, B0); HY_LOADF(A0, B0); HY_MMA(A1, B1); rem -= 2; }
                    if (rem == 1) { HY_LOADF(A1, B1); HY_MMA(A0, B0); HY_MMA(A1, B1); } else { HY_MMA(A0, B0); }
                }
#undef HY_LOADF
#undef HY_MMA
            }
#pragma unroll 1
            for (int m = mB + 1; m <= m_hi; ++m) HY_STEP_CHK(m);
#undef HY_STEP_CHK
        }
        __syncthreads();
        if (active) {
#pragma unroll
            for (int t = 0; t < NTL; ++t) { const int a = 8 * (2 * C.wave + t) + al;
#pragma unroll
                for (int rg = 0; rg < 4; ++rg) { const int t4 = 32 * a + 8 * rg + 4 * h;
                    LAS u32x2* up = (LAS u32x2*)(C.lds + bb * SB + t4 * 2); const u32x2 uo = *up; const u32x2 gv = gpre[t][rg];
                    const float v0 = bflo(gv.x) * (acc[t][4 * rg] + skip * bflo(uo.x)), v1 = bfhi(gv.x) * (acc[t][4 * rg + 1] + skip * bfhi(uo.x));
                    const float v2 = bflo(gv.y) * (acc[t][4 * rg + 2] + skip * bflo(uo.y)), v3 = bfhi(gv.y) * (acc[t][4 * rg + 3] + skip * bfhi(uo.y));
                    const u32x2 w = {pk2(v0, v1), pk2(v2, v3)};
                    if (o == 0) *up = w;
                    else { const int row = (L == SL) ? bb * SL + t4 : NLAT + bb * CL + t4; *(u32x2*)(WSP(bf16, WS_YHT) + (size_t)c * NTOK + row) = w; } } }
        }
    }
}

constexpr int RMS_GN_OFF = 34816;
__device__ __forceinline__ void rms_stage_gain(Ctx& C, int l) { __syncthreads(); stage2048(C, (LAS float*)(C.lds + RMS_GN_OFF), INP(I_MNG) + l * DM); __syncthreads(); }
__device__ __forceinline__ void rms_unit(Ctx& C, int l, int blk) {
    constexpr int RS = 1040;
    const int row0 = 32 * blk;
    const int tok = C.tid >> 4, sub = C.tid & 15;
    const bf16* Y = WSP(bf16, WS_YCAT) + (size_t)(row0 + tok) * DM + 32 * sub;
    u32x4 raw[3][4];
#pragma unroll
    for (int gi = 0; gi < 3; ++gi)
#pragma unroll
        for (int c8 = 0; c8 < 4; ++c8) raw[gi][c8] = *(const u32x4*)(Y + 512 * (gi == 2 ? 3 : gi) + 8 * c8);
    u32x4 hy[4];
    { const bf16* yh = WSP(bf16, WS_YHT);
#pragma unroll
      for (int k = 0; k < 4; ++k) { const int idx = C.tid + 512 * k, ch = idx >> 2, tc = idx & 3; hy[k] = *(const u32x4*)(yh + (size_t)ch * NTOK + row0 + 8 * tc); } }
    __syncthreads();
#pragma unroll
    for (int k = 0; k < 4; ++k) { const int idx = C.tid + 512 * k, ch = idx >> 2, tc = idx & 3; const u32x4 v = hy[k];
        LAS bf16* d = (LAS bf16*)(C.lds + (8 * tc) * RS + ch * 2);
        d[0] = (bf16)(v.x & 0xffff); d[RS / 2] = (bf16)(v.x >> 16); d[2 * (RS / 2)] = (bf16)(v.y & 0xffff); d[3 * (RS / 2)] = (bf16)(v.y >> 16);
        d[4 * (RS / 2)] = (bf16)(v.z & 0xffff); d[5 * (RS / 2)] = (bf16)(v.z >> 16); d[6 * (RS / 2)] = (bf16)(v.w & 0xffff); d[7 * (RS / 2)] = (bf16)(v.w >> 16); }
    __syncthreads();
    const LAS float* gn = (const LAS float*)(C.lds + RMS_GN_OFF);
    unsigned char* O = WSP(unsigned char, WS_HA8) + (size_t)(row0 + tok) * DM + 32 * sub;
#pragma unroll
    for (int gq = 0; gq < 4; ++gq) {
        float f[32]; float q = 0.f;
#pragma unroll
        for (int c8 = 0; c8 < 4; ++c8) { const u32x4 v = (gq == 2) ? *(const LAS u32x4*)(C.lds + tok * RS + (32 * sub + 8 * c8) * 2) : raw[gq == 3 ? 2 : gq][c8];
            float t8[8]; cvt8(v, t8);
#pragma unroll
            for (int j = 0; j < 8; ++j) { f[8 * c8 + j] = t8[j]; q += t8[j] * t8[j]; } }
        q = row16_sum(q);
        const float rs = 1.0f / sqrtf(q * (1.0f / 512.0f) + LN_EPS);
        const LAS float* gp = gn + 512 * gq + 32 * sub;
#pragma unroll
        for (int c8 = 0; c8 < 4; ++c8) { const f32x4 g0 = *(const LAS f32x4*)(gp + 8 * c8), g1 = *(const LAS f32x4*)(gp + 8 * c8 + 4);
            u32x2 w; w.x = pk4_fp8(f[8 * c8] * rs * g0[0], f[8 * c8 + 1] * rs * g0[1], f[8 * c8 + 2] * rs * g0[2], f[8 * c8 + 3] * rs * g0[3]);
            w.y = pk4_fp8(f[8 * c8 + 4] * rs * g1[0], f[8 * c8 + 5] * rs * g1[1], f[8 * c8 + 6] * rs * g1[2], f[8 * c8 + 7] * rs * g1[3]);
            *(u32x2*)(O + 512 * gq + 8 * c8) = w; }
        __builtin_amdgcn_sched_barrier(0);
    }
}

__device__ __forceinline__ void ph_post1(Ctx& C, int l, int nrows, bool dry = false) {
    LAS float* H2 = (LAS float*)C.lds;
    LAS float* RED = (LAS float*)(C.lds + 65536);
    LAS float* SGA = (LAS float*)(C.lds + 81920);
    LAS float* PAR = (LAS float*)(C.lds + 92160);
    unsigned* ctl = WSP(unsigned, WS_CTL);
    int nit = 0, cur_mrow = -1;
    const int nit_all = nrows / 8, it0 = (int)(((long)C.bid * nit_all) / C.G), it1 = (int)(((long)(C.bid + 1) * nit_all) / C.G);
    for (int it = it0; it < it1; ++it, ++nit) {
        const int row = it * 8 + C.wave;
        const int mrow = row < NLAT ? row / SL : 4; const float* mod = WSP(float, WS_MOD) + (size_t)(l * 5 + mrow) * 12288;
        __syncthreads();
        if (mrow != cur_mrow) { stage2048(C, PAR, mod + 4096); stage2048(C, PAR + 2048, INP(I_LN1G) + l * DM); stage2048(C, PAR + 4096, INP(I_LN1B) + l * DM); stage2048(C, PAR + 6144, mod + 8192); stage2048(C, PAR + 8192, mod + 6144); cur_mrow = mrow; __syncthreads(); }
        {
            float v[32], y[32], g1[32];
            if (l == 0) row_load(src_x0(C, row), C.lane, v); else row_load_bf16(WSP(bf16, WS_X) + (size_t)row * DM, C.lane, v);
            row_load_lds(PAR, C.lane, g1);
            { const bf16* yo = WSP(bf16, WS_YO) + (size_t)row * DM;
#pragma unroll
              for (int j = 0; j < 4; ++j) { float t8[8]; cvt8(*(const u32x4*)(yo + 512 * j + 8 * C.lane), t8);
#pragma unroll
                  for (int e = 0; e < 8; ++e) y[8 * j + e] = t8[e]; } }
#pragma unroll
            for (int i = 0; i < 32; ++i) v[i] = ALPHA * v[i] + g1[i] * y[i];
            row_ln(v); row_affine_lds(v, PAR + 2048, PAR + 4096, C.lane, 0.f);
            row_store_bf16(WSP(bf16, WS_X) + (size_t)row * DM, C.lane, v);
            row_ln(v); row_affine_lds(v, PAR + 6144, PAR + 8192, C.lane, 1.0f);
            row_store_fp8(WSP(unsigned char, WS_HB8) + (size_t)row * DM, C.lane, v);
#pragma unroll
            for (int j = 0; j < 4; ++j) { *(LAS f32x4*)(H2 + C.wave * DM + 512 * j + 8 * C.lane) = (f32x4){v[8 * j], v[8 * j + 1], v[8 * j + 2], v[8 * j + 3]};
                *(LAS f32x4*)(H2 + C.wave * DM + 512 * j + 8 * C.lane + 4) = (f32x4){v[8 * j + 4], v[8 * j + 5], v[8 * j + 6], v[8 * j + 7]}; }
        }
        __syncthreads();
        {
            const int e4 = C.lane & 7, cg = C.lane >> 3, cbase = 256 * C.wave + 32 * cg;
            f32x2 acc[8][2];
#pragma unroll
            for (int r = 0; r < 8; ++r) { acc[r][0] = (f32x2){0.f, 0.f}; acc[r][1] = (f32x2){0.f, 0.f}; }
            const float* wr = INP(I_WR) + (size_t)cbase * NE + 4 * e4;
#pragma unroll 2
            for (int cq = 0; cq < 32; cq += 4) {
                f32x4 w4[4];
#pragma unroll
                for (int k = 0; k < 4; ++k) w4[k] = *(const f32x4*)(wr + (size_t)(cq + k) * NE);
#pragma unroll
                for (int r = 0; r < 8; ++r) { const f32x4 hv = *(const LAS f32x4*)(H2 + r * DM + cbase + cq);
#pragma unroll
                    for (int k = 0; k < 4; ++k) { const f32x2 hh = {hv[k], hv[k]}; acc[r][0] += hh * (f32x2){w4[k][0], w4[k][1]}; acc[r][1] += hh * (f32x2){w4[k][2], w4[k][3]}; } } }
#pragma unroll
            for (int r = 0; r < 8; ++r)
#pragma unroll
                for (int k = 0; k < 2; ++k) { float x = acc[r][k].x, y = acc[r][k].y;
                    x += dpp_f<DPP_ROR8>(x); y += dpp_f<DPP_ROR8>(y); x = xor32_sum(xor16_sum(x)); y = xor32_sum(xor16_sum(y));
                    if (cg == 0) { RED[(C.wave * 8 + r) * 32 + 4 * e4 + 2 * k] = x; RED[(C.wave * 8 + r) * 32 + 4 * e4 + 2 * k + 1] = y; } }
        }
        __syncthreads();
        if (C.tid < 256) { const int r = C.tid >> 5, e = C.tid & 31; float s = 0.f;
#pragma unroll
            for (int p = 0; p < 8; ++p) s += RED[(p * 8 + r) * 32 + e];
            SGA[(nit * 8 + r) * 32 + e] = 1.0f / (1.0f + expf(-s)); }
    }
    __syncthreads();
    if (C.tid < nit * 8 && !dry) { const int r = C.tid, rw = (it0 + (r >> 3)) * 8 + (r & 7); float best = -INFINITY; int bg = 0;
        const LAS float* sg = SGA + r * 32; const float* rb = INP(I_RB);
        for (int gq = 0; gq < 8; ++gq) { const float a = sg[4 * gq] + rb[4 * gq], b = sg[4 * gq + 1] + rb[4 * gq + 1], c = sg[4 * gq + 2] + rb[4 * gq + 2], d = sg[4 * gq + 3] + rb[4 * gq + 3];
            const float hi1 = fmaxf(a, b), lo1 = fminf(a, b), hi2 = fmaxf(c, d), lo2 = fminf(c, d);
            const float top = fmaxf(hi1, hi2), second = fmaxf(fminf(hi1, hi2), (hi1 >= hi2) ? lo1 : lo2);
            const float sc = top + second; if (sc > best) { best = sc; bg = gq; } }
        int i0 = 0; float v0 = -INFINITY;
        for (int k = 0; k < 4; ++k) { const float x = sg[4 * bg + k] + rb[4 * bg + k]; if (x > v0) { v0 = x; i0 = k; } }
        int i1 = 0; float v1 = -INFINITY;
        for (int k = 0; k < 4; ++k) { const float x = sg[4 * bg + k] + rb[4 * bg + k]; if (k != i0 && x > v1) { v1 = x; i1 = k; } }
        const int e0 = 4 * bg + i0, e1 = 4 * bg + i1; const float w0 = sg[e0], w1 = sg[e1], ws = w0 + w1;
        const int p0 = (int)atomicAdd(ctl + CW_CNT + l * 2048 + e0 * 64, 1u), p1 = (int)atomicAdd(ctl + CW_CNT + l * 2048 + e1 * 64, 1u);
        WSP(int4, WS_TOKINFO)[rw] = make_int4(e0, p0, e1, p1); WSP(f32x2, WS_TOKW)[rw] = (f32x2){w0 / ws, w1 / ws};
        WSP(int, WS_EXPTOK)[(size_t)e0 * NTOK + p0] = rw; WSP(int, WS_EXPTOK)[(size_t)e1 * NTOK + p1] = rw; }
    __syncthreads();
}

__device__ __forceinline__ int moe_tables(Ctx& C, int l) {
    LAS int* T = (LAS int*)(C.lds + LDS_TAB);
    __syncthreads();
    if (C.tid < NE) { unsigned* ctl = WSP(unsigned, WS_CTL); T[200 + C.tid] = (int)__hip_atomic_load(ctl + CW_CNT + l * 2048 + C.tid * 64, __ATOMIC_RELAXED, __HIP_MEMORY_SCOPE_AGENT); }
    __syncthreads();
    if (C.tid == 0) { int nb = 0;
        for (int e = 0; e < NE; ++e) { const int cnt = T[200 + e]; T[168 + e] = nb; const int nbk = (cnt + 255) >> 8;
            for (int k = 0; k < nbk; ++k) if (nb + k < MAXBLK) T[nb + k] = e;
            nb += nbk; }
        T[232] = nb < MAXBLK ? nb : MAXBLK; }
    __syncthreads();
    return T[232];
}

__device__ __forceinline__ void ph_post2(Ctx& C, int l, int nrows) {
    const bool last = (l == 1);
    (void)moe_tables(C, l);
    const LAS int* T = (const LAS int*)(C.lds + LDS_TAB);
    LAS float* PAR = (LAS float*)C.lds;
    const int r0 = (int)(((long)C.bid * nrows) / C.G), r1 = (int)(((long)(C.bid + 1) * nrows) / C.G);
    int cur_mrow = -1;
    for (int rb = r0 & ~7; rb < r1; rb += 8) {
        const int mrow = rb < NLAT ? rb / SL : 4; const float* mod = WSP(float, WS_MOD) + (size_t)(l * 5 + mrow) * 12288;
        if (mrow != cur_mrow) { const float* modn = WSP(float, WS_MOD) + (size_t)((last ? l : l + 1) * 5 + mrow) * 12288;
            __syncthreads(); stage2048(C, PAR, mod + 10240); stage2048(C, PAR + 2048, INP(I_LN2G) + l * DM); stage2048(C, PAR + 4096, INP(I_LN2B) + l * DM); stage2048(C, PAR + 6144, modn + 2048); stage2048(C, PAR + 8192, modn); cur_mrow = mrow; __syncthreads(); }
        const int row = rb + C.wave;
        if (row >= r0 && row < r1) {
        const int4 ti = WSP(int4, WS_TOKINFO)[row]; const f32x2 tw = WSP(f32x2, WS_TOKW)[row];
        const int s0 = T[168 + ti.x] * 256 + ti.y, s1 = T[168 + ti.z] * 256 + ti.w;
        const unsigned char* y0 = WSP(unsigned char, WS_YS) + (size_t)s0 * DM; const unsigned char* y1 = WSP(unsigned char, WS_YS) + (size_t)s1 * DM;
        float v[32], g2[32]; row_load_bf16(WSP(bf16, WS_X) + (size_t)row * DM, C.lane, v); row_load_lds(PAR, C.lane, g2);
#pragma unroll
        for (int j = 0; j < 4; ++j) { float a[8], b[8]; cvt8_fp8(*(const u32x2*)(y0 + 512 * j + 8 * C.lane), a); cvt8_fp8(*(const u32x2*)(y1 + 512 * j + 8 * C.lane), b);
#pragma unroll
            for (int e = 0; e < 8; ++e) v[8 * j + e] = ALPHA * v[8 * j + e] + g2[8 * j + e] * ((tw.x * 0.0625f) * a[e] + (tw.y * 0.0625f) * b[e]); }
        row_ln(v); row_affine_lds(v, PAR + 2048, PAR + 4096, C.lane, 0.f);
        if (last) { row_store((float*)(C.out + (size_t)row * DM), C.lane, v); }
        else { row_store_bf16(WSP(bf16, WS_X) + (size_t)row * DM, C.lane, v);
            row_ln(v); row_affine_lds(v, PAR + 6144, PAR + 8192, C.lane, 1.0f);
            if (FP8_IN) row_store_fp8(WSP(unsigned char, WS_HA8) + (size_t)row * DM, C.lane, v); else row_store_bf16(WSP(bf16, WS_HB) + (size_t)row * DM, C.lane, v); }
        }
    }
}

constexpr int N_PHASES = 20;
__global__ void __launch_bounds__(512, 2) fwd_kernel(Args args) {
    extern __shared__ __attribute__((aligned(16))) unsigned char lds_raw[];
    Ctx C0; C0.lds = (LAS unsigned char*)lds_raw; C0.tid = threadIdx.x; C0.lane = C0.tid & 63; C0.wave = __builtin_amdgcn_readfirstlane(C0.tid >> 6); C0.bid = blockIdx.x; C0.G = gridDim.x;
    C0.in = (const float GAS* const __attribute__((address_space(4)))*)((const __attribute__((address_space(4))) Args*)__builtin_amdgcn_kernarg_segment_ptr())->in; C0.out = (float GAS*)args.out; C0.ws = (unsigned char GAS*)args.ws;
    volatile LAS unsigned* MISC = (volatile LAS unsigned*)(C0.lds + LDS_MISC);
    if (C0.tid < 4) MISC[C0.tid] = 0u;
    __syncthreads();
    XcdBarrier bar; bar.bar = (unsigned*)(unsigned GAS*)(C0.ws + WS_CTL) + CW_BAR; bar.x = 0; bar.st = nullptr;
    const int lo = args.ph_lo, hi = args.ph_hi;
    if (hi - lo > 1) bar = xcd_barrier_post((unsigned*)(unsigned GAS*)(C0.ws + WS_CTL) + CW_BAR, MISC);
#ifdef ONLY
#define IN(k) ((k) == ONLY)
#define INL(j) ((j) + 2 == ONLY)
#define SEAM(k) do { } while (0)
#else
#define IN(k) (lo <= (k) && (k) < hi)
#define INL(j) IN(pb + (j))
#define SEAM(k) do { if (IN(k) && IN((k) + 1)) xcd_barrier(bar); } while (0)
#endif

    if (IN(0)) { _Pragma("unroll") for (int rep = 0; rep < NREP(0); ++rep) { if (rep) xcd_barrier(bar); FRESH(D, C0);
        if (D.bid & 1) { p0_filters(D); p0_adaln(D); } else { p0_adaln(D); p0_filters(D); }        p0_rope(D); __syncthreads(); p0_convert(D, 0, NBP); } }
    SEAM(0);
    if (IN(1)) { _Pragma("unroll") for (int rep = 0; rep < NREP(1); ++rep) { if (rep) xcd_barrier(bar); FRESH(D, C0); ph_ln_mod(D, 0, NTOK); } }
    SEAM(1);
#define LAYER_BODY(l) do { \
        const int pb = 2 + 9 * l; const bool last = (l == 1); const int nrows = last ? NLAT : NTOK; \
        if (INL(0)) { _Pragma("unroll") for (int rep = 0; rep < NREP(2 + 9 * l + 0); ++rep) { if (rep) xcd_barrier(bar); \
            FRESH(C, C0); \
            pg8::Gemm g{FP8_IN ? (const bf16*)WSP(unsigned char, WS_HA8) : WSP(bf16, WS_HB), FP8_IN ? (const bf16*)(WSP(unsigned char, WS_WIN) + (size_t)l * INW * DM) : WSP(bf16, WS_WIN) + (size_t)l * INW * DM, FP8_IN ? DM / 2 : DM}; \
            pg8::DenseOrder S; S.init(NTOK, INW, C.G, C.bid); \
            pg8::EpiBf16 E{WSP(bf16, WS_Z), INW, 11}; \
            pg8::gemm_phase<pg8::EpiBf16, pg8::DenseOrder, false, FP8_IN != 0>(C.lds, g, S, E); \
        } \
        } SEAM(pb + 0); \
        if (INL(1)) { _Pragma("unroll") for (int rep = 0; rep < NREP(2 + 9 * l + 1); ++rep) { if (rep) xcd_barrier(bar); \
            const int n_attn = last ? 256 : 272, n_gmlp = last ? 256 : 272, n_pool = last ? 512 : 544, n_hyp = last ? 1536 : 1632; \
            { FRESH(C, C0); \
                \
              volatile LAS int* qn = (volatile LAS int*)(C.lds + LDS_MISC + 32); \
              unsigned* qctr = WSP(unsigned, WS_CTL) + CW_QUEUE + (l * 2 + rep) * 64; \
              const int b0 = 256, b1 = b0 + n_gmlp, b2 = b1 + (n_attn - 256), b3 = b2 + n_pool, total = b3 + n_hyp; \
              volatile LAS int* qc = (volatile LAS int*)(C.lds + LDS_MISC + 36); \
              unsigned* cctr = WSP(unsigned, WS_CTL) + CW_QUEUE + (4 + rep) * 64; \
              int u = C.bid, cu = (last || C.bid >= CONV_SPLIT) ? NCU : C.bid;        \
              while (u < total || cu < NCU) { \
                  int nxt = total, nxc = NCU; \
                  if (C.tid == 0) { if (u < total) nxt = (int)atomicAdd(qctr, 1u) + C.G; if (cu < NCU) { nxc = (int)atomicAdd(cctr, 1u) + C.G; if (nxc >= CONV_SPLIT) nxc = NCU; } } \
                  if (u < total) { FRESH(Cu, C); if (u < b0) attn_unit(Cu, l, u); else if (u < b1) gmlp_unit(Cu, l, u - b0); else if (u < b2) attn_unit(Cu, l, 256 + u - b1); else if (u < b3) pool_unit(Cu, l, u - b2); else hyprep_unit(Cu, l, u - b3); } \
                  if (cu < NCU) { FRESH(Cu, C); conv_unit(Cu, 1, cu * UB); } \
                  __syncthreads(); if (C.tid == 0) { *qn = nxt; *qc = nxc; } __syncthreads(); u = __builtin_amdgcn_readfirstlane(*qn); cu = __builtin_amdgcn_readfirstlane(*qc); \
              } } \
        } \
        } SEAM(pb + 1); \
        if (INL(2)) { _Pragma("unroll") for (int rep = 0; rep < NREP(2 + 9 * l + 2); ++rep) { if (rep) xcd_barrier(bar); \
            { FRESH(C, C0);        \
              volatile LAS int* qc = (volatile LAS int*)(C.lds + LDS_MISC + 36); \
              unsigned* cctr = WSP(unsigned, WS_CTL) + CW_QUEUE + (6 + 2 * l + rep) * 64; \
              const int nhu = (rep && PROBE_CONV == 1) ? 0 : (last ? 512 : 1024), ncu = (rep && PROBE_CONV == 2) ? 0 : (last ? NCU_E : NCU_E + NCU_P - TAILQ); \
                \
              const int quota = (ncu + C.G - 1) / C.G, cls = C.bid % 3; \
              int hu = C.bid, cu = C.bid, nh = 0, nc = 0; \
              while (hu < nhu || cu < ncu) { \
                  const bool cv = cu < ncu && (hu >= nhu || (nc < quota && (cls == 0 || (cls == 1 && nh >= 1)))); \
                  if (cv) { \
                      int nxc = ncu; if (C.tid == 0) nxc = (int)atomicAdd(cctr, 1u) + C.G; \
                      { FRESH(Cu, C); bg_conv_unit(Cu, l, cu); } \
                      __syncthreads(); if (C.tid == 0) *qc = nxc; __syncthreads(); cu = __builtin_amdgcn_readfirstlane(*qc); ++nc; \
                  } else { FRESH(Cu, C); if (hu < 512) hyena_unit<SL>(Cu, l, hu); else hyena_unit<CL>(Cu, l, hu - 512); hu += C.G; ++nh; } \
              } } \
        } \
        } SEAM(pb + 2); \
        if (INL(3)) { _Pragma("unroll") for (int rep = 0; rep < NREP(2 + 9 * l + 3); ++rep) { if (rep) xcd_barrier(bar); FRESH(C, C0); rms_stage_gain(C, l); for (int u = C.bid; u < nrows / 32; u += C.G) { FRESH(Cu, C); rms_unit(Cu, l, u); } } \
        } SEAM(pb + 3); \
        if (INL(4)) { _Pragma("unroll") for (int rep = 0; rep < NREP(2 + 9 * l + 4); ++rep) { if (rep) xcd_barrier(bar); \
            FRESH(C, C0); \
            pg8::Gemm g{FP8_OUT ? (const bf16*)WSP(unsigned char, WS_HA8) : WSP(bf16, WS_HB), FP8_OUT ? (const bf16*)(WSP(unsigned char, WS_WOUT) + (size_t)l * DM * DM) : WSP(bf16, WS_WOUT) + (size_t)l * DM * DM, FP8_OUT ? DM / 2 : DM}; \
            pg8::DenseOrder S; S.init(nrows, DM, C.G, C.bid); \
            pg8::EpiBf16 E{WSP(bf16, WS_YO), DM, 1 << 30}; \
            pg8::gemm_phase<pg8::EpiBf16, pg8::DenseOrder, false, FP8_OUT != 0>(C.lds, g, S, E); \
            if (!last && rep == 0 && TAILQ > 0) {        \
                FRESH(Ct, C0); \
                volatile LAS int* qc = (volatile LAS int*)(Ct.lds + LDS_MISC + 36); \
                unsigned* tctr = WSP(unsigned, WS_CTL) + CW_QUEUE + 12 * 64; \
                for (;;) { \
                    __syncthreads(); if (Ct.tid == 0) *qc = NCU_E + NCU_P - TAILQ + (int)atomicAdd(tctr, 1u); __syncthreads(); \
                    const int cu = __builtin_amdgcn_readfirstlane(*qc); if (cu >= NCU_E + NCU_P) break; \
                    FRESH(Cu, Ct); bg_conv_unit(Cu, 0, cu); \
                } } \
        } \
        } SEAM(pb + 4); \
        if (INL(5)) { FRESH(C, C0); ph_post1(C, l, nrows); if (PROBE_P1 && l == 0) { xcd_barrier(bar); FRESH(C2, C0); ph_post1(C2, l, nrows, true); } } \
        SEAM(pb + 5); \
        if (INL(6)) { _Pragma("unroll") for (int rep = 0; rep < NREP(2 + 9 * l + 6); ++rep) { if (rep) xcd_barrier(bar); \
            FRESH(C, C0); \
            const int nblk = moe_tables(C, l); const LAS int* T = (const LAS int*)(C.lds + LDS_TAB); \
            pg8::Gemm g{(const bf16*)WSP(unsigned char, WS_HB8), (const bf16*)(WSP(unsigned char, WS_WGU) + (size_t)l * NE * 1536 * DM), DM / 2}; \
            pg8::MoeOrder S; S.nblk = nblk; S.nN = 6; S.G = C.G; S.c = C.bid; S.blk_e = T; S.bst = T + 168; S.cnt = T + 200; S.exptok = WSP(int, WS_EXPTOK); S.ntok = NTOK; \
            pg8::EpiGLU E{WSP(unsigned char, WS_HG), DE}; \
            pg8::gemm_phase<pg8::EpiGLU, pg8::MoeOrder, true, true>(C.lds, g, S, E); \
        } } \
        SEAM(pb + 6); \
        if (INL(7)) { _Pragma("unroll") for (int rep = 0; rep < NREP(2 + 9 * l + 7); ++rep) { if (rep) xcd_barrier(bar); \
            FRESH(C, C0); \
            const int nblk = moe_tables(C, l); const LAS int* T = (const LAS int*)(C.lds + LDS_TAB); \
            pg8::Gemm g{(const bf16*)WSP(unsigned char, WS_HG), (const bf16*)(WSP(unsigned char, WS_WD) + (size_t)l * NE * DM * DE), DE / 2}; \
            pg8::MoeOrder S; S.nblk = nblk; S.nN = 8; S.G = C.G; S.c = C.bid; S.blk_e = T; S.bst = T + 168; S.cnt = T + 200; S.exptok = WSP(int, WS_EXPTOK); S.ntok = NTOK; \
            pg8::EpiFp8 E{WSP(unsigned char, WS_YS), DM, 16.0f}; \
            pg8::gemm_phase<pg8::EpiFp8, pg8::MoeOrder, false, true>(C.lds, g, S, E); \
        } } \
        SEAM(pb + 7); \
        if (INL(8)) { FRESH(C, C0); ph_post2(C, l, nrows); if (PROBE_P2 && l == 1) { xcd_barrier(bar); FRESH(C2, C0); ph_post2(C2, l, nrows); } } \
        SEAM(pb + 8); \
} while (0)
    LAYER_BODY(0);
    LAYER_BODY(1);
#undef IN
#undef INL
#undef SEAM
}

extern "C" void kernel_launch(void* const* d_in, const int* in_sizes, int n_in, void* d_out, int out_size, void* d_ws, size_t ws_size, hipStream_t stream) {
    static int grid = 0;
    if (grid == 0) {
        if (n_in != 35 || out_size != NLAT * DM || ws_size < WS_END) { fprintf(stderr, "kernel_launch: unexpected shapes (n_in %d out %d ws %zu)\n", n_in, out_size, ws_size); grid = -1; return; }
        int dev = 0, cus = 0;
        if (hipGetDevice(&dev) != hipSuccess || hipDeviceGetAttribute(&cus, hipDeviceAttributeMultiprocessorCount, dev) != hipSuccess) { grid = -1; return; }
        if (hipFuncSetAttribute((const void*)fwd_kernel, hipFuncAttributeMaxDynamicSharedMemorySize, LDS_BYTES) != hipSuccess) { fprintf(stderr, "kernel_launch: hipFuncSetAttribute failed\n"); grid = -1; return; }
        int per_cu = 0;
        if (hipOccupancyMaxActiveBlocksPerMultiprocessor(&per_cu, (const void*)fwd_kernel, 512, LDS_BYTES) != hipSuccess || per_cu < 1) fprintf(stderr, "kernel_launch: occupancy query says %d\n", per_cu);
        (void)hipGetLastError();
        grid = cus;
    }
    if (grid < 0) return;
    (void)hipMemsetAsync((char*)d_ws + WS_CTL, 0, CTL_ZERO_BYTES, stream);
    Args a{};
    for (int i = 0; i < 35; ++i) a.in[i] = (const float*)d_in[i];
    a.out = (float*)d_out; a.ws = (unsigned char*)d_ws;
    if (MK_N_LAUNCHES == 1) { a.ph_lo = 0; a.ph_hi = N_PHASES; hipLaunchKernelGGL(fwd_kernel, dim3(grid), dim3(512), LDS_BYTES, stream, a); }
    else for (int p = 0; p < N_PHASES; ++p) { a.ph_lo = p; a.ph_hi = p + 1; hipLaunchKernelGGL(fwd_kernel, dim3(grid), dim3(512), LDS_BYTES, stream, a); }
}
```

```cpp
#include <hip/hip_runtime.h>
#include <cstdio>
#include <cstdint>

#ifndef DUP_MASK
#define DUP_MASK 0u
#endif
#ifndef PROBE_P1
#define PROBE_P1 0
#endif
#ifndef PROBE_P2
#define PROBE_P2 0
#endif
#ifndef FP8_IN
#define FP8_IN 1
#endif
#ifndef FP8_OUT
#define FP8_OUT 1
#endif
#ifndef PROBE_P0
#define PROBE_P0 0
#endif
#ifndef PROBE_CONV
#define PROBE_CONV 0
#endif
#ifndef DUP_SUB
#define DUP_SUB 0u
#endif
#define NSUB(k) (((DUP_SUB >> (k)) & 1u) ? 2 : 1)
#define NREP(k) (((DUP_MASK >> (k)) & 1u) ? 2 : 1)
#ifndef MK_N_LAUNCHES
#define MK_N_LAUNCHES 1
#endif

#define LAS __attribute__((address_space(3)))
#define GAS __attribute__((address_space(1)))
typedef unsigned short bf16;
typedef short bf16x8 __attribute__((ext_vector_type(8)));
typedef float f32x2 __attribute__((ext_vector_type(2)));
typedef float f32x4 __attribute__((ext_vector_type(4)));
typedef float f32x16 __attribute__((ext_vector_type(16)));
typedef unsigned u32x2 __attribute__((ext_vector_type(2)));
typedef unsigned u32x4 __attribute__((ext_vector_type(4)));
typedef __bf16 bf16x2_t __attribute__((ext_vector_type(2)));

constexpr int DM = 2048, NB = 4, SL = 4096, CL = 256, NLAT = NB * SL, NCTX = NB * CL, NTOK = NLAT + NCTX;
constexpr int INW = 3840, DE = 768, NE = 32, MAXBLK = 168;
constexpr float LN_EPS = 1e-6f, ALPHA = 1.41421356237f, LOG2E = 1.44269504089f;

constexpr size_t MiB = 1u << 20;
constexpr size_t WS_CTL = 0, CTL_ZERO_BYTES = 1 * MiB;
constexpr size_t WS_MOD = 1 * MiB;
constexpr size_t WS_ROPE = 2 * MiB;
constexpr size_t WS_TOKINFO = 2 * MiB + 65536;
constexpr size_t WS_TOKW = WS_TOKINFO + (size_t)NTOK * 16;
constexpr size_t WS_ROWSLOT = WS_TOKW + (size_t)NTOK * 8;
constexpr size_t WS_SLOTW = WS_ROWSLOT + (size_t)NTOK * 8;
static_assert(WS_SLOTW + 43008 * 4 <= 4 * MiB, "small tables");
constexpr size_t WS_POOLWT = 3 * MiB;
constexpr size_t WS_GWSB = 3 * MiB + 512 * 1024;
constexpr size_t WS_WIN = 4 * MiB;
constexpr size_t WS_WOUT = 34 * MiB;
constexpr size_t WS_WGU = 50 * MiB;
constexpr size_t WS_WD = 434 * MiB;
constexpr size_t WS_FILT = 626 * MiB;
constexpr size_t WS_FILTC = 658 * MiB;
constexpr size_t WS_X = 660 * MiB;
constexpr size_t WS_HB = 796 * MiB;
constexpr size_t WS_Z = 864 * MiB;
constexpr size_t WS_YCAT = 992 * MiB;
constexpr size_t WS_TL = 1060 * MiB;
constexpr size_t WS_TC = 1108 * MiB;
constexpr size_t WS_YHT = 1112 * MiB;
constexpr size_t WS_YO = 1129 * MiB;
constexpr size_t WS_EXPTOK = 864 * MiB;
constexpr size_t WS_HG = 1032 * MiB;
constexpr size_t WS_YS = 1095 * MiB;
constexpr size_t WS_HB8 = 1265 * MiB;
constexpr size_t WS_HA8 = 1300 * MiB;
constexpr size_t WS_END = 1334 * MiB;
constexpr int CW_BAR = 4096;
constexpr int CW_CNT = 8192;
constexpr int CW_QUEUE = 14336;
constexpr int CW_NBLK = 12288;
constexpr int CW_BLKE = 12544;
constexpr int LDS_TAB = 132096;
constexpr int LDS_BYTES = 147456;
constexpr int LDS_MISC = 147392;

__device__ __forceinline__ unsigned pk2(float lo, float hi) { f32x2 v = {lo, hi}; bf16x2_t b = __builtin_convertvector(v, bf16x2_t); return __builtin_bit_cast(unsigned, b); }
__device__ __forceinline__ unsigned pk4_fp8(float a, float b, float c, float d) { int p = 0; p = __builtin_amdgcn_cvt_pk_fp8_f32(a, b, p, false); p = __builtin_amdgcn_cvt_pk_fp8_f32(c, d, p, true); return (unsigned)p; }
__device__ __forceinline__ float bflo(unsigned w) { return __uint_as_float(w << 16); }
__device__ __forceinline__ float bfhi(unsigned w) { return __uint_as_float(w & 0xffff0000u); }
__device__ __forceinline__ float bf1(bf16 v) { return __uint_as_float(((unsigned)v) << 16); }
template <int CTRL> __device__ __forceinline__ float dpp_f(float x) { return __int_as_float(__builtin_amdgcn_update_dpp(0, __float_as_int(x), CTRL, 0xF, 0xF, true)); }
#define DPP_XOR1 0xB1
#define DPP_XOR2 0x4E
#define DPP_HMIRROR 0x141
#define DPP_MIRROR 0x140
#define DPP_ROR8 0x128
__device__ __forceinline__ float xor16_sum(float x) { const auto r = __builtin_amdgcn_permlane16_swap(__float_as_uint(x), __float_as_uint(x), false, false); return __uint_as_float(r[0]) + __uint_as_float(r[1]); }
__device__ __forceinline__ float xor32_sum(float x) { const auto r = __builtin_amdgcn_permlane32_swap(__float_as_uint(x), __float_as_uint(x), false, false); return __uint_as_float(r[0]) + __uint_as_float(r[1]); }
__device__ __forceinline__ float xor32_max(float x) { const auto r = __builtin_amdgcn_permlane32_swap(__float_as_uint(x), __float_as_uint(x), false, false); return fmaxf(__uint_as_float(r[0]), __uint_as_float(r[1])); }
__device__ __forceinline__ float row16_sum(float v) { v += dpp_f<DPP_XOR1>(v); v += dpp_f<DPP_XOR2>(v); v += dpp_f<DPP_HMIRROR>(v); v += dpp_f<DPP_MIRROR>(v); return v; }
__device__ __forceinline__ float wave_sum(float v) { return xor32_sum(xor16_sum(row16_sum(v))); }
__device__ __forceinline__ float gelu_tanh(float x) { const float y = 0.7978845608f * (x + 0.044715f * x * x * x); const float t = __expf(2.0f * y); return 0.5f * x * (2.0f - 2.0f * __builtin_amdgcn_rcpf(t + 1.0f)); }
__device__ __forceinline__ float silu_f(float x) { return x * __builtin_amdgcn_rcpf(1.0f + __expf(-x)); }
#define LDS_WAIT() asm volatile("s_waitcnt lgkmcnt(0)" ::: "memory")
#define VM_WAIT() asm volatile("s_waitcnt vmcnt(0)" ::: "memory")

namespace pg8 {
#define PG8_LAS __attribute__((address_space(3)))
typedef unsigned short bf16_t;
constexpr int BM = 256, BK = 64, HALF = 128, HTB = HALF * BK * 2, STAGE_BYTES = 8 * HTB, NXCD = 8, WGM = 8;
__host__ __device__ __forceinline__ int lds_byte(int r, int c) { const int st = (r >> 4) * 2 + (c >> 5), rr = r & 15, cc = c & 31, ob = rr * 64 + cc * 2; return st * 1024 + (ob ^ (((ob >> 9) & 1) << 5)); }
__host__ __device__ __forceinline__ void stage_rc(int b, int& R, int& C) { const int st = b / 1024, sb = b % 1024, swz = sb ^ (((sb >> 9) & 1) << 5); R = (st >> 1) * 16 + swz / 64; C = (st & 1) * 32 + (swz % 64) / 2; }
__host__ __device__ __forceinline__ int perm32(int rho) { const int n = rho >> 4, i = rho & 15; return 8 * (i >> 2) + 4 * n + (i & 3); }

struct Unit { int pm, pn, pb; const int* amap; int nvalid; };
struct Gemm { const bf16_t* A; const bf16_t* Bt; int K; };

struct DenseOrder {
    int nM, nN, nwg, G, c;
    __device__ void init(int M, int N, int G_, int c_) { nM = M / BM; nN = N / BM; nwg = nM * nN; G = G_; c = c_; }
    __device__ bool next(int i, Unit& u) const {
        const long L = (long)i * G + c; if (L >= nwg) return false;
        int wgid = (int)L; { const int q = nwg / NXCD, r = nwg % NXCD, xcd = wgid % NXCD, off = wgid / NXCD; wgid = (xcd < r ? xcd * (q + 1) : r * (q + 1) + (xcd - r) * q) + off; }
        const int nig = WGM * nN, gid = wgid / nig, fm = gid * WGM, gsz = (nM - fm) < WGM ? (nM - fm) : WGM;
        u.pm = fm + ((wgid % nig) % gsz); u.pn = (wgid % nig) / gsz; u.pb = u.pn; u.amap = nullptr; u.nvalid = 0; return true;
    }
    __device__ __forceinline__ void a_ready(const Unit&) const {}
    __device__ __forceinline__ void done(const Unit&) const {}
};
struct MoeOrder {
    int nblk, nN, G, c; const PG8_LAS int* blk_e; const PG8_LAS int* bst; const PG8_LAS int* cnt; const int* exptok; int ntok;
    __device__ bool next(int i, Unit& u) const {
        const long L = (long)i * G + c; const int nwg = nblk * nN; if (L >= nwg) return false;
        int wgid = (int)L; { const int q = nwg / NXCD, r = nwg % NXCD, xcd = wgid % NXCD, off = wgid / NXCD; wgid = (xcd < r ? xcd * (q + 1) : r * (q + 1) + (xcd - r) * q) + off; }
        const int blk = wgid / nN, pn = wgid % nN, e = blk_e[blk], p0 = (blk - bst[e]) * 256;
        u.pm = blk; u.pn = pn; u.pb = e * nN + pn; u.amap = exptok + (size_t)e * ntok + p0; u.nvalid = cnt[e] - p0; return true;
    }
    __device__ __forceinline__ void a_ready(const Unit&) const {}
    __device__ __forceinline__ void done(const Unit&) const {}
};

struct EpiBf16 {
    static constexpr bool PERM = true;
    bf16_t* O; int ldc; int gelu_from;
    __device__ __forceinline__ void operator()(const f32x4 (&acc)[2][2][4][2], const Unit& u, int wr, int wc, int fr, int fq) const {
        const int row0 = u.pm * BM + wr * 64 + fr; const int col0 = u.pn * BM + wc * 32 + 8 * fq; const bool act = u.pn >= gelu_from;
#pragma unroll
        for (int ai = 0; ai < 2; ++ai)
#pragma unroll
            for (int m = 0; m < 4; ++m) { bf16_t* rowp = O + (size_t)(row0 + ai * HALF + m * 16) * ldc + col0;
#pragma unroll
                for (int bj = 0; bj < 2; ++bj) { f32x4 v0 = acc[ai][bj][m][0], v1 = acc[ai][bj][m][1];
                    if (act) {
#pragma unroll
                        for (int j = 0; j < 4; ++j) { v0[j] = gelu_tanh(v0[j]); v1[j] = gelu_tanh(v1[j]); } }
                    u32x4 w; w.x = pk2(v0[0], v0[1]); w.y = pk2(v0[2], v0[3]); w.z = pk2(v1[0], v1[1]); w.w = pk2(v1[2], v1[3]);
                    *(u32x4*)(rowp + bj * HALF) = w; } }
    }
};
struct EpiFp8 {
    static constexpr bool PERM = true;
    unsigned char* O; int ldc; float scale;
    __device__ __forceinline__ void operator()(const f32x4 (&acc)[2][2][4][2], const Unit& u, int wr, int wc, int fr, int fq) const {
        const int row0 = u.pm * BM + wr * 64 + fr; const int col0 = u.pn * BM + wc * 32 + 8 * fq;
#pragma unroll
        for (int ai = 0; ai < 2; ++ai)
#pragma unroll
            for (int m = 0; m < 4; ++m) { unsigned char* rowp = O + (size_t)(row0 + ai * HALF + m * 16) * ldc + col0;
#pragma unroll
                for (int bj = 0; bj < 2; ++bj) { const f32x4 v0 = acc[ai][bj][m][0] * scale, v1 = acc[ai][bj][m][1] * scale;
                    u32x2 w; w.x = pk4_fp8(v0[0], v0[1], v0[2], v0[3]); w.y = pk4_fp8(v1[0], v1[1], v1[2], v1[3]);
                    *(u32x2*)(rowp + bj * HALF) = w; } }
    }
};
struct EpiF32 {
    static constexpr bool PERM = false;
    float* C; int ldc;
    __device__ __forceinline__ void operator()(const f32x4 (&acc)[2][2][4][2], const Unit& u, int wr, int wc, int fr, int fq) const {
        const int row0 = u.pm * BM + wr * 64 + fr, col0 = u.pn * BM + wc * 32 + 4 * fq;
#pragma unroll
        for (int ai = 0; ai < 2; ++ai)
#pragma unroll
            for (int m = 0; m < 4; ++m) { float* rowp = C + (size_t)(row0 + ai * HALF + m * 16) * ldc + col0;
#pragma unroll
                for (int bj = 0; bj < 2; ++bj)
#pragma unroll
                    for (int n = 0; n < 2; ++n) *(f32x4*)(rowp + bj * HALF + n * 16) = acc[ai][bj][m][n]; }
    }
};
struct EpiGLU {
    static constexpr bool PERM = true;
    unsigned char* O; int ldc;
    __device__ __forceinline__ void operator()(const f32x4 (&acc)[2][2][4][2], const Unit& u, int wr, int wc, int fr, int fq) const {
        const int row0 = u.pm * BM + wr * 64 + fr; const int col0 = u.pn * HALF + wc * 32 + 8 * fq;
#pragma unroll
        for (int ai = 0; ai < 2; ++ai)
#pragma unroll
            for (int m = 0; m < 4; ++m) { unsigned char* rowp = O + (size_t)(row0 + ai * HALF + m * 16) * ldc + col0;
                float o[8];
#pragma unroll
                for (int n = 0; n < 2; ++n)
#pragma unroll
                    for (int j = 0; j < 4; ++j) { const float g = acc[ai][0][m][n][j], up = acc[ai][1][m][n][j]; o[4 * n + j] = (g * __builtin_amdgcn_rcpf(1.0f + __expf(-g))) * up; }
                u32x2 w; w.x = pk4_fp8(o[0], o[1], o[2], o[3]); w.y = pk4_fp8(o[4], o[5], o[6], o[7]);
                *(u32x2*)rowp = w; }
    }
};
struct EpiScaleBf16 {
    static constexpr bool PERM = true;
    bf16_t* O; int ldc; const float* rs;
    __device__ __forceinline__ void operator()(const f32x4 (&acc)[2][2][4][2], const Unit& u, int wr, int wc, int fr, int fq) const {
        const int row0 = u.pm * BM + wr * 64 + fr; const int col0 = u.pn * BM + wc * 32 + 8 * fq;
#pragma unroll
        for (int ai = 0; ai < 2; ++ai)
#pragma unroll
            for (int m = 0; m < 4; ++m) { const int row = row0 + ai * HALF + m * 16; const float s = rs[row]; bf16_t* rowp = O + (size_t)row * ldc + col0;
#pragma unroll
                for (int bj = 0; bj < 2; ++bj) { const f32x4 v0 = acc[ai][bj][m][0] * s, v1 = acc[ai][bj][m][1] * s;
                    u32x4 w; w.x = pk2(v0[0], v0[1]); w.y = pk2(v0[2], v0[3]); w.z = pk2(v1[0], v1[1]); w.w = pk2(v1[2], v1[3]);
                    *(u32x4*)(rowp + bj * HALF) = w; } }
    }
};

typedef int i32x8 __attribute__((ext_vector_type(8)));
typedef int i32x4v __attribute__((ext_vector_type(4)));
template <class Epi, class Sched, bool GATHER = false, bool FP8 = false, bool ALIGN_EPI = true, bool SP2 = true>
__device__ __forceinline__ void gemm_phase(PG8_LAS unsigned char* lds, const Gemm g, const Sched& S, const Epi& E) {
    int tid_ = threadIdx.x; asm volatile("" : "+v"(tid_));
    const int tid = tid_, wid = __builtin_amdgcn_readfirstlane(tid >> 6), lane = tid & 63, wr = wid >> 2, wc = wid & 3, fr = lane & 15, fq = lane >> 4;
    int K_ = g.K; asm volatile("" : "+s"(K_));
    const int K = K_, nt = K / BK;
    unsigned voffA[2], voffB[2];
#pragma unroll
    for (int i = 0; i < 2; ++i) { int R, C; stage_rc(tid * 16 + i * 8192, R, C); const int Rb = Epi::PERM ? ((R & ~31) + perm32(R & 31)) : R;
        voffA[i] = (unsigned)(R * K + C) * 2u; voffB[i] = (unsigned)(Rb * K + C) * 2u; }
    const size_t kstep = (size_t)(BK * 2);
    const size_t hstep = (size_t)HALF * K * 2;
    const size_t tstep = 2 * hstep;
    const unsigned ldsw = (unsigned)wid * 1024u;
    const int aoff = lds_byte(wr * 64 + fr, fq * 8), boff = lds_byte(wc * 32 + fr, fq * 8);
#define PG8_SA(b, h) (((b) * 2 + (h)) * HTB)
#define PG8_SB(b, h) ((4 + (b) * 2 + (h)) * HTB)
#define PG8_STAGE(bufoff, gbase, voff) do { _Pragma("unroll") for (int _i = 0; _i < 2; ++_i) \
        __builtin_amdgcn_global_load_lds((const unsigned*)((const char*)(gbase) + (voff)[_i]), (PG8_LAS unsigned*)(lds + (bufoff) + ldsw + _i * 8192), 16, 0, 0); } while (0)
#define PG8_STAGE_G(bufoff, kbytes, o0, o1) do { \
        __builtin_amdgcn_global_load_lds((const unsigned*)((const char*)g.A + (kbytes) + (o0)), (PG8_LAS unsigned*)(lds + (bufoff) + ldsw), 16, 0, 0); \
        __builtin_amdgcn_global_load_lds((const unsigned*)((const char*)g.A + (kbytes) + (o1)), (PG8_LAS unsigned*)(lds + (bufoff) + ldsw + 8192), 16, 0, 0); } while (0)
#define PG8_LOADMAP(u, O) do { _Pragma("unroll") for (int _h = 0; _h < 2; ++_h) _Pragma("unroll") for (int _i = 0; _i < 2; ++_i) { int _R, _C; stage_rc(tid * 16 + _i * 8192, _R, _C); const int _rr = _h * HALF + _R; \
        int _t = (_rr < (u).nvalid) ? (u).amap[_rr] : 0; _t = ((unsigned)_t < 17408u) ? _t : 0; O[_h][_i] = (unsigned)(_t * K + _C) * 2u; } } while (0)
#define PG8_LD8(p) __builtin_shufflevector(*(const PG8_LAS i32x4v*)(p), *(const PG8_LAS i32x4v*)((p) + 1024), 0, 1, 2, 3, 4, 5, 6, 7)
#define PG8_LDA(dst, b, h) do { if constexpr (FP8) { _Pragma("unroll") for (int m = 0; m < 4; ++m) dst##8[m] = PG8_LD8(lds + PG8_SA(b, h) + aoff + m * 2048); } \
        else { _Pragma("unroll") for (int m = 0; m < 4; ++m) _Pragma("unroll") for (int k = 0; k < 2; ++k) dst[m][k] = *(const PG8_LAS bf16x8*)(lds + PG8_SA(b, h) + aoff + m * 2048 + k * 1024); } } while (0)
#define PG8_LDB(dst, b, h) do { if constexpr (FP8) { _Pragma("unroll") for (int n = 0; n < 2; ++n) dst##8[n] = PG8_LD8(lds + PG8_SB(b, h) + boff + n * 2048); } \
        else { _Pragma("unroll") for (int n = 0; n < 2; ++n) _Pragma("unroll") for (int k = 0; k < 2; ++k) dst[n][k] = *(const PG8_LAS bf16x8*)(lds + PG8_SB(b, h) + boff + n * 2048 + k * 1024); } } while (0)
#define PG8_MMA(ai, bj, At, Bt) do { __builtin_amdgcn_s_setprio(1); \
        if constexpr (FP8) { _Pragma("unroll") for (int m = 0; m < 4; ++m) _Pragma("unroll") for (int n = 0; n < 2; ++n) \
            asm volatile("v_mfma_scale_f32_16x16x128_f8f6f4 %0, %1, %2, %0, %3, %4 op_sel_hi:[0,0,0]" : "+v"(acc[ai][bj][m][n]) : "v"(Bt##8[n]), "v"(At##8[m]), "v"(sc_w), "v"(sc_x)); } \
        else { _Pragma("unroll") for (int m = 0; m < 4; ++m) _Pragma("unroll") for (int n = 0; n < 2; ++n) _Pragma("unroll") for (int k = 0; k < 2; ++k) \
            acc[ai][bj][m][n] = __builtin_amdgcn_mfma_f32_16x16x32_bf16(Bt[n][k], At[m][k], acc[ai][bj][m][n], 0, 0, 0); } \
        __builtin_amdgcn_s_setprio(0); } while (0)
#define PG8_WAIT_V(n) asm volatile("s_waitcnt vmcnt(" #n ")" ::: "memory")
#define PG8_WAIT_L(n) asm volatile("s_waitcnt lgkmcnt(" #n ")" ::: "memory")
#define PG8_BAR __builtin_amdgcn_s_barrier()
#define PG8_SCHED __builtin_amdgcn_sched_barrier(0)
    Unit cur, nxt; int ui = 0;
    if (!S.next(0, cur)) return;
    f32x4 acc[2][2][4][2];
#pragma unroll
    for (int a = 0; a < 2; ++a)
#pragma unroll
        for (int b = 0; b < 2; ++b)
#pragma unroll
            for (int m = 0; m < 4; ++m)
#pragma unroll
                for (int n = 0; n < 2; ++n) acc[a][b][m][n] = (f32x4){0.f, 0.f, 0.f, 0.f};
    bf16x8 At[4][2], B0[2][2], B1[2][2]; i32x8 At8[4], B08[2], B18[2];
    const int sc_w = 0x79797979, sc_x = 0x7f7f7f7f;
    const char* cA = (const char*)g.A + (size_t)cur.pm * tstep; const char* cB = (const char*)g.Bt + (size_t)cur.pb * tstep;
    unsigned cO[2][2] = {{0u, 0u}, {0u, 0u}}, nO[2][2] = {{0u, 0u}, {0u, 0u}};
    S.a_ready(cur);
    if constexpr (GATHER) { static_assert(SP2, "GATHER needs the SP2 loop"); PG8_LOADMAP(cur, cO); }
    if constexpr (SP2) {
        PG8_STAGE(PG8_SB(0, 0), cB, voffB); PG8_STAGE(PG8_SB(0, 1), cB + hstep, voffB);
        if constexpr (GATHER) { PG8_STAGE_G(PG8_SA(0, 0), 0, cO[0][0], cO[0][1]); PG8_STAGE_G(PG8_SA(0, 1), 0, cO[1][0], cO[1][1]); }
        else { PG8_STAGE(PG8_SA(0, 0), cA, voffA); PG8_STAGE(PG8_SA(0, 1), cA + hstep, voffA); }
        if (wr == 1) PG8_BAR;
        PG8_WAIT_V(2); PG8_BAR;
        PG8_STAGE(PG8_SB(1, 0), cB + kstep, voffB);
        if constexpr (GATHER) PG8_STAGE_G(PG8_SA(1, 0), kstep, cO[0][0], cO[0][1]); else PG8_STAGE(PG8_SA(1, 0), cA + kstep, voffA);
        PG8_STAGE(PG8_SB(1, 1), cB + hstep + kstep, voffB);
        PG8_WAIT_V(6); PG8_BAR;
    } else {
        PG8_STAGE(PG8_SB(0, 0), cB, voffB); PG8_STAGE(PG8_SA(0, 0), cA, voffA); PG8_STAGE(PG8_SB(0, 1), cB + hstep, voffB); PG8_STAGE(PG8_SA(0, 1), cA + hstep, voffA);
        if (wr == 1) PG8_BAR;
        PG8_WAIT_V(4); PG8_BAR;
        PG8_STAGE(PG8_SB(1, 0), cB + kstep, voffB); PG8_STAGE(PG8_SA(1, 0), cA + kstep, voffA); PG8_STAGE(PG8_SB(1, 1), cB + hstep + kstep, voffB);
        PG8_WAIT_V(6); PG8_BAR;
    }
    for (;;) {
        const bool has_next = S.next(ui + 1, nxt);
        const char* nA = has_next ? (const char*)g.A + (size_t)nxt.pm * tstep : cA; const char* nB = has_next ? (const char*)g.Bt + (size_t)nxt.pb * tstep : cB;
        if constexpr (GATHER) { if (has_next) PG8_LOADMAP(nxt, nO); else {
#pragma unroll
            for (int _h = 0; _h < 2; ++_h) { nO[_h][0] = cO[_h][0]; nO[_h][1] = cO[_h][1]; } } }
#pragma unroll 1
        for (int t = 0; t < nt; t += 2) {
            const bool last = (t == nt - 2);
            const char* a1 = cA + (size_t)(t + 1) * kstep;
            const char* a2 = last ? nA : cA + (size_t)(t + 2) * kstep; const char* b2 = last ? nB : cB + (size_t)(t + 2) * kstep;
            const char* a3 = a2 + kstep; const char* b3 = b2 + kstep;
            if (last && has_next) S.a_ready(nxt);
            if constexpr (SP2) {
            const size_t k1 = (size_t)(t + 1) * kstep, k2 = last ? (size_t)0 : (size_t)(t + 2) * kstep, k3 = k2 + kstep;
            const unsigned g00 = last ? nO[0][0] : cO[0][0], g01 = last ? nO[0][1] : cO[0][1], g10 = last ? nO[1][0] : cO[1][0], g11 = last ? nO[1][1] : cO[1][1];
            PG8_LDB(B0, 0, 0); PG8_LDB(B1, 0, 1); PG8_SCHED; PG8_LDA(At, 0, 0);
            if constexpr (GATHER) PG8_STAGE_G(PG8_SA(1, 1), k1, cO[1][0], cO[1][1]); else PG8_STAGE(PG8_SA(1, 1), a1 + hstep, voffA);
            PG8_WAIT_V(8); PG8_WAIT_L(0); PG8_BAR; PG8_MMA(0, 0, At, B0); PG8_MMA(0, 1, At, B1); PG8_BAR; PG8_SCHED;
            PG8_LDA(At, 0, 1); PG8_STAGE(PG8_SB(0, 0), b2, voffB); PG8_STAGE(PG8_SB(0, 1), b2 + hstep, voffB);
            if constexpr (GATHER) PG8_STAGE_G(PG8_SA(0, 0), k2, g00, g01); else PG8_STAGE(PG8_SA(0, 0), a2, voffA);
            PG8_WAIT_V(8); PG8_WAIT_L(0); PG8_BAR; PG8_MMA(1, 0, At, B0); PG8_MMA(1, 1, At, B1); PG8_BAR; PG8_SCHED;
            PG8_LDB(B0, 1, 0); PG8_LDB(B1, 1, 1); PG8_SCHED; PG8_LDA(At, 1, 0);
            if constexpr (GATHER) PG8_STAGE_G(PG8_SA(0, 1), k2, g10, g11); else PG8_STAGE(PG8_SA(0, 1), a2 + hstep, voffA);
            PG8_WAIT_V(8); PG8_WAIT_L(0); PG8_BAR; PG8_MMA(0, 0, At, B0); PG8_MMA(0, 1, At, B1); PG8_BAR; PG8_SCHED;
            PG8_LDA(At, 1, 1); PG8_STAGE(PG8_SB(1, 0), b3, voffB); PG8_STAGE(PG8_SB(1, 1), b3 + hstep, voffB);
            if constexpr (GATHER) PG8_STAGE_G(PG8_SA(1, 0), k3, g00, g01); else PG8_STAGE(PG8_SA(1, 0), a3, voffA);
            PG8_WAIT_V(8); PG8_WAIT_L(0); PG8_BAR; PG8_MMA(1, 0, At, B0); PG8_MMA(1, 1, At, B1); PG8_BAR; PG8_SCHED;
            } else {
            PG8_LDB(B0, 0, 0); PG8_SCHED; PG8_LDA(At, 0, 0); PG8_STAGE(PG8_SA(1, 1), a1 + hstep, voffA);
            PG8_WAIT_L(8); PG8_BAR; PG8_WAIT_L(0); PG8_MMA(0, 0, At, B0); PG8_BAR; PG8_SCHED;
            PG8_LDB(B1, 0, 1); PG8_STAGE(PG8_SB(0, 0), b2, voffB);
            PG8_BAR; PG8_WAIT_L(0); PG8_MMA(0, 1, At, B1); PG8_BAR;
            PG8_LDA(At, 0, 1); PG8_STAGE(PG8_SA(0, 0), a2, voffA);
            PG8_BAR; PG8_WAIT_L(0); PG8_MMA(1, 0, At, B0); PG8_BAR; PG8_SCHED;
            PG8_STAGE(PG8_SB(0, 1), b2 + hstep, voffB);
            PG8_WAIT_V(6); PG8_BAR; PG8_MMA(1, 1, At, B1); PG8_BAR;
            PG8_LDB(B0, 1, 0); PG8_SCHED; PG8_LDA(At, 1, 0); PG8_STAGE(PG8_SA(0, 1), a2 + hstep, voffA);
            PG8_WAIT_L(8); PG8_BAR; PG8_WAIT_L(0); PG8_MMA(0, 0, At, B0); PG8_BAR; PG8_SCHED;
            PG8_LDB(B1, 1, 1); PG8_STAGE(PG8_SB(1, 0), b3, voffB);
            PG8_BAR; PG8_WAIT_L(0); PG8_MMA(0, 1, At, B1); PG8_BAR;
            PG8_LDA(At, 1, 1); PG8_STAGE(PG8_SA(1, 0), a3, voffA);
            PG8_BAR; PG8_WAIT_L(0); PG8_MMA(1, 0, At, B0); PG8_BAR; PG8_SCHED;
            PG8_STAGE(PG8_SB(1, 1), b3 + hstep, voffB);
            PG8_WAIT_V(6); PG8_BAR; PG8_MMA(1, 1, At, B1); PG8_BAR;
            }
        }
        if constexpr (ALIGN_EPI) { if (wr == 0) PG8_BAR; }
        if constexpr (FP8) asm volatile("s_nop 15\n\ts_nop 15" ::: "memory");
        E(acc, cur, wr, wc, fr, fq); S.done(cur);
        if (!has_next) break;
#pragma unroll
        for (int a = 0; a < 2; ++a)
#pragma unroll
            for (int b = 0; b < 2; ++b)
#pragma unroll
                for (int m = 0; m < 4; ++m)
#pragma unroll
                    for (int n = 0; n < 2; ++n) acc[a][b][m][n] = (f32x4){0.f, 0.f, 0.f, 0.f};
        cur = nxt; cA = nA; cB = nB; ++ui;
        if constexpr (GATHER) {
#pragma unroll
            for (int _h = 0; _h < 2; ++_h) { cO[_h][0] = nO[_h][0]; cO[_h][1] = nO[_h][1]; } }
        if constexpr (ALIGN_EPI) { if (wr == 1) PG8_BAR; }
    }
    PG8_WAIT_V(0);
    if constexpr (!ALIGN_EPI) { if (wr == 0) PG8_BAR; }
    PG8_BAR;
#undef PG8_SA
#undef PG8_SB
#undef PG8_STAGE
#undef PG8_STAGE_G
#undef PG8_LOADMAP
#undef PG8_LDA
#undef PG8_LDB
#undef PG8_MMA
#undef PG8_LD8
#undef PG8_WAIT_V
#undef PG8_WAIT_L
#undef PG8_BAR
#undef PG8_SCHED
}
}

#define XB_TMO      128
#define XB_XCNT(j)  (256  + 64 * (j))
#define XB_XSUB(j)  (1280 + 64 * (j))
#define XB_XGEN(j)  (2304 + 64 * (j))
#define XB_TOP      3328
#define XB_TOPGEN   3392
#define XCD_BAR_WORDS 3456
#define XB_SPIN_CAP (1u << 18)
__device__ __forceinline__ unsigned xb_ld(unsigned* p)              { return __hip_atomic_load(p, __ATOMIC_RELAXED, __HIP_MEMORY_SCOPE_AGENT); }
__device__ __forceinline__ unsigned xb_add(unsigned* p, unsigned v) { return __hip_atomic_fetch_add(p, v, __ATOMIC_RELAXED, __HIP_MEMORY_SCOPE_AGENT); }
__device__ __forceinline__ unsigned xb_xcc_id() { return (unsigned)__builtin_amdgcn_s_getreg((3 << 11) | 20) & 0xFu; }
#define XB_SPIN(cond, bar) do { unsigned _sp = 0; while (cond) { __builtin_amdgcn_s_sleep(1); \
    if ((++_sp & 255u) == 0u) { if (xb_ld(&(bar)[XB_TMO])) break; if (_sp > XB_SPIN_CAP) { atomicAdd(&(bar)[XB_TMO], 1u); break; } } } } while (0)
struct XcdBarrier { unsigned* bar; unsigned x; volatile LAS unsigned* st; };
__device__ __forceinline__ XcdBarrier xcd_barrier_post(unsigned* bar, volatile LAS unsigned* st) {
    XcdBarrier b; b.bar = bar; b.x = xb_xcc_id(); b.st = st;
    if (threadIdx.x == 0) (void)xb_add(&bar[XB_XCNT(b.x)], 1u);
    return b;
}
__device__ __forceinline__ void xcd_barrier_complete(unsigned* bar, unsigned x, unsigned& nloc, unsigned& nx) {
    const unsigned G = gridDim.x * gridDim.y * gridDim.z;
    unsigned sum, cnt, mine, sp = 0u;
    for (;;) {
        sum = 0u; cnt = 0u; mine = 0u;
#pragma unroll
        for (unsigned j = 0; j < 16; ++j) { const unsigned c = xb_ld(&bar[XB_XCNT(j)]); sum += c; cnt += (c > 0u) ? 1u : 0u; mine = (j == x) ? c : mine; }
        if (sum == G) break;
        __builtin_amdgcn_s_sleep(1);
        if ((++sp & 255u) == 0u) { if (xb_ld(&bar[XB_TMO])) break; if (sp > XB_SPIN_CAP) { atomicAdd(&bar[XB_TMO], 1u); break; } }
    }
    nloc = mine > 0u ? mine : 1u; nx = cnt > 0u ? cnt : 1u;
}
__device__ __forceinline__ void xcd_barrier(const XcdBarrier& b) {
    asm volatile("s_waitcnt vmcnt(0)" ::: "memory");
    __syncthreads();
    if (threadIdx.x == 0) {
        unsigned* bar = b.bar;
        __builtin_amdgcn_s_waitcnt(0);
        unsigned nloc = b.st[0], nx = b.st[1];
        if (nloc == 0u) { xcd_barrier_complete(bar, b.x, nloc, nx); b.st[0] = nloc; b.st[1] = nx; }
        const unsigned old = xb_add(&bar[XB_XSUB(b.x)], 1u);
        const unsigned gen = old / nloc;
        if (old + 1u == (gen + 1u) * nloc) {
            __builtin_amdgcn_fence(__ATOMIC_RELEASE, "agent");
            asm volatile("s_waitcnt vmcnt(0)" ::: "memory");
            const unsigned og = xb_add(&bar[XB_TOP], 1u);
            const unsigned tg = og / nx;
            if (og + 1u == (tg + 1u) * nx) xb_add(&bar[XB_TOPGEN], 1u);
            else XB_SPIN(xb_ld(&bar[XB_TOPGEN]) == tg, bar);
            __builtin_amdgcn_fence(__ATOMIC_ACQUIRE, "agent");
            xb_add(&bar[XB_XGEN(b.x)], 1u);
            asm volatile("s_waitcnt vmcnt(0)" ::: "memory");
        } else {
            XB_SPIN(xb_ld(&bar[XB_XGEN(b.x)]) == gen, bar);
            __builtin_amdgcn_fence(__ATOMIC_ACQUIRE, "agent");
            asm volatile("s_waitcnt vmcnt(0)" ::: "memory");
        }
    }
    __syncthreads();
}

struct Args { const float* in[35]; float* out; unsigned char* ws; int ph_lo, ph_hi; };
enum { I_X = 0, I_C, I_CTX, I_CCTX, I_WADA, I_BADA, I_WIN, I_WOUT, I_MNG, I_POOLW, I_POOLS, I_SINK, I_HCW, I_HCB, I_HW1, I_HB1, I_HF1, I_HW2, I_HB2, I_HF2, I_HW3, I_HSKIP,
       I_GLG, I_GLB, I_GWS, I_GBS, I_LN1G, I_LN1B, I_LN2G, I_LN2B, I_WR, I_RB, I_WG, I_WU, I_WD };
struct Ctx {
    LAS unsigned char* lds; int tid, lane, wave, bid, G;
    const float GAS* const __attribute__((address_space(4)))* in; float GAS* out; unsigned char GAS* ws;
};
#define WSP(T, off) ((T*)(T GAS*)(C.ws + (off)))
#define INP(k) ((const float*)C.in[k])
#define FRESH(D, S) Ctx D = S; asm volatile("" : "+v"(D.tid)); D.lane = D.tid & 63; D.wave = __builtin_amdgcn_readfirstlane(D.tid >> 6); asm volatile("" : "+s"(D.bid), "+s"(D.G), "+s"(D.in), "+s"(D.ws), "+s"(D.out))

struct TrBlk { const float GAS* src; unsigned char GAS* dst; int N, K, nb, which; bool gu; };
constexpr int TRP = 144, TRBUF = 256 * TRP;
#define WG_BAR() do { LDS_WAIT(); __builtin_amdgcn_s_barrier(); asm volatile("" ::: "memory"); } while (0)
constexpr int NBL = 4976, NBP = 368;
__device__ __forceinline__ TrBlk tr_decode(Ctx& C, int L, int j) {
    const bool c0 = j < 240, c1 = !c0 && j < NBP, ce = !c0 && !c1;
    const int q = j - (c0 ? 0 : (c1 ? 240 : NBP));
    const int e = ce ? q / 144 : 0, r = ce ? q % 144 : q;
    const int which = ce ? r / 48 : 0, r2 = ce ? r % 48 : r;
    const bool gu = ce && which < 2, dn = ce && which == 2;
    const int NB = c0 ? 15 : (gu ? 3 : 8), nb = r2 % NB, kb = r2 / NB;
    const int N = c0 ? INW : (gu ? DE : DM), K = dn ? DE : DM;
    const int mat = ce ? L * NE + e : L;
    const float GAS* base = c0 ? C.in[I_WIN] : (c1 ? C.in[I_WOUT] : (which == 0 ? C.in[I_WG] : (which == 1 ? C.in[I_WU] : C.in[I_WD])));
    const size_t wsoff = c0 ? WS_WIN : (c1 ? WS_WOUT : (gu ? WS_WGU : WS_WD));
    const int nrows = c0 ? INW : (gu ? 1536 : DM);
    TrBlk t; t.N = N; t.K = K; t.nb = nb; t.which = which; t.gu = gu;
    t.src = base + (size_t)mat * K * N + (size_t)(128 * kb) * N + 256 * nb;
    t.dst = C.ws + wsoff + (size_t)mat * nrows * K + 128 * kb;
    return t;
}
__device__ __forceinline__ void tr_load(const TrBlk& t, int wave, int lane, f32x4 (&v)[16]) {
#pragma unroll
    for (int i = 0; i < 16; ++i) v[i] = __builtin_nontemporal_load((const f32x4 GAS*)((const char GAS*)t.src + (size_t)(16 * wave + i) * t.N * 4 + 16u * lane));
}
__device__ __forceinline__ void tr_pack(LAS unsigned char* buf, int wave, int lane, const f32x4 (&v)[16]) {
#pragma unroll
    for (int j = 0; j < 4; ++j) { u32x4 o;
#pragma unroll
        for (int w = 0; w < 4; ++w) o[w] = pk4_fp8(64.f * v[4 * w][j], 64.f * v[4 * w + 1][j], 64.f * v[4 * w + 2][j], 64.f * v[4 * w + 3][j]);
        *(LAS u32x4*)(buf + (4 * lane + j) * TRP + 16 * wave) = o; }
}
__device__ __forceinline__ void tr_flush(const TrBlk& t, const LAS unsigned char* buf, int wave, int lane) {
#pragma unroll
    for (int tt = 0; tt < 4; ++tt) { const int nl = 32 * wave + 8 * tt + (lane >> 3), n = 256 * t.nb + nl;
        const u32x4 o = *(const LAS u32x4*)(buf + nl * TRP + 16 * (lane & 7));
        const int drow = t.gu ? ((n >> 7) * 256 + (n & 127) + 128 * t.which) : n;
        __builtin_nontemporal_store(o, (u32x4 GAS*)(t.dst + (size_t)drow * t.K + 16 * (lane & 7))); }
}
template <int NBK> __device__ __forceinline__ void tr_blocks(Ctx& C, int L, int b0) {
    f32x4 r0[16], r1[16], r2[16];
    LAS unsigned char* buf0 = C.lds; LAS unsigned char* buf1 = C.lds + TRBUF;
    const TrBlk t0 = tr_decode(C, L, b0), t1 = tr_decode(C, L, b0 + (NBK > 1 ? 1 : 0)), t2 = tr_decode(C, L, b0 + (NBK > 2 ? 2 : 0)), t3 = tr_decode(C, L, b0 + (NBK > 3 ? 3 : 0));
    tr_load(t0, C.wave, C.lane, r0); if (NBK > 1) tr_load(t1, C.wave, C.lane, r1); if (NBK > 2) tr_load(t2, C.wave, C.lane, r2);
    WG_BAR();
    tr_pack(buf0, C.wave, C.lane, r0);
    if (NBK > 3) tr_load(t3, C.wave, C.lane, r0);
    WG_BAR(); tr_flush(t0, buf0, C.wave, C.lane);
    if (NBK > 1) { tr_pack(buf1, C.wave, C.lane, r1); WG_BAR(); tr_flush(t1, buf1, C.wave, C.lane); }
    if (NBK > 2) { tr_pack(buf0, C.wave, C.lane, r2); WG_BAR(); tr_flush(t2, buf0, C.wave, C.lane); }
    if (NBK > 3) { tr_pack(buf1, C.wave, C.lane, r0); WG_BAR(); tr_flush(t3, buf1, C.wave, C.lane); }
}
__device__ __forceinline__ void p0_convert(Ctx& C, int L, int nblocks) {
#pragma unroll 1
    for (int j = C.bid; j < nblocks; j += C.G) tr_blocks<1>(C, L, j);
    __syncthreads();
}
#ifndef UB
#define UB 2
#endif
constexpr int NCU = NBL / UB;
#ifndef TAILQ
#define TAILQ (224 * 4 / UB)
#endif
#ifndef CONV_SPLIT
#define CONV_SPLIT 0
#endif
__device__ __forceinline__ void conv_unit(Ctx& C, int L, int b0) { tr_blocks<UB>(C, L, b0); }
constexpr int NCU_E = (NBL - NBP) / UB, NCU_P = NBP / UB;
__device__ __forceinline__ void bg_conv_unit(Ctx& C, int l, int cu) {
    const bool e = cu < NCU_E; conv_unit(C, e ? l : 1, e ? NBP + cu * UB : (cu - NCU_E) * UB);
}
__device__ __forceinline__ void p0_adaln(Ctx& C) {
    LAS float* sc = (LAS float*)C.lds;
    LAS float* red = (LAS float*)(C.lds + 40960);
    float* MOD = WSP(float, WS_MOD);
    for (int u = C.bid; u < 256; u += C.G) {
        const int l = u >> 7, colbase = (u & 127) * 96;
        __syncthreads();
        for (int i = C.tid; i < 5 * DM; i += 512) { const int r = i >> 11, k = i & 2047; const float v = r < 4 ? INP(I_C)[r * DM + k] : INP(I_CCTX)[k]; sc[i] = silu_f(v); }
        __syncthreads();
        float acc[5][2];
#pragma unroll
        for (int r = 0; r < 5; ++r) { acc[r][0] = 0.f; acc[r][1] = 0.f; }
        const int ln = C.lane < 48 ? C.lane : 47;
        const float* wp = INP(I_WADA) + ((size_t)l * DM + C.wave * 256) * 12288 + colbase + 2 * ln;
#pragma unroll 1
        for (int k0 = 0; k0 < 256; k0 += 16) { f32x2 wv[16];
#pragma unroll
            for (int k = 0; k < 16; ++k) wv[k] = *(const f32x2*)(wp + (size_t)(k0 + k) * 12288);
#pragma unroll
            for (int k = 0; k < 16; ++k)
#pragma unroll
                for (int r = 0; r < 5; ++r) { const float s = sc[r * DM + C.wave * 256 + k0 + k]; acc[r][0] += s * wv[k].x; acc[r][1] += s * wv[k].y; } }
        if (C.lane < 48) {
#pragma unroll
            for (int r = 0; r < 5; ++r) { red[(C.wave * 5 + r) * 96 + 2 * C.lane] = acc[r][0]; red[(C.wave * 5 + r) * 96 + 2 * C.lane + 1] = acc[r][1]; } }
        __syncthreads();
        for (int i = C.tid; i < 480; i += 512) { const int r = i / 96, cc = i % 96; float s = INP(I_BADA)[l * 12288 + colbase + cc];
#pragma unroll
            for (int w = 0; w < 8; ++w) s += red[(w * 5 + r) * 96 + cc];
            MOD[(size_t)(l * 5 + r) * 12288 + colbase + cc] = s; }
    }
    __syncthreads();
}
__device__ __forceinline__ void p0_filters(Ctx& C) {
    LAS float* feat = (LAS float*)C.lds;
    LAS float* h1 = (LAS float*)(C.lds + 4096);
    LAS float* h2 = (LAS float*)(C.lds + 8192);
    for (int u2 = C.bid; u2 < 528 + 0 * C.G; u2 += C.G) {
        const int u = 2 * (u2 % 264) + (u2 / 264);
        int l, L, tb; bf16* dst;
        if (u < 512) { l = u >> 8; tb = u & 255; L = SL; dst = WSP(bf16, WS_FILT) + (size_t)l * 2 * 512 * 8192; }
        else { l = 0; tb = u - 512; L = CL; dst = WSP(bf16, WS_FILTC); }
        const float invLm1 = 1.0f / (float)(L - 1);
        __syncthreads();
        LAS float* w1s = (LAS float*)(C.lds + 12288);
        LAS float* w2s = (LAS float*)(C.lds + 12288 + 33 * 64 * 4);
        for (int i = C.tid; i < 33 * 64; i += 512) w1s[i] = INP(I_HW1)[l * 33 * 64 + i];
        for (int i = C.tid; i < 64 * 64; i += 512) w2s[i] = INP(I_HW2)[l * 64 * 64 + i];
        for (int i = C.tid; i < 16 * 33; i += 512) { const int p = i / 33, j = i % 33; const int t = 16 * tb + p; float v;
            if (j == 0) v = (float)t * invLm1;
            else { const int fi = (j - 1) & 15; const float fr = 1e-4f + (float)fi * ((15.0f - 1e-4f) / 15.0f); const float ang = (6.283185307179586f / (float)L) * (float)t * fr; v = (j <= 16) ? cosf(ang) : -sinf(ang); }
            feat[i] = v; }
        __syncthreads();
        for (int i = C.tid; i < 1024; i += 512) { const int p = i >> 6, hh = i & 63; float s = INP(I_HB1)[l * 64 + hh];
#pragma unroll
            for (int j = 0; j < 33; ++j) s += feat[p * 33 + j] * w1s[j * 64 + hh];
            h1[i] = sinf(INP(I_HF1)[l * 64 + hh] * s); }
        __syncthreads();
        for (int i = C.tid; i < 1024; i += 512) { const int p = i >> 6, hh = i & 63; float s = INP(I_HB2)[l * 64 + hh];
#pragma unroll 16
            for (int j = 0; j < 64; ++j) s += h1[p * 64 + j] * w2s[j * 64 + hh];
            h2[i] = sinf(INP(I_HF2)[l * 64 + hh] * s); }
        __syncthreads();
        float acc[16][4];
#pragma unroll
        for (int p = 0; p < 16; ++p) { acc[p][0] = 0.f; acc[p][1] = 0.f; acc[p][2] = 0.f; acc[p][3] = 0.f; }
#pragma unroll 4
        for (int k = 0; k < 64; ++k) { const f32x4 w = *(const f32x4*)(INP(I_HW3) + (size_t)(l * 64 + k) * 2048 + 4 * C.tid);
#pragma unroll
            for (int p = 0; p < 16; ++p) { const float h = h2[p * 64 + k]; acc[p][0] += h * w[0]; acc[p][1] += h * w[1]; acc[p][2] += h * w[2]; acc[p][3] += h * w[3]; } }
#pragma unroll
        for (int j = 0; j < 4; ++j) { const int col = 4 * C.tid + j, o = col >> 10, dir = (col >> 9) & 1, c = col & 511;
            const float delta = 4.605170186f * (1.0f / 1.5f + (float)c * ((1.0f / 0.3f - 1.0f / 1.5f) / 511.0f));
            bf16* d = dst + (size_t)(o * 512 + c) * (2 * L);
            float val[16];
#pragma unroll
            for (int p = 0; p < 16; ++p) { const int t = 16 * tb + p; val[p] = acc[p][j] * __expf(-(float)t * invLm1 * delta); }
            if (dir == 0) {
                u32x4 w0, w1; w0.x = pk2(val[15], val[14]); w0.y = pk2(val[13], val[12]); w0.z = pk2(val[11], val[10]); w0.w = pk2(val[9], val[8]);
                w1.x = pk2(val[7], val[6]); w1.y = pk2(val[5], val[4]); w1.z = pk2(val[3], val[2]); w1.w = pk2(val[1], val[0]);
                u32x4* q = (u32x4*)(d + L - 16 * (tb + 1)); q[0] = w0; q[1] = w1;
            } else if (tb == 0) {
#pragma unroll
                for (int p = 1; p < 16; ++p) d[L - 1 + p] = (bf16)(pk2(val[p], 0.f) & 0xffffu);
            } else {
                typedef u32x4 __attribute__((aligned(2))) u32x4_u;
                u32x4 w0, w1; w0.x = pk2(val[0], val[1]); w0.y = pk2(val[2], val[3]); w0.z = pk2(val[4], val[5]); w0.w = pk2(val[6], val[7]);
                w1.x = pk2(val[8], val[9]); w1.y = pk2(val[10], val[11]); w1.z = pk2(val[12], val[13]); w1.w = pk2(val[14], val[15]);
                u32x4_u* q = (u32x4_u*)(d + L - 1 + 16 * tb); q[0] = w0; q[1] = w1;
            }
            if (dir == 1 && 16 * (tb + 1) == L) d[2 * L - 1] = 0; }
    }
    __syncthreads();
}
__device__ __forceinline__ void p0_rope(Ctx& C) {
    { const int idx = C.bid * 512 + C.tid;
      for (int e = idx; e < 131072; e += C.G * 512) { const f32x2 v = *(const f32x2*)(INP(I_GWS) + 2 * (size_t)e); WSP(unsigned, WS_GWSB)[e] = pk2(v.x, v.y); } }
    { const int idx = C.bid * 512 + C.tid;
      for (int e = idx; e < 131072; e += C.G * 512) { const int i = e & 127, j = (e >> 7) & 127, lg = e >> 14, l = lg >> 2, gi = lg & 3;
          const float v = INP(I_POOLW)[(size_t)lg * 16384 + i * 128 + j] * INP(I_POOLS)[l * 512 + 128 * gi + j];
          WSP(bf16, WS_POOLWT)[e] = (bf16)(pk2(v, 0.f) & 0xffffu); } }
    if (C.bid == (C.G > 200 ? 200 : 0)) { f32x2* R = WSP(f32x2, WS_ROPE);
        for (int i = C.tid; i < 1024; i += 512) { const int pos = i >> 4, fi = i & 15; const float inv = powf(10000.0f, -(float)fi / 16.0f); const float a = (float)pos * inv; R[i] = (f32x2){cosf(a), sinf(a)}; } }
}

__device__ __forceinline__ const float* src_x0(Ctx& C, int row) {
    return row < NLAT ? INP(I_X) + (size_t)row * DM : INP(I_CTX) + (size_t)(row - NLAT) * DM;
}
__device__ __forceinline__ void row_load(const float* p, int lane, float (&v)[32]) {
#pragma unroll
    for (int j = 0; j < 4; ++j) { const f32x4 a = *(const f32x4*)(p + 512 * j + 8 * lane), b = *(const f32x4*)(p + 512 * j + 8 * lane + 4);
        v[8 * j] = a[0]; v[8 * j + 1] = a[1]; v[8 * j + 2] = a[2]; v[8 * j + 3] = a[3]; v[8 * j + 4] = b[0]; v[8 * j + 5] = b[1]; v[8 * j + 6] = b[2]; v[8 * j + 7] = b[3]; }
}
__device__ __forceinline__ void row_load_bf16(const bf16* p, int lane, float (&v)[32]) {
#pragma unroll
    for (int j = 0; j < 4; ++j) { const u32x4 r = *(const u32x4*)(p + 512 * j + 8 * lane);
        v[8 * j] = __uint_as_float(r.x << 16); v[8 * j + 1] = __uint_as_float(r.x & 0xffff0000u); v[8 * j + 2] = __uint_as_float(r.y << 16); v[8 * j + 3] = __uint_as_float(r.y & 0xffff0000u);
        v[8 * j + 4] = __uint_as_float(r.z << 16); v[8 * j + 5] = __uint_as_float(r.z & 0xffff0000u); v[8 * j + 6] = __uint_as_float(r.w << 16); v[8 * j + 7] = __uint_as_float(r.w & 0xffff0000u); }
}
__device__ __forceinline__ void row_store(float* p, int lane, const float (&v)[32]) {
#pragma unroll
    for (int j = 0; j < 4; ++j) { *(f32x4*)(p + 512 * j + 8 * lane) = (f32x4){v[8 * j], v[8 * j + 1], v[8 * j + 2], v[8 * j + 3]}; *(f32x4*)(p + 512 * j + 8 * lane + 4) = (f32x4){v[8 * j + 4], v[8 * j + 5], v[8 * j + 6], v[8 * j + 7]}; }
}
__device__ __forceinline__ void row_store_bf16(bf16* p, int lane, const float (&v)[32]) {
#pragma unroll
    for (int j = 0; j < 4; ++j) { u32x4 w; w.x = pk2(v[8 * j], v[8 * j + 1]); w.y = pk2(v[8 * j + 2], v[8 * j + 3]); w.z = pk2(v[8 * j + 4], v[8 * j + 5]); w.w = pk2(v[8 * j + 6], v[8 * j + 7]); *(u32x4*)(p + 512 * j + 8 * lane) = w; }
}
__device__ __forceinline__ void row_store_fp8(unsigned char* p, int lane, const float (&v)[32]) {
#pragma unroll
    for (int j = 0; j < 4; ++j) { u32x2 w; w.x = pk4_fp8(v[8 * j], v[8 * j + 1], v[8 * j + 2], v[8 * j + 3]); w.y = pk4_fp8(v[8 * j + 4], v[8 * j + 5], v[8 * j + 6], v[8 * j + 7]); *(u32x2*)(p + 512 * j + 8 * lane) = w; }
}
__device__ __forceinline__ void row_ln(float (&v)[32]) {
    float s = 0.f;
#pragma unroll
    for (int i = 0; i < 32; ++i) s += v[i];
    const float mean = wave_sum(s) * (1.0f / DM); float q = 0.f;
#pragma unroll
    for (int i = 0; i < 32; ++i) { v[i] -= mean; q += v[i] * v[i]; }
    const float rstd = 1.0f / sqrtf(wave_sum(q) * (1.0f / DM) + LN_EPS);
#pragma unroll
    for (int i = 0; i < 32; ++i) v[i] *= rstd;
}
__device__ __forceinline__ void row_affine(float (&v)[32], const float* mul, const float* add, int lane, float mul_off) {
    float a[32], b[32]; row_load(mul, lane, a); row_load(add, lane, b);
#pragma unroll
    for (int i = 0; i < 32; ++i) v[i] = v[i] * (a[i] + mul_off) + b[i];
}
__device__ __forceinline__ void row_load_lds(const LAS float* p, int lane, float (&v)[32]) {
#pragma unroll
    for (int j = 0; j < 4; ++j) { const f32x4 a = *(const LAS f32x4*)(p + 512 * j + 8 * lane), b = *(const LAS f32x4*)(p + 512 * j + 8 * lane + 4);
        v[8 * j] = a[0]; v[8 * j + 1] = a[1]; v[8 * j + 2] = a[2]; v[8 * j + 3] = a[3]; v[8 * j + 4] = b[0]; v[8 * j + 5] = b[1]; v[8 * j + 6] = b[2]; v[8 * j + 7] = b[3]; }
}
__device__ __forceinline__ void row_affine_lds(float (&v)[32], const LAS float* mul, const LAS float* add, int lane, float mul_off) {
    float a[32], b[32]; row_load_lds(mul, lane, a); row_load_lds(add, lane, b);
#pragma unroll
    for (int i = 0; i < 32; ++i) v[i] = v[i] * (a[i] + mul_off) + b[i];
}
__device__ __forceinline__ void stage2048(Ctx& C, LAS float* dst, const float* src) { *(LAS f32x4*)(dst + 4 * C.tid) = *(const f32x4*)(src + 4 * C.tid); }
__device__ __forceinline__ void ph_ln_mod(Ctx& C, int l, int nrows) {
    LAS float* PAR = (LAS float*)C.lds;
    const int r0 = (int)(((long)C.bid * nrows) / C.G), r1 = (int)(((long)(C.bid + 1) * nrows) / C.G);
    int cur_mrow = -1;
    for (int rb = r0 & ~7; rb < r1; rb += 8) {
        const int mrow = rb < NLAT ? rb / SL : 4; const float* mod = WSP(float, WS_MOD) + (size_t)(l * 5 + mrow) * 12288;
        if (mrow != cur_mrow) { __syncthreads(); stage2048(C, PAR, mod + 2048); stage2048(C, PAR + 2048, mod); cur_mrow = mrow; __syncthreads(); }
        const int row = rb + C.wave;
        if (row >= r0 && row < r1) {
            float v[32]; row_load(src_x0(C, row), C.lane, v); row_ln(v); row_affine_lds(v, PAR, PAR + 2048, C.lane, 1.0f);
            if (FP8_IN) row_store_fp8(WSP(unsigned char, WS_HA8) + (size_t)row * DM, C.lane, v); else row_store_bf16(WSP(bf16, WS_HB) + (size_t)row * DM, C.lane, v);
        }
    }
    __syncthreads();
}

__device__ __forceinline__ void cvt8(const u32x4 r, float (&f)[8]) { f[0] = bflo(r.x); f[1] = bfhi(r.x); f[2] = bflo(r.y); f[3] = bfhi(r.y); f[4] = bflo(r.z); f[5] = bfhi(r.z); f[6] = bflo(r.w); f[7] = bfhi(r.w); }
__device__ __forceinline__ void cvt8_fp8(const u32x2 r, float (&f)[8]) { const f32x2 a = __builtin_amdgcn_cvt_pk_f32_fp8((int)r.x, false), b = __builtin_amdgcn_cvt_pk_f32_fp8((int)r.x, true), c = __builtin_amdgcn_cvt_pk_f32_fp8((int)r.y, false), d = __builtin_amdgcn_cvt_pk_f32_fp8((int)r.y, true);
    f[0] = a.x; f[1] = a.y; f[2] = b.x; f[3] = b.y; f[4] = c.x; f[5] = c.y; f[6] = d.x; f[7] = d.y; }
__device__ __forceinline__ bf16x8 pack8(const float (&f)[8]) { u32x4 w; w.x = pk2(f[0], f[1]); w.y = pk2(f[2], f[3]); w.z = pk2(f[4], f[5]); w.w = pk2(f[6], f[7]); return __builtin_bit_cast(bf16x8, w); }
#define MFMA32(a, b, c) __builtin_amdgcn_mfma_f32_32x32x16_bf16((a), (b), (c), 0, 0, 0)

__device__ __forceinline__ void attn_unit(Ctx& C, int l, int uidx) {
    constexpr int KS = 144, VS = 272, VT_OFF = 128 * KS;
    const bool isctx = uidx >= 256;
    int b, kh, nb;
    if (!isctx) { b = uidx >> 6; kh = (uidx >> 5) & 1; nb = uidx & 31; } else { const int v = uidx - 256; b = v >> 2; kh = (v >> 1) & 1; nb = v & 1; }
    const int rowbase = isctx ? NLAT + b * CL : b * SL, crow = NLAT + b * CL;
    const int g = C.wave >> 1, th = C.wave & 1, head = kh * 4 + g, r32 = C.lane & 31, h = C.lane >> 5;
    const bf16* Z = WSP(bf16, WS_Z); const f32x2* ROPE = WSP(f32x2, WS_ROPE);
    bf16x8 Qf[2][4];
#pragma unroll
    for (int qb = 0; qb < 2; ++qb) {
        const int tq = 128 * nb + 64 * th + 32 * qb + r32;
        const bf16* qp = Z + (size_t)(rowbase + tq) * INW + 512 + 64 * head + 8 * h;
        float f[4][8];
#pragma unroll
        for (int s = 0; s < 4; ++s) cvt8(*(const u32x4*)(qp + 16 * s), f[s]);
        if (!isctx) {
            const int pr = tq >> 6, pc = tq & 63;
#pragma unroll
            for (int j = 0; j < 8; ++j) {
                const f32x2 cr = ROPE[pr * 16 + 8 * h + j], cc = ROPE[pc * 16 + 8 * h + j];
                const float a0 = f[0][j], b0 = f[1][j]; f[0][j] = a0 * cr.x - b0 * cr.y; f[1][j] = b0 * cr.x + a0 * cr.y;
                const float a1 = f[2][j], b1 = f[3][j]; f[2][j] = a1 * cc.x - b1 * cc.y; f[3][j] = b1 * cc.x + a1 * cc.y; }
        }
#pragma unroll
        for (int s = 0; s < 4; ++s) {
#pragma unroll
            for (int j = 0; j < 8; ++j) f[s][j] *= 0.125f * LOG2E;
            Qf[qb][s] = pack8(f[s]); }
    }
    float m_[2], l_[2]; f32x16 O[2][2];
    { const float sk = INP(I_SINK)[l * 8 + head] * LOG2E; m_[0] = sk; m_[1] = sk; l_[0] = 1.f; l_[1] = 1.f; }
#pragma unroll
    for (int a = 0; a < 2; ++a)
#pragma unroll
        for (int q = 0; q < 2; ++q)
#pragma unroll
            for (int i = 0; i < 16; ++i) O[a][q][i] = 0.f;
#define AT_VALID(tt_) ((tt_) >= 3 || ((nb - 1 + (tt_)) >= 0 && (nb - 1 + (tt_)) < SL / 128))
#define AT_KROW0(tt_) (((tt_) < 3) ? rowbase + 128 * (nb - 1 + (tt_)) : crow + 128 * ((tt_) - 3))
#define AT_PREFETCH(tt_) do { const int krow0_ = AT_KROW0(tt_); _Pragma("unroll") for (int r = 0; r < 2; ++r) { const int idx = C.tid + 512 * r, key = idx >> 3, cd = idx & 7; \
        const bf16* kp = Z + (size_t)(krow0_ + key) * INW + 1024 + 64 * kh; kraw[r] = *(const u32x4*)(kp + 8 * cd); if ((tt_) < 3) kpar[r] = *(const u32x4*)(kp + 8 * (cd ^ 2)); \
        vraw[r] = *(const u32x4*)(kp + 128 + 8 * cd); } } while (0)
    __syncthreads();
    u32x4 kraw[2], kpar[2], vraw[2];
    kpar[0] = (u32x4){0u, 0u, 0u, 0u}; kpar[1] = kpar[0];
    int tt = isctx ? 3 : (nb == 0 ? 1 : 0);
    AT_PREFETCH(tt);
    while (tt < 5) {
        int ntt = tt + 1; if (ntt < 3 && !AT_VALID(ntt)) ntt = 3;
        const bool band = tt < 3; const int kb = nb - 1 + tt;
        LDS_WAIT(); __builtin_amdgcn_s_barrier(); asm volatile("" ::: "memory");
#pragma unroll
        for (int r = 0; r < 2; ++r) {
            const int idx = C.tid + 512 * r, key = idx >> 3, cd = idx & 7;
            u32x4 raw = kraw[r];
            if (band) {
                float x[8], y[8]; cvt8(raw, x); cvt8(kpar[r], y);
                const int tk = 128 * kb + key, pos = (cd & 4) ? (tk & 63) : (tk >> 6), i0 = 8 * (cd & 1); const bool isb = (cd >> 1) & 1;
#pragma unroll
                for (int j = 0; j < 8; ++j) { const f32x2 cs = ROPE[pos * 16 + i0 + j]; x[j] = isb ? (x[j] * cs.x + y[j] * cs.y) : (x[j] * cs.x - y[j] * cs.y); }
                raw = __builtin_bit_cast(u32x4, pack8(x));
            }
            *(LAS u32x4*)(C.lds + key * KS + cd * 16) = raw;
            const u32x4 vr = vraw[r];
            LAS bf16* vt = (LAS bf16*)(C.lds + VT_OFF + (8 * cd) * VS + key * 2);
            vt[0] = (bf16)(vr.x & 0xffff); vt[VS / 2] = (bf16)(vr.x >> 16); vt[2 * (VS / 2)] = (bf16)(vr.y & 0xffff); vt[3 * (VS / 2)] = (bf16)(vr.y >> 16);
            vt[4 * (VS / 2)] = (bf16)(vr.z & 0xffff); vt[5 * (VS / 2)] = (bf16)(vr.z >> 16); vt[6 * (VS / 2)] = (bf16)(vr.w & 0xffff); vt[7 * (VS / 2)] = (bf16)(vr.w >> 16);
        }
        if (ntt < 5) AT_PREFETCH(ntt);
        LDS_WAIT(); __builtin_amdgcn_s_barrier(); asm volatile("" ::: "memory");
        const int sub_lo = (tt == 0) ? 2 * th : 0, sub_hi = (tt == 2) ? 2 * th + 1 : 3;
        for (int sub = sub_lo; sub <= sub_hi; ++sub) {
            bf16x8 Kf[4];
#pragma unroll
            for (int s = 0; s < 4; ++s) Kf[s] = *(const LAS bf16x8*)(C.lds + (32 * sub + r32) * KS + (16 * s + 8 * h) * 2);
            bf16x8 Pf[2][2];
#pragma unroll
            for (int qb = 0; qb < 2; ++qb) {
                f32x16 S;
#pragma unroll
                for (int i = 0; i < 16; ++i) S[i] = 0.f;
#pragma unroll
                for (int s = 0; s < 4; ++s) S = MFMA32(Kf[s], Qf[qb][s], S);
                const int tq = 128 * nb + 64 * th + 32 * qb + r32;
                float mx = -INFINITY;
#pragma unroll
                for (int i = 0; i < 16; ++i) { float x = S[i];
                    if (tt == 0 || tt == 2) { const int kpos = 128 * kb + 32 * sub + (i & 3) + 8 * (i >> 2) + 4 * h; const int dq = tq - kpos; if (dq > 128 || dq < -128) x = -INFINITY; }
                    S[i] = x; mx = fmaxf(mx, x); }
                mx = xor32_max(mx);
                const float mnew = fmaxf(m_[qb], mx), alpha = __builtin_amdgcn_exp2f(m_[qb] - mnew);
                float rs = 0.f; float p[16];
#pragma unroll
                for (int i = 0; i < 16; ++i) { p[i] = __builtin_amdgcn_exp2f(S[i] - mnew); rs += p[i]; }
                rs = xor32_sum(rs);
                l_[qb] = l_[qb] * alpha + rs; m_[qb] = mnew;
#pragma unroll
                for (int i = 0; i < 16; ++i) { O[0][qb][i] *= alpha; O[1][qb][i] *= alpha; }
#pragma unroll
                for (int s2 = 0; s2 < 2; ++s2) { float t8[8];
#pragma unroll
                    for (int j = 0; j < 8; ++j) t8[j] = p[8 * s2 + j];
                    Pf[qb][s2] = pack8(t8); }
            }
#pragma unroll
            for (int db = 0; db < 2; ++db)
#pragma unroll
                for (int s2 = 0; s2 < 2; ++s2) {
                    const LAS unsigned char* vp = C.lds + VT_OFF + (32 * db + r32) * VS + (32 * sub + 16 * s2 + 4 * h) * 2;
                    const u32x2 v0 = *(const LAS u32x2*)vp, v1 = *(const LAS u32x2*)(vp + 16);
                    const u32x4 vv = {v0.x, v0.y, v1.x, v1.y}; const bf16x8 Vf = __builtin_bit_cast(bf16x8, vv);
                    O[db][0] = MFMA32(Vf, Pf[0][s2], O[db][0]); O[db][1] = MFMA32(Vf, Pf[1][s2], O[db][1]);
                }
        }
        tt = ntt;
    }
#undef AT_VALID
#undef AT_KROW0
#undef AT_PREFETCH
    bf16* Y = WSP(bf16, WS_YCAT);
#pragma unroll
    for (int qb = 0; qb < 2; ++qb) {
        const int tq = 128 * nb + 64 * th + 32 * qb + r32; const float inv = 1.0f / l_[qb];
        bf16* yp = Y + (size_t)(rowbase + tq) * DM + 512 + 64 * head;
#pragma unroll
        for (int db = 0; db < 2; ++db)
#pragma unroll
            for (int rg = 0; rg < 4; ++rg) { u32x2 w; w.x = pk2(O[db][qb][4 * rg] * inv, O[db][qb][4 * rg + 1] * inv); w.y = pk2(O[db][qb][4 * rg + 2] * inv, O[db][qb][4 * rg + 3] * inv);
                *(u32x2*)(yp + 32 * db + 8 * rg + 4 * h) = w; }
    }
}

__device__ __forceinline__ void gmlp_unit(Ctx& C, int l, int uidx) {
    constexpr int VS = 272;
    const int ck = uidx >> 1, hf = uidx & 1, row0 = 128 * ck;
    const bf16* Z = WSP(bf16, WS_Z);
    const int gl = C.wave >> 1, ph = C.wave & 1, g = 4 * hf + gl, r32 = C.lane & 31, h = C.lane >> 5;
    bf16x8 Wf[2][8]; u32x2 upre[2][2][4];
    { const bf16* wsb = WSP(bf16, WS_GWSB) + ((size_t)(l * 8 + g) * 128 + 64 * ph + r32) * 128 + 8 * h;
#pragma unroll
      for (int pb = 0; pb < 2; ++pb)
#pragma unroll
          for (int s = 0; s < 8; ++s) Wf[pb][s] = *(const bf16x8*)(wsb + (size_t)(32 * pb) * 128 + 16 * s);
#pragma unroll
      for (int pb = 0; pb < 2; ++pb) { const bf16* up = Z + (size_t)(row0 + 64 * ph + 32 * pb + r32) * INW + 2816 + 64 * g + 4 * h;
#pragma unroll
          for (int cb = 0; cb < 2; ++cb)
#pragma unroll
              for (int rg = 0; rg < 4; ++rg) upre[pb][cb][rg] = *(const u32x2*)(up + 32 * cb + 8 * rg); } }
    __syncthreads();
    {
        const int tok = C.tid >> 2, part = C.tid & 3;
        const bf16* zp = Z + (size_t)(row0 + tok) * INW + 3328 + 128 * part;
        const bf16* zq = Z + (size_t)(row0 + tok) * INW + 3328 + 256 * hf + 64 * part;
        u32x4 r1[16], r2[8];
#pragma unroll
        for (int c8 = 0; c8 < 16; ++c8) r1[c8] = *(const u32x4*)(zp + 8 * c8);
#pragma unroll
        for (int c8 = 0; c8 < 8; ++c8) r2[c8] = *(const u32x4*)(zq + 8 * c8);
        float s = 0.f, q = 0.f;
#pragma unroll
        for (int c8 = 0; c8 < 16; ++c8) { float f[8]; cvt8(r1[c8], f);
#pragma unroll
            for (int j = 0; j < 8; ++j) { s += f[j]; q += f[j] * f[j]; } }
        s += dpp_f<DPP_XOR1>(s); s += dpp_f<DPP_XOR2>(s); q += dpp_f<DPP_XOR1>(q); q += dpp_f<DPP_XOR2>(q);
        const float mean = s * (1.0f / 512.0f); const float var = fmaxf(q * (1.0f / 512.0f) - mean * mean, 0.f); const float rstd = 1.0f / sqrtf(var + LN_EPS);
        const float* lg = INP(I_GLG) + l * 512 + 256 * hf + 64 * part; const float* lb = INP(I_GLB) + l * 512 + 256 * hf + 64 * part;
#pragma unroll
        for (int c8 = 0; c8 < 8; ++c8) { float f[8]; cvt8(r2[c8], f);
            const f32x4 g0 = *(const f32x4*)(lg + 8 * c8), g1 = *(const f32x4*)(lg + 8 * c8 + 4), b0 = *(const f32x4*)(lb + 8 * c8), b1 = *(const f32x4*)(lb + 8 * c8 + 4);
            const float gg[8] = {g0[0], g0[1], g0[2], g0[3], g1[0], g1[1], g1[2], g1[3]}, bb[8] = {b0[0], b0[1], b0[2], b0[3], b1[0], b1[1], b1[2], b1[3]};
#pragma unroll
            for (int j = 0; j < 8; ++j) { const float vn = (f[j] - mean) * rstd * gg[j] + bb[j];
                *(LAS bf16*)(C.lds + (64 * part + 8 * c8 + j) * VS + tok * 2) = (bf16)(pk2(vn, 0.f) & 0xffffu); } }
    }
    __syncthreads();
    f32x16 acc[2][2];
#pragma unroll
    for (int a = 0; a < 2; ++a)
#pragma unroll
        for (int b = 0; b < 2; ++b)
#pragma unroll
            for (int i = 0; i < 16; ++i) acc[a][b][i] = 0.f;
#pragma unroll
    for (int s = 0; s < 8; ++s) {
        bf16x8 Vf[2];
#pragma unroll
        for (int cb = 0; cb < 2; ++cb) Vf[cb] = *(const LAS bf16x8*)(C.lds + (64 * gl + 32 * cb + r32) * VS + (16 * s + 8 * h) * 2);
#pragma unroll
        for (int cb = 0; cb < 2; ++cb)
#pragma unroll
            for (int pb = 0; pb < 2; ++pb) acc[cb][pb] = MFMA32(Vf[cb], Wf[pb][s], acc[cb][pb]);
    }
    bf16* Y = WSP(bf16, WS_YCAT);
#pragma unroll
    for (int pb = 0; pb < 2; ++pb) { const int p = 64 * ph + 32 * pb + r32; const float bs = INP(I_GBS)[(l * 8 + g) * 128 + p];
        bf16* yp = Y + (size_t)(row0 + p) * DM + 1536 + 64 * g + 4 * h;
#pragma unroll
        for (int cb = 0; cb < 2; ++cb)
#pragma unroll
            for (int rg = 0; rg < 4; ++rg) { const u32x2 uv = upre[pb][cb][rg];
                u32x2 w; w.x = pk2(bflo(uv.x) * (acc[cb][pb][4 * rg] + bs), bfhi(uv.x) * (acc[cb][pb][4 * rg + 1] + bs)); w.y = pk2(bflo(uv.y) * (acc[cb][pb][4 * rg + 2] + bs), bfhi(uv.y) * (acc[cb][pb][4 * rg + 3] + bs));
                *(u32x2*)(yp + 32 * cb + 8 * rg) = w; } }
}

__device__ __forceinline__ void pool_unit(Ctx& C, int l, int blk) {
    constexpr int RS = 1040, DT_OFF = 48 * RS;
    const int row0 = 32 * blk;
    const int s0 = row0 < NLAT ? (row0 / SL) * SL : NLAT + ((row0 - NLAT) / CL) * CL, L = row0 < NLAT ? SL : CL, t0 = row0 - s0;
    const bf16* Z = WSP(bf16, WS_Z);
    __syncthreads();
    for (int idx = C.tid; idx < 48 * 64; idx += 512) { const int r = idx >> 6, ch = idx & 63, t = t0 - 8 + r; u32x4 v = {0u, 0u, 0u, 0u};
        if (t >= 0 && t < L) v = *(const u32x4*)(Z + (size_t)(s0 + t) * INW + 8 * ch);
        *(LAS u32x4*)(C.lds + r * RS + ch * 16) = v; }
    __syncthreads();
    {
        const int c8 = C.tid & 63, tg = C.tid >> 6, hw = 1 << (c8 >> 4);
#pragma unroll 1
        for (int k = 0; k < 4; ++k) { const int tt = 4 * tg + k, t = t0 + tt; const int lo = max(t - hw, 0), hi = min(t + hw, L);
            float sacc[8];
#pragma unroll
            for (int j = 0; j < 8; ++j) sacc[j] = 0.f;
            for (int q = lo; q < hi; ++q) { float f[8]; cvt8(*(const LAS u32x4*)(C.lds + (q - t0 + 8) * RS + c8 * 16), f);
#pragma unroll
                for (int j = 0; j < 8; ++j) sacc[j] += f[j]; }
            float cf[8]; cvt8(*(const LAS u32x4*)(C.lds + (tt + 8) * RS + c8 * 16), cf); const float inv = 1.0f / (float)(hi - lo);
#pragma unroll
            for (int j = 0; j < 8; ++j) sacc[j] = sacc[j] * inv - cf[j];
            *(LAS bf16x8*)(C.lds + DT_OFF + tt * RS + c8 * 16) = pack8(sacc); }
    }
    __syncthreads();
    const int gi = C.wave >> 1, oh = C.wave & 1, r32 = C.lane & 31, h = C.lane >> 5;
    f32x16 acc[2];
#pragma unroll
    for (int a = 0; a < 2; ++a)
#pragma unroll
        for (int i = 0; i < 16; ++i) acc[a][i] = 0.f;
    const bf16* wt = WSP(bf16, WS_POOLWT) + (size_t)((l * 4 + gi) * 128 + 64 * oh + r32) * 128 + 8 * h;
#pragma unroll
    for (int s = 0; s < 8; ++s) {
        const bf16x8 Bf = *(const LAS bf16x8*)(C.lds + DT_OFF + r32 * RS + (128 * gi + 16 * s + 8 * h) * 2);
#pragma unroll
        for (int rb = 0; rb < 2; ++rb) { const bf16x8 Af = *(const bf16x8*)(wt + (size_t)(32 * rb) * 128 + 16 * s); acc[rb] = MFMA32(Af, Bf, acc[rb]); }
    }
    bf16* yp = WSP(bf16, WS_YCAT) + (size_t)(row0 + r32) * DM + 128 * gi + 64 * oh;
#pragma unroll
    for (int rb = 0; rb < 2; ++rb)
#pragma unroll
        for (int rg = 0; rg < 4; ++rg) { u32x2 w; w.x = pk2(acc[rb][4 * rg], acc[rb][4 * rg + 1]); w.y = pk2(acc[rb][4 * rg + 2], acc[rb][4 * rg + 3]); *(u32x2*)(yp + 32 * rb + 8 * rg + 4 * h) = w; }
}

__device__ __forceinline__ void hyprep_unit(Ctx& C, int l, int uidx) {
    constexpr int RS = 528;
    int seq, tb, cb, L, rowbase; bf16* T;
    if (uidx < 1536) { seq = uidx / 384; const int rem = uidx % 384; tb = rem / 6; cb = rem % 6; L = SL; rowbase = seq * SL; T = WSP(bf16, WS_TL); }
    else { const int v = uidx - 1536; seq = v / 24; const int rem = v % 24; tb = rem / 6; cb = rem % 6; L = CL; rowbase = NLAT + seq * CL; T = WSP(bf16, WS_TC); }
    const int t0 = 64 * tb; const bf16* Z = WSP(bf16, WS_Z);
    __syncthreads();
    for (int idx = C.tid; idx < 66 * 32; idx += 512) { const int r = idx >> 5, ch = idx & 31, t = t0 - 1 + r; u32x4 v = {0u, 0u, 0u, 0u};
        if (t >= 0 && t < L) v = *(const u32x4*)(Z + (size_t)(rowbase + t) * INW + 1280 + 256 * cb + 8 * ch);
        *(LAS u32x4*)(C.lds + r * RS + ch * 16) = v; }
    __syncthreads();
    const int c = C.tid & 255, hf = C.tid >> 8, ch = 256 * cb + c, comp = ch >> 9, cc = ch & 511;
    const float w0 = INP(I_HCW)[(l * 3 + 0) * 1536 + ch], w1 = INP(I_HCW)[(l * 3 + 1) * 1536 + ch], w2 = INP(I_HCW)[(l * 3 + 2) * 1536 + ch], bias = INP(I_HCB)[l * 1536 + ch];
    bf16* dst = T + ((size_t)(comp * 512 + cc) * 4 + seq) * L + t0 + 32 * hf;
    float zm = bf1(*(const LAS bf16*)(C.lds + (32 * hf) * RS + c * 2)), zc = bf1(*(const LAS bf16*)(C.lds + (32 * hf + 1) * RS + c * 2));
#pragma unroll
    for (int k = 0; k < 4; ++k) { float o[8];
#pragma unroll
        for (int e = 0; e < 8; ++e) { const float zn = bf1(*(const LAS bf16*)(C.lds + (32 * hf + 8 * k + e + 2) * RS + c * 2)); o[e] = bias + w0 * zm + w1 * zc + w2 * zn; zm = zc; zc = zn; }
        u32x4 w; w.x = pk2(o[0], o[1]); w.y = pk2(o[2], o[3]); w.z = pk2(o[4], o[5]); w.w = pk2(o[6], o[7]); *(u32x4*)(dst + 8 * k) = w; }
}

template <int L, int NT = 512>
__device__ __forceinline__ void hyena_unit(Ctx& C, int l, int c) {
    constexpr int NBLK = L / 32, NTILE = NBLK / 8, NTL = (NTILE >= 16) ? 2 : 1;
    constexpr int SB = 2 * L + 16, Z_OFF = 4 * SB, R_OFF = Z_OFF + 64, CSZ = 4 * L;
    const bf16* T = (L == SL) ? WSP(bf16, WS_TL) : WSP(bf16, WS_TC);
    const int r32 = C.lane & 31, h = C.lane >> 5;
    const bool active = (2 * C.wave < NTILE);
    const int qi = (r32 + 1) >> 2, ri = (r32 + 1) & 3, pcp = (4 - ri) & 3;
    const int laneA = R_OFF + pcp * CSZ + (pcp ? 8 + 64 * pcp : 0) - 8 * (qi + (ri ? 1 : 0)) + 16 * h;
    const int al = r32 >> 2, bb = r32 & 3;
    const int laneB = bb * SB + 16 * h;
    for (int o = 0; o < 2; ++o) {
        __syncthreads();
        if (o == 0) { const bf16* src = T + (size_t)(2 * 512 + c) * 4 * L;
            for (int idx = C.tid; idx < 4 * L / 8; idx += NT) { const int b = idx / (L / 8), tc = idx % (L / 8); *(LAS u32x4*)(C.lds + b * SB + tc * 16) = *(const u32x4*)(src + 8 * idx); }
            if (C.tid < 4) *(LAS u32x4*)(C.lds + Z_OFF + 16 * C.tid) = (u32x4){0u, 0u, 0u, 0u}; }
        { const bf16* fsrc = (L == SL) ? WSP(bf16, WS_FILT) + (size_t)((l * 2 + o) * 512 + c) * (2 * L) : WSP(bf16, WS_FILTC) + (size_t)(o * 512 + c) * (2 * L);
          for (int idx = C.tid; idx < L / 4; idx += NT) *(LAS u32x4*)(C.lds + R_OFF + 16 * idx) = *(const u32x4*)(fsrc + 8 * idx); }
        __syncthreads();
        for (int idx = C.tid; idx < 3 * (L / 2); idx += NT) { const int p = 1 + idx / (L / 2), w = idx % (L / 2); unsigned short e[4];
#pragma unroll
            for (int k = 0; k < 4; ++k) { const int n = 4 * w + p + k; e[k] = n < 2 * L ? *(const LAS bf16*)(C.lds + R_OFF + 2 * n) : (bf16)0; }
            *(LAS u32x2*)(C.lds + R_OFF + p * CSZ + 8 + 64 * p + 8 * w) = (u32x2){(unsigned)e[0] | ((unsigned)e[1] << 16), (unsigned)e[2] | ((unsigned)e[3] << 16)}; }
        __syncthreads();
        f32x16 acc[NTL];
#pragma unroll
        for (int t = 0; t < NTL; ++t)
#pragma unroll
            for (int i = 0; i < 16; ++i) acc[t][i] = 0.f;
        u32x2 gpre[NTL][4]; float skip = 0.f;
        if (active) { skip = INP(I_HSKIP)[(l * 2 + o) * 512 + c]; const bf16* gate_ = T + (size_t)(o * 512 + c) * 4 * L + (size_t)bb * L;
#pragma unroll
            for (int t = 0; t < NTL; ++t)
#pragma unroll
                for (int rg = 0; rg < 4; ++rg) gpre[t][rg] = *(const u32x2*)(gate_ + 32 * (8 * (2 * C.wave + t) + al) + 8 * rg + 4 * h); }
        if (active) {
            const int a0 = 8 * (2 * C.wave);
            const int m_lo = a0 - (NBLK - 1), m_hi = a0 + 8 * (NTL - 1) + 7;
            const int mA = m_hi - (NBLK - 1), mB = a0;
            int off8 = 8; asm volatile("" : "+v"(off8));
#define HY_STEP_CHK(m_) do { bf16x8 Af_[2]; \
                _Pragma("unroll") for (int s = 0; s < 2; ++s) { const LAS unsigned char* ap = C.lds + laneA + 2 * (L - 32 * (m_) + 16 * s); const u32x2 x0 = *(const LAS u32x2*)ap, x1 = *(const LAS u32x2*)(ap + off8); \
                    const u32x4 xx = {x0.x, x0.y, x1.x, x1.y}; Af_[s] = __builtin_bit_cast(bf16x8, xx); } \
                _Pragma("unroll") for (int t = 0; t < NTL; ++t) { const int q = a0 + 8 * t + al - (m_); const bool ok = (q >= 0) && (q < NBLK); \
                    _Pragma("unroll") for (int s = 0; s < 2; ++s) { const int addr = ok ? (laneB + 64 * q + 32 * s) : Z_OFF; const bf16x8 Bf_ = *(const LAS bf16x8*)(C.lds + addr); acc[t] = MFMA32(Af_[s], Bf_, acc[t]); } } } while (0)
#pragma unroll 1
            for (int m = m_lo; m < mA; ++m) HY_STEP_CHK(m);
            {
                int o1 = 8, o2 = 32, o3 = 40; asm volatile("" : "+v"(o1), "+v"(o2), "+v"(o3));
                const LAS unsigned char* pa0 = C.lds + laneA + 2 * (L - 32 * mA); const LAS unsigned char* pa1 = pa0 + o1; const LAS unsigned char* pa2 = pa0 + o2; const LAS unsigned char* pa3 = pa0 + o3;
                const LAS unsigned char* pb = C.lds + laneB + 64 * (a0 + al - mA);
#define HY_LOADF(Af_, Bf_) do { { const u32x2 x0 = *(const LAS u32x2*)pa0, x1 = *(const LAS u32x2*)pa1, x2 = *(const LAS u32x2*)pa2, x3 = *(const LAS u32x2*)pa3; \
                    const u32x4 xa = {x0.x, x0.y, x1.x, x1.y}, xb = {x2.x, x2.y, x3.x, x3.y}; Af_[0] = __builtin_bit_cast(bf16x8, xa); Af_[1] = __builtin_bit_cast(bf16x8, xb); } \
                _Pragma("unroll") for (int t = 0; t < NTL; ++t) _Pragma("unroll") for (int s = 0; s < 2; ++s) Bf_[t][s] = *(const LAS bf16x8*)(pb + 512 * t + 32 * s); \
                pa0 -= 64; pa1 -= 64; pa2 -= 64; pa3 -= 64; pb -= 64; asm volatile("" : "+v"(pa0), "+v"(pa1), "+v"(pa2), "+v"(pa3)); } while (0)
#define HY_MMA(Af_, Bf_) do { _Pragma("unroll") for (int s = 0; s < 2; ++s) _Pragma("unroll") for (int t = 0; t < NTL; ++t) acc[t] = MFMA32(Af_[s], Bf_[t][s], acc[t]); } while (0)
                int nfast = mB - mA + 1;
                if constexpr (NTL == 2) {
                    bf16x8 Bx[8][2], By[8][2];
#define HY_LOADA(Af_) do { const u32x2 x0 = *(const LAS u32x2*)pa0, x1 = *(const LAS u32x2*)pa1, x2 = *(const LAS u32x2*)pa2, x3 = *(const LAS u32x2*)pa3; \
                        const u32x4 xa = {x0.x, x0.y, x1.x, x1.y}, xb = {x2.x, x2.y, x3.x, x3.y}; Af_[0] = __builtin_bit_cast(bf16x8, xa); Af_[1] = __builtin_bit_cast(bf16x8, xb); \
                        pa0 -= 64; pa1 -= 64; pa2 -= 64; pa3 -= 64; asm volatile("" : "+v"(pa0), "+v"(pa1), "+v"(pa2), "+v"(pa3)); } while (0)
#define HY_GROUP(Bold, Bnew, more) do { _Pragma("unroll") for (int i = 0; i < 8; ++i) { bf16x8 An_[2] = {Ac_[0], Ac_[1]}; \
                        if (i < 7) { HY_LOADA(An_); Bnew[i + 1][0] = *(const LAS bf16x8*)(pb - 64 * (i + 1)); Bnew[i + 1][1] = *(const LAS bf16x8*)(pb - 64 * (i + 1) + 32); } \
                        else if (more) { HY_LOADA(An_); Bold[0][0] = *(const LAS bf16x8*)(pb - 512); Bold[0][1] = *(const LAS bf16x8*)(pb - 512 + 32); }        \
                        acc[0] = MFMA32(Ac_[0], Bnew[i][0], acc[0]); acc[1] = MFMA32(Ac_[0], Bold[i][0], acc[1]); acc[0] = MFMA32(Ac_[1], Bnew[i][1], acc[0]); acc[1] = MFMA32(Ac_[1], Bold[i][1], acc[1]); \
                        Ac_[0] = An_[0]; Ac_[1] = An_[1]; } \
                        pb -= 512; } while (0)
                    if (nfast >= 16) {
#pragma unroll
                        for (int i = 0; i < 8; ++i) { Bx[i][0] = *(const LAS bf16x8*)(pb + 512 - 64 * i); Bx[i][1] = *(const LAS bf16x8*)(pb + 512 - 64 * i + 32); }
                        bf16x8 Ac_[2]; HY_LOADA(Ac_); By[0][0] = *(const LAS bf16x8*)pb; By[0][1] = *(const LAS bf16x8*)(pb + 32);
#pragma unroll 1
                        while (nfast >= 16) { HY_GROUP(Bx, By, true); HY_GROUP(By, Bx, nfast >= 32); nfast -= 16; }
                    }
#undef HY_LOADA
#undef HY_GROUP
                }
                bf16x8 A0[2], B0[NTL][2], A1[2], B1[NTL][2];
                if (nfast > 0) {
                    int rem = nfast - 1;
                    HY_LOADF(A0, B0);
#pragma unroll 1
                    while (rem >= 2) { HY_LOADF(A1, B1); HY_MMA(A0, B0); HY_LOADF(A0, B0); HY_MMA(A1, B1); rem -= 2; }
                    if (rem == 1) { HY_LOADF(A1, B1); HY_MMA(A0, B0); HY_MMA(A1, B1); } else { HY_MMA(A0, B0); }
                }
#undef HY_LOADF
#undef HY_MMA
            }
#pragma unroll 1
            for (int m = mB + 1; m <= m_hi; ++m) HY_STEP_CHK(m);
#undef HY_STEP_CHK
        }
        __syncthreads();
        if (active) {
#pragma unroll
            for (int t = 0; t < NTL; ++t) { const int a = 8 * (2 * C.wave + t) + al;
#pragma unroll
                for (int rg = 0; rg < 4; ++rg) { const int t4 = 32 * a + 8 * rg + 4 * h;
                    LAS u32x2* up = (LAS u32x2*)(C.lds + bb * SB + t4 * 2); const u32x2 uo = *up; const u32x2 gv = gpre[t][rg];
                    const float v0 = bflo(gv.x) * (acc[t][4 * rg] + skip * bflo(uo.x)), v1 = bfhi(gv.x) * (acc[t][4 * rg + 1] + skip * bfhi(uo.x));
                    const float v2 = bflo(gv.y) * (acc[t][4 * rg + 2] + skip * bflo(uo.y)), v3 = bfhi(gv.y) * (acc[t][4 * rg + 3] + skip * bfhi(uo.y));
                    const u32x2 w = {pk2(v0, v1), pk2(v2, v3)};
                    if (o == 0) *up = w;
                    else { const int row = (L == SL) ? bb * SL + t4 : NLAT + bb * CL + t4; *(u32x2*)(WSP(bf16, WS_YHT) + (size_t)c * NTOK + row) = w; } } }
        }
    }
}

constexpr int RMS_GN_OFF = 34816;
__device__ __forceinline__ void rms_stage_gain(Ctx& C, int l) { __syncthreads(); stage2048(C, (LAS float*)(C.lds + RMS_GN_OFF), INP(I_MNG) + l * DM); __syncthreads(); }
__device__ __forceinline__ void rms_unit(Ctx& C, int l, int blk) {
    constexpr int RS = 1040;
    const int row0 = 32 * blk;
    const int tok = C.tid >> 4, sub = C.tid & 15;
    const bf16* Y = WSP(bf16, WS_YCAT) + (size_t)(row0 + tok) * DM + 32 * sub;
    u32x4 raw[3][4];
#pragma unroll
    for (int gi = 0; gi < 3; ++gi)
#pragma unroll
        for (int c8 = 0; c8 < 4; ++c8) raw[gi][c8] = *(const u32x4*)(Y + 512 * (gi == 2 ? 3 : gi) + 8 * c8);
    u32x4 hy[4];
    { const bf16* yh = WSP(bf16, WS_YHT);
#pragma unroll
      for (int k = 0; k < 4; ++k) { const int idx = C.tid + 512 * k, ch = idx >> 2, tc = idx & 3; hy[k] = *(const u32x4*)(yh + (size_t)ch * NTOK + row0 + 8 * tc); } }
    __syncthreads();
#pragma unroll
    for (int k = 0; k < 4; ++k) { const int idx = C.tid + 512 * k, ch = idx >> 2, tc = idx & 3; const u32x4 v = hy[k];
        LAS bf16* d = (LAS bf16*)(C.lds + (8 * tc) * RS + ch * 2);
        d[0] = (bf16)(v.x & 0xffff); d[RS / 2] = (bf16)(v.x >> 16); d[2 * (RS / 2)] = (bf16)(v.y & 0xffff); d[3 * (RS / 2)] = (bf16)(v.y >> 16);
        d[4 * (RS / 2)] = (bf16)(v.z & 0xffff); d[5 * (RS / 2)] = (bf16)(v.z >> 16); d[6 * (RS / 2)] = (bf16)(v.w & 0xffff); d[7 * (RS / 2)] = (bf16)(v.w >> 16); }
    __syncthreads();
    const LAS float* gn = (const LAS float*)(C.lds + RMS_GN_OFF);
    unsigned char* O = WSP(unsigned char, WS_HA8) + (size_t)(row0 + tok) * DM + 32 * sub;
#pragma unroll
    for (int gq = 0; gq < 4; ++gq) {
        float f[32]; float q = 0.f;
#pragma unroll
        for (int c8 = 0; c8 < 4; ++c8) { const u32x4 v = (gq == 2) ? *(const LAS u32x4*)(C.lds + tok * RS + (32 * sub + 8 * c8) * 2) : raw[gq == 3 ? 2 : gq][c8];
            float t8[8]; cvt8(v, t8);
#pragma unroll
            for (int j = 0; j < 8; ++j) { f[8 * c8 + j] = t8[j]; q += t8[j] * t8[j]; } }
        q = row16_sum(q);
        const float rs = 1.0f / sqrtf(q * (1.0f / 512.0f) + LN_EPS);
        const LAS float* gp = gn + 512 * gq + 32 * sub;
#pragma unroll
        for (int c8 = 0; c8 < 4; ++c8) { const f32x4 g0 = *(const LAS f32x4*)(gp + 8 * c8), g1 = *(const LAS f32x4*)(gp + 8 * c8 + 4);
            u32x2 w; w.x = pk4_fp8(f[8 * c8] * rs * g0[0], f[8 * c8 + 1] * rs * g0[1], f[8 * c8 + 2] * rs * g0[2], f[8 * c8 + 3] * rs * g0[3]);
            w.y = pk4_fp8(f[8 * c8 + 4] * rs * g1[0], f[8 * c8 + 5] * rs * g1[1], f[8 * c8 + 6] * rs * g1[2], f[8 * c8 + 7] * rs * g1[3]);
            *(u32x2*)(O + 512 * gq + 8 * c8) = w; }
        __builtin_amdgcn_sched_barrier(0);
    }
}

__device__ __forceinline__ void ph_post1(Ctx& C, int l, int nrows, bool dry = false) {
    LAS float* H2 = (LAS float*)C.lds;
    LAS float* RED = (LAS float*)(C.lds + 65536);
    LAS float* SGA = (LAS float*)(C.lds + 81920);
    LAS float* PAR = (LAS float*)(C.lds + 92160);
    unsigned* ctl = WSP(unsigned, WS_CTL);
    int nit = 0, cur_mrow = -1;
    const int nit_all = nrows / 8, it0 = (int)(((long)C.bid * nit_all) / C.G), it1 = (int)(((long)(C.bid + 1) * nit_all) / C.G);
    for (int it = it0; it < it1; ++it, ++nit) {
        const int row = it * 8 + C.wave;
        const int mrow = row < NLAT ? row / SL : 4; const float* mod = WSP(float, WS_MOD) + (size_t)(l * 5 + mrow) * 12288;
        __syncthreads();
        if (mrow != cur_mrow) { stage2048(C, PAR, mod + 4096); stage2048(C, PAR + 2048, INP(I_LN1G) + l * DM); stage2048(C, PAR + 4096, INP(I_LN1B) + l * DM); stage2048(C, PAR + 6144, mod + 8192); stage2048(C, PAR + 8192, mod + 6144); cur_mrow = mrow; __syncthreads(); }
        {
            float v[32], y[32], g1[32];
            if (l == 0) row_load(src_x0(C, row), C.lane, v); else row_load_bf16(WSP(bf16, WS_X) + (size_t)row * DM, C.lane, v);
            row_load_lds(PAR, C.lane, g1);
            { const bf16* yo = WSP(bf16, WS_YO) + (size_t)row * DM;
#pragma unroll
              for (int j = 0; j < 4; ++j) { float t8[8]; cvt8(*(const u32x4*)(yo + 512 * j + 8 * C.lane), t8);
#pragma unroll
                  for (int e = 0; e < 8; ++e) y[8 * j + e] = t8[e]; } }
#pragma unroll
            for (int i = 0; i < 32; ++i) v[i] = ALPHA * v[i] + g1[i] * y[i];
            row_ln(v); row_affine_lds(v, PAR + 2048, PAR + 4096, C.lane, 0.f);
            row_store_bf16(WSP(bf16, WS_X) + (size_t)row * DM, C.lane, v);
            row_ln(v); row_affine_lds(v, PAR + 6144, PAR + 8192, C.lane, 1.0f);
            row_store_fp8(WSP(unsigned char, WS_HB8) + (size_t)row * DM, C.lane, v);
#pragma unroll
            for (int j = 0; j < 4; ++j) { *(LAS f32x4*)(H2 + C.wave * DM + 512 * j + 8 * C.lane) = (f32x4){v[8 * j], v[8 * j + 1], v[8 * j + 2], v[8 * j + 3]};
                *(LAS f32x4*)(H2 + C.wave * DM + 512 * j + 8 * C.lane + 4) = (f32x4){v[8 * j + 4], v[8 * j + 5], v[8 * j + 6], v[8 * j + 7]}; }
        }
        __syncthreads();
        {
            const int e4 = C.lane & 7, cg = C.lane >> 3, cbase = 256 * C.wave + 32 * cg;
            f32x2 acc[8][2];
#pragma unroll
            for (int r = 0; r < 8; ++r) { acc[r][0] = (f32x2){0.f, 0.f}; acc[r][1] = (f32x2){0.f, 0.f}; }
            const float* wr = INP(I_WR) + (size_t)cbase * NE + 4 * e4;
#pragma unroll 2
            for (int cq = 0; cq < 32; cq += 4) {
                f32x4 w4[4];
#pragma unroll
                for (int k = 0; k < 4; ++k) w4[k] = *(const f32x4*)(wr + (size_t)(cq + k) * NE);
#pragma unroll
                for (int r = 0; r < 8; ++r) { const f32x4 hv = *(const LAS f32x4*)(H2 + r * DM + cbase + cq);
#pragma unroll
                    for (int k = 0; k < 4; ++k) { const f32x2 hh = {hv[k], hv[k]}; acc[r][0] += hh * (f32x2){w4[k][0], w4[k][1]}; acc[r][1] += hh * (f32x2){w4[k][2], w4[k][3]}; } } }
#pragma unroll
            for (int r = 0; r < 8; ++r)
#pragma unroll
                for (int k = 0; k < 2; ++k) { float x = acc[r][k].x, y = acc[r][k].y;
                    x += dpp_f<DPP_ROR8>(x); y += dpp_f<DPP_ROR8>(y); x = xor32_sum(xor16_sum(x)); y = xor32_sum(xor16_sum(y));
                    if (cg == 0) { RED[(C.wave * 8 + r) * 32 + 4 * e4 + 2 * k] = x; RED[(C.wave * 8 + r) * 32 + 4 * e4 + 2 * k + 1] = y; } }
        }
        __syncthreads();
        if (C.tid < 256) { const int r = C.tid >> 5, e = C.tid & 31; float s = 0.f;
#pragma unroll
            for (int p = 0; p < 8; ++p) s += RED[(p * 8 + r) * 32 + e];
            SGA[(nit * 8 + r) * 32 + e] = 1.0f / (1.0f + expf(-s)); }
    }
    __syncthreads();
    if (C.tid < nit * 8 && !dry) { const int r = C.tid, rw = (it0 + (r >> 3)) * 8 + (r & 7); float best = -INFINITY; int bg = 0;
        const LAS float* sg = SGA + r * 32; const float* rb = INP(I_RB);
        for (int gq = 0; gq < 8; ++gq) { const float a = sg[4 * gq] + rb[4 * gq], b = sg[4 * gq + 1] + rb[4 * gq + 1], c = sg[4 * gq + 2] + rb[4 * gq + 2], d = sg[4 * gq + 3] + rb[4 * gq + 3];
            const float hi1 = fmaxf(a, b), lo1 = fminf(a, b), hi2 = fmaxf(c, d), lo2 = fminf(c, d);
            const float top = fmaxf(hi1, hi2), second = fmaxf(fminf(hi1, hi2), (hi1 >= hi2) ? lo1 : lo2);
            const float sc = top + second; if (sc > best) { best = sc; bg = gq; } }
        int i0 = 0; float v0 = -INFINITY;
        for (int k = 0; k < 4; ++k) { const float x = sg[4 * bg + k] + rb[4 * bg + k]; if (x > v0) { v0 = x; i0 = k; } }
        int i1 = 0; float v1 = -INFINITY;
        for (int k = 0; k < 4; ++k) { const float x = sg[4 * bg + k] + rb[4 * bg + k]; if (k != i0 && x > v1) { v1 = x; i1 = k; } }
        const int e0 = 4 * bg + i0, e1 = 4 * bg + i1; const float w0 = sg[e0], w1 = sg[e1], ws = w0 + w1;
        const int p0 = (int)atomicAdd(ctl + CW_CNT + l * 2048 + e0 * 64, 1u), p1 = (int)atomicAdd(ctl + CW_CNT + l * 2048 + e1 * 64, 1u);
        WSP(int4, WS_TOKINFO)[rw] = make_int4(e0, p0, e1, p1); WSP(f32x2, WS_TOKW)[rw] = (f32x2){w0 / ws, w1 / ws};
        WSP(int, WS_EXPTOK)[(size_t)e0 * NTOK + p0] = rw; WSP(int, WS_EXPTOK)[(size_t)e1 * NTOK + p1] = rw; }
    __syncthreads();
}

__device__ __forceinline__ int moe_tables(Ctx& C, int l) {
    LAS int* T = (LAS int*)(C.lds + LDS_TAB);
    __syncthreads();
    if (C.tid < NE) { unsigned* ctl = WSP(unsigned, WS_CTL); T[200 + C.tid] = (int)__hip_atomic_load(ctl + CW_CNT + l * 2048 + C.tid * 64, __ATOMIC_RELAXED, __HIP_MEMORY_SCOPE_AGENT); }
    __syncthreads();
    if (C.tid == 0) { int nb = 0;
        for (int e = 0; e < NE; ++e) { const int cnt = T[200 + e]; T[168 + e] = nb; const int nbk = (cnt + 255) >> 8;
            for (int k = 0; k < nbk; ++k) if (nb + k < MAXBLK) T[nb + k] = e;
            nb += nbk; }
        T[232] = nb < MAXBLK ? nb : MAXBLK; }
    __syncthreads();
    return T[232];
}

__device__ __forceinline__ void ph_post2(Ctx& C, int l, int nrows) {
    const bool last = (l == 1);
    (void)moe_tables(C, l);
    const LAS int* T = (const LAS int*)(C.lds + LDS_TAB);
    LAS float* PAR = (LAS float*)C.lds;
    const int r0 = (int)(((long)C.bid * nrows) / C.G), r1 = (int)(((long)(C.bid + 1) * nrows) / C.G);
    int cur_mrow = -1;
    for (int rb = r0 & ~7; rb < r1; rb += 8) {
        const int mrow = rb < NLAT ? rb / SL : 4; const float* mod = WSP(float, WS_MOD) + (size_t)(l * 5 + mrow) * 12288;
        if (mrow != cur_mrow) { const float* modn = WSP(float, WS_MOD) + (size_t)((last ? l : l + 1) * 5 + mrow) * 12288;
            __syncthreads(); stage2048(C, PAR, mod + 10240); stage2048(C, PAR + 2048, INP(I_LN2G) + l * DM); stage2048(C, PAR + 4096, INP(I_LN2B) + l * DM); stage2048(C, PAR + 6144, modn + 2048); stage2048(C, PAR + 8192, modn); cur_mrow = mrow; __syncthreads(); }
        const int row = rb + C.wave;
        if (row >= r0 && row < r1) {
        const int4 ti = WSP(int4, WS_TOKINFO)[row]; const f32x2 tw = WSP(f32x2, WS_TOKW)[row];
        const int s0 = T[168 + ti.x] * 256 + ti.y, s1 = T[168 + ti.z] * 256 + ti.w;
        const unsigned char* y0 = WSP(unsigned char, WS_YS) + (size_t)s0 * DM; const unsigned char* y1 = WSP(unsigned char, WS_YS) + (size_t)s1 * DM;
        float v[32], g2[32]; row_load_bf16(WSP(bf16, WS_X) + (size_t)row * DM, C.lane, v); row_load_lds(PAR, C.lane, g2);
#pragma unroll
        for (int j = 0; j < 4; ++j) { float a[8], b[8]; cvt8_fp8(*(const u32x2*)(y0 + 512 * j + 8 * C.lane), a); cvt8_fp8(*(const u32x2*)(y1 + 512 * j + 8 * C.lane), b);
#pragma unroll
            for (int e = 0; e < 8; ++e) v[8 * j + e] = ALPHA * v[8 * j + e] + g2[8 * j + e] * ((tw.x * 0.0625f) * a[e] + (tw.y * 0.0625f) * b[e]); }
        row_ln(v); row_affine_lds(v, PAR + 2048, PAR + 4096, C.lane, 0.f);
        if (last) { row_store((float*)(C.out + (size_t)row * DM), C.lane, v); }
        else { row_store_bf16(WSP(bf16, WS_X) + (size_t)row * DM, C.lane, v);
            row_ln(v); row_affine_lds(v, PAR + 6144, PAR + 8192, C.lane, 1.0f);
            if (FP8_IN) row_store_fp8(WSP(unsigned char, WS_HA8) + (size_t)row * DM, C.lane, v); else row_store_bf16(WSP(bf16, WS_HB) + (size_t)row * DM, C.lane, v); }
        }
    }
}

constexpr int N_PHASES = 20;
__global__ void __launch_bounds__(512, 2) fwd_kernel(Args args) {
    extern __shared__ __attribute__((aligned(16))) unsigned char lds_raw[];
    Ctx C0; C0.lds = (LAS unsigned char*)lds_raw; C0.tid = threadIdx.x; C0.lane = C0.tid & 63; C0.wave = __builtin_amdgcn_readfirstlane(C0.tid >> 6); C0.bid = blockIdx.x; C0.G = gridDim.x;
    C0.in = (const float GAS* const __attribute__((address_space(4)))*)((const __attribute__((address_space(4))) Args*)__builtin_amdgcn_kernarg_segment_ptr())->in; C0.out = (float GAS*)args.out; C0.ws = (unsigned char GAS*)args.ws;
    volatile LAS unsigned* MISC = (volatile LAS unsigned*)(C0.lds + LDS_MISC);
    if (C0.tid < 4) MISC[C0.tid] = 0u;
    __syncthreads();
    XcdBarrier bar; bar.bar = (unsigned*)(unsigned GAS*)(C0.ws + WS_CTL) + CW_BAR; bar.x = 0; bar.st = nullptr;
    const int lo = args.ph_lo, hi = args.ph_hi;
    if (hi - lo > 1) bar = xcd_barrier_post((unsigned*)(unsigned GAS*)(C0.ws + WS_CTL) + CW_BAR, MISC);
#ifdef ONLY
#define IN(k) ((k) == ONLY)
#define INL(j) ((j) + 2 == ONLY)
#define SEAM(k) do { } while (0)
#else
#define IN(k) (lo <= (k) && (k) < hi)
#define INL(j) IN(pb + (j))
#define SEAM(k) do { if (IN(k) && IN((k) + 1)) xcd_barrier(bar); } while (0)
#endif

    if (IN(0)) { _Pragma("unroll") for (int rep = 0; rep < NREP(0); ++rep) { if (rep) xcd_barrier(bar); FRESH(D, C0);
        if (D.bid & 1) { p0_filters(D); p0_adaln(D); } else { p0_adaln(D); p0_filters(D); }        p0_rope(D); __syncthreads(); p0_convert(D, 0, NBP); } }
    SEAM(0);
    if (IN(1)) { _Pragma("unroll") for (int rep = 0; rep < NREP(1); ++rep) { if (rep) xcd_barrier(bar); FRESH(D, C0); ph_ln_mod(D, 0, NTOK); } }
    SEAM(1);
#define LAYER_BODY(l) do { \
        const int pb = 2 + 9 * l; const bool last = (l == 1); const int nrows = last ? NLAT : NTOK; \
        if (INL(0)) { _Pragma("unroll") for (int rep = 0; rep < NREP(2 + 9 * l + 0); ++rep) { if (rep) xcd_barrier(bar); \
            FRESH(C, C0); \
            pg8::Gemm g{FP8_IN ? (const bf16*)WSP(unsigned char, WS_HA8) : WSP(bf16, WS_HB), FP8_IN ? (const bf16*)(WSP(unsigned char, WS_WIN) + (size_t)l * INW * DM) : WSP(bf16, WS_WIN) + (size_t)l * INW * DM, FP8_IN ? DM / 2 : DM}; \
            pg8::DenseOrder S; S.init(NTOK, INW, C.G, C.bid); \
            pg8::EpiBf16 E{WSP(bf16, WS_Z), INW, 11}; \
            pg8::gemm_phase<pg8::EpiBf16, pg8::DenseOrder, false, FP8_IN != 0>(C.lds, g, S, E); \
        } \
        } SEAM(pb + 0); \
        if (INL(1)) { _Pragma("unroll") for (int rep = 0; rep < NREP(2 + 9 * l + 1); ++rep) { if (rep) xcd_barrier(bar); \
            const int n_attn = last ? 256 : 272, n_gmlp = last ? 256 : 272, n_pool = last ? 512 : 544, n_hyp = last ? 1536 : 1632; \
            { FRESH(C, C0); \
                \
              volatile LAS int* qn = (volatile LAS int*)(C.lds + LDS_MISC + 32); \
              unsigned* qctr = WSP(unsigned, WS_CTL) + CW_QUEUE + (l * 2 + rep) * 64; \
              const int b0 = 256, b1 = b0 + n_gmlp, b2 = b1 + (n_attn - 256), b3 = b2 + n_pool, total = b3 + n_hyp; \
              volatile LAS int* qc = (volatile LAS int*)(C.lds + LDS_MISC + 36); \
              unsigned* cctr = WSP(unsigned, WS_CTL) + CW_QUEUE + (4 + rep) * 64; \
              int u = C.bid, cu = (last || C.bid >= CONV_SPLIT) ? NCU : C.bid;        \
              while (u < total || cu < NCU) { \
                  int nxt = total, nxc = NCU; \
                  if (C.tid == 0) { if (u < total) nxt = (int)atomicAdd(qctr, 1u) + C.G; if (cu < NCU) { nxc = (int)atomicAdd(cctr, 1u) + C.G; if (nxc >= CONV_SPLIT) nxc = NCU; } } \
                  if (u < total) { FRESH(Cu, C); if (u < b0) attn_unit(Cu, l, u); else if (u < b1) gmlp_unit(Cu, l, u - b0); else if (u < b2) attn_unit(Cu, l, 256 + u - b1); else if (u < b3) pool_unit(Cu, l, u - b2); else hyprep_unit(Cu, l, u - b3); } \
                  if (cu < NCU) { FRESH(Cu, C); conv_unit(Cu, 1, cu * UB); } \
                  __syncthreads(); if (C.tid == 0) { *qn = nxt; *qc = nxc; } __syncthreads(); u = __builtin_amdgcn_readfirstlane(*qn); cu = __builtin_amdgcn_readfirstlane(*qc); \
              } } \
        } \
        } SEAM(pb + 1); \
        if (INL(2)) { _Pragma("unroll") for (int rep = 0; rep < NREP(2 + 9 * l + 2); ++rep) { if (rep) xcd_barrier(bar); \
            { FRESH(C, C0);        \
              volatile LAS int* qc = (volatile LAS int*)(C.lds + LDS_MISC + 36); \
              unsigned* cctr = WSP(unsigned, WS_CTL) + CW_QUEUE + (6 + 2 * l + rep) * 64; \
              const int nhu = (rep && PROBE_CONV == 1) ? 0 : (last ? 512 : 512 + 64), ncu = (rep && PROBE_CONV == 2) ? 0 : (last ? NCU_E : NCU_E + NCU_P - TAILQ); \
                \
              const int quota = (ncu + C.G - 1) / C.G, cls = C.bid % 3; \
              int hu = C.bid, cu = C.bid, nh = 0, nc = 0; \
              while (hu < nhu || cu < ncu) { \
                  const bool cv = cu < ncu && (hu >= nhu || (nc < quota && (cls == 0 || (cls == 1 && nh >= 1)))); \
                  if (cv) { \
                      int nxc = ncu; if (C.tid == 0) nxc = (int)atomicAdd(cctr, 1u) + C.G; \
                      { FRESH(Cu, C); bg_conv_unit(Cu, l, cu); } \
                      __syncthreads(); if (C.tid == 0) *qc = nxc; __syncthreads(); cu = __builtin_amdgcn_readfirstlane(*qc); ++nc; \
                  } else { FRESH(Cu, C); if (hu < 512) hyena_unit<SL>(Cu, l, hu); else { Ctx Cw = Cu; Cw.lds = Cu.lds + Cu.wave * 8192; Cw.tid = Cu.lane; Cw.wave = 0; hyena_unit<CL, 64>(Cw, l, 8 * (hu - 512) + Cu.wave); }        hu += C.G; ++nh; } \
              } } \
        } \
        } SEAM(pb + 2); \
        if (INL(3)) { _Pragma("unroll") for (int rep = 0; rep < NREP(2 + 9 * l + 3); ++rep) { if (rep) xcd_barrier(bar); FRESH(C, C0); rms_stage_gain(C, l); for (int u = C.bid; u < nrows / 32; u += C.G) { FRESH(Cu, C); rms_unit(Cu, l, u); } } \
        } SEAM(pb + 3); \
        if (INL(4)) { _Pragma("unroll") for (int rep = 0; rep < NREP(2 + 9 * l + 4); ++rep) { if (rep) xcd_barrier(bar); \
            FRESH(C, C0); \
            pg8::Gemm g{FP8_OUT ? (const bf16*)WSP(unsigned char, WS_HA8) : WSP(bf16, WS_HB), FP8_OUT ? (const bf16*)(WSP(unsigned char, WS_WOUT) + (size_t)l * DM * DM) : WSP(bf16, WS_WOUT) + (size_t)l * DM * DM, FP8_OUT ? DM / 2 : DM}; \
            pg8::DenseOrder S; S.init(nrows, DM, C.G, C.bid); \
            pg8::EpiBf16 E{WSP(bf16, WS_YO), DM, 1 << 30}; \
            pg8::gemm_phase<pg8::EpiBf16, pg8::DenseOrder, false, FP8_OUT != 0>(C.lds, g, S, E); \
            if (!last && rep == 0 && TAILQ > 0) {        \
                FRESH(Ct, C0); \
                volatile LAS int* qc = (volatile LAS int*)(Ct.lds + LDS_MISC + 36); \
                unsigned* tctr = WSP(unsigned, WS_CTL) + CW_QUEUE + 12 * 64; \
                for (;;) { \
                    __syncthreads(); if (Ct.tid == 0) *qc = NCU_E + NCU_P - TAILQ + (int)atomicAdd(tctr, 1u); __syncthreads(); \
                    const int cu = __builtin_amdgcn_readfirstlane(*qc); if (cu >= NCU_E + NCU_P) break; \
                    FRESH(Cu, Ct); bg_conv_unit(Cu, 0, cu); \
                } } \
        } \
        } SEAM(pb + 4); \
        if (INL(5)) { FRESH(C, C0); ph_post1(C, l, nrows); if (PROBE_P1 && l == 0) { xcd_barrier(bar); FRESH(C2, C0); ph_post1(C2, l, nrows, true); } } \
        SEAM(pb + 5); \
        if (INL(6)) { _Pragma("unroll") for (int rep = 0; rep < NREP(2 + 9 * l + 6); ++rep) { if (rep) xcd_barrier(bar); \
            FRESH(C, C0); \
            const int nblk = moe_tables(C, l); const LAS int* T = (const LAS int*)(C.lds + LDS_TAB); \
            pg8::Gemm g{(const bf16*)WSP(unsigned char, WS_HB8), (const bf16*)(WSP(unsigned char, WS_WGU) + (size_t)l * NE * 1536 * DM), DM / 2}; \
            pg8::MoeOrder S; S.nblk = nblk; S.nN = 6; S.G = C.G; S.c = C.bid; S.blk_e = T; S.bst = T + 168; S.cnt = T + 200; S.exptok = WSP(int, WS_EXPTOK); S.ntok = NTOK; \
            pg8::EpiGLU E{WSP(unsigned char, WS_HG), DE}; \
            pg8::gemm_phase<pg8::EpiGLU, pg8::MoeOrder, true, true>(C.lds, g, S, E); \
        } } \
        SEAM(pb + 6); \
        if (INL(7)) { _Pragma("unroll") for (int rep = 0; rep < NREP(2 + 9 * l + 7); ++rep) { if (rep) xcd_barrier(bar); \
            FRESH(C, C0); \
            const int nblk = moe_tables(C, l); const LAS int* T = (const LAS int*)(C.lds + LDS_TAB); \
            pg8::Gemm g{(const bf16*)WSP(unsigned char, WS_HG), (const bf16*)(WSP(unsigned char, WS_WD) + (size_t)l * NE * DM * DE), DE / 2}; \
            pg8::MoeOrder S; S.nblk = nblk; S.nN = 8; S.G = C.G; S.c = C.bid; S.blk_e = T; S.bst = T + 168; S.cnt = T + 200; S.exptok = WSP(int, WS_EXPTOK); S.ntok = NTOK; \
            pg8::EpiFp8 E{WSP(unsigned char, WS_YS), DM, 16.0f}; \
            pg8::gemm_phase<pg8::EpiFp8, pg8::MoeOrder, false, true>(C.lds, g, S, E); \
        } } \
        SEAM(pb + 7); \
        if (INL(8)) { FRESH(C, C0); ph_post2(C, l, nrows); if (PROBE_P2 && l == 1) { xcd_barrier(bar); FRESH(C2, C0); ph_post2(C2, l, nrows); } } \
        SEAM(pb + 8); \
} while (0)
    LAYER_BODY(0);
    LAYER_BODY(1);
#undef IN
#undef INL
#undef SEAM
}

extern "C" void kernel_launch(void* const* d_in, const int* in_sizes, int n_in, void* d_out, int out_size, void* d_ws, size_t ws_size, hipStream_t stream) {
    static int grid = 0;
    if (grid == 0) {
        if (n_in != 35 || out_size != NLAT * DM || ws_size < WS_END) { fprintf(stderr, "kernel_launch: unexpected shapes (n_in %d out %d ws %zu)\n", n_in, out_size, ws_size); grid = -1; return; }
        int dev = 0, cus = 0;
        if (hipGetDevice(&dev) != hipSuccess || hipDeviceGetAttribute(&cus, hipDeviceAttributeMultiprocessorCount, dev) != hipSuccess) { grid = -1; return; }
        if (hipFuncSetAttribute((const void*)fwd_kernel, hipFuncAttributeMaxDynamicSharedMemorySize, LDS_BYTES) != hipSuccess) { fprintf(stderr, "kernel_launch: hipFuncSetAttribute failed\n"); grid = -1; return; }
        int per_cu = 0;
        if (hipOccupancyMaxActiveBlocksPerMultiprocessor(&per_cu, (const void*)fwd_kernel, 512, LDS_BYTES) != hipSuccess || per_cu < 1) fprintf(stderr, "kernel_launch: occupancy query says %d\n", per_cu);
        (void)hipGetLastError();
        grid = cus;
    }
    if (grid < 0) return;
    (void)hipMemsetAsync((char*)d_ws + WS_CTL, 0, CTL_ZERO_BYTES, stream);
    Args a{};
    for (int i = 0; i < 35; ++i) a.in[i] = (const float*)d_in[i];
    a.out = (float*)d_out; a.ws = (unsigned char*)d_ws;
    if (MK_N_LAUNCHES == 1) { a.ph_lo = 0; a.ph_hi = N_PHASES; hipLaunchKernelGGL(fwd_kernel, dim3(grid), dim3(512), LDS_BYTES, stream, a); }
    else for (int p = 0; p < N_PHASES; ++p) { a.ph_lo = p; a.ph_hi = p + 1; hipLaunchKernelGGL(fwd_kernel, dim3(grid), dim3(512), LDS_BYTES, stream, a); }
}
```

```cpp
#include <hip/hip_runtime.h>
#include <cstdio>
#include <cstdint>

#ifndef DUP_MASK
#define DUP_MASK 0u
#endif
#ifndef PROBE_P1
#define PROBE_P1 0
#endif
#ifndef PROBE_P2
#define PROBE_P2 0
#endif
#ifndef FP8_IN
#define FP8_IN 1
#endif
#ifndef FP8_OUT
#define FP8_OUT 1
#endif
#ifndef PROBE_P0
#define PROBE_P0 0
#endif
#ifndef PROBE_CONV
#define PROBE_CONV 0
#endif
#ifndef DUP_SUB
#define DUP_SUB 0u
#endif
#define NSUB(k) (((DUP_SUB >> (k)) & 1u) ? 2 : 1)
#define NREP(k) (((DUP_MASK >> (k)) & 1u) ? 2 : 1)
#ifndef MK_N_LAUNCHES
#define MK_N_LAUNCHES 1
#endif

#define LAS __attribute__((address_space(3)))
#define GAS __attribute__((address_space(1)))
typedef unsigned short bf16;
typedef short bf16x8 __attribute__((ext_vector_type(8)));
typedef float f32x2 __attribute__((ext_vector_type(2)));
typedef float f32x4 __attribute__((ext_vector_type(4)));
typedef float f32x16 __attribute__((ext_vector_type(16)));
typedef unsigned u32x2 __attribute__((ext_vector_type(2)));
typedef unsigned u32x4 __attribute__((ext_vector_type(4)));
typedef __bf16 bf16x2_t __attribute__((ext_vector_type(2)));

constexpr int DM = 2048, NB = 4, SL = 4096, CL = 256, NLAT = NB * SL, NCTX = NB * CL, NTOK = NLAT + NCTX;
constexpr int INW = 3840, DE = 768, NE = 32, MAXBLK = 168;
constexpr float LN_EPS = 1e-6f, ALPHA = 1.41421356237f, LOG2E = 1.44269504089f;

constexpr size_t MiB = 1u << 20;
constexpr size_t WS_CTL = 0, CTL_ZERO_BYTES = 1 * MiB;
constexpr size_t WS_MOD = 1 * MiB;
constexpr size_t WS_ROPE = 2 * MiB;
constexpr size_t WS_TOKINFO = 2 * MiB + 65536;
constexpr size_t WS_TOKW = WS_TOKINFO + (size_t)NTOK * 16;
constexpr size_t WS_ROWSLOT = WS_TOKW + (size_t)NTOK * 8;
constexpr size_t WS_SLOTW = WS_ROWSLOT + (size_t)NTOK * 8;
static_assert(WS_SLOTW + 43008 * 4 <= 4 * MiB, "small tables");
constexpr size_t WS_POOLWT = 3 * MiB;
constexpr size_t WS_GWSB = 3 * MiB + 512 * 1024;
constexpr size_t WS_WIN = 4 * MiB;
constexpr size_t WS_WOUT = 34 * MiB;
constexpr size_t WS_WGU = 50 * MiB;
constexpr size_t WS_WD = 434 * MiB;
constexpr size_t WS_FILT = 626 * MiB;
constexpr size_t WS_FILTC = 658 * MiB;
constexpr size_t WS_X = 660 * MiB;
constexpr size_t WS_HB = 796 * MiB;
constexpr size_t WS_Z = 864 * MiB;
constexpr size_t WS_YCAT = 992 * MiB;
constexpr size_t WS_TL = 1060 * MiB;
constexpr size_t WS_TC = 1108 * MiB;
constexpr size_t WS_YHT = 1112 * MiB;
constexpr size_t WS_YO = 1129 * MiB;
constexpr size_t WS_EXPTOK = 864 * MiB;
constexpr size_t WS_HG = 1032 * MiB;
constexpr size_t WS_YS = 1095 * MiB;
constexpr size_t WS_HB8 = 1265 * MiB;
constexpr size_t WS_HA8 = 1300 * MiB;
constexpr size_t WS_END = 1334 * MiB;
constexpr int CW_BAR = 4096;
constexpr int CW_CNT = 8192;
constexpr int CW_QUEUE = 14336;
constexpr int CW_NBLK = 12288;
constexpr int CW_BLKE = 12544;
constexpr int LDS_TAB = 132096;
constexpr int LDS_BYTES = 147456;
constexpr int LDS_MISC = 147392;

__device__ __forceinline__ unsigned pk2(float lo, float hi) { f32x2 v = {lo, hi}; bf16x2_t b = __builtin_convertvector(v, bf16x2_t); return __builtin_bit_cast(unsigned, b); }
__device__ __forceinline__ unsigned pk4_fp8(float a, float b, float c, float d) { int p = 0; p = __builtin_amdgcn_cvt_pk_fp8_f32(a, b, p, false); p = __builtin_amdgcn_cvt_pk_fp8_f32(c, d, p, true); return (unsigned)p; }
__device__ __forceinline__ float bflo(unsigned w) { return __uint_as_float(w << 16); }
__device__ __forceinline__ float bfhi(unsigned w) { return __uint_as_float(w & 0xffff0000u); }
__device__ __forceinline__ float bf1(bf16 v) { return __uint_as_float(((unsigned)v) << 16); }
template <int CTRL> __device__ __forceinline__ float dpp_f(float x) { return __int_as_float(__builtin_amdgcn_update_dpp(0, __float_as_int(x), CTRL, 0xF, 0xF, true)); }
#define DPP_XOR1 0xB1
#define DPP_XOR2 0x4E
#define DPP_HMIRROR 0x141
#define DPP_MIRROR 0x140
#define DPP_ROR8 0x128
__device__ __forceinline__ float xor16_sum(float x) { const auto r = __builtin_amdgcn_permlane16_swap(__float_as_uint(x), __float_as_uint(x), false, false); return __uint_as_float(r[0]) + __uint_as_float(r[1]); }
__device__ __forceinline__ float xor32_sum(float x) { const auto r = __builtin_amdgcn_permlane32_swap(__float_as_uint(x), __float_as_uint(x), false, false); return __uint_as_float(r[0]) + __uint_as_float(r[1]); }
__device__ __forceinline__ float xor32_max(float x) { const auto r = __builtin_amdgcn_permlane32_swap(__float_as_uint(x), __float_as_uint(x), false, false); return fmaxf(__uint_as_float(r[0]), __uint_as_float(r[1])); }
__device__ __forceinline__ float row16_sum(float v) { v += dpp_f<DPP_XOR1>(v); v += dpp_f<DPP_XOR2>(v); v += dpp_f<DPP_HMIRROR>(v); v += dpp_f<DPP_MIRROR>(v); return v; }
__device__ __forceinline__ float wave_sum(float v) { return xor32_sum(xor16_sum(row16_sum(v))); }
__device__ __forceinline__ float gelu_tanh(float x) { const float y = 0.7978845608f * (x + 0.044715f * x * x * x); const float t = __expf(2.0f * y); return 0.5f * x * (2.0f - 2.0f * __builtin_amdgcn_rcpf(t + 1.0f)); }
__device__ __forceinline__ float silu_f(float x) { return x * __builtin_amdgcn_rcpf(1.0f + __expf(-x)); }
#define LDS_WAIT() asm volatile("s_waitcnt lgkmcnt(0)" ::: "memory")
#define VM_WAIT() asm volatile("s_waitcnt vmcnt(0)" ::: "memory")

namespace pg8 {
#define PG8_LAS __attribute__((address_space(3)))
typedef unsigned short bf16_t;
constexpr int BM = 256, BK = 64, HALF = 128, HTB = HALF * BK * 2, STAGE_BYTES = 8 * HTB, NXCD = 8, WGM = 8;
__host__ __device__ __forceinline__ int lds_byte(int r, int c) { const int st = (r >> 4) * 2 + (c >> 5), rr = r & 15, cc = c & 31, ob = rr * 64 + cc * 2; return st * 1024 + (ob ^ (((ob >> 9) & 1) << 5)); }
__host__ __device__ __forceinline__ void stage_rc(int b, int& R, int& C) { const int st = b / 1024, sb = b % 1024, swz = sb ^ (((sb >> 9) & 1) << 5); R = (st >> 1) * 16 + swz / 64; C = (st & 1) * 32 + (swz % 64) / 2; }
__host__ __device__ __forceinline__ int perm32(int rho) { const int n = rho >> 4, i = rho & 15; return 8 * (i >> 2) + 4 * n + (i & 3); }

struct Unit { int pm, pn, pb; const int* amap; int nvalid; };
struct Gemm { const bf16_t* A; const bf16_t* Bt; int K; };

struct DenseOrder {
    int nM, nN, nwg, G, c;
    __device__ void init(int M, int N, int G_, int c_) { nM = M / BM; nN = N / BM; nwg = nM * nN; G = G_; c = c_; }
    __device__ bool next(int i, Unit& u) const {
        const long L = (long)i * G + c; if (L >= nwg) return false;
        int wgid = (int)L; { const int q = nwg / NXCD, r = nwg % NXCD, xcd = wgid % NXCD, off = wgid / NXCD; wgid = (xcd < r ? xcd * (q + 1) : r * (q + 1) + (xcd - r) * q) + off; }
        const int nig = WGM * nN, gid = wgid / nig, fm = gid * WGM, gsz = (nM - fm) < WGM ? (nM - fm) : WGM;
        u.pm = fm + ((wgid % nig) % gsz); u.pn = (wgid % nig) / gsz; u.pb = u.pn; u.amap = nullptr; u.nvalid = 0; return true;
    }
    __device__ __forceinline__ void a_ready(const Unit&) const {}
    __device__ __forceinline__ void done(const Unit&) const {}
};
struct MoeOrder {
    int nblk, nN, G, c; const PG8_LAS int* blk_e; const PG8_LAS int* bst; const PG8_LAS int* cnt; const int* exptok; int ntok;
    __device__ bool next(int i, Unit& u) const {
        const long L = (long)i * G + c; const int nwg = nblk * nN; if (L >= nwg) return false;
        int wgid = (int)L; { const int q = nwg / NXCD, r = nwg % NXCD, xcd = wgid % NXCD, off = wgid / NXCD; wgid = (xcd < r ? xcd * (q + 1) : r * (q + 1) + (xcd - r) * q) + off; }
        const int blk = wgid / nN, pn = wgid % nN, e = blk_e[blk], p0 = (blk - bst[e]) * 256;
        u.pm = blk; u.pn = pn; u.pb = e * nN + pn; u.amap = exptok + (size_t)e * ntok + p0; u.nvalid = cnt[e] - p0; return true;
    }
    __device__ __forceinline__ void a_ready(const Unit&) const {}
    __device__ __forceinline__ void done(const Unit&) const {}
};

struct EpiBf16 {
    static constexpr bool PERM = true;
    bf16_t* O; int ldc; int gelu_from;
    __device__ __forceinline__ void operator()(const f32x4 (&acc)[2][2][4][2], const Unit& u, int wr, int wc, int fr, int fq) const {
        const int row0 = u.pm * BM + wr * 64 + fr; const int col0 = u.pn * BM + wc * 32 + 8 * fq; const bool act = u.pn >= gelu_from;
#pragma unroll
        for (int ai = 0; ai < 2; ++ai)
#pragma unroll
            for (int m = 0; m < 4; ++m) { bf16_t* rowp = O + (size_t)(row0 + ai * HALF + m * 16) * ldc + col0;
#pragma unroll
                for (int bj = 0; bj < 2; ++bj) { f32x4 v0 = acc[ai][bj][m][0], v1 = acc[ai][bj][m][1];
                    if (act) {
#pragma unroll
                        for (int j = 0; j < 4; ++j) { v0[j] = gelu_tanh(v0[j]); v1[j] = gelu_tanh(v1[j]); } }
                    u32x4 w; w.x = pk2(v0[0], v0[1]); w.y = pk2(v0[2], v0[3]); w.z = pk2(v1[0], v1[1]); w.w = pk2(v1[2], v1[3]);
                    *(u32x4*)(rowp + bj * HALF) = w; } }
    }
};
struct EpiFp8 {
    static constexpr bool PERM = true;
    unsigned char* O; int ldc; float scale;
    __device__ __forceinline__ void operator()(const f32x4 (&acc)[2][2][4][2], const Unit& u, int wr, int wc, int fr, int fq) const {
        const int row0 = u.pm * BM + wr * 64 + fr; const int col0 = u.pn * BM + wc * 32 + 8 * fq;
#pragma unroll
        for (int ai = 0; ai < 2; ++ai)
#pragma unroll
            for (int m = 0; m < 4; ++m) { unsigned char* rowp = O + (size_t)(row0 + ai * HALF + m * 16) * ldc + col0;
#pragma unroll
                for (int bj = 0; bj < 2; ++bj) { const f32x4 v0 = acc[ai][bj][m][0] * scale, v1 = acc[ai][bj][m][1] * scale;
                    u32x2 w; w.x = pk4_fp8(v0[0], v0[1], v0[2], v0[3]); w.y = pk4_fp8(v1[0], v1[1], v1[2], v1[3]);
                    *(u32x2*)(rowp + bj * HALF) = w; } }
    }
};
struct EpiF32 {
    static constexpr bool PERM = false;
    float* C; int ldc;
    __device__ __forceinline__ void operator()(const f32x4 (&acc)[2][2][4][2], const Unit& u, int wr, int wc, int fr, int fq) const {
        const int row0 = u.pm * BM + wr * 64 + fr, col0 = u.pn * BM + wc * 32 + 4 * fq;
#pragma unroll
        for (int ai = 0; ai < 2; ++ai)
#pragma unroll
            for (int m = 0; m < 4; ++m) { float* rowp = C + (size_t)(row0 + ai * HALF + m * 16) * ldc + col0;
#pragma unroll
                for (int bj = 0; bj < 2; ++bj)
#pragma unroll
                    for (int n = 0; n < 2; ++n) *(f32x4*)(rowp + bj * HALF + n * 16) = acc[ai][bj][m][n]; }
    }
};
struct EpiGLU {
    static constexpr bool PERM = true;
    unsigned char* O; int ldc;
    __device__ __forceinline__ void operator()(const f32x4 (&acc)[2][2][4][2], const Unit& u, int wr, int wc, int fr, int fq) const {
        const int row0 = u.pm * BM + wr * 64 + fr; const int col0 = u.pn * HALF + wc * 32 + 8 * fq;
#pragma unroll
        for (int ai = 0; ai < 2; ++ai)
#pragma unroll
            for (int m = 0; m < 4; ++m) { unsigned char* rowp = O + (size_t)(row0 + ai * HALF + m * 16) * ldc + col0;
                float o[8];
#pragma unroll
                for (int n = 0; n < 2; ++n)
#pragma unroll
                    for (int j = 0; j < 4; ++j) { const float g = acc[ai][0][m][n][j], up = acc[ai][1][m][n][j]; o[4 * n + j] = (g * __builtin_amdgcn_rcpf(1.0f + __expf(-g))) * up; }
                u32x2 w; w.x = pk4_fp8(o[0], o[1], o[2], o[3]); w.y = pk4_fp8(o[4], o[5], o[6], o[7]);
                *(u32x2*)rowp = w; }
    }
};
struct EpiScaleBf16 {
    static constexpr bool PERM = true;
    bf16_t* O; int ldc; const float* rs;
    __device__ __forceinline__ void operator()(const f32x4 (&acc)[2][2][4][2], const Unit& u, int wr, int wc, int fr, int fq) const {
        const int row0 = u.pm * BM + wr * 64 + fr; const int col0 = u.pn * BM + wc * 32 + 8 * fq;
#pragma unroll
        for (int ai = 0; ai < 2; ++ai)
#pragma unroll
            for (int m = 0; m < 4; ++m) { const int row = row0 + ai * HALF + m * 16; const float s = rs[row]; bf16_t* rowp = O + (size_t)row * ldc + col0;
#pragma unroll
                for (int bj = 0; bj < 2; ++bj) { const f32x4 v0 = acc[ai][bj][m][0] * s, v1 = acc[ai][bj][m][1] * s;
                    u32x4 w; w.x = pk2(v0[0], v0[1]); w.y = pk2(v0[2], v0[3]); w.z = pk2(v1[0], v1[1]); w.w = pk2(v1[2], v1[3]);
                    *(u32x4*)(rowp + bj * HALF) = w; } }
    }
};

typedef int i32x8 __attribute__((ext_vector_type(8)));
typedef int i32x4v __attribute__((ext_vector_type(4)));
template <class Epi, class Sched, bool GATHER = false, bool FP8 = false, bool ALIGN_EPI = true, bool SP2 = true>
__device__ __forceinline__ void gemm_phase(PG8_LAS unsigned char* lds, const Gemm g, const Sched& S, const Epi& E) {
    int tid_ = threadIdx.x; asm volatile("" : "+v"(tid_));
    const int tid = tid_, wid = __builtin_amdgcn_readfirstlane(tid >> 6), lane = tid & 63, wr = wid >> 2, wc = wid & 3, fr = lane & 15, fq = lane >> 4;
    int K_ = g.K; asm volatile("" : "+s"(K_));
    const int K = K_, nt = K / BK;
    unsigned voffA[2], voffB[2];
#pragma unroll
    for (int i = 0; i < 2; ++i) { int R, C; stage_rc(tid * 16 + i * 8192, R, C); const int Rb = Epi::PERM ? ((R & ~31) + perm32(R & 31)) : R;
        voffA[i] = (unsigned)(R * K + C) * 2u; voffB[i] = (unsigned)(Rb * K + C) * 2u; }
    const size_t kstep = (size_t)(BK * 2);
    const size_t hstep = (size_t)HALF * K * 2;
    const size_t tstep = 2 * hstep;
    const unsigned ldsw = (unsigned)wid * 1024u;
    const int aoff = lds_byte(wr * 64 + fr, fq * 8), boff = lds_byte(wc * 32 + fr, fq * 8);
#define PG8_SA(b, h) (((b) * 2 + (h)) * HTB)
#define PG8_SB(b, h) ((4 + (b) * 2 + (h)) * HTB)
#define PG8_STAGE(bufoff, gbase, voff) do { _Pragma("unroll") for (int _i = 0; _i < 2; ++_i) \
        __builtin_amdgcn_global_load_lds((const unsigned*)((const char*)(gbase) + (voff)[_i]), (PG8_LAS unsigned*)(lds + (bufoff) + ldsw + _i * 8192), 16, 0, 0); } while (0)
#define PG8_STAGE_G(bufoff, kbytes, o0, o1) do { \
        __builtin_amdgcn_global_load_lds((const unsigned*)((const char*)g.A + (kbytes) + (o0)), (PG8_LAS unsigned*)(lds + (bufoff) + ldsw), 16, 0, 0); \
        __builtin_amdgcn_global_load_lds((const unsigned*)((const char*)g.A + (kbytes) + (o1)), (PG8_LAS unsigned*)(lds + (bufoff) + ldsw + 8192), 16, 0, 0); } while (0)
#define PG8_LOADMAP(u, O) do { _Pragma("unroll") for (int _h = 0; _h < 2; ++_h) _Pragma("unroll") for (int _i = 0; _i < 2; ++_i) { int _R, _C; stage_rc(tid * 16 + _i * 8192, _R, _C); const int _rr = _h * HALF + _R; \
        int _t = (_rr < (u).nvalid) ? (u).amap[_rr] : 0; _t = ((unsigned)_t < 17408u) ? _t : 0; O[_h][_i] = (unsigned)(_t * K + _C) * 2u; } } while (0)
#define PG8_LD8(p) __builtin_shufflevector(*(const PG8_LAS i32x4v*)(p), *(const PG8_LAS i32x4v*)((p) + 1024), 0, 1, 2, 3, 4, 5, 6, 7)
#define PG8_LDA(dst, b, h) do { if constexpr (FP8) { _Pragma("unroll") for (int m = 0; m < 4; ++m) dst##8[m] = PG8_LD8(lds + PG8_SA(b, h) + aoff + m * 2048); } \
        else { _Pragma("unroll") for (int m = 0; m < 4; ++m) _Pragma("unroll") for (int k = 0; k < 2; ++k) dst[m][k] = *(const PG8_LAS bf16x8*)(lds + PG8_SA(b, h) + aoff + m * 2048 + k * 1024); } } while (0)
#define PG8_LDB(dst, b, h) do { if constexpr (FP8) { _Pragma("unroll") for (int n = 0; n < 2; ++n) dst##8[n] = PG8_LD8(lds + PG8_SB(b, h) + boff + n * 2048); } \
        else { _Pragma("unroll") for (int n = 0; n < 2; ++n) _Pragma("unroll") for (int k = 0; k < 2; ++k) dst[n][k] = *(const PG8_LAS bf16x8*)(lds + PG8_SB(b, h) + boff + n * 2048 + k * 1024); } } while (0)
#define PG8_MMA(ai, bj, At, Bt) do { __builtin_amdgcn_s_setprio(1); \
        if constexpr (FP8) { _Pragma("unroll") for (int m = 0; m < 4; ++m) _Pragma("unroll") for (int n = 0; n < 2; ++n) \
            asm volatile("v_mfma_scale_f32_16x16x128_f8f6f4 %0, %1, %2, %0, %3, %4 op_sel_hi:[0,0,0]" : "+v"(acc[ai][bj][m][n]) : "v"(Bt##8[n]), "v"(At##8[m]), "v"(sc_w), "v"(sc_x)); } \
        else { _Pragma("unroll") for (int m = 0; m < 4; ++m) _Pragma("unroll") for (int n = 0; n < 2; ++n) _Pragma("unroll") for (int k = 0; k < 2; ++k) \
            acc[ai][bj][m][n] = __builtin_amdgcn_mfma_f32_16x16x32_bf16(Bt[n][k], At[m][k], acc[ai][bj][m][n], 0, 0, 0); } \
        __builtin_amdgcn_s_setprio(0); } while (0)
#define PG8_WAIT_V(n) asm volatile("s_waitcnt vmcnt(" #n ")" ::: "memory")
#define PG8_WAIT_L(n) asm volatile("s_waitcnt lgkmcnt(" #n ")" ::: "memory")
#define PG8_BAR __builtin_amdgcn_s_barrier()
#define PG8_SCHED __builtin_amdgcn_sched_barrier(0)
    Unit cur, nxt; int ui = 0;
    if (!S.next(0, cur)) return;
    f32x4 acc[2][2][4][2];
#pragma unroll
    for (int a = 0; a < 2; ++a)
#pragma unroll
        for (int b = 0; b < 2; ++b)
#pragma unroll
            for (int m = 0; m < 4; ++m)
#pragma unroll
                for (int n = 0; n < 2; ++n) acc[a][b][m][n] = (f32x4){0.f, 0.f, 0.f, 0.f};
    bf16x8 At[4][2], B0[2][2], B1[2][2]; i32x8 At8[4], B08[2], B18[2];
    const int sc_w = 0x79797979, sc_x = 0x7f7f7f7f;
    const char* cA = (const char*)g.A + (size_t)cur.pm * tstep; const char* cB = (const char*)g.Bt + (size_t)cur.pb * tstep;
    unsigned cO[2][2] = {{0u, 0u}, {0u, 0u}}, nO[2][2] = {{0u, 0u}, {0u, 0u}};
    S.a_ready(cur);
    if constexpr (GATHER) { static_assert(SP2, "GATHER needs the SP2 loop"); PG8_LOADMAP(cur, cO); }
    if constexpr (SP2) {
        PG8_STAGE(PG8_SB(0, 0), cB, voffB); PG8_STAGE(PG8_SB(0, 1), cB + hstep, voffB);
        if constexpr (GATHER) { PG8_STAGE_G(PG8_SA(0, 0), 0, cO[0][0], cO[0][1]); PG8_STAGE_G(PG8_SA(0, 1), 0, cO[1][0], cO[1][1]); }
        else { PG8_STAGE(PG8_SA(0, 0), cA, voffA); PG8_STAGE(PG8_SA(0, 1), cA + hstep, voffA); }
        if (wr == 1) PG8_BAR;
        PG8_WAIT_V(2); PG8_BAR;
        PG8_STAGE(PG8_SB(1, 0), cB + kstep, voffB);
        if constexpr (GATHER) PG8_STAGE_G(PG8_SA(1, 0), kstep, cO[0][0], cO[0][1]); else PG8_STAGE(PG8_SA(1, 0), cA + kstep, voffA);
        PG8_STAGE(PG8_SB(1, 1), cB + hstep + kstep, voffB);
        PG8_WAIT_V(6); PG8_BAR;
    } else {
        PG8_STAGE(PG8_SB(0, 0), cB, voffB); PG8_STAGE(PG8_SA(0, 0), cA, voffA); PG8_STAGE(PG8_SB(0, 1), cB + hstep, voffB); PG8_STAGE(PG8_SA(0, 1), cA + hstep, voffA);
        if (wr == 1) PG8_BAR;
        PG8_WAIT_V(4); PG8_BAR;
        PG8_STAGE(PG8_SB(1, 0), cB + kstep, voffB); PG8_STAGE(PG8_SA(1, 0), cA + kstep, voffA); PG8_STAGE(PG8_SB(1, 1), cB + hstep + kstep, voffB);
        PG8_WAIT_V(6); PG8_BAR;
    }
    for (;;) {
        const bool has_next = S.next(ui + 1, nxt);
        const char* nA = has_next ? (const char*)g.A + (size_t)nxt.pm * tstep : cA; const char* nB = has_next ? (const char*)g.Bt + (size_t)nxt.pb * tstep : cB;
        if constexpr (GATHER) { if (has_next) PG8_LOADMAP(nxt, nO); else {
#pragma unroll
            for (int _h = 0; _h < 2; ++_h) { nO[_h][0] = cO[_h][0]; nO[_h][1] = cO[_h][1]; } } }
#pragma unroll 1
        for (int t = 0; t < nt; t += 2) {
            const bool last = (t == nt - 2);
            const char* a1 = cA + (size_t)(t + 1) * kstep;
            const char* a2 = last ? nA : cA + (size_t)(t + 2) * kstep; const char* b2 = last ? nB : cB + (size_t)(t + 2) * kstep;
            const char* a3 = a2 + kstep; const char* b3 = b2 + kstep;
            if (last && has_next) S.a_ready(nxt);
            if constexpr (SP2) {
            const size_t k1 = (size_t)(t + 1) * kstep, k2 = last ? (size_t)0 : (size_t)(t + 2) * kstep, k3 = k2 + kstep;
            const unsigned g00 = last ? nO[0][0] : cO[0][0], g01 = last ? nO[0][1] : cO[0][1], g10 = last ? nO[1][0] : cO[1][0], g11 = last ? nO[1][1] : cO[1][1];
            PG8_LDB(B0, 0, 0); PG8_LDB(B1, 0, 1); PG8_SCHED; PG8_LDA(At, 0, 0);
            if constexpr (GATHER) PG8_STAGE_G(PG8_SA(1, 1), k1, cO[1][0], cO[1][1]); else PG8_STAGE(PG8_SA(1, 1), a1 + hstep, voffA);
            PG8_WAIT_V(8); PG8_WAIT_L(0); PG8_BAR; PG8_MMA(0, 0, At, B0); PG8_MMA(0, 1, At, B1); PG8_BAR; PG8_SCHED;
            PG8_LDA(At, 0, 1); PG8_STAGE(PG8_SB(0, 0), b2, voffB); PG8_STAGE(PG8_SB(0, 1), b2 + hstep, voffB);
            if constexpr (GATHER) PG8_STAGE_G(PG8_SA(0, 0), k2, g00, g01); else PG8_STAGE(PG8_SA(0, 0), a2, voffA);
            PG8_WAIT_V(8); PG8_WAIT_L(0); PG8_BAR; PG8_MMA(1, 0, At, B0); PG8_MMA(1, 1, At, B1); PG8_BAR; PG8_SCHED;
            PG8_LDB(B0, 1, 0); PG8_LDB(B1, 1, 1); PG8_SCHED; PG8_LDA(At, 1, 0);
            if constexpr (GATHER) PG8_STAGE_G(PG8_SA(0, 1), k2, g10, g11); else PG8_STAGE(PG8_SA(0, 1), a2 + hstep, voffA);
            PG8_WAIT_V(8); PG8_WAIT_L(0); PG8_BAR; PG8_MMA(0, 0, At, B0); PG8_MMA(0, 1, At, B1); PG8_BAR; PG8_SCHED;
            PG8_LDA(At, 1, 1); PG8_STAGE(PG8_SB(1, 0), b3, voffB); PG8_STAGE(PG8_SB(1, 1), b3 + hstep, voffB);
            if constexpr (GATHER) PG8_STAGE_G(PG8_SA(1, 0), k3, g00, g01); else PG8_STAGE(PG8_SA(1, 0), a3, voffA);
            PG8_WAIT_V(8); PG8_WAIT_L(0); PG8_BAR; PG8_MMA(1, 0, At, B0); PG8_MMA(1, 1, At, B1); PG8_BAR; PG8_SCHED;
            } else {
            PG8_LDB(B0, 0, 0); PG8_SCHED; PG8_LDA(At, 0, 0); PG8_STAGE(PG8_SA(1, 1), a1 + hstep, voffA);
            PG8_WAIT_L(8); PG8_BAR; PG8_WAIT_L(0); PG8_MMA(0, 0, At, B0); PG8_BAR; PG8_SCHED;
            PG8_LDB(B1, 0, 1); PG8_STAGE(PG8_SB(0, 0), b2, voffB);
            PG8_BAR; PG8_WAIT_L(0); PG8_MMA(0, 1, At, B1); PG8_BAR;
            PG8_LDA(At, 0, 1); PG8_STAGE(PG8_SA(0, 0), a2, voffA);
            PG8_BAR; PG8_WAIT_L(0); PG8_MMA(1, 0, At, B0); PG8_BAR; PG8_SCHED;
            PG8_STAGE(PG8_SB(0, 1), b2 + hstep, voffB);
            PG8_WAIT_V(6); PG8_BAR; PG8_MMA(1, 1, At, B1); PG8_BAR;
            PG8_LDB(B0, 1, 0); PG8_SCHED; PG8_LDA(At, 1, 0); PG8_STAGE(PG8_SA(0, 1), a2 + hstep, voffA);
            PG8_WAIT_L(8); PG8_BAR; PG8_WAIT_L(0); PG8_MMA(0, 0, At, B0); PG8_BAR; PG8_SCHED;
            PG8_LDB(B1, 1, 1); PG8_STAGE(PG8_SB(1, 0), b3, voffB);
            PG8_BAR; PG8_WAIT_L(0); PG8_MMA(0, 1, At, B1); PG8_BAR;
            PG8_LDA(At, 1, 1); PG8_STAGE(PG8_SA(1, 0), a3, voffA);
            PG8_BAR; PG8_WAIT_L(0); PG8_MMA(1, 0, At, B0); PG8_BAR; PG8_SCHED;
            PG8_STAGE(PG8_SB(1, 1), b3 + hstep, voffB);
            PG8_WAIT_V(6); PG8_BAR; PG8_MMA(1, 1, At, B1); PG8_BAR;
            }
        }
        if constexpr (ALIGN_EPI) { if (wr == 0) PG8_BAR; }
        if constexpr (FP8) asm volatile("s_nop 15\n\ts_nop 15" ::: "memory");
        E(acc, cur, wr, wc, fr, fq); S.done(cur);
        if (!has_next) break;
#pragma unroll
        for (int a = 0; a < 2; ++a)
#pragma unroll
            for (int b = 0; b < 2; ++b)
#pragma unroll
                for (int m = 0; m < 4; ++m)
#pragma unroll
                    for (int n = 0; n < 2; ++n) acc[a][b][m][n] = (f32x4){0.f, 0.f, 0.f, 0.f};
        cur = nxt; cA = nA; cB = nB; ++ui;
        if constexpr (GATHER) {
#pragma unroll
            for (int _h = 0; _h < 2; ++_h) { cO[_h][0] = nO[_h][0]; cO[_h][1] = nO[_h][1]; } }
        if constexpr (ALIGN_EPI) { if (wr == 1) PG8_BAR; }
    }
    PG8_WAIT_V(0);
    if constexpr (!ALIGN_EPI) { if (wr == 0) PG8_BAR; }
    PG8_BAR;
#undef PG8_SA
#undef PG8_SB
#undef PG8_STAGE
#undef PG8_STAGE_G
#undef PG8_LOADMAP
#undef PG8_LDA
#undef PG8_LDB
#undef PG8_MMA
#undef PG8_LD8
#undef PG8_WAIT_V
#undef PG8_WAIT_L
#undef PG8_BAR
#undef PG8_SCHED
}
}

#define XB_TMO      128
#define XB_XCNT(j)  (256  + 64 * (j))
#define XB_XSUB(j)  (1280 + 64 * (j))
#define XB_XGEN(j)  (2304 + 64 * (j))
#define XB_TOP      3328
#define XB_TOPGEN   3392
#define XCD_BAR_WORDS 3456
#define XB_SPIN_CAP (1u << 18)
__device__ __forceinline__ unsigned xb_ld(unsigned* p)              { return __hip_atomic_load(p, __ATOMIC_RELAXED, __HIP_MEMORY_SCOPE_AGENT); }
__device__ __forceinline__ unsigned xb_add(unsigned* p, unsigned v) { return __hip_atomic_fetch_add(p, v, __ATOMIC_RELAXED, __HIP_MEMORY_SCOPE_AGENT); }
__device__ __forceinline__ unsigned xb_xcc_id() { return (unsigned)__builtin_amdgcn_s_getreg((3 << 11) | 20) & 0xFu; }
#define XB_SPIN(cond, bar) do { unsigned _sp = 0; while (cond) { __builtin_amdgcn_s_sleep(1); \
    if ((++_sp & 255u) == 0u) { if (xb_ld(&(bar)[XB_TMO])) break; if (_sp > XB_SPIN_CAP) { atomicAdd(&(bar)[XB_TMO], 1u); break; } } } } while (0)
struct XcdBarrier { unsigned* bar; unsigned x; volatile LAS unsigned* st; };
__device__ __forceinline__ XcdBarrier xcd_barrier_post(unsigned* bar, volatile LAS unsigned* st) {
    XcdBarrier b; b.bar = bar; b.x = xb_xcc_id(); b.st = st;
    if (threadIdx.x == 0) (void)xb_add(&bar[XB_XCNT(b.x)], 1u);
    return b;
}
__device__ __forceinline__ void xcd_barrier_complete(unsigned* bar, unsigned x, unsigned& nloc, unsigned& nx) {
    const unsigned G = gridDim.x * gridDim.y * gridDim.z;
    unsigned sum, cnt, mine, sp = 0u;
    for (;;) {
        sum = 0u; cnt = 0u; mine = 0u;
#pragma unroll
        for (unsigned j = 0; j < 16; ++j) { const unsigned c = xb_ld(&bar[XB_XCNT(j)]); sum += c; cnt += (c > 0u) ? 1u : 0u; mine = (j == x) ? c : mine; }
        if (sum == G) break;
        __builtin_amdgcn_s_sleep(1);
        if ((++sp & 255u) == 0u) { if (xb_ld(&bar[XB_TMO])) break; if (sp > XB_SPIN_CAP) { atomicAdd(&bar[XB_TMO], 1u); break; } }
    }
    nloc = mine > 0u ? mine : 1u; nx = cnt > 0u ? cnt : 1u;
}
__device__ __forceinline__ void xcd_barrier(const XcdBarrier& b) {
    asm volatile("s_waitcnt vmcnt(0)" ::: "memory");
    __syncthreads();
    if (threadIdx.x == 0) {
        unsigned* bar = b.bar;
        __builtin_amdgcn_s_waitcnt(0);
        unsigned nloc = b.st[0], nx = b.st[1];
        if (nloc == 0u) { xcd_barrier_complete(bar, b.x, nloc, nx); b.st[0] = nloc; b.st[1] = nx; }
        const unsigned old = xb_add(&bar[XB_XSUB(b.x)], 1u);
        const unsigned gen = old / nloc;
        if (old + 1u == (gen + 1u) * nloc) {
            __builtin_amdgcn_fence(__ATOMIC_RELEASE, "agent");
            asm volatile("s_waitcnt vmcnt(0)" ::: "memory");
            const unsigned og = xb_add(&bar[XB_TOP], 1u);
            const unsigned tg = og / nx;
            if (og + 1u == (tg + 1u) * nx) xb_add(&bar[XB_TOPGEN], 1u);
            else XB_SPIN(xb_ld(&bar[XB_TOPGEN]) == tg, bar);
            __builtin_amdgcn_fence(__ATOMIC_ACQUIRE, "agent");
            xb_add(&bar[XB_XGEN(b.x)], 1u);
            asm volatile("s_waitcnt vmcnt(0)" ::: "memory");
        } else {
            XB_SPIN(xb_ld(&bar[XB_XGEN(b.x)]) == gen, bar);
            __builtin_amdgcn_fence(__ATOMIC_ACQUIRE, "agent");
            asm volatile("s_waitcnt vmcnt(0)" ::: "memory");
        }
    }
    __syncthreads();
}

struct Args { const float* in[35]; float* out; unsigned char* ws; int ph_lo, ph_hi; };
enum { I_X = 0, I_C, I_CTX, I_CCTX, I_WADA, I_BADA, I_WIN, I_WOUT, I_MNG, I_POOLW, I_POOLS, I_SINK, I_HCW, I_HCB, I_HW1, I_HB1, I_HF1, I_HW2, I_HB2, I_HF2, I_HW3, I_HSKIP,
       I_GLG, I_GLB, I_GWS, I_GBS, I_LN1G, I_LN1B, I_LN2G, I_LN2B, I_WR, I_RB, I_WG, I_WU, I_WD };
struct Ctx {
    LAS unsigned char* lds; int tid, lane, wave, bid, G;
    const float GAS* const __attribute__((address_space(4)))* in; float GAS* out; unsigned char GAS* ws;
};
#define WSP(T, off) ((T*)(T GAS*)(C.ws + (off)))
#define INP(k) ((const float*)C.in[k])
#define FRESH(D, S) Ctx D = S; asm volatile("" : "+v"(D.tid)); D.lane = D.tid & 63; D.wave = __builtin_amdgcn_readfirstlane(D.tid >> 6); asm volatile("" : "+s"(D.bid), "+s"(D.G), "+s"(D.in), "+s"(D.ws), "+s"(D.out))

struct TrBlk { const float GAS* src; unsigned char GAS* dst; int N, K, nb, which; bool gu; };
constexpr int TRP = 144, TRBUF = 256 * TRP;
#define WG_BAR() do { LDS_WAIT(); __builtin_amdgcn_s_barrier(); asm volatile("" ::: "memory"); } while (0)
constexpr int NBL = 4976, NBP = 368;
__device__ __forceinline__ TrBlk tr_decode(Ctx& C, int L, int j) {
    const bool c0 = j < 240, c1 = !c0 && j < NBP, ce = !c0 && !c1;
    const int q = j - (c0 ? 0 : (c1 ? 240 : NBP));
    const int e = ce ? q / 144 : 0, r = ce ? q % 144 : q;
    const int which = ce ? r / 48 : 0, r2 = ce ? r % 48 : r;
    const bool gu = ce && which < 2, dn = ce && which == 2;
    const int NB = c0 ? 15 : (gu ? 3 : 8), nb = r2 % NB, kb = r2 / NB;
    const int N = c0 ? INW : (gu ? DE : DM), K = dn ? DE : DM;
    const int mat = ce ? L * NE + e : L;
    const float GAS* base = c0 ? C.in[I_WIN] : (c1 ? C.in[I_WOUT] : (which == 0 ? C.in[I_WG] : (which == 1 ? C.in[I_WU] : C.in[I_WD])));
    const size_t wsoff = c0 ? WS_WIN : (c1 ? WS_WOUT : (gu ? WS_WGU : WS_WD));
    const int nrows = c0 ? INW : (gu ? 1536 : DM);
    TrBlk t; t.N = N; t.K = K; t.nb = nb; t.which = which; t.gu = gu;
    t.src = base + (size_t)mat * K * N + (size_t)(128 * kb) * N + 256 * nb;
    t.dst = C.ws + wsoff + (size_t)mat * nrows * K + 128 * kb;
    return t;
}
__device__ __forceinline__ void tr_load(const TrBlk& t, int wave, int lane, f32x4 (&v)[16]) {
#pragma unroll
    for (int i = 0; i < 16; ++i) v[i] = __builtin_nontemporal_load((const f32x4 GAS*)((const char GAS*)t.src + (size_t)(16 * wave + i) * t.N * 4 + 16u * lane));
}
__device__ __forceinline__ void tr_pack(LAS unsigned char* buf, int wave, int lane, const f32x4 (&v)[16]) {
#pragma unroll
    for (int j = 0; j < 4; ++j) { u32x4 o;
#pragma unroll
        for (int w = 0; w < 4; ++w) o[w] = pk4_fp8(64.f * v[4 * w][j], 64.f * v[4 * w + 1][j], 64.f * v[4 * w + 2][j], 64.f * v[4 * w + 3][j]);
        *(LAS u32x4*)(buf + (4 * lane + j) * TRP + 16 * wave) = o; }
}
__device__ __forceinline__ void tr_flush(const TrBlk& t, const LAS unsigned char* buf, int wave, int lane) {
#pragma unroll
    for (int tt = 0; tt < 4; ++tt) { const int nl = 32 * wave + 8 * tt + (lane >> 3), n = 256 * t.nb + nl;
        const u32x4 o = *(const LAS u32x4*)(buf + nl * TRP + 16 * (lane & 7));
        const int drow = t.gu ? ((n >> 7) * 256 + (n & 127) + 128 * t.which) : n;
        __builtin_nontemporal_store(o, (u32x4 GAS*)(t.dst + (size_t)drow * t.K + 16 * (lane & 7))); }
}
template <int NBK> __device__ __forceinline__ void tr_blocks(Ctx& C, int L, int b0) {
    f32x4 r0[16], r1[16], r2[16];
    LAS unsigned char* buf0 = C.lds; LAS unsigned char* buf1 = C.lds + TRBUF;
    const TrBlk t0 = tr_decode(C, L, b0), t1 = tr_decode(C, L, b0 + (NBK > 1 ? 1 : 0)), t2 = tr_decode(C, L, b0 + (NBK > 2 ? 2 : 0)), t3 = tr_decode(C, L, b0 + (NBK > 3 ? 3 : 0));
    tr_load(t0, C.wave, C.lane, r0); if (NBK > 1) tr_load(t1, C.wave, C.lane, r1); if (NBK > 2) tr_load(t2, C.wave, C.lane, r2);
    WG_BAR();
    tr_pack(buf0, C.wave, C.lane, r0);
    if (NBK > 3) tr_load(t3, C.wave, C.lane, r0);
    WG_BAR(); tr_flush(t0, buf0, C.wave, C.lane);
    if (NBK > 1) { tr_pack(buf1, C.wave, C.lane, r1); WG_BAR(); tr_flush(t1, buf1, C.wave, C.lane); }
    if (NBK > 2) { tr_pack(buf0, C.wave, C.lane, r2); WG_BAR(); tr_flush(t2, buf0, C.wave, C.lane); }
    if (NBK > 3) { tr_pack(buf1, C.wave, C.lane, r0); WG_BAR(); tr_flush(t3, buf1, C.wave, C.lane); }
}
__device__ __forceinline__ void p0_convert(Ctx& C, int L, int nblocks) {
#pragma unroll 1
    for (int j = C.bid; j < nblocks; j += C.G) tr_blocks<1>(C, L, j);
    __syncthreads();
}
#ifndef UB
#define UB 2
#endif
constexpr int NCU = NBL / UB;
#ifndef TAILQ
#define TAILQ (224 * 4 / UB)
#endif
#ifndef CONV_SPLIT
#define CONV_SPLIT 0
#endif
__device__ __forceinline__ void conv_unit(Ctx& C, int L, int b0) { tr_blocks<UB>(C, L, b0); }
constexpr int NCU_E = (NBL - NBP) / UB, NCU_P = NBP / UB;
__device__ __forceinline__ void bg_conv_unit(Ctx& C, int l, int cu) {
    const bool e = cu < NCU_E; conv_unit(C, e ? l : 1, e ? NBP + cu * UB : (cu - NCU_E) * UB);
}
__device__ __forceinline__ void p0_adaln(Ctx& C) {
    LAS float* sc = (LAS float*)C.lds;
    LAS float* red = (LAS float*)(C.lds + 40960);
    float* MOD = WSP(float, WS_MOD);
    for (int u = C.bid; u < 256; u += C.G) {
        const int l = u >> 7, colbase = (u & 127) * 96;
        __syncthreads();
        for (int i = C.tid; i < 5 * DM; i += 512) { const int r = i >> 11, k = i & 2047; const float v = r < 4 ? INP(I_C)[r * DM + k] : INP(I_CCTX)[k]; sc[i] = silu_f(v); }
        __syncthreads();
        float acc[5][2];
#pragma unroll
        for (int r = 0; r < 5; ++r) { acc[r][0] = 0.f; acc[r][1] = 0.f; }
        const int ln = C.lane < 48 ? C.lane : 47;
        const float* wp = INP(I_WADA) + ((size_t)l * DM + C.wave * 256) * 12288 + colbase + 2 * ln;
#pragma unroll 1
        for (int k0 = 0; k0 < 256; k0 += 16) { f32x2 wv[16];
#pragma unroll
            for (int k = 0; k < 16; ++k) wv[k] = *(const f32x2*)(wp + (size_t)(k0 + k) * 12288);
#pragma unroll
            for (int k = 0; k < 16; ++k)
#pragma unroll
                for (int r = 0; r < 5; ++r) { const float s = sc[r * DM + C.wave * 256 + k0 + k]; acc[r][0] += s * wv[k].x; acc[r][1] += s * wv[k].y; } }
        if (C.lane < 48) {
#pragma unroll
            for (int r = 0; r < 5; ++r) { red[(C.wave * 5 + r) * 96 + 2 * C.lane] = acc[r][0]; red[(C.wave * 5 + r) * 96 + 2 * C.lane + 1] = acc[r][1]; } }
        __syncthreads();
        for (int i = C.tid; i < 480; i += 512) { const int r = i / 96, cc = i % 96; float s = INP(I_BADA)[l * 12288 + colbase + cc];
#pragma unroll
            for (int w = 0; w < 8; ++w) s += red[(w * 5 + r) * 96 + cc];
            MOD[(size_t)(l * 5 + r) * 12288 + colbase + cc] = s; }
    }
    __syncthreads();
}
__device__ __forceinline__ void p0_filter_unit(Ctx& C, int u) {
    LAS float* feat = (LAS float*)C.lds;
    LAS float* h1 = (LAS float*)(C.lds + 4096);
    LAS float* h2 = (LAS float*)(C.lds + 8192);
    {
        int l, L, tb; bf16* dst;
        if (u < 512) { l = u >> 8; tb = u & 255; L = SL; dst = WSP(bf16, WS_FILT) + (size_t)l * 2 * 512 * 8192; }
        else { l = 0; tb = u - 512; L = CL; dst = WSP(bf16, WS_FILTC); }
        const float invLm1 = 1.0f / (float)(L - 1);
        __syncthreads();
        LAS float* w1s = (LAS float*)(C.lds + 12288);
        LAS float* w2s = (LAS float*)(C.lds + 12288 + 33 * 64 * 4);
        for (int i = C.tid; i < 33 * 64; i += 512) w1s[i] = INP(I_HW1)[l * 33 * 64 + i];
        for (int i = C.tid; i < 64 * 64; i += 512) w2s[i] = INP(I_HW2)[l * 64 * 64 + i];
        for (int i = C.tid; i < 16 * 33; i += 512) { const int p = i / 33, j = i % 33; const int t = 16 * tb + p; float v;
            if (j == 0) v = (float)t * invLm1;
            else { const int fi = (j - 1) & 15; const float fr = 1e-4f + (float)fi * ((15.0f - 1e-4f) / 15.0f); const float ang = (6.283185307179586f / (float)L) * (float)t * fr; v = (j <= 16) ? cosf(ang) : -sinf(ang); }
            feat[i] = v; }
        __syncthreads();
        for (int i = C.tid; i < 1024; i += 512) { const int p = i >> 6, hh = i & 63; float s = INP(I_HB1)[l * 64 + hh];
#pragma unroll
            for (int j = 0; j < 33; ++j) s += feat[p * 33 + j] * w1s[j * 64 + hh];
            h1[i] = sinf(INP(I_HF1)[l * 64 + hh] * s); }
        __syncthreads();
        for (int i = C.tid; i < 1024; i += 512) { const int p = i >> 6, hh = i & 63; float s = INP(I_HB2)[l * 64 + hh];
#pragma unroll 16
            for (int j = 0; j < 64; ++j) s += h1[p * 64 + j] * w2s[j * 64 + hh];
            h2[i] = sinf(INP(I_HF2)[l * 64 + hh] * s); }
        __syncthreads();
        float acc[16][4];
#pragma unroll
        for (int p = 0; p < 16; ++p) { acc[p][0] = 0.f; acc[p][1] = 0.f; acc[p][2] = 0.f; acc[p][3] = 0.f; }
#pragma unroll 4
        for (int k = 0; k < 64; ++k) { const f32x4 w = *(const f32x4*)(INP(I_HW3) + (size_t)(l * 64 + k) * 2048 + 4 * C.tid);
#pragma unroll
            for (int p = 0; p < 16; ++p) { const float h = h2[p * 64 + k]; acc[p][0] += h * w[0]; acc[p][1] += h * w[1]; acc[p][2] += h * w[2]; acc[p][3] += h * w[3]; } }
#pragma unroll
        for (int j = 0; j < 4; ++j) { const int col = 4 * C.tid + j, o = col >> 10, dir = (col >> 9) & 1, c = col & 511;
            const float delta = 4.605170186f * (1.0f / 1.5f + (float)c * ((1.0f / 0.3f - 1.0f / 1.5f) / 511.0f));
            bf16* d = dst + (size_t)(o * 512 + c) * (2 * L);
            float val[16];
#pragma unroll
            for (int p = 0; p < 16; ++p) { const int t = 16 * tb + p; val[p] = acc[p][j] * __expf(-(float)t * invLm1 * delta); }
            if (dir == 0) {
                u32x4 w0, w1; w0.x = pk2(val[15], val[14]); w0.y = pk2(val[13], val[12]); w0.z = pk2(val[11], val[10]); w0.w = pk2(val[9], val[8]);
                w1.x = pk2(val[7], val[6]); w1.y = pk2(val[5], val[4]); w1.z = pk2(val[3], val[2]); w1.w = pk2(val[1], val[0]);
                u32x4* q = (u32x4*)(d + L - 16 * (tb + 1)); q[0] = w0; q[1] = w1;
            } else if (tb == 0) {
#pragma unroll
                for (int p = 1; p < 16; ++p) d[L - 1 + p] = (bf16)(pk2(val[p], 0.f) & 0xffffu);
            } else {
                typedef u32x4 __attribute__((aligned(2))) u32x4_u;
                u32x4 w0, w1; w0.x = pk2(val[0], val[1]); w0.y = pk2(val[2], val[3]); w0.z = pk2(val[4], val[5]); w0.w = pk2(val[6], val[7]);
                w1.x = pk2(val[8], val[9]); w1.y = pk2(val[10], val[11]); w1.z = pk2(val[12], val[13]); w1.w = pk2(val[14], val[15]);
                u32x4_u* q = (u32x4_u*)(d + L - 1 + 16 * tb); q[0] = w0; q[1] = w1;
            }
            if (dir == 1 && 16 * (tb + 1) == L) d[2 * L - 1] = 0; }
    }
}
__device__ __forceinline__ void p0_filters(Ctx& C) {
    for (int u2 = C.bid; u2 < 512; u2 += C.G) p0_filter_unit(C, 2 * (u2 % 256) + (u2 / 256));
    __syncthreads();
}
__device__ __forceinline__ void p0_rope(Ctx& C) {
    { const int idx = C.bid * 512 + C.tid;
      for (int e = idx; e < 131072; e += C.G * 512) { const f32x2 v = *(const f32x2*)(INP(I_GWS) + 2 * (size_t)e); WSP(unsigned, WS_GWSB)[e] = pk2(v.x, v.y); } }
    { const int idx = C.bid * 512 + C.tid;
      for (int e = idx; e < 131072; e += C.G * 512) { const int i = e & 127, j = (e >> 7) & 127, lg = e >> 14, l = lg >> 2, gi = lg & 3;
          const float v = INP(I_POOLW)[(size_t)lg * 16384 + i * 128 + j] * INP(I_POOLS)[l * 512 + 128 * gi + j];
          WSP(bf16, WS_POOLWT)[e] = (bf16)(pk2(v, 0.f) & 0xffffu); } }
    if (C.bid == (C.G > 200 ? 200 : 0)) { f32x2* R = WSP(f32x2, WS_ROPE);
        for (int i = C.tid; i < 1024; i += 512) { const int pos = i >> 4, fi = i & 15; const float inv = powf(10000.0f, -(float)fi / 16.0f); const float a = (float)pos * inv; R[i] = (f32x2){cosf(a), sinf(a)}; } }
}

__device__ __forceinline__ const float* src_x0(Ctx& C, int row) {
    return row < NLAT ? INP(I_X) + (size_t)row * DM : INP(I_CTX) + (size_t)(row - NLAT) * DM;
}
__device__ __forceinline__ void row_load(const float* p, int lane, float (&v)[32]) {
#pragma unroll
    for (int j = 0; j < 4; ++j) { const f32x4 a = *(const f32x4*)(p + 512 * j + 8 * lane), b = *(const f32x4*)(p + 512 * j + 8 * lane + 4);
        v[8 * j] = a[0]; v[8 * j + 1] = a[1]; v[8 * j + 2] = a[2]; v[8 * j + 3] = a[3]; v[8 * j + 4] = b[0]; v[8 * j + 5] = b[1]; v[8 * j + 6] = b[2]; v[8 * j + 7] = b[3]; }
}
__device__ __forceinline__ void row_load_bf16(const bf16* p, int lane, float (&v)[32]) {
#pragma unroll
    for (int j = 0; j < 4; ++j) { const u32x4 r = *(const u32x4*)(p + 512 * j + 8 * lane);
        v[8 * j] = __uint_as_float(r.x << 16); v[8 * j + 1] = __uint_as_float(r.x & 0xffff0000u); v[8 * j + 2] = __uint_as_float(r.y << 16); v[8 * j + 3] = __uint_as_float(r.y & 0xffff0000u);
        v[8 * j + 4] = __uint_as_float(r.z << 16); v[8 * j + 5] = __uint_as_float(r.z & 0xffff0000u); v[8 * j + 6] = __uint_as_float(r.w << 16); v[8 * j + 7] = __uint_as_float(r.w & 0xffff0000u); }
}
__device__ __forceinline__ void row_store(float* p, int lane, const float (&v)[32]) {
#pragma unroll
    for (int j = 0; j < 4; ++j) { *(f32x4*)(p + 512 * j + 8 * lane) = (f32x4){v[8 * j], v[8 * j + 1], v[8 * j + 2], v[8 * j + 3]}; *(f32x4*)(p + 512 * j + 8 * lane + 4) = (f32x4){v[8 * j + 4], v[8 * j + 5], v[8 * j + 6], v[8 * j + 7]}; }
}
__device__ __forceinline__ void row_store_bf16(bf16* p, int lane, const float (&v)[32]) {
#pragma unroll
    for (int j = 0; j < 4; ++j) { u32x4 w; w.x = pk2(v[8 * j], v[8 * j + 1]); w.y = pk2(v[8 * j + 2], v[8 * j + 3]); w.z = pk2(v[8 * j + 4], v[8 * j + 5]); w.w = pk2(v[8 * j + 6], v[8 * j + 7]); *(u32x4*)(p + 512 * j + 8 * lane) = w; }
}
__device__ __forceinline__ void row_store_fp8(unsigned char* p, int lane, const float (&v)[32]) {
#pragma unroll
    for (int j = 0; j < 4; ++j) { u32x2 w; w.x = pk4_fp8(v[8 * j], v[8 * j + 1], v[8 * j + 2], v[8 * j + 3]); w.y = pk4_fp8(v[8 * j + 4], v[8 * j + 5], v[8 * j + 6], v[8 * j + 7]); *(u32x2*)(p + 512 * j + 8 * lane) = w; }
}
__device__ __forceinline__ void row_ln(float (&v)[32]) {
    float s = 0.f;
#pragma unroll
    for (int i = 0; i < 32; ++i) s += v[i];
    const float mean = wave_sum(s) * (1.0f / DM); float q = 0.f;
#pragma unroll
    for (int i = 0; i < 32; ++i) { v[i] -= mean; q += v[i] * v[i]; }
    const float rstd = 1.0f / sqrtf(wave_sum(q) * (1.0f / DM) + LN_EPS);
#pragma unroll
    for (int i = 0; i < 32; ++i) v[i] *= rstd;
}
__device__ __forceinline__ void row_affine(float (&v)[32], const float* mul, const float* add, int lane, float mul_off) {
    float a[32], b[32]; row_load(mul, lane, a); row_load(add, lane, b);
#pragma unroll
    for (int i = 0; i < 32; ++i) v[i] = v[i] * (a[i] + mul_off) + b[i];
}
__device__ __forceinline__ void row_load_lds(const LAS float* p, int lane, float (&v)[32]) {
#pragma unroll
    for (int j = 0; j < 4; ++j) { const f32x4 a = *(const LAS f32x4*)(p + 512 * j + 8 * lane), b = *(const LAS f32x4*)(p + 512 * j + 8 * lane + 4);
        v[8 * j] = a[0]; v[8 * j + 1] = a[1]; v[8 * j + 2] = a[2]; v[8 * j + 3] = a[3]; v[8 * j + 4] = b[0]; v[8 * j + 5] = b[1]; v[8 * j + 6] = b[2]; v[8 * j + 7] = b[3]; }
}
__device__ __forceinline__ void row_affine_lds(float (&v)[32], const LAS float* mul, const LAS float* add, int lane, float mul_off) {
    float a[32], b[32]; row_load_lds(mul, lane, a); row_load_lds(add, lane, b);
#pragma unroll
    for (int i = 0; i < 32; ++i) v[i] = v[i] * (a[i] + mul_off) + b[i];
}
__device__ __forceinline__ void stage2048(Ctx& C, LAS float* dst, const float* src) { *(LAS f32x4*)(dst + 4 * C.tid) = *(const f32x4*)(src + 4 * C.tid); }
__device__ __forceinline__ void ph_ln_mod(Ctx& C, int l, int nrows) {
    LAS float* PAR = (LAS float*)C.lds;
    const int r0 = (int)(((long)C.bid * nrows) / C.G), r1 = (int)(((long)(C.bid + 1) * nrows) / C.G);
    int cur_mrow = -1;
    for (int rb = r0 & ~7; rb < r1; rb += 8) {
        const int mrow = rb < NLAT ? rb / SL : 4; const float* mod = WSP(float, WS_MOD) + (size_t)(l * 5 + mrow) * 12288;
        if (mrow != cur_mrow) { __syncthreads(); stage2048(C, PAR, mod + 2048); stage2048(C, PAR + 2048, mod); cur_mrow = mrow; __syncthreads(); }
        const int row = rb + C.wave;
        if (row >= r0 && row < r1) {
            float v[32]; row_load(src_x0(C, row), C.lane, v); row_ln(v); row_affine_lds(v, PAR, PAR + 2048, C.lane, 1.0f);
            if (FP8_IN) row_store_fp8(WSP(unsigned char, WS_HA8) + (size_t)row * DM, C.lane, v); else row_store_bf16(WSP(bf16, WS_HB) + (size_t)row * DM, C.lane, v);
        }
    }
    __syncthreads();
}

__device__ __forceinline__ void cvt8(const u32x4 r, float (&f)[8]) { f[0] = bflo(r.x); f[1] = bfhi(r.x); f[2] = bflo(r.y); f[3] = bfhi(r.y); f[4] = bflo(r.z); f[5] = bfhi(r.z); f[6] = bflo(r.w); f[7] = bfhi(r.w); }
__device__ __forceinline__ void cvt8_fp8(const u32x2 r, float (&f)[8]) { const f32x2 a = __builtin_amdgcn_cvt_pk_f32_fp8((int)r.x, false), b = __builtin_amdgcn_cvt_pk_f32_fp8((int)r.x, true), c = __builtin_amdgcn_cvt_pk_f32_fp8((int)r.y, false), d = __builtin_amdgcn_cvt_pk_f32_fp8((int)r.y, true);
    f[0] = a.x; f[1] = a.y; f[2] = b.x; f[3] = b.y; f[4] = c.x; f[5] = c.y; f[6] = d.x; f[7] = d.y; }
__device__ __forceinline__ bf16x8 pack8(const float (&f)[8]) { u32x4 w; w.x = pk2(f[0], f[1]); w.y = pk2(f[2], f[3]); w.z = pk2(f[4], f[5]); w.w = pk2(f[6], f[7]); return __builtin_bit_cast(bf16x8, w); }
#define MFMA32(a, b, c) __builtin_amdgcn_mfma_f32_32x32x16_bf16((a), (b), (c), 0, 0, 0)

__device__ __forceinline__ void attn_unit(Ctx& C, int l, int uidx) {
    constexpr int KS = 144, VS = 272, VT_OFF = 128 * KS;
    const bool isctx = uidx >= 256;
    int b, kh, nb;
    if (!isctx) { b = uidx >> 6; kh = (uidx >> 5) & 1; nb = uidx & 31; } else { const int v = uidx - 256; b = v >> 2; kh = (v >> 1) & 1; nb = v & 1; }
    const int rowbase = isctx ? NLAT + b * CL : b * SL, crow = NLAT + b * CL;
    const int g = C.wave >> 1, th = C.wave & 1, head = kh * 4 + g, r32 = C.lane & 31, h = C.lane >> 5;
    const bf16* Z = WSP(bf16, WS_Z); const f32x2* ROPE = WSP(f32x2, WS_ROPE);
    bf16x8 Qf[2][4];
#pragma unroll
    for (int qb = 0; qb < 2; ++qb) {
        const int tq = 128 * nb + 64 * th + 32 * qb + r32;
        const bf16* qp = Z + (size_t)(rowbase + tq) * INW + 512 + 64 * head + 8 * h;
        float f[4][8];
#pragma unroll
        for (int s = 0; s < 4; ++s) cvt8(*(const u32x4*)(qp + 16 * s), f[s]);
        if (!isctx) {
            const int pr = tq >> 6, pc = tq & 63;
#pragma unroll
            for (int j = 0; j < 8; ++j) {
                const f32x2 cr = ROPE[pr * 16 + 8 * h + j], cc = ROPE[pc * 16 + 8 * h + j];
                const float a0 = f[0][j], b0 = f[1][j]; f[0][j] = a0 * cr.x - b0 * cr.y; f[1][j] = b0 * cr.x + a0 * cr.y;
                const float a1 = f[2][j], b1 = f[3][j]; f[2][j] = a1 * cc.x - b1 * cc.y; f[3][j] = b1 * cc.x + a1 * cc.y; }
        }
#pragma unroll
        for (int s = 0; s < 4; ++s) {
#pragma unroll
            for (int j = 0; j < 8; ++j) f[s][j] *= 0.125f * LOG2E;
            Qf[qb][s] = pack8(f[s]); }
    }
    float m_[2], l_[2]; f32x16 O[2][2];
    { const float sk = INP(I_SINK)[l * 8 + head] * LOG2E; m_[0] = sk; m_[1] = sk; l_[0] = 1.f; l_[1] = 1.f; }
#pragma unroll
    for (int a = 0; a < 2; ++a)
#pragma unroll
        for (int q = 0; q < 2; ++q)
#pragma unroll
            for (int i = 0; i < 16; ++i) O[a][q][i] = 0.f;
#define AT_VALID(tt_) ((tt_) >= 3 || ((nb - 1 + (tt_)) >= 0 && (nb - 1 + (tt_)) < SL / 128))
#define AT_KROW0(tt_) (((tt_) < 3) ? rowbase + 128 * (nb - 1 + (tt_)) : crow + 128 * ((tt_) - 3))
#define AT_PREFETCH(tt_) do { const int krow0_ = AT_KROW0(tt_); _Pragma("unroll") for (int r = 0; r < 2; ++r) { const int idx = C.tid + 512 * r, key = idx >> 3, cd = idx & 7; \
        const bf16* kp = Z + (size_t)(krow0_ + key) * INW + 1024 + 64 * kh; kraw[r] = *(const u32x4*)(kp + 8 * cd); if ((tt_) < 3) kpar[r] = *(const u32x4*)(kp + 8 * (cd ^ 2)); \
        vraw[r] = *(const u32x4*)(kp + 128 + 8 * cd); } } while (0)
    __syncthreads();
    u32x4 kraw[2], kpar[2], vraw[2];
    kpar[0] = (u32x4){0u, 0u, 0u, 0u}; kpar[1] = kpar[0];
    int tt = isctx ? 3 : (nb == 0 ? 1 : 0);
    AT_PREFETCH(tt);
    while (tt < 5) {
        int ntt = tt + 1; if (ntt < 3 && !AT_VALID(ntt)) ntt = 3;
        const bool band = tt < 3; const int kb = nb - 1 + tt;
        LDS_WAIT(); __builtin_amdgcn_s_barrier(); asm volatile("" ::: "memory");
#pragma unroll
        for (int r = 0; r < 2; ++r) {
            const int idx = C.tid + 512 * r, key = idx >> 3, cd = idx & 7;
            u32x4 raw = kraw[r];
            if (band) {
                float x[8], y[8]; cvt8(raw, x); cvt8(kpar[r], y);
                const int tk = 128 * kb + key, pos = (cd & 4) ? (tk & 63) : (tk >> 6), i0 = 8 * (cd & 1); const bool isb = (cd >> 1) & 1;
#pragma unroll
                for (int j = 0; j < 8; ++j) { const f32x2 cs = ROPE[pos * 16 + i0 + j]; x[j] = isb ? (x[j] * cs.x + y[j] * cs.y) : (x[j] * cs.x - y[j] * cs.y); }
                raw = __builtin_bit_cast(u32x4, pack8(x));
            }
            *(LAS u32x4*)(C.lds + key * KS + cd * 16) = raw;
            const u32x4 vr = vraw[r];
            LAS bf16* vt = (LAS bf16*)(C.lds + VT_OFF + (8 * cd) * VS + key * 2);
            vt[0] = (bf16)(vr.x & 0xffff); vt[VS / 2] = (bf16)(vr.x >> 16); vt[2 * (VS / 2)] = (bf16)(vr.y & 0xffff); vt[3 * (VS / 2)] = (bf16)(vr.y >> 16);
            vt[4 * (VS / 2)] = (bf16)(vr.z & 0xffff); vt[5 * (VS / 2)] = (bf16)(vr.z >> 16); vt[6 * (VS / 2)] = (bf16)(vr.w & 0xffff); vt[7 * (VS / 2)] = (bf16)(vr.w >> 16);
        }
        if (ntt < 5) AT_PREFETCH(ntt);
        LDS_WAIT(); __builtin_amdgcn_s_barrier(); asm volatile("" ::: "memory");
        const int sub_lo = (tt == 0) ? 2 * th : 0, sub_hi = (tt == 2) ? 2 * th + 1 : 3;
        for (int sub = sub_lo; sub <= sub_hi; ++sub) {
            bf16x8 Kf[4];
#pragma unroll
            for (int s = 0; s < 4; ++s) Kf[s] = *(const LAS bf16x8*)(C.lds + (32 * sub + r32) * KS + (16 * s + 8 * h) * 2);
            bf16x8 Pf[2][2];
#pragma unroll
            for (int qb = 0; qb < 2; ++qb) {
                f32x16 S;
#pragma unroll
                for (int i = 0; i < 16; ++i) S[i] = 0.f;
#pragma unroll
                for (int s = 0; s < 4; ++s) S = MFMA32(Kf[s], Qf[qb][s], S);
                const int tq = 128 * nb + 64 * th + 32 * qb + r32;
                float mx = -INFINITY;
#pragma unroll
                for (int i = 0; i < 16; ++i) { float x = S[i];
                    if (tt == 0 || tt == 2) { const int kpos = 128 * kb + 32 * sub + (i & 3) + 8 * (i >> 2) + 4 * h; const int dq = tq - kpos; if (dq > 128 || dq < -128) x = -INFINITY; }
                    S[i] = x; mx = fmaxf(mx, x); }
                mx = xor32_max(mx);
                const float mnew = fmaxf(m_[qb], mx), alpha = __builtin_amdgcn_exp2f(m_[qb] - mnew);
                float rs = 0.f; float p[16];
#pragma unroll
                for (int i = 0; i < 16; ++i) { p[i] = __builtin_amdgcn_exp2f(S[i] - mnew); rs += p[i]; }
                rs = xor32_sum(rs);
                l_[qb] = l_[qb] * alpha + rs; m_[qb] = mnew;
#pragma unroll
                for (int i = 0; i < 16; ++i) { O[0][qb][i] *= alpha; O[1][qb][i] *= alpha; }
#pragma unroll
                for (int s2 = 0; s2 < 2; ++s2) { float t8[8];
#pragma unroll
                    for (int j = 0; j < 8; ++j) t8[j] = p[8 * s2 + j];
                    Pf[qb][s2] = pack8(t8); }
            }
#pragma unroll
            for (int db = 0; db < 2; ++db)
#pragma unroll
                for (int s2 = 0; s2 < 2; ++s2) {
                    const LAS unsigned char* vp = C.lds + VT_OFF + (32 * db + r32) * VS + (32 * sub + 16 * s2 + 4 * h) * 2;
                    const u32x2 v0 = *(const LAS u32x2*)vp, v1 = *(const LAS u32x2*)(vp + 16);
                    const u32x4 vv = {v0.x, v0.y, v1.x, v1.y}; const bf16x8 Vf = __builtin_bit_cast(bf16x8, vv);
                    O[db][0] = MFMA32(Vf, Pf[0][s2], O[db][0]); O[db][1] = MFMA32(Vf, Pf[1][s2], O[db][1]);
                }
        }
        tt = ntt;
    }
#undef AT_VALID
#undef AT_KROW0
#undef AT_PREFETCH
    bf16* Y = WSP(bf16, WS_YCAT);
#pragma unroll
    for (int qb = 0; qb < 2; ++qb) {
        const int tq = 128 * nb + 64 * th + 32 * qb + r32; const float inv = 1.0f / l_[qb];
        bf16* yp = Y + (size_t)(rowbase + tq) * DM + 512 + 64 * head;
#pragma unroll
        for (int db = 0; db < 2; ++db)
#pragma unroll
            for (int rg = 0; rg < 4; ++rg) { u32x2 w; w.x = pk2(O[db][qb][4 * rg] * inv, O[db][qb][4 * rg + 1] * inv); w.y = pk2(O[db][qb][4 * rg + 2] * inv, O[db][qb][4 * rg + 3] * inv);
                *(u32x2*)(yp + 32 * db + 8 * rg + 4 * h) = w; }
    }
}

__device__ __forceinline__ void gmlp_unit(Ctx& C, int l, int uidx) {
    constexpr int VS = 272;
    const int ck = uidx >> 1, hf = uidx & 1, row0 = 128 * ck;
    const bf16* Z = WSP(bf16, WS_Z);
    const int gl = C.wave >> 1, ph = C.wave & 1, g = 4 * hf + gl, r32 = C.lane & 31, h = C.lane >> 5;
    bf16x8 Wf[2][8]; u32x2 upre[2][2][4];
    { const bf16* wsb = WSP(bf16, WS_GWSB) + ((size_t)(l * 8 + g) * 128 + 64 * ph + r32) * 128 + 8 * h;
#pragma unroll
      for (int pb = 0; pb < 2; ++pb)
#pragma unroll
          for (int s = 0; s < 8; ++s) Wf[pb][s] = *(const bf16x8*)(wsb + (size_t)(32 * pb) * 128 + 16 * s);
#pragma unroll
      for (int pb = 0; pb < 2; ++pb) { const bf16* up = Z + (size_t)(row0 + 64 * ph + 32 * pb + r32) * INW + 2816 + 64 * g + 4 * h;
#pragma unroll
          for (int cb = 0; cb < 2; ++cb)
#pragma unroll
              for (int rg = 0; rg < 4; ++rg) upre[pb][cb][rg] = *(const u32x2*)(up + 32 * cb + 8 * rg); } }
    __syncthreads();
    {
        const int tok = C.tid >> 2, part = C.tid & 3;
        const bf16* zp = Z + (size_t)(row0 + tok) * INW + 3328 + 128 * part;
        const bf16* zq = Z + (size_t)(row0 + tok) * INW + 3328 + 256 * hf + 64 * part;
        u32x4 r1[16], r2[8];
#pragma unroll
        for (int c8 = 0; c8 < 16; ++c8) r1[c8] = *(const u32x4*)(zp + 8 * c8);
#pragma unroll
        for (int c8 = 0; c8 < 8; ++c8) r2[c8] = *(const u32x4*)(zq + 8 * c8);
        float s = 0.f, q = 0.f;
#pragma unroll
        for (int c8 = 0; c8 < 16; ++c8) { float f[8]; cvt8(r1[c8], f);
#pragma unroll
            for (int j = 0; j < 8; ++j) { s += f[j]; q += f[j] * f[j]; } }
        s += dpp_f<DPP_XOR1>(s); s += dpp_f<DPP_XOR2>(s); q += dpp_f<DPP_XOR1>(q); q += dpp_f<DPP_XOR2>(q);
        const float mean = s * (1.0f / 512.0f); const float var = fmaxf(q * (1.0f / 512.0f) - mean * mean, 0.f); const float rstd = 1.0f / sqrtf(var + LN_EPS);
        const float* lg = INP(I_GLG) + l * 512 + 256 * hf + 64 * part; const float* lb = INP(I_GLB) + l * 512 + 256 * hf + 64 * part;
#pragma unroll
        for (int c8 = 0; c8 < 8; ++c8) { float f[8]; cvt8(r2[c8], f);
            const f32x4 g0 = *(const f32x4*)(lg + 8 * c8), g1 = *(const f32x4*)(lg + 8 * c8 + 4), b0 = *(const f32x4*)(lb + 8 * c8), b1 = *(const f32x4*)(lb + 8 * c8 + 4);
            const float gg[8] = {g0[0], g0[1], g0[2], g0[3], g1[0], g1[1], g1[2], g1[3]}, bb[8] = {b0[0], b0[1], b0[2], b0[3], b1[0], b1[1], b1[2], b1[3]};
#pragma unroll
            for (int j = 0; j < 8; ++j) { const float vn = (f[j] - mean) * rstd * gg[j] + bb[j];
                *(LAS bf16*)(C.lds + (64 * part + 8 * c8 + j) * VS + tok * 2) = (bf16)(pk2(vn, 0.f) & 0xffffu); } }
    }
    __syncthreads();
    f32x16 acc[2][2];
#pragma unroll
    for (int a = 0; a < 2; ++a)
#pragma unroll
        for (int b = 0; b < 2; ++b)
#pragma unroll
            for (int i = 0; i < 16; ++i) acc[a][b][i] = 0.f;
#pragma unroll
    for (int s = 0; s < 8; ++s) {
        bf16x8 Vf[2];
#pragma unroll
        for (int cb = 0; cb < 2; ++cb) Vf[cb] = *(const LAS bf16x8*)(C.lds + (64 * gl + 32 * cb + r32) * VS + (16 * s + 8 * h) * 2);
#pragma unroll
        for (int cb = 0; cb < 2; ++cb)
#pragma unroll
            for (int pb = 0; pb < 2; ++pb) acc[cb][pb] = MFMA32(Vf[cb], Wf[pb][s], acc[cb][pb]);
    }
    bf16* Y = WSP(bf16, WS_YCAT);
#pragma unroll
    for (int pb = 0; pb < 2; ++pb) { const int p = 64 * ph + 32 * pb + r32; const float bs = INP(I_GBS)[(l * 8 + g) * 128 + p];
        bf16* yp = Y + (size_t)(row0 + p) * DM + 1536 + 64 * g + 4 * h;
#pragma unroll
        for (int cb = 0; cb < 2; ++cb)
#pragma unroll
            for (int rg = 0; rg < 4; ++rg) { const u32x2 uv = upre[pb][cb][rg];
                u32x2 w; w.x = pk2(bflo(uv.x) * (acc[cb][pb][4 * rg] + bs), bfhi(uv.x) * (acc[cb][pb][4 * rg + 1] + bs)); w.y = pk2(bflo(uv.y) * (acc[cb][pb][4 * rg + 2] + bs), bfhi(uv.y) * (acc[cb][pb][4 * rg + 3] + bs));
                *(u32x2*)(yp + 32 * cb + 8 * rg) = w; } }
}

__device__ __forceinline__ void pool_unit(Ctx& C, int l, int blk) {
    constexpr int RS = 1040, DT_OFF = 48 * RS;
    const int row0 = 32 * blk;
    const int s0 = row0 < NLAT ? (row0 / SL) * SL : NLAT + ((row0 - NLAT) / CL) * CL, L = row0 < NLAT ? SL : CL, t0 = row0 - s0;
    const bf16* Z = WSP(bf16, WS_Z);
    __syncthreads();
    for (int idx = C.tid; idx < 48 * 64; idx += 512) { const int r = idx >> 6, ch = idx & 63, t = t0 - 8 + r; u32x4 v = {0u, 0u, 0u, 0u};
        if (t >= 0 && t < L) v = *(const u32x4*)(Z + (size_t)(s0 + t) * INW + 8 * ch);
        *(LAS u32x4*)(C.lds + r * RS + ch * 16) = v; }
    __syncthreads();
    {
        const int c8 = C.tid & 63, tg = C.tid >> 6, hw = 1 << (c8 >> 4);
#pragma unroll 1
        for (int k = 0; k < 4; ++k) { const int tt = 4 * tg + k, t = t0 + tt; const int lo = max(t - hw, 0), hi = min(t + hw, L);
            float sacc[8];
#pragma unroll
            for (int j = 0; j < 8; ++j) sacc[j] = 0.f;
            for (int q = lo; q < hi; ++q) { float f[8]; cvt8(*(const LAS u32x4*)(C.lds + (q - t0 + 8) * RS + c8 * 16), f);
#pragma unroll
                for (int j = 0; j < 8; ++j) sacc[j] += f[j]; }
            float cf[8]; cvt8(*(const LAS u32x4*)(C.lds + (tt + 8) * RS + c8 * 16), cf); const float inv = 1.0f / (float)(hi - lo);
#pragma unroll
            for (int j = 0; j < 8; ++j) sacc[j] = sacc[j] * inv - cf[j];
            *(LAS bf16x8*)(C.lds + DT_OFF + tt * RS + c8 * 16) = pack8(sacc); }
    }
    __syncthreads();
    const int gi = C.wave >> 1, oh = C.wave & 1, r32 = C.lane & 31, h = C.lane >> 5;
    f32x16 acc[2];
#pragma unroll
    for (int a = 0; a < 2; ++a)
#pragma unroll
        for (int i = 0; i < 16; ++i) acc[a][i] = 0.f;
    const bf16* wt = WSP(bf16, WS_POOLWT) + (size_t)((l * 4 + gi) * 128 + 64 * oh + r32) * 128 + 8 * h;
#pragma unroll
    for (int s = 0; s < 8; ++s) {
        const bf16x8 Bf = *(const LAS bf16x8*)(C.lds + DT_OFF + r32 * RS + (128 * gi + 16 * s + 8 * h) * 2);
#pragma unroll
        for (int rb = 0; rb < 2; ++rb) { const bf16x8 Af = *(const bf16x8*)(wt + (size_t)(32 * rb) * 128 + 16 * s); acc[rb] = MFMA32(Af, Bf, acc[rb]); }
    }
    bf16* yp = WSP(bf16, WS_YCAT) + (size_t)(row0 + r32) * DM + 128 * gi + 64 * oh;
#pragma unroll
    for (int rb = 0; rb < 2; ++rb)
#pragma unroll
        for (int rg = 0; rg < 4; ++rg) { u32x2 w; w.x = pk2(acc[rb][4 * rg], acc[rb][4 * rg + 1]); w.y = pk2(acc[rb][4 * rg + 2], acc[rb][4 * rg + 3]); *(u32x2*)(yp + 32 * rb + 8 * rg + 4 * h) = w; }
}

__device__ __forceinline__ void hyprep_unit(Ctx& C, int l, int uidx) {
    constexpr int RS = 528;
    int seq, tb, cb, L, rowbase; bf16* T;
    if (uidx < 1536) { seq = uidx / 384; const int rem = uidx % 384; tb = rem / 6; cb = rem % 6; L = SL; rowbase = seq * SL; T = WSP(bf16, WS_TL); }
    else { const int v = uidx - 1536; seq = v / 24; const int rem = v % 24; tb = rem / 6; cb = rem % 6; L = CL; rowbase = NLAT + seq * CL; T = WSP(bf16, WS_TC); }
    const int t0 = 64 * tb; const bf16* Z = WSP(bf16, WS_Z);
    __syncthreads();
    for (int idx = C.tid; idx < 66 * 32; idx += 512) { const int r = idx >> 5, ch = idx & 31, t = t0 - 1 + r; u32x4 v = {0u, 0u, 0u, 0u};
        if (t >= 0 && t < L) v = *(const u32x4*)(Z + (size_t)(rowbase + t) * INW + 1280 + 256 * cb + 8 * ch);
        *(LAS u32x4*)(C.lds + r * RS + ch * 16) = v; }
    __syncthreads();
    const int c = C.tid & 255, hf = C.tid >> 8, ch = 256 * cb + c, comp = ch >> 9, cc = ch & 511;
    const float w0 = INP(I_HCW)[(l * 3 + 0) * 1536 + ch], w1 = INP(I_HCW)[(l * 3 + 1) * 1536 + ch], w2 = INP(I_HCW)[(l * 3 + 2) * 1536 + ch], bias = INP(I_HCB)[l * 1536 + ch];
    bf16* dst = T + ((size_t)(comp * 512 + cc) * 4 + seq) * L + t0 + 32 * hf;
    float zm = bf1(*(const LAS bf16*)(C.lds + (32 * hf) * RS + c * 2)), zc = bf1(*(const LAS bf16*)(C.lds + (32 * hf + 1) * RS + c * 2));
#pragma unroll
    for (int k = 0; k < 4; ++k) { float o[8];
#pragma unroll
        for (int e = 0; e < 8; ++e) { const float zn = bf1(*(const LAS bf16*)(C.lds + (32 * hf + 8 * k + e + 2) * RS + c * 2)); o[e] = bias + w0 * zm + w1 * zc + w2 * zn; zm = zc; zc = zn; }
        u32x4 w; w.x = pk2(o[0], o[1]); w.y = pk2(o[2], o[3]); w.z = pk2(o[4], o[5]); w.w = pk2(o[6], o[7]); *(u32x4*)(dst + 8 * k) = w; }
}

template <int L, int NT = 512>
__device__ __forceinline__ void hyena_unit(Ctx& C, int l, int c) {
    constexpr int NBLK = L / 32, NTILE = NBLK / 8, NTL = (NTILE >= 16) ? 2 : 1;
    constexpr int SB = 2 * L + 16, Z_OFF = 4 * SB, R_OFF = Z_OFF + 64, CSZ = 4 * L;
    const bf16* T = (L == SL) ? WSP(bf16, WS_TL) : WSP(bf16, WS_TC);
    const int r32 = C.lane & 31, h = C.lane >> 5;
    const bool active = (2 * C.wave < NTILE);
    const int qi = (r32 + 1) >> 2, ri = (r32 + 1) & 3, pcp = (4 - ri) & 3;
    const int laneA = R_OFF + pcp * CSZ + (pcp ? 8 + 64 * pcp : 0) - 8 * (qi + (ri ? 1 : 0)) + 16 * h;
    const int al = r32 >> 2, bb = r32 & 3;
    const int laneB = bb * SB + 16 * h;
    for (int o = 0; o < 2; ++o) {
        __syncthreads();
        if (o == 0) { const bf16* src = T + (size_t)(2 * 512 + c) * 4 * L;
            for (int idx = C.tid; idx < 4 * L / 8; idx += NT) { const int b = idx / (L / 8), tc = idx % (L / 8); *(LAS u32x4*)(C.lds + b * SB + tc * 16) = *(const u32x4*)(src + 8 * idx); }
            if (C.tid < 4) *(LAS u32x4*)(C.lds + Z_OFF + 16 * C.tid) = (u32x4){0u, 0u, 0u, 0u}; }
        { const bf16* fsrc = (L == SL) ? WSP(bf16, WS_FILT) + (size_t)((l * 2 + o) * 512 + c) * (2 * L) : WSP(bf16, WS_FILTC) + (size_t)(o * 512 + c) * (2 * L);
          for (int idx = C.tid; idx < L / 4; idx += NT) *(LAS u32x4*)(C.lds + R_OFF + 16 * idx) = *(const u32x4*)(fsrc + 8 * idx); }
        __syncthreads();
        for (int idx = C.tid; idx < 3 * (L / 2); idx += NT) { const int p = 1 + idx / (L / 2), w = idx % (L / 2); unsigned short e[4];
#pragma unroll
            for (int k = 0; k < 4; ++k) { const int n = 4 * w + p + k; e[k] = n < 2 * L ? *(const LAS bf16*)(C.lds + R_OFF + 2 * n) : (bf16)0; }
            *(LAS u32x2*)(C.lds + R_OFF + p * CSZ + 8 + 64 * p + 8 * w) = (u32x2){(unsigned)e[0] | ((unsigned)e[1] << 16), (unsigned)e[2] | ((unsigned)e[3] << 16)}; }
        __syncthreads();
        f32x16 acc[NTL];
#pragma unroll
        for (int t = 0; t < NTL; ++t)
#pragma unroll
            for (int i = 0; i < 16; ++i) acc[t][i] = 0.f;
        u32x2 gpre[NTL][4]; float skip = 0.f;
        if (active) { skip = INP(I_HSKIP)[(l * 2 + o) * 512 + c]; const bf16* gate_ = T + (size_t)(o * 512 + c) * 4 * L + (size_t)bb * L;
#pragma unroll
            for (int t = 0; t < NTL; ++t)
#pragma unroll
                for (int rg = 0; rg < 4; ++rg) gpre[t][rg] = *(const u32x2*)(gate_ + 32 * (8 * (2 * C.wave + t) + al) + 8 * rg + 4 * h); }
        if (active) {
            const int a0 = 8 * (2 * C.wave);
            const int m_lo = a0 - (NBLK - 1), m_hi = a0 + 8 * (NTL - 1) + 7;
            const int mA = m_hi - (NBLK - 1), mB = a0;
            int off8 = 8; asm volatile("" : "+v"(off8));
#define HY_STEP_CHK(m_) do { bf16x8 Af_[2]; \
                _Pragma("unroll") for (int s = 0; s < 2; ++s) { const LAS unsigned char* ap = C.lds + laneA + 2 * (L - 32 * (m_) + 16 * s); const u32x2 x0 = *(const LAS u32x2*)ap, x1 = *(const LAS u32x2*)(ap + off8); \
                    const u32x4 xx = {x0.x, x0.y, x1.x, x1.y}; Af_[s] = __builtin_bit_cast(bf16x8, xx); } \
                _Pragma("unroll") for (int t = 0; t < NTL; ++t) { const int q = a0 + 8 * t + al - (m_); const bool ok = (q >= 0) && (q < NBLK); \
                    _Pragma("unroll") for (int s = 0; s < 2; ++s) { const int addr = ok ? (laneB + 64 * q + 32 * s) : Z_OFF; const bf16x8 Bf_ = *(const LAS bf16x8*)(C.lds + addr); acc[t] = MFMA32(Af_[s], Bf_, acc[t]); } } } while (0)
#pragma unroll 1
            for (int m = m_lo; m < mA; ++m) HY_STEP_CHK(m);
            {
                int o1 = 8, o2 = 32, o3 = 40; asm volatile("" : "+v"(o1), "+v"(o2), "+v"(o3));
                const LAS unsigned char* pa0 = C.lds + laneA + 2 * (L - 32 * mA); const LAS unsigned char* pa1 = pa0 + o1; const LAS unsigned char* pa2 = pa0 + o2; const LAS unsigned char* pa3 = pa0 + o3;
                const LAS unsigned char* pb = C.lds + laneB + 64 * (a0 + al - mA);
#define HY_LOADF(Af_, Bf_) do { { const u32x2 x0 = *(const LAS u32x2*)pa0, x1 = *(const LAS u32x2*)pa1, x2 = *(const LAS u32x2*)pa2, x3 = *(const LAS u32x2*)pa3; \
                    const u32x4 xa = {x0.x, x0.y, x1.x, x1.y}, xb = {x2.x, x2.y, x3.x, x3.y}; Af_[0] = __builtin_bit_cast(bf16x8, xa); Af_[1] = __builtin_bit_cast(bf16x8, xb); } \
                _Pragma("unroll") for (int t = 0; t < NTL; ++t) _Pragma("unroll") for (int s = 0; s < 2; ++s) Bf_[t][s] = *(const LAS bf16x8*)(pb + 512 * t + 32 * s); \
                pa0 -= 64; pa1 -= 64; pa2 -= 64; pa3 -= 64; pb -= 64; asm volatile("" : "+v"(pa0), "+v"(pa1), "+v"(pa2), "+v"(pa3)); } while (0)
#define HY_MMA(Af_, Bf_) do { _Pragma("unroll") for (int s = 0; s < 2; ++s) _Pragma("unroll") for (int t = 0; t < NTL; ++t) acc[t] = MFMA32(Af_[s], Bf_[t][s], acc[t]); } while (0)
                int nfast = mB - mA + 1;
                if constexpr (NTL == 2) {
                    bf16x8 Bx[8][2], By[8][2];
#define HY_LOADA(Af_) do { const u32x2 x0 = *(const LAS u32x2*)pa0, x1 = *(const LAS u32x2*)pa1, x2 = *(const LAS u32x2*)pa2, x3 = *(const LAS u32x2*)pa3; \
                        const u32x4 xa = {x0.x, x0.y, x1.x, x1.y}, xb = {x2.x, x2.y, x3.x, x3.y}; Af_[0] = __builtin_bit_cast(bf16x8, xa); Af_[1] = __builtin_bit_cast(bf16x8, xb); \
                        pa0 -= 64; pa1 -= 64; pa2 -= 64; pa3 -= 64; asm volatile("" : "+v"(pa0), "+v"(pa1), "+v"(pa2), "+v"(pa3)); } while (0)
#define HY_GROUP(Bold, Bnew, more) do { _Pragma("unroll") for (int i = 0; i < 8; ++i) { bf16x8 An_[2] = {Ac_[0], Ac_[1]}; \
                        if (i < 7) { HY_LOADA(An_); Bnew[i + 1][0] = *(const LAS bf16x8*)(pb - 64 * (i + 1)); Bnew[i + 1][1] = *(const LAS bf16x8*)(pb - 64 * (i + 1) + 32); } \
                        else if (more) { HY_LOADA(An_); Bold[0][0] = *(const LAS bf16x8*)(pb - 512); Bold[0][1] = *(const LAS bf16x8*)(pb - 512 + 32); }        \
                        acc[0] = MFMA32(Ac_[0], Bnew[i][0], acc[0]); acc[1] = MFMA32(Ac_[0], Bold[i][0], acc[1]); acc[0] = MFMA32(Ac_[1], Bnew[i][1], acc[0]); acc[1] = MFMA32(Ac_[1], Bold[i][1], acc[1]); \
                        Ac_[0] = An_[0]; Ac_[1] = An_[1]; } \
                        pb -= 512; } while (0)
                    if (nfast >= 16) {
#pragma unroll
                        for (int i = 0; i < 8; ++i) { Bx[i][0] = *(const LAS bf16x8*)(pb + 512 - 64 * i); Bx[i][1] = *(const LAS bf16x8*)(pb + 512 - 64 * i + 32); }
                        bf16x8 Ac_[2]; HY_LOADA(Ac_); By[0][0] = *(const LAS bf16x8*)pb; By[0][1] = *(const LAS bf16x8*)(pb + 32);
#pragma unroll 1
                        while (nfast >= 16) { HY_GROUP(Bx, By, true); HY_GROUP(By, Bx, nfast >= 32); nfast -= 16; }
                    }
#undef HY_LOADA
#undef HY_GROUP
                }
                bf16x8 A0[2], B0[NTL][2], A1[2], B1[NTL][2];
                if (nfast > 0) {
                    int rem = nfast - 1;
                    HY_LOADF(A0, B0);
#pragma unroll 1
                    while (rem >= 2) { HY_LOADF(A1, B1); HY_MMA(A0, B0); HY_LOADF(A0, B0); HY_MMA(A1, B1); rem -= 2; }
                    if (rem == 1) { HY_LOADF(A1, B1); HY_MMA(A0, B0); HY_MMA(A1, B1); } else { HY_MMA(A0, B0); }
                }
#undef HY_LOADF
#undef HY_MMA
            }
#pragma unroll 1
            for (int m = mB + 1; m <= m_hi; ++m) HY_STEP_CHK(m);
#undef HY_STEP_CHK
        }
        __syncthreads();
        if (active) {
#pragma unroll
            for (int t = 0; t < NTL; ++t) { const int a = 8 * (2 * C.wave + t) + al;
#pragma unroll
                for (int rg = 0; rg < 4; ++rg) { const int t4 = 32 * a + 8 * rg + 4 * h;
                    LAS u32x2* up = (LAS u32x2*)(C.lds + bb * SB + t4 * 2); const u32x2 uo = *up; const u32x2 gv = gpre[t][rg];
                    const float v0 = bflo(gv.x) * (acc[t][4 * rg] + skip * bflo(uo.x)), v1 = bfhi(gv.x) * (acc[t][4 * rg + 1] + skip * bfhi(uo.x));
                    const float v2 = bflo(gv.y) * (acc[t][4 * rg + 2] + skip * bflo(uo.y)), v3 = bfhi(gv.y) * (acc[t][4 * rg + 3] + skip * bfhi(uo.y));
                    const u32x2 w = {pk2(v0, v1), pk2(v2, v3)};
                    if (o == 0) *up = w;
                    else { const int row = (L == SL) ? bb * SL + t4 : NLAT + bb * CL + t4; *(u32x2*)(WSP(bf16, WS_YHT) + (size_t)c * NTOK + row) = w; } } }
        }
    }
}

constexpr int RMS_GN_OFF = 34816;
__device__ __forceinline__ void rms_stage_gain(Ctx& C, int l) { __syncthreads(); stage2048(C, (LAS float*)(C.lds + RMS_GN_OFF), INP(I_MNG) + l * DM); __syncthreads(); }
__device__ __forceinline__ void rms_unit(Ctx& C, int l, int blk) {
    constexpr int RS = 1040;
    const int row0 = 32 * blk;
    const int tok = C.tid >> 4, sub = C.tid & 15;
    const bf16* Y = WSP(bf16, WS_YCAT) + (size_t)(row0 + tok) * DM + 32 * sub;
    u32x4 raw[3][4];
#pragma unroll
    for (int gi = 0; gi < 3; ++gi)
#pragma unroll
        for (int c8 = 0; c8 < 4; ++c8) raw[gi][c8] = *(const u32x4*)(Y + 512 * (gi == 2 ? 3 : gi) + 8 * c8);
    u32x4 hy[4];
    { const bf16* yh = WSP(bf16, WS_YHT);
#pragma unroll
      for (int k = 0; k < 4; ++k) { const int idx = C.tid + 512 * k, ch = idx >> 2, tc = idx & 3; hy[k] = *(const u32x4*)(yh + (size_t)ch * NTOK + row0 + 8 * tc); } }
    __syncthreads();
#pragma unroll
    for (int k = 0; k < 4; ++k) { const int idx = C.tid + 512 * k, ch = idx >> 2, tc = idx & 3; const u32x4 v = hy[k];
        LAS bf16* d = (LAS bf16*)(C.lds + (8 * tc) * RS + ch * 2);
        d[0] = (bf16)(v.x & 0xffff); d[RS / 2] = (bf16)(v.x >> 16); d[2 * (RS / 2)] = (bf16)(v.y & 0xffff); d[3 * (RS / 2)] = (bf16)(v.y >> 16);
        d[4 * (RS / 2)] = (bf16)(v.z & 0xffff); d[5 * (RS / 2)] = (bf16)(v.z >> 16); d[6 * (RS / 2)] = (bf16)(v.w & 0xffff); d[7 * (RS / 2)] = (bf16)(v.w >> 16); }
    __syncthreads();
    const LAS float* gn = (const LAS float*)(C.lds + RMS_GN_OFF);
    unsigned char* O = WSP(unsigned char, WS_HA8) + (size_t)(row0 + tok) * DM + 32 * sub;
#pragma unroll
    for (int gq = 0; gq < 4; ++gq) {
        float f[32]; float q = 0.f;
#pragma unroll
        for (int c8 = 0; c8 < 4; ++c8) { const u32x4 v = (gq == 2) ? *(const LAS u32x4*)(C.lds + tok * RS + (32 * sub + 8 * c8) * 2) : raw[gq == 3 ? 2 : gq][c8];
            float t8[8]; cvt8(v, t8);
#pragma unroll
            for (int j = 0; j < 8; ++j) { f[8 * c8 + j] = t8[j]; q += t8[j] * t8[j]; } }
        q = row16_sum(q);
        const float rs = 1.0f / sqrtf(q * (1.0f / 512.0f) + LN_EPS);
        const LAS float* gp = gn + 512 * gq + 32 * sub;
#pragma unroll
        for (int c8 = 0; c8 < 4; ++c8) { const f32x4 g0 = *(const LAS f32x4*)(gp + 8 * c8), g1 = *(const LAS f32x4*)(gp + 8 * c8 + 4);
            u32x2 w; w.x = pk4_fp8(f[8 * c8] * rs * g0[0], f[8 * c8 + 1] * rs * g0[1], f[8 * c8 + 2] * rs * g0[2], f[8 * c8 + 3] * rs * g0[3]);
            w.y = pk4_fp8(f[8 * c8 + 4] * rs * g1[0], f[8 * c8 + 5] * rs * g1[1], f[8 * c8 + 6] * rs * g1[2], f[8 * c8 + 7] * rs * g1[3]);
            *(u32x2*)(O + 512 * gq + 8 * c8) = w; }
        __builtin_amdgcn_sched_barrier(0);
    }
}

__device__ __forceinline__ void ph_post1(Ctx& C, int l, int nrows, bool dry = false) {
    LAS float* H2 = (LAS float*)C.lds;
    LAS float* RED = (LAS float*)(C.lds + 65536);
    LAS float* SGA = (LAS float*)(C.lds + 81920);
    LAS float* PAR = (LAS float*)(C.lds + 92160);
    unsigned* ctl = WSP(unsigned, WS_CTL);
    int nit = 0, cur_mrow = -1;
    const int nit_all = nrows / 8, it0 = (int)(((long)C.bid * nit_all) / C.G), it1 = (int)(((long)(C.bid + 1) * nit_all) / C.G);
    for (int it = it0; it < it1; ++it, ++nit) {
        const int row = it * 8 + C.wave;
        const int mrow = row < NLAT ? row / SL : 4; const float* mod = WSP(float, WS_MOD) + (size_t)(l * 5 + mrow) * 12288;
        __syncthreads();
        if (mrow != cur_mrow) { stage2048(C, PAR, mod + 4096); stage2048(C, PAR + 2048, INP(I_LN1G) + l * DM); stage2048(C, PAR + 4096, INP(I_LN1B) + l * DM); stage2048(C, PAR + 6144, mod + 8192); stage2048(C, PAR + 8192, mod + 6144); cur_mrow = mrow; __syncthreads(); }
        {
            float v[32], y[32], g1[32];
            if (l == 0) row_load(src_x0(C, row), C.lane, v); else row_load_bf16(WSP(bf16, WS_X) + (size_t)row * DM, C.lane, v);
            row_load_lds(PAR, C.lane, g1);
            { const bf16* yo = WSP(bf16, WS_YO) + (size_t)row * DM;
#pragma unroll
              for (int j = 0; j < 4; ++j) { float t8[8]; cvt8(*(const u32x4*)(yo + 512 * j + 8 * C.lane), t8);
#pragma unroll
                  for (int e = 0; e < 8; ++e) y[8 * j + e] = t8[e]; } }
#pragma unroll
            for (int i = 0; i < 32; ++i) v[i] = ALPHA * v[i] + g1[i] * y[i];
            row_ln(v); row_affine_lds(v, PAR + 2048, PAR + 4096, C.lane, 0.f);
            row_store_bf16(WSP(bf16, WS_X) + (size_t)row * DM, C.lane, v);
            row_ln(v); row_affine_lds(v, PAR + 6144, PAR + 8192, C.lane, 1.0f);
            row_store_fp8(WSP(unsigned char, WS_HB8) + (size_t)row * DM, C.lane, v);
#pragma unroll
            for (int j = 0; j < 4; ++j) { *(LAS f32x4*)(H2 + C.wave * DM + 512 * j + 8 * C.lane) = (f32x4){v[8 * j], v[8 * j + 1], v[8 * j + 2], v[8 * j + 3]};
                *(LAS f32x4*)(H2 + C.wave * DM + 512 * j + 8 * C.lane + 4) = (f32x4){v[8 * j + 4], v[8 * j + 5], v[8 * j + 6], v[8 * j + 7]}; }
        }
        __syncthreads();
        {
            const int e4 = C.lane & 7, cg = C.lane >> 3, cbase = 256 * C.wave + 32 * cg;
            f32x2 acc[8][2];
#pragma unroll
            for (int r = 0; r < 8; ++r) { acc[r][0] = (f32x2){0.f, 0.f}; acc[r][1] = (f32x2){0.f, 0.f}; }
            const float* wr = INP(I_WR) + (size_t)cbase * NE + 4 * e4;
#pragma unroll 2
            for (int cq = 0; cq < 32; cq += 4) {
                f32x4 w4[4];
#pragma unroll
                for (int k = 0; k < 4; ++k) w4[k] = *(const f32x4*)(wr + (size_t)(cq + k) * NE);
#pragma unroll
                for (int r = 0; r < 8; ++r) { const f32x4 hv = *(const LAS f32x4*)(H2 + r * DM + cbase + cq);
#pragma unroll
                    for (int k = 0; k < 4; ++k) { const f32x2 hh = {hv[k], hv[k]}; acc[r][0] += hh * (f32x2){w4[k][0], w4[k][1]}; acc[r][1] += hh * (f32x2){w4[k][2], w4[k][3]}; } } }
#pragma unroll
            for (int r = 0; r < 8; ++r)
#pragma unroll
                for (int k = 0; k < 2; ++k) { float x = acc[r][k].x, y = acc[r][k].y;
                    x += dpp_f<DPP_ROR8>(x); y += dpp_f<DPP_ROR8>(y); x = xor32_sum(xor16_sum(x)); y = xor32_sum(xor16_sum(y));
                    if (cg == 0) { RED[(C.wave * 8 + r) * 32 + 4 * e4 + 2 * k] = x; RED[(C.wave * 8 + r) * 32 + 4 * e4 + 2 * k + 1] = y; } }
        }
        __syncthreads();
        if (C.tid < 256) { const int r = C.tid >> 5, e = C.tid & 31; float s = 0.f;
#pragma unroll
            for (int p = 0; p < 8; ++p) s += RED[(p * 8 + r) * 32 + e];
            SGA[(nit * 8 + r) * 32 + e] = 1.0f / (1.0f + expf(-s)); }
    }
    __syncthreads();
    if (C.tid < nit * 8 && !dry) { const int r = C.tid, rw = (it0 + (r >> 3)) * 8 + (r & 7); float best = -INFINITY; int bg = 0;
        const LAS float* sg = SGA + r * 32; const float* rb = INP(I_RB);
        for (int gq = 0; gq < 8; ++gq) { const float a = sg[4 * gq] + rb[4 * gq], b = sg[4 * gq + 1] + rb[4 * gq + 1], c = sg[4 * gq + 2] + rb[4 * gq + 2], d = sg[4 * gq + 3] + rb[4 * gq + 3];
            const float hi1 = fmaxf(a, b), lo1 = fminf(a, b), hi2 = fmaxf(c, d), lo2 = fminf(c, d);
            const float top = fmaxf(hi1, hi2), second = fmaxf(fminf(hi1, hi2), (hi1 >= hi2) ? lo1 : lo2);
            const float sc = top + second; if (sc > best) { best = sc; bg = gq; } }
        int i0 = 0; float v0 = -INFINITY;
        for (int k = 0; k < 4; ++k) { const float x = sg[4 * bg + k] + rb[4 * bg + k]; if (x > v0) { v0 = x; i0 = k; } }
        int i1 = 0; float v1 = -INFINITY;
        for (int k = 0; k < 4; ++k) { const float x = sg[4 * bg + k] + rb[4 * bg + k]; if (k != i0 && x > v1) { v1 = x; i1 = k; } }
        const int e0 = 4 * bg + i0, e1 = 4 * bg + i1; const float w0 = sg[e0], w1 = sg[e1], ws = w0 + w1;
        const int p0 = (int)atomicAdd(ctl + CW_CNT + l * 2048 + e0 * 64, 1u), p1 = (int)atomicAdd(ctl + CW_CNT + l * 2048 + e1 * 64, 1u);
        WSP(int4, WS_TOKINFO)[rw] = make_int4(e0, p0, e1, p1); WSP(f32x2, WS_TOKW)[rw] = (f32x2){w0 / ws, w1 / ws};
        WSP(int, WS_EXPTOK)[(size_t)e0 * NTOK + p0] = rw; WSP(int, WS_EXPTOK)[(size_t)e1 * NTOK + p1] = rw; }
    __syncthreads();
}

__device__ __forceinline__ int moe_tables(Ctx& C, int l) {
    LAS int* T = (LAS int*)(C.lds + LDS_TAB);
    __syncthreads();
    if (C.tid < NE) { unsigned* ctl = WSP(unsigned, WS_CTL); T[200 + C.tid] = (int)__hip_atomic_load(ctl + CW_CNT + l * 2048 + C.tid * 64, __ATOMIC_RELAXED, __HIP_MEMORY_SCOPE_AGENT); }
    __syncthreads();
    if (C.tid == 0) { int nb = 0;
        for (int e = 0; e < NE; ++e) { const int cnt = T[200 + e]; T[168 + e] = nb; const int nbk = (cnt + 255) >> 8;
            for (int k = 0; k < nbk; ++k) if (nb + k < MAXBLK) T[nb + k] = e;
            nb += nbk; }
        T[232] = nb < MAXBLK ? nb : MAXBLK; }
    __syncthreads();
    return T[232];
}

__device__ __forceinline__ void ph_post2(Ctx& C, int l, int nrows) {
    const bool last = (l == 1);
    (void)moe_tables(C, l);
    const LAS int* T = (const LAS int*)(C.lds + LDS_TAB);
    LAS float* PAR = (LAS float*)C.lds;
    const int r0 = (int)(((long)C.bid * nrows) / C.G), r1 = (int)(((long)(C.bid + 1) * nrows) / C.G);
    int cur_mrow = -1;
    for (int rb = r0 & ~7; rb < r1; rb += 8) {
        const int mrow = rb < NLAT ? rb / SL : 4; const float* mod = WSP(float, WS_MOD) + (size_t)(l * 5 + mrow) * 12288;
        if (mrow != cur_mrow) { const float* modn = WSP(float, WS_MOD) + (size_t)((last ? l : l + 1) * 5 + mrow) * 12288;
            __syncthreads(); stage2048(C, PAR, mod + 10240); stage2048(C, PAR + 2048, INP(I_LN2G) + l * DM); stage2048(C, PAR + 4096, INP(I_LN2B) + l * DM); stage2048(C, PAR + 6144, modn + 2048); stage2048(C, PAR + 8192, modn); cur_mrow = mrow; __syncthreads(); }
        const int row = rb + C.wave;
        if (row >= r0 && row < r1) {
        const int4 ti = WSP(int4, WS_TOKINFO)[row]; const f32x2 tw = WSP(f32x2, WS_TOKW)[row];
        const int s0 = T[168 + ti.x] * 256 + ti.y, s1 = T[168 + ti.z] * 256 + ti.w;
        const unsigned char* y0 = WSP(unsigned char, WS_YS) + (size_t)s0 * DM; const unsigned char* y1 = WSP(unsigned char, WS_YS) + (size_t)s1 * DM;
        float v[32], g2[32]; row_load_bf16(WSP(bf16, WS_X) + (size_t)row * DM, C.lane, v); row_load_lds(PAR, C.lane, g2);
#pragma unroll
        for (int j = 0; j < 4; ++j) { float a[8], b[8]; cvt8_fp8(*(const u32x2*)(y0 + 512 * j + 8 * C.lane), a); cvt8_fp8(*(const u32x2*)(y1 + 512 * j + 8 * C.lane), b);
#pragma unroll
            for (int e = 0; e < 8; ++e) v[8 * j + e] = ALPHA * v[8 * j + e] + g2[8 * j + e] * ((tw.x * 0.0625f) * a[e] + (tw.y * 0.0625f) * b[e]); }
        row_ln(v); row_affine_lds(v, PAR + 2048, PAR + 4096, C.lane, 0.f);
        if (last) { row_store((float*)(C.out + (size_t)row * DM), C.lane, v); }
        else { row_store_bf16(WSP(bf16, WS_X) + (size_t)row * DM, C.lane, v);
            row_ln(v); row_affine_lds(v, PAR + 6144, PAR + 8192, C.lane, 1.0f);
            if (FP8_IN) row_store_fp8(WSP(unsigned char, WS_HA8) + (size_t)row * DM, C.lane, v); else row_store_bf16(WSP(bf16, WS_HB) + (size_t)row * DM, C.lane, v); }
        }
    }
}

constexpr int N_PHASES = 20;
__global__ void __launch_bounds__(512, 2) fwd_kernel(Args args) {
    extern __shared__ __attribute__((aligned(16))) unsigned char lds_raw[];
    Ctx C0; C0.lds = (LAS unsigned char*)lds_raw; C0.tid = threadIdx.x; C0.lane = C0.tid & 63; C0.wave = __builtin_amdgcn_readfirstlane(C0.tid >> 6); C0.bid = blockIdx.x; C0.G = gridDim.x;
    C0.in = (const float GAS* const __attribute__((address_space(4)))*)((const __attribute__((address_space(4))) Args*)__builtin_amdgcn_kernarg_segment_ptr())->in; C0.out = (float GAS*)args.out; C0.ws = (unsigned char GAS*)args.ws;
    volatile LAS unsigned* MISC = (volatile LAS unsigned*)(C0.lds + LDS_MISC);
    if (C0.tid < 4) MISC[C0.tid] = 0u;
    __syncthreads();
    XcdBarrier bar; bar.bar = (unsigned*)(unsigned GAS*)(C0.ws + WS_CTL) + CW_BAR; bar.x = 0; bar.st = nullptr;
    const int lo = args.ph_lo, hi = args.ph_hi;
    if (hi - lo > 1) bar = xcd_barrier_post((unsigned*)(unsigned GAS*)(C0.ws + WS_CTL) + CW_BAR, MISC);
#ifdef ONLY
#define IN(k) ((k) == ONLY)
#define INL(j) ((j) + 2 == ONLY)
#define SEAM(k) do { } while (0)
#else
#define IN(k) (lo <= (k) && (k) < hi)
#define INL(j) IN(pb + (j))
#define SEAM(k) do { if (IN(k) && IN((k) + 1)) xcd_barrier(bar); } while (0)
#endif

    if (IN(0)) { _Pragma("unroll") for (int rep = 0; rep < NREP(0); ++rep) { if (rep) xcd_barrier(bar); FRESH(D, C0);
        if (D.bid & 1) { p0_filters(D); p0_adaln(D); } else { p0_adaln(D); p0_filters(D); }        p0_rope(D); __syncthreads(); p0_convert(D, 0, NBP); } }
    SEAM(0);
    if (IN(1)) { _Pragma("unroll") for (int rep = 0; rep < NREP(1); ++rep) { if (rep) xcd_barrier(bar); FRESH(D, C0); ph_ln_mod(D, 0, NTOK); } }
    SEAM(1);
#define LAYER_BODY(l) do { \
        const int pb = 2 + 9 * l; const bool last = (l == 1); const int nrows = last ? NLAT : NTOK; \
        if (INL(0)) { _Pragma("unroll") for (int rep = 0; rep < NREP(2 + 9 * l + 0); ++rep) { if (rep) xcd_barrier(bar); \
            FRESH(C, C0); \
            pg8::Gemm g{FP8_IN ? (const bf16*)WSP(unsigned char, WS_HA8) : WSP(bf16, WS_HB), FP8_IN ? (const bf16*)(WSP(unsigned char, WS_WIN) + (size_t)l * INW * DM) : WSP(bf16, WS_WIN) + (size_t)l * INW * DM, FP8_IN ? DM / 2 : DM}; \
            pg8::DenseOrder S; S.init(NTOK, INW, C.G, C.bid); \
            pg8::EpiBf16 E{WSP(bf16, WS_Z), INW, 11}; \
            pg8::gemm_phase<pg8::EpiBf16, pg8::DenseOrder, false, FP8_IN != 0>(C.lds, g, S, E); \
        } \
        } SEAM(pb + 0); \
        if (INL(1)) { _Pragma("unroll") for (int rep = 0; rep < NREP(2 + 9 * l + 1); ++rep) { if (rep) xcd_barrier(bar); \
            const int n_attn = last ? 256 : 272, n_gmlp = last ? 256 : 272, n_pool = last ? 512 : 544, n_hyp = last ? 1536 : 1632; \
            { FRESH(C, C0); \
                \
              volatile LAS int* qn = (volatile LAS int*)(C.lds + LDS_MISC + 32); \
              unsigned* qctr = WSP(unsigned, WS_CTL) + CW_QUEUE + (l * 2 + rep) * 64; \
              const int n_fc = last ? 0 : 16, bf = 256, b0 = bf + n_fc, b1 = b0 + n_gmlp, b2 = b1 + (n_attn - 256), b3 = b2 + n_pool, total = b3 + n_hyp;        \
              volatile LAS int* qc = (volatile LAS int*)(C.lds + LDS_MISC + 36); \
              unsigned* cctr = WSP(unsigned, WS_CTL) + CW_QUEUE + (4 + rep) * 64; \
              int u = C.bid, cu = (last || C.bid >= CONV_SPLIT) ? NCU : C.bid;        \
              while (u < total || cu < NCU) { \
                  int nxt = total, nxc = NCU; \
                  if (C.tid == 0) { if (u < total) nxt = (int)atomicAdd(qctr, 1u) + C.G; if (cu < NCU) { nxc = (int)atomicAdd(cctr, 1u) + C.G; if (nxc >= CONV_SPLIT) nxc = NCU; } } \
                  if (u < total) { FRESH(Cu, C); if (u < bf) attn_unit(Cu, l, u); else if (u < b0) p0_filter_unit(Cu, 512 + u - bf); else if (u < b1) gmlp_unit(Cu, l, u - b0); else if (u < b2) attn_unit(Cu, l, 256 + u - b1); else if (u < b3) pool_unit(Cu, l, u - b2); else hyprep_unit(Cu, l, u - b3); } \
                  if (cu < NCU) { FRESH(Cu, C); conv_unit(Cu, 1, cu * UB); } \
                  __syncthreads(); if (C.tid == 0) { *qn = nxt; *qc = nxc; } __syncthreads(); u = __builtin_amdgcn_readfirstlane(*qn); cu = __builtin_amdgcn_readfirstlane(*qc); \
              } } \
        } \
        } SEAM(pb + 1); \
        if (INL(2)) { _Pragma("unroll") for (int rep = 0; rep < NREP(2 + 9 * l + 2); ++rep) { if (rep) xcd_barrier(bar); \
            { FRESH(C, C0);        \
              volatile LAS int* qc = (volatile LAS int*)(C.lds + LDS_MISC + 36); \
              unsigned* cctr = WSP(unsigned, WS_CTL) + CW_QUEUE + (6 + 2 * l + rep) * 64; \
              const int nhu = (rep && PROBE_CONV == 1) ? 0 : (last ? 512 : 512 + 64), ncu = (rep && PROBE_CONV == 2) ? 0 : (last ? NCU_E : NCU_E + NCU_P - TAILQ); \
                \
              const int quota = (ncu + C.G - 1) / C.G, cls = C.bid % 3; \
              int hu = C.bid, cu = C.bid, nh = 0, nc = 0; \
              while (hu < nhu || cu < ncu) { \
                  const bool cv = cu < ncu && (hu >= nhu || (nc < quota && (cls == 0 || (cls == 1 && nh >= 1)))); \
                  if (cv) { \
                      int nxc = ncu; if (C.tid == 0) nxc = (int)atomicAdd(cctr, 1u) + C.G; \
                      { FRESH(Cu, C); bg_conv_unit(Cu, l, cu); } \
                      __syncthreads(); if (C.tid == 0) *qc = nxc; __syncthreads(); cu = __builtin_amdgcn_readfirstlane(*qc); ++nc; \
                  } else { FRESH(Cu, C); if (hu < 512) hyena_unit<SL>(Cu, l, hu); else { Ctx Cw = Cu; Cw.lds = Cu.lds + Cu.wave * 8192; Cw.tid = Cu.lane; Cw.wave = 0; hyena_unit<CL, 64>(Cw, l, 8 * (hu - 512) + Cu.wave); }        hu += C.G; ++nh; } \
              } } \
        } \
        } SEAM(pb + 2); \
        if (INL(3)) { _Pragma("unroll") for (int rep = 0; rep < NREP(2 + 9 * l + 3); ++rep) { if (rep) xcd_barrier(bar); FRESH(C, C0); rms_stage_gain(C, l); for (int u = C.bid; u < nrows / 32; u += C.G) { FRESH(Cu, C); rms_unit(Cu, l, u); } } \
        } SEAM(pb + 3); \
        if (INL(4)) { _Pragma("unroll") for (int rep = 0; rep < NREP(2 + 9 * l + 4); ++rep) { if (rep) xcd_barrier(bar); \
            FRESH(C, C0); \
            pg8::Gemm g{FP8_OUT ? (const bf16*)WSP(unsigned char, WS_HA8) : WSP(bf16, WS_HB), FP8_OUT ? (const bf16*)(WSP(unsigned char, WS_WOUT) + (size_t)l * DM * DM) : WSP(bf16, WS_WOUT) + (size_t)l * DM * DM, FP8_OUT ? DM / 2 : DM}; \
            pg8::DenseOrder S; S.init(nrows, DM, C.G, C.bid); \
            pg8::EpiBf16 E{WSP(bf16, WS_YO), DM, 1 << 30}; \
            pg8::gemm_phase<pg8::EpiBf16, pg8::DenseOrder, false, FP8_OUT != 0>(C.lds, g, S, E); \
            if (!last && rep == 0 && TAILQ > 0) {        \
                FRESH(Ct, C0); \
                volatile LAS int* qc = (volatile LAS int*)(Ct.lds + LDS_MISC + 36); \
                unsigned* tctr = WSP(unsigned, WS_CTL) + CW_QUEUE + 12 * 64; \
                for (;;) { \
                    __syncthreads(); if (Ct.tid == 0) *qc = NCU_E + NCU_P - TAILQ + (int)atomicAdd(tctr, 1u); __syncthreads(); \
                    const int cu = __builtin_amdgcn_readfirstlane(*qc); if (cu >= NCU_E + NCU_P) break; \
                    FRESH(Cu, Ct); bg_conv_unit(Cu, 0, cu); \
                } } \
        } \
        } SEAM(pb + 4); \
        if (INL(5)) { FRESH(C, C0); ph_post1(C, l, nrows); if (PROBE_P1 && l == 0) { xcd_barrier(bar); FRESH(C2, C0); ph_post1(C2, l, nrows, true); } } \
        SEAM(pb + 5); \
        if (INL(6)) { _Pragma("unroll") for (int rep = 0; rep < NREP(2 + 9 * l + 6); ++rep) { if (rep) xcd_barrier(bar); \
            FRESH(C, C0); \
            const int nblk = moe_tables(C, l); const LAS int* T = (const LAS int*)(C.lds + LDS_TAB); \
            pg8::Gemm g{(const bf16*)WSP(unsigned char, WS_HB8), (const bf16*)(WSP(unsigned char, WS_WGU) + (size_t)l * NE * 1536 * DM), DM / 2}; \
            pg8::MoeOrder S; S.nblk = nblk; S.nN = 6; S.G = C.G; S.c = C.bid; S.blk_e = T; S.bst = T + 168; S.cnt = T + 200; S.exptok = WSP(int, WS_EXPTOK); S.ntok = NTOK; \
            pg8::EpiGLU E{WSP(unsigned char, WS_HG), DE}; \
            pg8::gemm_phase<pg8::EpiGLU, pg8::MoeOrder, true, true>(C.lds, g, S, E); \
        } } \
        SEAM(pb + 6); \
        if (INL(7)) { _Pragma("unroll") for (int rep = 0; rep < NREP(2 + 9 * l + 7); ++rep) { if (rep) xcd_barrier(bar); \
            FRESH(C, C0); \
            const int nblk = moe_tables(C, l); const LAS int* T = (const LAS int*)(C.lds + LDS_TAB); \
            pg8::Gemm g{(const bf16*)WSP(unsigned char, WS_HG), (const bf16*)(WSP(unsigned char, WS_WD) + (size_t)l * NE * DM * DE), DE / 2}; \
            pg8::MoeOrder S; S.nblk = nblk; S.nN = 8; S.G = C.G; S.c = C.bid; S.blk_e = T; S.bst = T + 168; S.cnt = T + 200; S.exptok = WSP(int, WS_EXPTOK); S.ntok = NTOK; \
            pg8::EpiFp8 E{WSP(unsigned char, WS_YS), DM, 16.0f}; \
            pg8::gemm_phase<pg8::EpiFp8, pg8::MoeOrder, false, true>(C.lds, g, S, E); \
        } } \
        SEAM(pb + 7); \
        if (INL(8)) { FRESH(C, C0); ph_post2(C, l, nrows); if (PROBE_P2 && l == 1) { xcd_barrier(bar); FRESH(C2, C0); ph_post2(C2, l, nrows); } } \
        SEAM(pb + 8); \
} while (0)
    LAYER_BODY(0);
    LAYER_BODY(1);
#undef IN
#undef INL
#undef SEAM
}

extern "C" void kernel_launch(void* const* d_in, const int* in_sizes, int n_in, void* d_out, int out_size, void* d_ws, size_t ws_size, hipStream_t stream) {
    static int grid = 0;
    if (grid == 0) {
        if (n_in != 35 || out_size != NLAT * DM || ws_size < WS_END) { fprintf(stderr, "kernel_launch: unexpected shapes (n_in %d out %d ws %zu)\n", n_in, out_size, ws_size); grid = -1; return; }
        int dev = 0, cus = 0;
        if (hipGetDevice(&dev) != hipSuccess || hipDeviceGetAttribute(&cus, hipDeviceAttributeMultiprocessorCount, dev) != hipSuccess) { grid = -1; return; }
        if (hipFuncSetAttribute((const void*)fwd_kernel, hipFuncAttributeMaxDynamicSharedMemorySize, LDS_BYTES) != hipSuccess) { fprintf(stderr, "kernel_launch: hipFuncSetAttribute failed\n"); grid = -1; return; }
        int per_cu = 0;
        if (hipOccupancyMaxActiveBlocksPerMultiprocessor(&per_cu, (const void*)fwd_kernel, 512, LDS_BYTES) != hipSuccess || per_cu < 1) fprintf(stderr, "kernel_launch: occupancy query says %d\n", per_cu);
        (void)hipGetLastError();
        grid = cus;
    }
    if (grid < 0) return;
    (void)hipMemsetAsync((char*)d_ws + WS_CTL, 0, CTL_ZERO_BYTES, stream);
    Args a{};
    for (int i = 0; i < 35; ++i) a.in[i] = (const float*)d_in[i];
    a.out = (float*)d_out; a.ws = (unsigned char*)d_ws;
    if (MK_N_LAUNCHES == 1) { a.ph_lo = 0; a.ph_hi = N_PHASES; hipLaunchKernelGGL(fwd_kernel, dim3(grid), dim3(512), LDS_BYTES, stream, a); }
    else for (int p = 0; p < N_PHASES; ++p) { a.ph_lo = p; a.ph_hi = p + 1; hipLaunchKernelGGL(fwd_kernel, dim3(grid), dim3(512), LDS_BYTES, stream, a); }
}
```
